# Optimizing an MI355X kernel written in HIP

```python
import math
import jax, jax.numpy as jnp
from jax import lax
import numpy as np

D_MODEL = 1024
BATCH = 8
SEQ = 2048
DEPTH = 2

M_HEADS = 4
M_HEAD_DIM = 64
M_WIDTH = M_HEADS * M_HEAD_DIM
A_HEADS = 8
A_HEAD_DIM = 64
A_WIDTH = A_HEADS * A_HEAD_DIM
S_GROUPS = 16
S_GROUP_DIM = 16
S_WIDTH = S_GROUPS * S_GROUP_DIM
S_STATE = 64
D_MIX = M_WIDTH + A_WIDTH + S_WIDTH

CONV_K = 4
M_CHUNK = 64
MOBA_BLOCK = 256
MOBA_TOPK = 3
MOBA_QCHUNK = 32
ROPE_THETA = 500000.0
ROPE_DIM = A_HEAD_DIM // 4

N_GROUPS = 4
EXPERTS_PER_GROUP = 8
N_EXPERTS = N_GROUPS * EXPERTS_PER_GROUP
EXPERT_TOPK = 2
D_EXPERT = 512
DISPATCH_BLOCK = 128
EPS = 1e-6

COL_SIZES = [M_WIDTH, M_WIDTH, M_WIDTH, M_WIDTH, M_HEADS, M_HEADS,
             A_WIDTH, A_WIDTH, A_WIDTH,
             S_WIDTH]
D_IN = int(sum(COL_SIZES))
COL_SPLITS = [int(c) for c in np.cumsum(COL_SIZES)[:-1]]

kernel_name = "hymba_style_mlstm_moba_s5_hmoe"

F32 = jnp.float32


def rmsnorm(x, g):
    xf = x.astype(F32)
    y = xf * lax.rsqrt(jnp.mean(xf * xf, axis=-1, keepdims=True) + EPS)
    return (y * g.astype(F32)).astype(x.dtype)


def causal_dwconv(x, w, b):
    kw, s = w.shape[0], x.shape[1]
    xp = jnp.pad(x, ((0, 0), (kw - 1, 0), (0, 0)))
    y = b
    for j in range(kw):
        y = y + xp[:, j:j + s] * w[j]
    return y


def partial_rope(x, pos):
    half = ROPE_DIM // 2
    inv = ROPE_THETA ** (-jnp.arange(half, dtype=F32) * 2.0 / ROPE_DIM)
    ang = pos[:, None] * inv[None, :]
    cos, sin = jnp.cos(ang)[:, None, :], jnp.sin(ang)[:, None, :]
    x1 = x[..., :half].astype(F32)
    x2 = x[..., half:ROPE_DIM].astype(F32)
    rot = jnp.concatenate([x1 * cos - x2 * sin, x2 * cos + x1 * sin], axis=-1).astype(x.dtype)
    return jnp.concatenate([rot, x[..., ROPE_DIM:]], axis=-1)


def mlstm_heads(q, k, v, o_pre, i_pre, f_pre, out_g):
    bsz, s, _ = q.shape
    nc = s // M_CHUNK
    dh = M_HEAD_DIM

    def to_chunks(t):
        return t.astype(F32).reshape(bsz, nc, M_CHUNK, M_HEADS, dh).transpose(1, 0, 3, 2, 4)

    def gate_chunks(g):
        return g.astype(F32).reshape(bsz, nc, M_CHUNK, M_HEADS).transpose(1, 0, 3, 2)

    qc, kc, vc = to_chunks(q), to_chunks(k) * (dh ** -0.5), to_chunks(v)
    ic = gate_chunks(i_pre)
    lfc = jax.nn.log_sigmoid(gate_chunks(f_pre))
    causal = jnp.tril(jnp.ones((M_CHUNK, M_CHUNK), dtype=bool))

    def step(carry, inp):
        C, n, m = carry
        qb, kb, vb, ib, lfb = inp
        b = jnp.cumsum(lfb, axis=-1)
        a = b + m[..., None]
        W = b[..., :, None] - b[..., None, :] + ib[..., None, :]
        W = jnp.where(causal, W, -jnp.inf)
        m_t = jnp.maximum(a, jnp.max(W, axis=-1))
        inter = jnp.exp(a - m_t)
        Sqk = jnp.einsum('bhtd,bhsd->bhts', qb, kb) * jnp.exp(W - m_t[..., None])
        num = inter[..., None] * jnp.einsum('bhtd,bhde->bhte', qb, C) + jnp.einsum('bhts,bhse->bhte', Sqk, vb)
        den = inter * jnp.einsum('bhtd,bhd->bht', qb, n) + jnp.sum(Sqk, axis=-1)
        h = num / jnp.maximum(jnp.abs(den), jnp.exp(-m_t))[..., None]
        bL = b[..., -1]
        g_s = bL[..., None] - b + ib
        m_new = jnp.maximum(bL + m, jnp.max(g_s, axis=-1))
        decay = jnp.exp(bL + m - m_new)
        wts = jnp.exp(g_s - m_new[..., None])
        C_new = decay[..., None, None] * C + jnp.einsum('bhs,bhsd,bhse->bhde', wts, kb, vb)
        n_new = decay[..., None] * n + jnp.einsum('bhs,bhsd->bhd', wts, kb)
        return (C_new, n_new, m_new), h

    init = (jnp.zeros((bsz, M_HEADS, dh, dh), F32), jnp.zeros((bsz, M_HEADS, dh), F32),
            jnp.zeros((bsz, M_HEADS), F32))
    _, hs = lax.scan(step, init, (qc, kc, vc, ic, lfc))
    h = hs.transpose(1, 0, 3, 2, 4).reshape(bsz, s, M_HEADS, dh)
    h = rmsnorm(h, out_g).reshape(bsz, s, M_WIDTH)
    return (h * jax.nn.sigmoid(o_pre.astype(F32))).astype(q.dtype)


def moba_heads(q, k, v, q_g, k_g, out_g):
    bsz, s, _ = q.shape
    dh = A_HEAD_DIM
    pos = jnp.arange(s, dtype=F32)
    heads = lambda t: t.reshape(bsz, s, A_HEADS, dh)
    q = partial_rope(rmsnorm(heads(q), q_g), pos).transpose(0, 2, 1, 3)
    k = partial_rope(rmsnorm(heads(k), k_g), pos).transpose(0, 2, 1, 3)
    v = heads(v).transpose(0, 2, 1, 3)
    nb = -(-s // MOBA_BLOCK)
    pad = nb * MOBA_BLOCK - s
    padk = lambda t: jnp.pad(t, ((0, 0), (0, 0), (0, pad), (0, 0))).reshape(bsz, A_HEADS, nb, MOBA_BLOCK, dh)
    kb, vb = padk(k), padk(v)
    q_blk = jnp.arange(s) // MOBA_BLOCK
    gate = jnp.einsum('bhsd,bhnd->bhsn', q, jnp.mean(kb, axis=3)).astype(F32)
    past = jnp.arange(nb)[None, :] < q_blk[:, None]
    gate = jnp.where(past, gate, -jnp.inf)
    n_sel = min(MOBA_TOPK, nb)
    _, sel = lax.top_k(gate, n_sel)
    sel_ok = sel < q_blk[:, None]
    nq = s // MOBA_QCHUNK

    def chunk(t):
        return jnp.moveaxis(t.reshape(t.shape[0], t.shape[1], nq, MOBA_QCHUNK, *t.shape[3:]), 2, 0)

    bi = jnp.arange(bsz)[:, None, None, None]
    hi = jnp.arange(A_HEADS)[None, :, None, None]
    scale = dh ** -0.5

    def attend(args):
        qc, sc, okc, c = args
        start = c * MOBA_QCHUNK
        own = start // MOBA_BLOCK
        ko = lax.dynamic_index_in_dim(kb, own, axis=2, keepdims=False)
        vo = lax.dynamic_index_in_dim(vb, own, axis=2, keepdims=False)
        qpos = start + jnp.arange(MOBA_QCHUNK)
        kpos = own * MOBA_BLOCK + jnp.arange(MOBA_BLOCK)
        s_own = jnp.einsum('bhqd,bhkd->bhqk', qc, ko).astype(F32) * scale
        s_own = jnp.where(kpos[None, :] <= qpos[:, None], s_own, -jnp.inf)
        ks = kb[bi, hi, sc]
        vs = vb[bi, hi, sc]
        s_sel = jnp.einsum('bhqd,bhqnkd->bhqnk', qc, ks).astype(F32) * scale
        s_sel = jnp.where(okc[..., None], s_sel, -jnp.inf)
        logits = jnp.concatenate([s_sel.reshape(bsz, A_HEADS, MOBA_QCHUNK, n_sel * MOBA_BLOCK), s_own], axis=-1)
        p = jax.nn.softmax(logits, axis=-1).astype(v.dtype)
        p_sel = p[..., :n_sel * MOBA_BLOCK].reshape(bsz, A_HEADS, MOBA_QCHUNK, n_sel, MOBA_BLOCK)
        p_own = p[..., n_sel * MOBA_BLOCK:]
        return jnp.einsum('bhqnk,bhqnkd->bhqd', p_sel, vs) + jnp.einsum('bhqk,bhkd->bhqd', p_own, vo)

    out = lax.map(attend, (chunk(q), chunk(sel), chunk(sel_ok), jnp.arange(nq)))
    out = out.transpose(1, 0, 3, 2, 4).reshape(bsz, s, A_HEADS, dh)
    return rmsnorm(out, out_g).reshape(bsz, s, A_WIDTH)


def s5_groups(u, a_re, a_im, b_re, b_im, c_re, c_im, d, log_dt, glu_w, glu_b, out_g):
    bsz, s, _ = u.shape
    ug = u.astype(F32).reshape(bsz, s, S_GROUPS, S_GROUP_DIM)
    lr, li = a_re.astype(F32), a_im.astype(F32)
    dt = jnp.exp(log_dt.astype(F32))[:, None]
    mag = jnp.exp(lr * dt)
    abar_re, abar_im = mag * jnp.cos(li * dt), mag * jnp.sin(li * dt)
    zr, zi = abar_re - 1.0, abar_im
    den = lr * lr + li * li
    fr, fi = (zr * lr + zi * li) / den, (zi * lr - zr * li) / den
    br, bim = b_re.astype(F32), b_im.astype(F32)
    bbar_re = fr[..., None] * br - fi[..., None] * bim
    bbar_im = fr[..., None] * bim + fi[..., None] * br
    bu_re = jnp.einsum('bsgh,gph->bsgp', ug, bbar_re)
    bu_im = jnp.einsum('bsgh,gph->bsgp', ug, bbar_im)
    ar = jnp.broadcast_to(abar_re, bu_re.shape)
    ai = jnp.broadcast_to(abar_im, bu_re.shape)

    def combine(e1, e2):
        a1r, a1i, b1r, b1i = e1
        a2r, a2i, b2r, b2i = e2
        return (a2r * a1r - a2i * a1i, a2r * a1i + a2i * a1r,
                a2r * b1r - a2i * b1i + b2r, a2r * b1i + a2i * b1r + b2i)

    _, _, xr, xi = lax.associative_scan(combine, (ar, ai, bu_re, bu_im), axis=1)
    y = (jnp.einsum('bsgp,ghp->bsgh', xr, c_re.astype(F32))
         - jnp.einsum('bsgp,ghp->bsgh', xi, c_im.astype(F32))
         + d.astype(F32) * ug).reshape(bsz, s, S_WIDTH)
    z = jax.nn.gelu(y)
    y = z * jax.nn.sigmoid(z @ glu_w.astype(F32) + glu_b.astype(F32))
    y = rmsnorm(y.reshape(bsz, s, S_GROUPS, S_GROUP_DIM), out_g).reshape(bsz, s, S_WIDTH)
    return y.astype(u.dtype)


def hierarchical_moe(x, w_group, b_group, w_expert, b_expert, w_gate, w_up, w_down):
    bsz, s, dm = x.shape
    T = bsz * s
    xf = x.reshape(T, dm)
    gl = (xf @ w_group).astype(F32) + b_group.astype(F32)
    pg = jax.nn.softmax(gl, axis=-1)
    g_sel = jnp.argmax(gl, axis=-1)
    el = ((xf @ w_expert).astype(F32) + b_expert.astype(F32)).reshape(T, N_GROUPS, EXPERTS_PER_GROUP)
    el_g = jnp.take_along_axis(el, g_sel[:, None, None], axis=1)[:, 0]
    top_v, top_i = lax.top_k(el_g, EXPERT_TOPK)
    wts = jax.nn.softmax(top_v, axis=-1) * jnp.take_along_axis(pg, g_sel[:, None], axis=1)
    eid = g_sel[:, None] * EXPERTS_PER_GROUP + top_i
    A = T * EXPERT_TOPK
    e_flat = eid.reshape(-1)
    tok_flat = jnp.repeat(jnp.arange(T, dtype=jnp.int32), EXPERT_TOPK)
    w_flat = wts.reshape(-1)
    order = jnp.argsort(e_flat)
    e_s, tok_s, w_s = e_flat[order], tok_flat[order], w_flat[order]
    counts = jnp.bincount(e_flat, length=N_EXPERTS)
    starts = jnp.cumsum(counts) - counts
    padded = (counts + DISPATCH_BLOCK - 1) // DISPATCH_BLOCK * DISPATCH_BLOCK
    pends = jnp.cumsum(padded)
    pstarts = pends - padded
    dest = pstarts[e_s] + (jnp.arange(A) - starts[e_s])
    R = (A + N_EXPERTS * (DISPATCH_BLOCK - 1) + DISPATCH_BLOCK - 1) // DISPATCH_BLOCK * DISPATCH_BLOCK
    nblk = R // DISPATCH_BLOCK
    row_tok = jnp.full((R,), T, dtype=jnp.int32).at[dest].set(tok_s)
    row_w = jnp.zeros((R,), F32).at[dest].set(w_s)
    blk_exp = jnp.minimum(jnp.searchsorted(pends, jnp.arange(nblk) * DISPATCH_BLOCK, side='right'),
                          N_EXPERTS - 1)
    x_pad = jnp.concatenate([xf, jnp.zeros((1, dm), xf.dtype)], axis=0)
    xs = x_pad[row_tok].reshape(nblk, DISPATCH_BLOCK, dm)

    def expert_block(args):
        xb, e = args
        h = jax.nn.silu(xb @ w_gate[e]) * (xb @ w_up[e])
        return h @ w_down[e]

    ys = lax.map(expert_block, (xs, blk_exp)).reshape(R, dm)
    out = jax.ops.segment_sum(ys * row_w[:, None].astype(ys.dtype), row_tok, num_segments=T + 1)[:T]
    return out.reshape(bsz, s, dm)


def setup_inputs(seed: int = 0) -> dict:
    key = jax.random.key(seed)
    ks = iter(jax.random.split(key, 64))
    L = DEPTH

    def nrm(shape, scale):
        return jax.random.normal(next(ks), shape, F32) * scale

    def gain(shape):
        return 1.0 + nrm(shape, 0.02)

    x = nrm((BATCH, SEQ, D_MODEL), 1.0)
    s_a_re = -0.5 + nrm((L, S_GROUPS, S_STATE), 0.01)
    s_a_im = math.pi * jnp.arange(S_STATE, dtype=F32)[None, None, :] + nrm((L, S_GROUPS, S_STATE), 0.01)
    log_dt = jnp.log(0.001) + jax.random.uniform(next(ks), (L, S_GROUPS), F32) * (jnp.log(0.1) - jnp.log(0.001))
    cplx_b = S_GROUP_DIM ** -0.5 / math.sqrt(2.0)
    cplx_c = S_STATE ** -0.5 / math.sqrt(2.0)
    return {
        "x": x,
        "norm1_g": gain((L, D_MODEL)),
        "w_in": nrm((L, D_MODEL, D_IN), D_MODEL ** -0.5),
        "m_bias_i": nrm((L, M_HEADS), 0.1),
        "m_bias_f": jnp.linspace(3.0, 6.0, M_HEADS)[None, :] + nrm((L, M_HEADS), 0.1),
        "m_conv_w": nrm((L, CONV_K, 2 * M_WIDTH), CONV_K ** -0.5),
        "m_conv_b": nrm((L, 2 * M_WIDTH), 0.02),
        "m_out_g": gain((L, M_HEADS, M_HEAD_DIM)),
        "a_q_g": gain((L, A_HEAD_DIM)),
        "a_k_g": gain((L, A_HEAD_DIM)),
        "a_out_g": gain((L, A_HEADS, A_HEAD_DIM)),
        "s_a_re": s_a_re,
        "s_a_im": s_a_im,
        "s_b_re": nrm((L, S_GROUPS, S_STATE, S_GROUP_DIM), cplx_b),
        "s_b_im": nrm((L, S_GROUPS, S_STATE, S_GROUP_DIM), cplx_b),
        "s_c_re": nrm((L, S_GROUPS, S_GROUP_DIM, S_STATE), cplx_c),
        "s_c_im": nrm((L, S_GROUPS, S_GROUP_DIM, S_STATE), cplx_c),
        "s_d": nrm((L, S_GROUPS, S_GROUP_DIM), 1.0),
        "s_log_dt": log_dt,
        "s_glu_w": nrm((L, S_WIDTH, S_WIDTH), S_WIDTH ** -0.5),
        "s_glu_b": nrm((L, S_WIDTH), 0.02),
        "s_out_g": gain((L, S_GROUPS, S_GROUP_DIM)),
        "w_out": nrm((L, D_MIX, D_MODEL), D_MIX ** -0.5),
        "norm2_g": gain((L, D_MODEL)),
        "r_group_w": nrm((L, D_MODEL, N_GROUPS), D_MODEL ** -0.5),
        "r_group_b": nrm((L, N_GROUPS), 0.01),
        "r_expert_w": nrm((L, D_MODEL, N_EXPERTS), D_MODEL ** -0.5),
        "r_expert_b": nrm((L, N_EXPERTS), 0.01),
        "e_w_gate": nrm((L, N_EXPERTS, D_MODEL, D_EXPERT), D_MODEL ** -0.5),
        "e_w_up": nrm((L, N_EXPERTS, D_MODEL, D_EXPERT), D_MODEL ** -0.5),
        "e_w_down": nrm((L, N_EXPERTS, D_EXPERT, D_MODEL), D_EXPERT ** -0.5),
    }


def reference(x, norm1_g, w_in, m_bias_i, m_bias_f, m_conv_w, m_conv_b, m_out_g,
              a_q_g, a_k_g, a_out_g, s_a_re, s_a_im, s_b_re, s_b_im, s_c_re, s_c_im,
              s_d, s_log_dt, s_glu_w, s_glu_b, s_out_g, w_out, norm2_g,
              r_group_w, r_group_b, r_expert_w, r_expert_b, e_w_gate, e_w_up, e_w_down):
    for l in range(DEPTH):
        h = rmsnorm(x, norm1_g[l])
        proj = h @ w_in[l]
        mq, mk, mv, mo, mi, mf, aq, ak, av, su = jnp.split(proj, COL_SPLITS, axis=-1)
        qk = jax.nn.silu(causal_dwconv(jnp.concatenate([mq, mk], axis=-1), m_conv_w[l], m_conv_b[l]))
        mq, mk = qk[..., :M_WIDTH], qk[..., M_WIDTH:]
        y_m = mlstm_heads(mq, mk, mv, mo, mi + m_bias_i[l], mf + m_bias_f[l], m_out_g[l])
        y_a = moba_heads(aq, ak, av, a_q_g[l], a_k_g[l], a_out_g[l])
        y_s = s5_groups(su, s_a_re[l], s_a_im[l], s_b_re[l], s_b_im[l], s_c_re[l], s_c_im[l],
                        s_d[l].reshape(S_GROUPS, S_GROUP_DIM), s_log_dt[l], s_glu_w[l], s_glu_b[l], s_out_g[l])
        mix = jnp.concatenate([y_m.astype(x.dtype), y_a.astype(x.dtype), y_s.astype(x.dtype)], axis=-1)
        x = x + mix @ w_out[l]
        x = x + hierarchical_moe(rmsnorm(x, norm2_g[l]), r_group_w[l], r_group_b[l], r_expert_w[l],
                                 r_expert_b[l], e_w_gate[l], e_w_up[l], e_w_down[l])
    return x
```

```cpp
#include <hip/hip_runtime.h>
#include <hip/hip_cooperative_groups.h>
#include <cstdio>
#include <cstdint>
namespace cg = cooperative_groups;

#ifndef MULTI
#define MULTI 1
#endif

#define DI __device__ __forceinline__
#define LAS __attribute__((address_space(3)))
typedef unsigned short bf16_t;
typedef short bf16x8 __attribute__((ext_vector_type(8)));
typedef short s16x4 __attribute__((ext_vector_type(4)));
typedef float f32x16 __attribute__((ext_vector_type(16)));
typedef unsigned u32x4 __attribute__((ext_vector_type(4)));
typedef unsigned u32x2 __attribute__((ext_vector_type(2)));

constexpr int T = 16384, DM = 1024, SEQ = 2048, NBATCH = 8;
constexpr int DIN = 2824, PJ = 2816;
constexpr int NE = 32, DE = 512, ECAP = 16384;
constexpr float EPS = 1e-6f;
constexpr int C_MQ = 0, C_MK = 256, C_MV = 512, C_MO = 768, C_AQ = 1024, C_AK = 1536, C_AV = 2048, C_SU = 2560;

constexpr size_t MiB = 1u << 20;
constexpr size_t WS_CTL = 0;
constexpr size_t WS_XRES = 1 * MiB;
constexpr size_t WS_HBUF = 65 * MiB;
constexpr size_t WS_PROJ = 97 * MiB;
constexpr size_t WS_GATES = 185 * MiB;
constexpr size_t WS_MIX = 186 * MiB;
constexpr size_t WS_HRAW = 218 * MiB;
constexpr size_t WS_ZBUF = 234 * MiB;
constexpr size_t WS_TOKL = 250 * MiB;
constexpr size_t WS_WL = 252 * MiB;
constexpr size_t WS_TINFO = 254 * MiB;
constexpr size_t WS_HMOE = 256 * MiB;
constexpr size_t WS_YMOE = 292 * MiB;
constexpr size_t WS_END = 364 * MiB;

struct P {
    const float* in[31];
    float* out;
    char* ws;
};

DI float bf2f(bf16_t b) { return __uint_as_float(((unsigned)b) << 16); }
DI bf16_t f2bf(float f) { unsigned u = __float_as_uint(f); u += 0x7fffu + ((u >> 16) & 1u); return (bf16_t)(u >> 16); }
DI unsigned pk2(float lo, float hi) { unsigned r; asm("v_cvt_pk_bf16_f32 %0, %1, %2" : "=v"(r) : "v"(lo), "v"(hi)); return r; }
DI float wave_sum(float v) {
#pragma unroll
    for (int o = 32; o > 0; o >>= 1) v += __shfl_xor(v, o);
    return v;
}
DI float sigmoidf_(float x) { return 1.0f / (1.0f + expf(-x)); }
DI s16x4 tr_read(const LAS char* p) {
    typedef short v4i16_t __attribute__((ext_vector_type(4)));
    return __builtin_bit_cast(s16x4, __builtin_amdgcn_ds_read_tr16_b64_v4i16((LAS v4i16_t*)p));
}

constexpr int BK = 32, A_PITCH = 80, B_PITCH = 320, SA_BYTES = 128 * A_PITCH, SB_BYTES = BK * B_PITCH;
constexpr int GEMM_LDS = 2 * SA_BYTES + 2 * SB_BYTES;

template <class Epi>
DI void gemm_tile(const bf16_t* a0, const bf16_t* a1, const float* b0, size_t ldb, int KT, char* lds_generic, const Epi& epi) {
    LAS char* lds = (LAS char*)lds_generic;
    const int t = threadIdx.x, lane = t & 63, w = t >> 6, wm = w >> 1, wn = w & 1;
    const int r = lane & 31, h = lane >> 5;
    const int i16 = lane & 15, q = i16 >> 2, pp = i16 & 3, blk = (lane >> 4) & 1;
    const int arow = t >> 2, akc = t & 3, bk = t >> 5, bn4 = t & 31;
    f32x16 acc[2][2];
#pragma unroll
    for (int i = 0; i < 2; ++i)
#pragma unroll
        for (int j = 0; j < 2; ++j)
#pragma unroll
            for (int e = 0; e < 16; ++e) acc[i][j][e] = 0.f;
    u32x4 ra0, ra1; float4 rb[4];
    auto gload = [&](int kt) {
        ra0 = *(const u32x4*)(a0 + kt * BK);
        ra1 = *(const u32x4*)(a1 + kt * BK);
#pragma unroll
        for (int i = 0; i < 4; ++i) rb[i] = *(const float4*)(b0 + (size_t)(kt * BK + i * 8) * ldb);
    };
    auto sstore = [&](int buf) {
        LAS char* sA = lds + buf * SA_BYTES; LAS char* sB = lds + 2 * SA_BYTES + buf * SB_BYTES;
        *(LAS u32x4*)(sA + arow * A_PITCH + akc * 16) = ra0;
        *(LAS u32x4*)(sA + (arow + 64) * A_PITCH + akc * 16) = ra1;
#pragma unroll
        for (int i = 0; i < 4; ++i) {
            u32x2 v; v.x = pk2(rb[i].x, rb[i].y); v.y = pk2(rb[i].z, rb[i].w);
            *(LAS u32x2*)(sB + (bk + 8 * i) * B_PITCH + bn4 * 8) = v;
        }
    };
    auto compute = [&](int buf) {
        const LAS char* sA = lds + buf * SA_BYTES; const LAS char* sB = lds + 2 * SA_BYTES + buf * SB_BYTES;
#pragma unroll
        for (int ks = 0; ks < 2; ++ks) {
            bf16x8 af[2], bfr[2];
#pragma unroll
            for (int tm = 0; tm < 2; ++tm) af[tm] = *(const LAS bf16x8*)(sA + (wm * 64 + tm * 32 + r) * A_PITCH + (ks * 16 + 8 * h) * 2);
#pragma unroll
            for (int tn = 0; tn < 2; ++tn) {
                const LAS char* pb = sB + (ks * 16 + 8 * h + q) * B_PITCH + (wn * 64 + tn * 32 + 16 * blk) * 2 + 8 * pp;
                s16x4 lo = tr_read(pb), hi = tr_read(pb + 4 * B_PITCH);
                bfr[tn] = __builtin_shufflevector(lo, hi, 0, 1, 2, 3, 4, 5, 6, 7);
            }
#pragma unroll
            for (int tm = 0; tm < 2; ++tm)
#pragma unroll
                for (int tn = 0; tn < 2; ++tn) acc[tm][tn] = __builtin_amdgcn_mfma_f32_32x32x16_bf16(af[tm], bfr[tn], acc[tm][tn], 0, 0, 0);
        }
    };
    gload(0); sstore(0); __syncthreads();
    for (int kt = 0; kt < KT; ++kt) {
        if (kt + 1 < KT) gload(kt + 1);
        compute(kt & 1);
        if (kt + 1 < KT) sstore((kt + 1) & 1);
        __syncthreads();
    }
    epi(acc, wm, wn, r, h);
}
#define ACC_ROW(wm, tm, h, reg) ((wm) * 64 + (tm) * 32 + 4 * (h) + ((reg) & 3) + 8 * ((reg) >> 2))

struct EpiBf16 {
    bf16_t* out; size_t ld;
    DI void operator()(const f32x16 (&acc)[2][2], int wm, int wn, int r, int h) const {
#pragma unroll
        for (int tm = 0; tm < 2; ++tm)
#pragma unroll
            for (int tn = 0; tn < 2; ++tn)
#pragma unroll
                for (int e = 0; e < 16; ++e) out[(size_t)ACC_ROW(wm, tm, h, e) * ld + wn * 64 + tn * 32 + r] = f2bf(acc[tm][tn][e]);
    }
};
struct EpiResid {
    float* out; const float* res; size_t ld;
    DI void operator()(const f32x16 (&acc)[2][2], int wm, int wn, int r, int h) const {
#pragma unroll
        for (int tm = 0; tm < 2; ++tm)
#pragma unroll
            for (int tn = 0; tn < 2; ++tn)
#pragma unroll
                for (int e = 0; e < 16; ++e) { size_t o = (size_t)ACC_ROW(wm, tm, h, e) * ld + wn * 64 + tn * 32 + r; out[o] = res[o] + acc[tm][tn][e]; }
    }
};
struct EpiGateUp {
    bf16_t* out;
    DI void operator()(const f32x16 (&acc)[2][2], int wm, int wn, int r, int h) const {
#pragma unroll
        for (int tm = 0; tm < 2; ++tm)
#pragma unroll
            for (int e = 0; e < 16; ++e) {
                float g = acc[tm][0][e], u = acc[tm][1][e];
                out[(size_t)ACC_ROW(wm, tm, h, e) * DE + wn * 32 + r] = f2bf(g / (1.0f + expf(-g)) * u);
            }
    }
};
struct EpiDown {
    bf16_t* out; const float* roww;
    int nvalid;
    DI void operator()(const f32x16 (&acc)[2][2], int wm, int wn, int r, int h) const {
#pragma unroll
        for (int tm = 0; tm < 2; ++tm)
#pragma unroll
            for (int e = 0; e < 16; ++e) {
                int row = ACC_ROW(wm, tm, h, e);
                float wv = row < nvalid ? roww[row] : 0.f;
#pragma unroll
                for (int tn = 0; tn < 2; ++tn) out[(size_t)row * DM + wn * 64 + tn * 32 + r] = f2bf(acc[tm][tn][e] * wv);
            }
    }
};

DI void moe_prefix(const int* cnt, int* stp  ) {
    __syncthreads();
    if (threadIdx.x == 0) { int a = 0; for (int e = 0; e < NE; ++e) { stp[e] = a; a += (cnt[e] + 127) >> 7; } stp[NE] = a; }
    __syncthreads();
}

__device__ void phase_norm1(const P& p, int l, char* lds) {
    const int lane = threadIdx.x & 63;
    const int gw = blockIdx.x * 4 + (threadIdx.x >> 6), nw = gridDim.x * 4;
    float* xres = (float*)(p.ws + WS_XRES);
    bf16_t* hbuf = (bf16_t*)(p.ws + WS_HBUF);
    float* gates = (float*)(p.ws + WS_GATES);
    const float* g1 = p.in[1] + l * DM;
    const float* win = p.in[2] + (size_t)l * DM * DIN;
    int* stp = (int*)lds;
    const bf16_t* ymoe = (const bf16_t*)(p.ws + WS_YMOE);
    const int4* tinfo = (const int4*)(p.ws + WS_TINFO);
    if (l > 0) moe_prefix((const int*)(p.ws + WS_CTL) + (l - 1) * NE, stp);
    for (int row = gw; row < T; row += nw) {
        float4 v[4];
        const float* xs = (l == 0) ? p.in[0] + (size_t)row * DM : xres + (size_t)row * DM;
#pragma unroll
        for (int i = 0; i < 4; ++i) v[i] = *(const float4*)(xs + i * 256 + lane * 4);
        if (l > 0) {
            int4 ti = tinfo[row];
            const bf16_t* y0 = ymoe + (size_t)(stp[ti.x] * 128 + ti.y) * DM;
            const bf16_t* y1 = ymoe + (size_t)(stp[ti.z] * 128 + ti.w) * DM;
#pragma unroll
            for (int i = 0; i < 4; ++i) {
                uint2 a = *(const uint2*)(y0 + i * 256 + lane * 4), b = *(const uint2*)(y1 + i * 256 + lane * 4);
                v[i].x += bf2f(a.x & 0xffff) + bf2f(b.x & 0xffff); v[i].y += bf2f(a.x >> 16) + bf2f(b.x >> 16);
                v[i].z += bf2f(a.y & 0xffff) + bf2f(b.y & 0xffff); v[i].w += bf2f(a.y >> 16) + bf2f(b.y >> 16);
                *(float4*)(xres + (size_t)row * DM + i * 256 + lane * 4) = v[i];
            }
        }
        float ss = 0.f;
#pragma unroll
        for (int i = 0; i < 4; ++i) ss += v[i].x * v[i].x + v[i].y * v[i].y + v[i].z * v[i].z + v[i].w * v[i].w;
        ss = wave_sum(ss);
        const float rstd = rsqrtf(ss * (1.0f / DM) + EPS);
        float gd[8];
#pragma unroll
        for (int j = 0; j < 8; ++j) gd[j] = 0.f;
#pragma unroll
        for (int i = 0; i < 4; ++i) {
            const int k0 = i * 256 + lane * 4;
            float4 g = *(const float4*)(g1 + k0);
            float hv[4] = {v[i].x * rstd * g.x, v[i].y * rstd * g.y, v[i].z * rstd * g.z, v[i].w * rstd * g.w};
            uint2 o; o.x = pk2(hv[0], hv[1]); o.y = pk2(hv[2], hv[3]);
            *(uint2*)(hbuf + (size_t)row * DM + k0) = o;
#pragma unroll
            for (int e = 0; e < 4; ++e) {
                const float* wr = win + (size_t)(k0 + e) * DIN + 1024;
                float4 w0 = *(const float4*)wr, w1 = *(const float4*)(wr + 4);
                gd[0] += hv[e] * w0.x; gd[1] += hv[e] * w0.y; gd[2] += hv[e] * w0.z; gd[3] += hv[e] * w0.w;
                gd[4] += hv[e] * w1.x; gd[5] += hv[e] * w1.y; gd[6] += hv[e] * w1.z; gd[7] += hv[e] * w1.w;
            }
        }
#pragma unroll
        for (int j = 0; j < 8; ++j) gd[j] = wave_sum(gd[j]);
        if (lane == 0) {
            const float* bi = p.in[3] + l * 4; const float* bf = p.in[4] + l * 4;
            float4 o0 = {gd[0] + bi[0], gd[1] + bi[1], gd[2] + bi[2], gd[3] + bi[3]};
            float4 o1 = {gd[4] + bf[0], gd[5] + bf[1], gd[6] + bf[2], gd[7] + bf[3]};
            *(float4*)(gates + (size_t)row * 8) = o0; *(float4*)(gates + (size_t)row * 8 + 4) = o1;
        }
    }
}

__device__ void phase_inproj(const P& p, int l, char* lds) {
    const int t = threadIdx.x;
    const bf16_t* hbuf = (const bf16_t*)(p.ws + WS_HBUF);
    bf16_t* projb = (bf16_t*)(p.ws + WS_PROJ);
    const float* win = p.in[2] + (size_t)l * DM * DIN;
    for (int tile = blockIdx.x; tile < 128 * 22; tile += gridDim.x) {
        const int mt = tile / 22, vt = tile % 22;
        const int acol = vt < 8 ? vt * 128 : (vt < 20 ? 1032 + (vt - 8) * 128 : 2568 + (vt - 20) * 128);
        const bf16_t* a0 = hbuf + (size_t)(mt * 128 + (t >> 2)) * DM + (t & 3) * 8;
        const float* b0 = win + (size_t)(t >> 5) * DIN + acol + (t & 31) * 4;
        EpiBf16 epi{projb + (size_t)mt * 128 * PJ + vt * 128, (size_t)PJ};
        gemm_tile(a0, a0 + (size_t)64 * DM, b0, DIN, DM / BK, lds, epi);
    }
}

__constant__ float ROPE_INV_REV[8] = {0.15915494309189535f, 0.03086376340470123f, 0.005985185712713705f, 0.001160663641240061f,
                                      0.00022507907903927653f, 4.364795279280289e-05f, 8.464330808241401e-06f, 1.6414262627950345e-06f};
__device__ void phase_qkprep(const P& p, int l) {
    bf16_t* projb = (bf16_t*)(p.ws + WS_PROJ);
    const int nthreads = gridDim.x * 256;
    for (int idx = blockIdx.x * 256 + threadIdx.x; idx < T * 16; idx += nthreads) {
        const int token = idx >> 4, hw = idx & 15, which = hw >> 3, head = hw & 7;
        bf16_t* ptr = projb + (size_t)token * PJ + C_AQ + which * 512 + head * 64;
        const float* g = (which ? p.in[9] : p.in[8]) + l * 64;
        float x[64];
#pragma unroll
        for (int c = 0; c < 8; ++c) {
            uint4 u = *(const uint4*)(ptr + c * 8);
            x[c * 8 + 0] = bf2f(u.x & 0xffff); x[c * 8 + 1] = bf2f(u.x >> 16); x[c * 8 + 2] = bf2f(u.y & 0xffff); x[c * 8 + 3] = bf2f(u.y >> 16);
            x[c * 8 + 4] = bf2f(u.z & 0xffff); x[c * 8 + 5] = bf2f(u.z >> 16); x[c * 8 + 6] = bf2f(u.w & 0xffff); x[c * 8 + 7] = bf2f(u.w >> 16);
        }
        float ss = 0.f;
#pragma unroll
        for (int d = 0; d < 64; ++d) ss += x[d] * x[d];
        const float rstd = rsqrtf(ss * (1.0f / 64.0f) + EPS);
#pragma unroll
        for (int d = 0; d < 64; ++d) x[d] = x[d] * rstd * g[d];
        const int pos = token & (SEQ - 1);
#pragma unroll
        for (int d = 0; d < 8; ++d) {
            double rr = (double)pos * (double)ROPE_INV_REV[d];
            rr -= floor(rr);
            const float sn = __builtin_amdgcn_sinf((float)rr), cs = __builtin_amdgcn_cosf((float)rr);
            const float x1 = x[d], x2 = x[d + 8];
            x[d] = x1 * cs - x2 * sn; x[d + 8] = x2 * cs + x1 * sn;
        }
        const float sc = which ? 1.0f : 0.125f;
#pragma unroll
        for (int c = 0; c < 8; ++c) {
            uint4 u;
            u.x = pk2(x[c * 8 + 0] * sc, x[c * 8 + 1] * sc); u.y = pk2(x[c * 8 + 2] * sc, x[c * 8 + 3] * sc);
            u.z = pk2(x[c * 8 + 4] * sc, x[c * 8 + 5] * sc); u.w = pk2(x[c * 8 + 6] * sc, x[c * 8 + 7] * sc);
            *(uint4*)(ptr + c * 8) = u;
        }
    }
}

__device__ void mlstm_item_simple(const P& p, int l, int item, float* sm) {
    const int b = item >> 4, hd = (item >> 2) & 3, dq = item & 3;
    const int t = threadIdx.x;
    const bf16_t* projb = (const bf16_t*)(p.ws + WS_PROJ);
    const float* gates = (const float*)(p.ws + WS_GATES);
    float* hraw = (float*)(p.ws + WS_HRAW);
    const float* cw = p.in[5] + l * 4 * 512; const float* cb = p.in[6] + l * 512;
    float* Q = sm; float* K = Q + 64 * 65; float* Sm = K + 64 * 65; float* V = Sm + 64 * 65; float* C = V + 64 * 16; float* nv = C + 64 * 16;
    float* bc = nv + 64; float* Mt = bc + 64; float* uu = Mt + 64; float* den = uu + 64; float* misc = den + 64;
    __syncthreads();
    for (int i = t; i < 1024; i += 256) C[i] = 0.f;
    if (t < 64) nv[t] = 0.f;
    if (t == 0) misc[0] = 0.f;
    for (int c = 0; c < 32; ++c) {
        __syncthreads();
        const int row0 = b * SEQ + c * 64;
        for (int i = t; i < 8192; i += 256) {
            const int which = i >> 12, tt = (i >> 6) & 63, d = i & 63, ch = which * 256 + hd * 64 + d;
            float a = cb[ch];
#pragma unroll
            for (int j = 0; j < 4; ++j) { const int ts = c * 64 + tt + j - 3; if (ts >= 0) a += bf2f(projb[(size_t)(b * SEQ + ts) * PJ + ch]) * cw[j * 512 + ch]; }
            float y = a / (1.0f + expf(-a));
            if (which) K[tt * 65 + d] = y * 0.125f; else Q[tt * 65 + d] = y;
        }
        for (int i = t; i < 1024; i += 256) { const int tt = i >> 4, d = i & 15; V[i] = bf2f(projb[(size_t)(row0 + tt) * PJ + C_MV + hd * 64 + dq * 16 + d]); }
        if (t < 64) {
            const float ig = gates[(size_t)(row0 + t) * 8 + hd], fg = gates[(size_t)(row0 + t) * 8 + 4 + hd];
            const float lf = fminf(fg, 0.f) - log1pf(expf(-fabsf(fg)));
            float bs = lf;
#pragma unroll
            for (int o = 1; o < 64; o <<= 1) { float v = __shfl_up(bs, o); if (t >= o) bs += v; }
            const float u = ig - bs; float um = u;
#pragma unroll
            for (int o = 1; o < 64; o <<= 1) { float v = __shfl_up(um, o); if (t >= o) um = fmaxf(um, v); }
            bc[t] = bs; uu[t] = u; Mt[t] = fmaxf(misc[0], um);
        }
        __syncthreads();
        for (int i = t; i < 4096; i += 256) {
            const int tt = i >> 6, s = i & 63; float v = 0.f;
            if (s <= tt) { float dsum = 0.f; for (int d = 0; d < 64; ++d) dsum += Q[tt * 65 + d] * K[s * 65 + d]; v = dsum * expf(uu[s] - Mt[tt]); }
            Sm[tt * 65 + s] = v;
        }
        __syncthreads();
        if (t < 64) {
            const float inter = expf(misc[0] - Mt[t]);
            float qn = 0.f, rs = 0.f;
            for (int d = 0; d < 64; ++d) { qn += Q[t * 65 + d] * nv[d]; rs += Sm[t * 65 + d]; }
            den[t] = fmaxf(fabsf(inter * qn + rs), expf(-(bc[t] + Mt[t])));
        }
        __syncthreads();
        for (int i = t; i < 1024; i += 256) {
            const int tt = i >> 4, d = i & 15;
            const float inter = expf(misc[0] - Mt[tt]);
            float a = 0.f, bsum = 0.f;
            for (int k = 0; k < 64; ++k) { a += Q[tt * 65 + k] * C[k * 16 + d]; bsum += Sm[tt * 65 + k] * V[k * 16 + d]; }
            hraw[(size_t)(row0 + tt) * 256 + hd * 64 + dq * 16 + d] = (inter * a + bsum) / den[tt];
        }
        __syncthreads();
        const float Mlast = Mt[63], decay = expf(misc[0] - Mlast);
        for (int i = t; i < 1024; i += 256) {
            const int dk = i >> 4, d = i & 15; float a = 0.f;
            for (int s = 0; s < 64; ++s) a += expf(uu[s] - Mlast) * K[s * 65 + dk] * V[s * 16 + d];
            C[i] = decay * C[i] + a;
        }
        if (t < 64) { float a = 0.f; for (int s = 0; s < 64; ++s) a += expf(uu[s] - Mlast) * K[s * 65 + t]; nv[t] = decay * nv[t] + a; }
        __syncthreads();
        if (t == 0) misc[0] = bc[63] + Mlast;
    }
}

__device__ void moba_item_simple(const P& p, int l, int item, float* sm) {
    const int b = item >> 6, hd = (item >> 3) & 7, qb = 7 - (item & 7);
    const int t = threadIdx.x;
    const bf16_t* projb = (const bf16_t*)(p.ws + WS_PROJ);
    bf16_t* mix = (bf16_t*)(p.ws + WS_MIX);
    float* kmean = sm;
    float* red = sm + 512;
    float* Kt = sm + 1024;
    float* Vt = Kt + 4096;
    const size_t rowb = (size_t)b * SEQ;
    __syncthreads();
    for (int n = 0; n < qb; ++n) {
        const int d = t & 63, part = t >> 6; float s = 0.f;
        for (int rr = 0; rr < 64; ++rr) s += bf2f(projb[(rowb + n * 256 + part * 64 + rr) * PJ + C_AK + hd * 64 + d]);
        red[part * 64 + d] = s;
        __syncthreads();
        if (t < 64) kmean[n * 64 + t] = (red[t] + red[64 + t] + red[128 + t] + red[192 + t]) * (1.0f / 256.0f);
        __syncthreads();
    }
    const int qpos = qb * 256 + t;
    float q[64], acc[64];
    {
        const bf16_t* qp = projb + (rowb + qpos) * PJ + C_AQ + hd * 64;
#pragma unroll
        for (int c = 0; c < 8; ++c) {
            uint4 u = *(const uint4*)(qp + c * 8);
            q[c * 8 + 0] = bf2f(u.x & 0xffff); q[c * 8 + 1] = bf2f(u.x >> 16); q[c * 8 + 2] = bf2f(u.y & 0xffff); q[c * 8 + 3] = bf2f(u.y >> 16);
            q[c * 8 + 4] = bf2f(u.z & 0xffff); q[c * 8 + 5] = bf2f(u.z >> 16); q[c * 8 + 6] = bf2f(u.w & 0xffff); q[c * 8 + 7] = bf2f(u.w >> 16);
        }
    }
#pragma unroll
    for (int d = 0; d < 64; ++d) acc[d] = 0.f;
    unsigned mask = 0;
    {
        float gate[8];
#pragma unroll
        for (int n = 0; n < 8; ++n) {
            float s = 0.f;
            if (n < qb) {
#pragma unroll
                for (int d = 0; d < 64; ++d) s += q[d] * kmean[n * 64 + d];
            }
            gate[n] = s;
        }
#pragma unroll
        for (int it = 0; it < 3; ++it) {
            int best = -1; float bv = -INFINITY;
#pragma unroll
            for (int n = 0; n < 8; ++n) if (n < qb && !((mask >> n) & 1u) && gate[n] > bv) { bv = gate[n]; best = n; }
            if (best >= 0) mask |= 1u << best;
        }
    }
    float m = -INFINITY, lsum = 0.f;
    for (int n = 0; n <= qb; ++n) {
        const bool active = (n == qb) || ((mask >> n) & 1u);
        for (int kt = 0; kt < 4; ++kt) {
            __syncthreads();
            for (int i = t; i < 4096; i += 256) {
                const int rr = i >> 6, d = i & 63; const size_t ro = (rowb + n * 256 + kt * 64 + rr) * PJ;
                Kt[i] = bf2f(projb[ro + C_AK + hd * 64 + d]); Vt[i] = bf2f(projb[ro + C_AV + hd * 64 + d]);
            }
            __syncthreads();
            if (active) {
                for (int j = 0; j < 64; ++j) {
                    const int key = n * 256 + kt * 64 + j;
                    if (key > qpos) break;
                    float s = 0.f;
#pragma unroll
                    for (int d = 0; d < 64; ++d) s += q[d] * Kt[j * 64 + d];
                    if (s > m) {
                        const float sc = expf(m - s); lsum = lsum * sc + 1.0f; m = s;
#pragma unroll
                        for (int d = 0; d < 64; ++d) acc[d] = acc[d] * sc + Vt[j * 64 + d];
                    } else {
                        const float pj = expf(s - m); lsum += pj;
#pragma unroll
                        for (int d = 0; d < 64; ++d) acc[d] += pj * Vt[j * 64 + d];
                    }
                }
            }
        }
    }
    const float il = 1.0f / lsum; float ss = 0.f;
#pragma unroll
    for (int d = 0; d < 64; ++d) { acc[d] *= il; ss += acc[d] * acc[d]; }
    const float rstd = rsqrtf(ss * (1.0f / 64.0f) + EPS);
    const float* og = p.in[10] + (l * 8 + hd) * 64;
    bf16_t* op = mix + (rowb + qpos) * DM + 256 + hd * 64;
#pragma unroll
    for (int c = 0; c < 8; ++c) {
        uint4 u;
        u.x = pk2(acc[c * 8 + 0] * rstd * og[c * 8 + 0], acc[c * 8 + 1] * rstd * og[c * 8 + 1]);
        u.y = pk2(acc[c * 8 + 2] * rstd * og[c * 8 + 2], acc[c * 8 + 3] * rstd * og[c * 8 + 3]);
        u.z = pk2(acc[c * 8 + 4] * rstd * og[c * 8 + 4], acc[c * 8 + 5] * rstd * og[c * 8 + 5]);
        u.w = pk2(acc[c * 8 + 6] * rstd * og[c * 8 + 6], acc[c * 8 + 7] * rstd * og[c * 8 + 7]);
        *(uint4*)(op + c * 8) = u;
    }
}

__device__ void s5_item_simple(const P& p, int l, int item, float* sm) {
    const int t = threadIdx.x, lane = t & 63, w = t >> 6;
    const int bg = item * 4 + w, b = bg >> 4, g = bg & 15;
    const bf16_t* projb = (const bf16_t*)(p.ws + WS_PROJ);
    float* zbuf = (float*)(p.ws + WS_ZBUF);
    float* xr = sm + w * (2 * 16 * 65); float* xi = xr + 16 * 65;
    const int lg = l * 16 + g;
    const float lr = p.in[11][lg * 64 + lane], li = p.in[12][lg * 64 + lane];
    const float dt = expf(p.in[18][lg]);
    const float mag = expf(lr * dt);
    const float are = mag * cosf(li * dt), aim = mag * sinf(li * dt);
    const float zr = are - 1.0f, zi = aim, dn = lr * lr + li * li;
    const float fr = (zr * lr + zi * li) / dn, fi = (zi * lr - zr * li) / dn;
    float bbr[16], bbi[16];
#pragma unroll
    for (int hh = 0; hh < 16; ++hh) {
        const float br = p.in[13][((size_t)lg * 64 + lane) * 16 + hh], bi = p.in[14][((size_t)lg * 64 + lane) * 16 + hh];
        bbr[hh] = fr * br - fi * bi; bbi[hh] = fr * bi + fi * br;
    }
    const float* cre = p.in[15] + (size_t)lg * 16 * 64; const float* cim = p.in[16] + (size_t)lg * 16 * 64;
    const float* dd = p.in[17] + lg * 16;
    float sr = 0.f, si = 0.f;
    __syncthreads();
    for (int c = 0; c < SEQ / 16; ++c) {
        const size_t row0 = (size_t)b * SEQ + c * 16;
        for (int tt = 0; tt < 16; ++tt) {
            const bf16_t* up = projb + (row0 + tt) * PJ + C_SU + g * 16;
            uint4 u0 = *(const uint4*)up, u1 = *(const uint4*)(up + 8);
            float u[16] = {bf2f(u0.x & 0xffff), bf2f(u0.x >> 16), bf2f(u0.y & 0xffff), bf2f(u0.y >> 16), bf2f(u0.z & 0xffff), bf2f(u0.z >> 16), bf2f(u0.w & 0xffff), bf2f(u0.w >> 16),
                           bf2f(u1.x & 0xffff), bf2f(u1.x >> 16), bf2f(u1.y & 0xffff), bf2f(u1.y >> 16), bf2f(u1.z & 0xffff), bf2f(u1.z >> 16), bf2f(u1.w & 0xffff), bf2f(u1.w >> 16)};
            float br = 0.f, bi = 0.f;
#pragma unroll
            for (int hh = 0; hh < 16; ++hh) { br += bbr[hh] * u[hh]; bi += bbi[hh] * u[hh]; }
            const float nr = are * sr - aim * si + br, ni = are * si + aim * sr + bi;
            sr = nr; si = ni;
            xr[tt * 65 + lane] = sr; xi[tt * 65 + lane] = si;
        }
        __syncthreads();
        {
            const int tt = lane >> 2, hq = lane & 3;
            float y[4] = {0.f, 0.f, 0.f, 0.f};
            for (int pp = 0; pp < 64; ++pp) {
                const float a = xr[tt * 65 + pp], bq = xi[tt * 65 + pp];
#pragma unroll
                for (int j = 0; j < 4; ++j) y[j] += cre[(hq * 4 + j) * 64 + pp] * a - cim[(hq * 4 + j) * 64 + pp] * bq;
            }
#pragma unroll
            for (int j = 0; j < 4; ++j) {
                const int hh = hq * 4 + j;
                float v = y[j] + dd[hh] * bf2f(projb[(row0 + tt) * PJ + C_SU + g * 16 + hh]);
                const float inner = 0.7978845608028654f * (v + 0.044715f * v * v * v);
                const float th = 1.0f - 2.0f / (expf(2.0f * inner) + 1.0f);
                zbuf[(row0 + tt) * 256 + g * 16 + hh] = 0.5f * v * (1.0f + th);
            }
        }
        __syncthreads();
    }
}

__device__ void phase_mix(const P& p, int l, char* lds) {
    for (int item = blockIdx.x; item < 128 + 32 + 512; item += gridDim.x) {
        if (item < 128) mlstm_item_simple(p, l, item, (float*)lds);
        else if (item < 160) s5_item_simple(p, l, item - 128, (float*)lds);
        else {
            const int i2 = item - 160;
            const int qo = i2 >> 6, bh = i2 & 63;
            moba_item_simple(p, l, (bh << 3) | qo, (float*)lds);
        }
    }
}

__device__ void phase_glu(const P& p, int l, char* lds) {
    const int t = threadIdx.x;
    const bf16_t* projb = (const bf16_t*)(p.ws + WS_PROJ);
    bf16_t* mix = (bf16_t*)(p.ws + WS_MIX);
    const float* zbuf = (const float*)(p.ws + WS_ZBUF);
    const float* hraw = (const float*)(p.ws + WS_HRAW);
    const float* gw = p.in[19] + (size_t)l * 256 * 256; const float* gb = p.in[20] + l * 256;
    const float* sg = p.in[21] + l * 256; const float* mg = p.in[7] + l * 256;
    float* zs = (float*)lds; float* ys = zs + 16 * 256;
    for (int tile = blockIdx.x; tile < T / 16; tile += gridDim.x) {
        const size_t row0 = (size_t)tile * 16;
        __syncthreads();
        for (int i = t; i < 4096; i += 256) zs[i] = zbuf[row0 * 256 + i];
        __syncthreads();
        float a[16];
#pragma unroll
        for (int r = 0; r < 16; ++r) a[r] = gb[t];
        for (int k = 0; k < 256; ++k) {
            const float wv = gw[k * 256 + t];
#pragma unroll
            for (int r = 0; r < 16; ++r) a[r] += zs[r * 256 + k] * wv;
        }
#pragma unroll
        for (int r = 0; r < 16; ++r) ys[r * 256 + t] = zs[r * 256 + t] * sigmoidf_(a[r]);
        __syncthreads();
        {
            const int r = t >> 4, g = t & 15; float ss = 0.f;
#pragma unroll
            for (int hh = 0; hh < 16; ++hh) { const float v = ys[r * 256 + g * 16 + hh]; ss += v * v; }
            const float rstd = rsqrtf(ss * (1.0f / 16.0f) + EPS);
#pragma unroll
            for (int hh = 0; hh < 16; ++hh) mix[(row0 + r) * DM + 768 + g * 16 + hh] = f2bf(ys[r * 256 + g * 16 + hh] * rstd * sg[g * 16 + hh]);
        }
        {
            const int pr = t >> 2, qd = t & 3, r = pr >> 2, hd = pr & 3;
            const float* hp = hraw + (row0 + r) * 256 + hd * 64 + qd * 16;
            float v[16]; float ss = 0.f;
#pragma unroll
            for (int d = 0; d < 16; ++d) { v[d] = hp[d]; ss += v[d] * v[d]; }
            ss += __shfl_xor(ss, 1); ss += __shfl_xor(ss, 2);
            const float rstd = rsqrtf(ss * (1.0f / 64.0f) + EPS);
#pragma unroll
            for (int d = 0; d < 16; ++d) {
                const int col = hd * 64 + qd * 16 + d;
                const float o = bf2f(projb[(row0 + r) * PJ + C_MO + col]);
                mix[(row0 + r) * DM + col] = f2bf(v[d] * rstd * mg[col] * sigmoidf_(o));
            }
        }
    }
}

__device__ void phase_outproj(const P& p, int l, char* lds) {
    const int t = threadIdx.x;
    const bf16_t* mix = (const bf16_t*)(p.ws + WS_MIX);
    float* xres = (float*)(p.ws + WS_XRES);
    const float* wout = p.in[22] + (size_t)l * DM * DM;
    const float* xin = (l == 0) ? p.in[0] : xres;
    for (int tile = blockIdx.x; tile < 128 * 8; tile += gridDim.x) {
        const int mt = tile >> 3, nt = tile & 7;
        const bf16_t* a0 = mix + (size_t)(mt * 128 + (t >> 2)) * DM + (t & 3) * 8;
        const float* b0 = wout + (size_t)(t >> 5) * DM + nt * 128 + (t & 31) * 4;
        const size_t o = (size_t)mt * 128 * DM + nt * 128;
        EpiResid epi{xres + o, xin + o, (size_t)DM};
        gemm_tile(a0, a0 + (size_t)64 * DM, b0, DM, DM / BK, lds, epi);
    }
}

__device__ void phase_norm2(const P& p, int l) {
    const int lane = threadIdx.x & 63;
    const int gw = blockIdx.x * 4 + (threadIdx.x >> 6), nw = gridDim.x * 4;
    const float* xres = (const float*)(p.ws + WS_XRES);
    bf16_t* hbuf = (bf16_t*)(p.ws + WS_HBUF);
    const float* g2 = p.in[23] + l * DM;
    const float* wg = p.in[24] + (size_t)l * DM * 4; const float* bg = p.in[25] + l * 4;
    const float* we = p.in[26] + (size_t)l * DM * NE; const float* be = p.in[27] + l * NE;
    int* cnt = (int*)(p.ws + WS_CTL) + l * NE;
    int* tokl = (int*)(p.ws + WS_TOKL); float* wl = (float*)(p.ws + WS_WL); int4* tinfo = (int4*)(p.ws + WS_TINFO);
    for (int row = gw; row < T; row += nw) {
        float4 v[4];
#pragma unroll
        for (int i = 0; i < 4; ++i) v[i] = *(const float4*)(xres + (size_t)row * DM + i * 256 + lane * 4);
        float ss = 0.f;
#pragma unroll
        for (int i = 0; i < 4; ++i) ss += v[i].x * v[i].x + v[i].y * v[i].y + v[i].z * v[i].z + v[i].w * v[i].w;
        ss = wave_sum(ss);
        const float rstd = rsqrtf(ss * (1.0f / DM) + EPS);
        float gl[4] = {0.f, 0.f, 0.f, 0.f};
        float el[32];
#pragma unroll
        for (int j = 0; j < 32; ++j) el[j] = 0.f;
#pragma unroll
        for (int i = 0; i < 4; ++i) {
            const int k0 = i * 256 + lane * 4;
            float4 g = *(const float4*)(g2 + k0);
            float hv[4] = {v[i].x * rstd * g.x, v[i].y * rstd * g.y, v[i].z * rstd * g.z, v[i].w * rstd * g.w};
            uint2 o; o.x = pk2(hv[0], hv[1]); o.y = pk2(hv[2], hv[3]);
            *(uint2*)(hbuf + (size_t)row * DM + k0) = o;
#pragma unroll
            for (int e = 0; e < 4; ++e) {
                float4 w4 = *(const float4*)(wg + (size_t)(k0 + e) * 4);
                gl[0] += hv[e] * w4.x; gl[1] += hv[e] * w4.y; gl[2] += hv[e] * w4.z; gl[3] += hv[e] * w4.w;
                const float* wr = we + (size_t)(k0 + e) * NE;
#pragma unroll
                for (int j = 0; j < 8; ++j) {
                    float4 x4 = *(const float4*)(wr + j * 4);
                    el[j * 4 + 0] += hv[e] * x4.x; el[j * 4 + 1] += hv[e] * x4.y; el[j * 4 + 2] += hv[e] * x4.z; el[j * 4 + 3] += hv[e] * x4.w;
                }
            }
        }
#pragma unroll
        for (int j = 0; j < 4; ++j) gl[j] = wave_sum(gl[j]) + bg[j];
#pragma unroll
        for (int j = 0; j < 32; ++j) el[j] = wave_sum(el[j]) + be[j];
        int gs = 0; float gm = gl[0];
#pragma unroll
        for (int j = 1; j < 4; ++j) if (gl[j] > gm) { gm = gl[j]; gs = j; }
        float se = 0.f;
#pragma unroll
        for (int j = 0; j < 4; ++j) se += expf(gl[j] - gm);
        const float pg = 1.0f / se;
        float ev[8];
#pragma unroll
        for (int j = 0; j < 8; ++j) {
            float x = el[j];
#pragma unroll
            for (int g = 1; g < 4; ++g) x = (gs == g) ? el[g * 8 + j] : x;
            ev[j] = x;
        }
        int i1 = 0; float v1 = ev[0];
#pragma unroll
        for (int j = 1; j < 8; ++j) if (ev[j] > v1) { v1 = ev[j]; i1 = j; }
        int i2 = -1; float v2 = -INFINITY;
#pragma unroll
        for (int j = 0; j < 8; ++j) if (j != i1 && ev[j] > v2) { v2 = ev[j]; i2 = j; }
        const float ex = expf(v2 - v1);
        const float w1 = pg / (1.0f + ex), w2 = pg * ex / (1.0f + ex);
        if (lane == 0) {
            const int e1 = gs * 8 + i1, e2 = gs * 8 + i2;
            const int s1 = atomicAdd(&cnt[e1], 1), s2 = atomicAdd(&cnt[e2], 1);
            tokl[e1 * ECAP + s1] = row; wl[e1 * ECAP + s1] = w1;
            tokl[e2 * ECAP + s2] = row; wl[e2 * ECAP + s2] = w2;
            tinfo[row] = make_int4(e1, s1, e2, s2);
        }
    }
}

__device__ void phase_moe1(const P& p, int l, char* lds) {
    const int t = threadIdx.x;
    const bf16_t* hbuf = (const bf16_t*)(p.ws + WS_HBUF);
    bf16_t* hmoe = (bf16_t*)(p.ws + WS_HMOE);
    const int* cnt = (const int*)(p.ws + WS_CTL) + l * NE;
    const int* tokl = (const int*)(p.ws + WS_TOKL);
    int* stp = (int*)(lds + GEMM_LDS);
    moe_prefix(cnt, stp);
    const int ntiles = stp[NE] * 8;
    for (int tile = blockIdx.x; tile < ntiles; tile += gridDim.x) {
        const int mtg = tile >> 3;
        int e = 0;
        while (stp[e + 1] * 8 <= tile) ++e;
        const int te = stp[e + 1] - stp[e], local = tile - stp[e] * 8, nt = local / te, mt = local % te;
        (void)mtg;
        const int ne = cnt[e];
        const int i0 = mt * 128 + (t >> 2), i1 = i0 + 64;
        const int tok0 = tokl[e * ECAP + (i0 < ne ? i0 : 0)], tok1 = tokl[e * ECAP + (i1 < ne ? i1 : 0)];
        const bf16_t* a0 = hbuf + (size_t)tok0 * DM + (t & 3) * 8;
        const bf16_t* a1 = hbuf + (size_t)tok1 * DM + (t & 3) * 8;
        const int vcol = (t & 31) * 4, wn = vcol >> 6, tn = (vcol >> 5) & 1, rr = vcol & 31;
        const float* wsrc = (tn ? p.in[29] : p.in[28]) + ((size_t)l * NE + e) * DM * DE;
        const float* b0 = wsrc + (size_t)(t >> 5) * DE + nt * 64 + wn * 32 + rr;
        EpiGateUp epi{hmoe + (size_t)(stp[e] + mt) * 128 * DE + nt * 64};
        gemm_tile(a0, a1, b0, DE, DM / BK, lds, epi);
    }
}

__device__ void phase_moe2(const P& p, int l, char* lds) {
    const int t = threadIdx.x;
    const bf16_t* hmoe = (const bf16_t*)(p.ws + WS_HMOE);
    bf16_t* ymoe = (bf16_t*)(p.ws + WS_YMOE);
    const int* cnt = (const int*)(p.ws + WS_CTL) + l * NE;
    const float* wl = (const float*)(p.ws + WS_WL);
    int* stp = (int*)(lds + GEMM_LDS);
    moe_prefix(cnt, stp);
    const int ntiles = stp[NE] * 8;
    for (int tile = blockIdx.x; tile < ntiles; tile += gridDim.x) {
        int e = 0;
        while (stp[e + 1] * 8 <= tile) ++e;
        const int te = stp[e + 1] - stp[e], local = tile - stp[e] * 8, nt = local / te, mt = local % te;
        const int ne = cnt[e];
        const size_t r0 = (size_t)(stp[e] + mt) * 128;
        const bf16_t* a0 = hmoe + (r0 + (t >> 2)) * DE + (t & 3) * 8;
        const float* b0 = p.in[30] + ((size_t)l * NE + e) * DE * DM + (size_t)(t >> 5) * DM + nt * 128 + (t & 31) * 4;
        EpiDown epi{ymoe + r0 * DM + nt * 128, wl + e * ECAP + mt * 128, ne - mt * 128};
        gemm_tile(a0, a0 + (size_t)64 * DE, b0, DM, DE / BK, lds, epi);
    }
}

__device__ void phase_final(const P& p, char* lds) {
    const int lane = threadIdx.x & 63;
    const int gw = blockIdx.x * 4 + (threadIdx.x >> 6), nw = gridDim.x * 4;
    const float* xres = (const float*)(p.ws + WS_XRES);
    const bf16_t* ymoe = (const bf16_t*)(p.ws + WS_YMOE);
    const int4* tinfo = (const int4*)(p.ws + WS_TINFO);
    int* stp = (int*)lds;
    moe_prefix((const int*)(p.ws + WS_CTL) + NE, stp);
    for (int row = gw; row < T; row += nw) {
        int4 ti = tinfo[row];
        const bf16_t* y0 = ymoe + (size_t)(stp[ti.x] * 128 + ti.y) * DM;
        const bf16_t* y1 = ymoe + (size_t)(stp[ti.z] * 128 + ti.w) * DM;
#pragma unroll
        for (int i = 0; i < 4; ++i) {
            float4 v = *(const float4*)(xres + (size_t)row * DM + i * 256 + lane * 4);
            uint2 a = *(const uint2*)(y0 + i * 256 + lane * 4), b = *(const uint2*)(y1 + i * 256 + lane * 4);
            v.x += bf2f(a.x & 0xffff) + bf2f(b.x & 0xffff); v.y += bf2f(a.x >> 16) + bf2f(b.x >> 16);
            v.z += bf2f(a.y & 0xffff) + bf2f(b.y & 0xffff); v.w += bf2f(a.y >> 16) + bf2f(b.y >> 16);
            *(float4*)(p.out + (size_t)row * DM + i * 256 + lane * 4) = v;
        }
    }
}

constexpr int LDS_BYTES = 65536;
constexpr int NPHASE = 9;

DI void run_phase(const P& p, int ph, int l, char* lds) {
    switch (ph) {
        case 0: phase_norm1(p, l, lds); break;
        case 1: phase_inproj(p, l, lds); break;
        case 2: phase_qkprep(p, l); break;
        case 3: phase_mix(p, l, lds); break;
        case 4: phase_glu(p, l, lds); break;
        case 5: phase_outproj(p, l, lds); break;
        case 6: phase_norm2(p, l); break;
        case 7: phase_moe1(p, l, lds); break;
        case 8: phase_moe2(p, l, lds); break;
        default: phase_final(p, lds); break;
    }
}

#if MULTI
__global__ void __launch_bounds__(256) k_phase(P p, int ph, int l) {
    extern __shared__ __attribute__((aligned(16))) char lds[];
    run_phase(p, ph, l, lds);
}
#else
__global__ void __launch_bounds__(256) k_mega(P p) {
    extern __shared__ __attribute__((aligned(16))) char lds[];
    cg::grid_group grid = cg::this_grid();
    for (int l = 0; l < 2; ++l) {
        for (int ph = 0; ph < NPHASE; ++ph) { run_phase(p, ph, l, lds); grid.sync(); }
    }
    run_phase(p, NPHASE, 0, lds);
}
#endif

extern "C" void kernel_launch(void* const* d_in, const int* in_sizes, int n_in, void* d_out, int out_size, void* d_ws, size_t ws_size, hipStream_t stream) {
    static int grid = 0;
    if (grid == 0) {
        if (n_in != 31 || out_size != T * DM || ws_size < WS_END) { fprintf(stderr, "kernel_launch: unexpected sizes n_in %d out %d ws %zu\n", n_in, out_size, ws_size); grid = -1; return; }
        int dev = 0, cus = 0, per_cu = 0;
        (void)hipGetDevice(&dev);
        (void)hipDeviceGetAttribute(&cus, hipDeviceAttributeMultiprocessorCount, dev);
#if MULTI
        (void)hipFuncSetAttribute((const void*)k_phase, hipFuncAttributeMaxDynamicSharedMemorySize, LDS_BYTES);
        (void)hipOccupancyMaxActiveBlocksPerMultiprocessor(&per_cu, (const void*)k_phase, 256, LDS_BYTES);
#else
        (void)hipFuncSetAttribute((const void*)k_mega, hipFuncAttributeMaxDynamicSharedMemorySize, LDS_BYTES);
        (void)hipOccupancyMaxActiveBlocksPerMultiprocessor(&per_cu, (const void*)k_mega, 256, LDS_BYTES);
#endif
        if (per_cu < 1) { fprintf(stderr, "kernel_launch: occupancy query gave %d\n", per_cu); per_cu = 1; }
        if (per_cu > 2) per_cu = 2;
        grid = cus * per_cu;
        fprintf(stderr, "kernel_launch: cus %d per_cu %d grid %d\n", cus, per_cu, grid);
    }
    if (grid < 0) return;
    (void)hipMemsetAsync((char*)d_ws + WS_CTL, 0, 4096, stream);
    P p{};
    for (int i = 0; i < 31; ++i) p.in[i] = (const float*)d_in[i];
    p.out = (float*)d_out; p.ws = (char*)d_ws;
#if MULTI
    for (int l = 0; l < 2; ++l)
        for (int ph = 0; ph < NPHASE; ++ph) hipLaunchKernelGGL(k_phase, dim3(grid), dim3(256), LDS_BYTES, stream, p, ph, l);
    hipLaunchKernelGGL(k_phase, dim3(grid), dim3(256), LDS_BYTES, stream, p, NPHASE, 0);
#else
    void* args[] = {&p};
    hipError_t e = hipLaunchCooperativeKernel((const void*)k_mega, dim3(grid), dim3(256), args, LDS_BYTES, stream);
    if (e != hipSuccess) fprintf(stderr, "cooperative launch failed: %s (grid %d)\n", hipGetErrorString(e), grid);
#endif
}
```

```cpp
#include <hip/hip_runtime.h>
#include <hip/hip_cooperative_groups.h>
#include <cstdio>
#include <cstdint>
namespace cg = cooperative_groups;

#ifndef MULTI
#define MULTI 0
#define MAXPH 9
#define NLAYER 2
#define L1PH 9
#endif

#define DI __device__ __forceinline__
#define LAS __attribute__((address_space(3)))
typedef unsigned short bf16_t;
typedef short bf16x8 __attribute__((ext_vector_type(8)));
typedef short s16x4 __attribute__((ext_vector_type(4)));
typedef float f32x16 __attribute__((ext_vector_type(16)));
typedef unsigned u32x4 __attribute__((ext_vector_type(4)));
typedef unsigned u32x2 __attribute__((ext_vector_type(2)));

constexpr int T = 16384, DM = 1024, SEQ = 2048, NBATCH = 8;
constexpr int DIN = 2824, PJ = 2816;
constexpr int NE = 32, DE = 512, ECAP = 16384;
constexpr float EPS = 1e-6f;
constexpr int C_MQ = 0, C_MK = 256, C_MV = 512, C_MO = 768, C_AQ = 1024, C_AK = 1536, C_AV = 2048, C_SU = 2560;

constexpr size_t MiB = 1u << 20;
constexpr size_t WS_CTL = 0;
constexpr size_t WS_XRES = 1 * MiB;
constexpr size_t WS_HBUF = 65 * MiB;
constexpr size_t WS_PROJ = 97 * MiB;
constexpr size_t WS_GATES = 185 * MiB;
constexpr size_t WS_MIX = 186 * MiB;
constexpr size_t WS_HRAW = 218 * MiB;
constexpr size_t WS_ZBUF = 234 * MiB;
constexpr size_t WS_TOKL = 250 * MiB;
constexpr size_t WS_WL = 252 * MiB;
constexpr size_t WS_TINFO = 254 * MiB;
constexpr size_t WS_HMOE = 256 * MiB;
constexpr size_t WS_YMOE = 292 * MiB;
constexpr size_t WS_END = 364 * MiB;

struct P {
    const float* in[31];
    float* out;
    char* ws;
};

DI float bf2f(bf16_t b) { return __uint_as_float(((unsigned)b) << 16); }
DI bf16_t f2bf(float f) { unsigned u = __float_as_uint(f); u += 0x7fffu + ((u >> 16) & 1u); return (bf16_t)(u >> 16); }
DI unsigned pk2(float lo, float hi) { unsigned r; asm("v_cvt_pk_bf16_f32 %0, %1, %2" : "=v"(r) : "v"(lo), "v"(hi)); return r; }
DI float wave_sum(float v) {
#pragma unroll
    for (int o = 32; o > 0; o >>= 1) v += __shfl_xor(v, o);
    return v;
}
DI float sigmoidf_(float x) { return 1.0f / (1.0f + expf(-x)); }
DI s16x4 tr_read(const LAS char* p) {
    typedef short v4i16_t __attribute__((ext_vector_type(4)));
    return __builtin_bit_cast(s16x4, __builtin_amdgcn_ds_read_tr16_b64_v4i16((LAS v4i16_t*)p));
}

constexpr int BK = 32, A_PITCH = 80, B_PITCH = 320, SA_BYTES = 128 * A_PITCH, SB_BYTES = BK * B_PITCH;
constexpr int GEMM_LDS = 2 * SA_BYTES + 2 * SB_BYTES;

template <class Epi>
DI void gemm_tile(const bf16_t* a0, const bf16_t* a1, const float* b0, size_t ldb, int KT, char* lds_generic, const Epi& epi) {
    LAS char* lds = (LAS char*)lds_generic;
    const int t = threadIdx.x, lane = t & 63, w = t >> 6, wm = w >> 1, wn = w & 1;
    const int r = lane & 31, h = lane >> 5;
    const int i16 = lane & 15, q = i16 >> 2, pp = i16 & 3, blk = (lane >> 4) & 1;
    const int arow = t >> 2, akc = t & 3, bk = t >> 5, bn4 = t & 31;
    f32x16 acc[2][2];
#pragma unroll
    for (int i = 0; i < 2; ++i)
#pragma unroll
        for (int j = 0; j < 2; ++j)
#pragma unroll
            for (int e = 0; e < 16; ++e) acc[i][j][e] = 0.f;
    u32x4 ra0, ra1; float4 rb[4];
    auto gload = [&](int kt) {
        ra0 = *(const u32x4*)(a0 + kt * BK);
        ra1 = *(const u32x4*)(a1 + kt * BK);
#pragma unroll
        for (int i = 0; i < 4; ++i) rb[i] = *(const float4*)(b0 + (size_t)(kt * BK + i * 8) * ldb);
    };
    auto sstore = [&](int buf) {
        LAS char* sA = lds + buf * SA_BYTES; LAS char* sB = lds + 2 * SA_BYTES + buf * SB_BYTES;
        *(LAS u32x4*)(sA + arow * A_PITCH + akc * 16) = ra0;
        *(LAS u32x4*)(sA + (arow + 64) * A_PITCH + akc * 16) = ra1;
#pragma unroll
        for (int i = 0; i < 4; ++i) {
            u32x2 v; v.x = pk2(rb[i].x, rb[i].y); v.y = pk2(rb[i].z, rb[i].w);
            *(LAS u32x2*)(sB + (bk + 8 * i) * B_PITCH + bn4 * 8) = v;
        }
    };
    auto compute = [&](int buf) {
        const LAS char* sA = lds + buf * SA_BYTES; const LAS char* sB = lds + 2 * SA_BYTES + buf * SB_BYTES;
#pragma unroll
        for (int ks = 0; ks < 2; ++ks) {
            bf16x8 af[2], bfr[2];
#pragma unroll
            for (int tm = 0; tm < 2; ++tm) af[tm] = *(const LAS bf16x8*)(sA + (wm * 64 + tm * 32 + r) * A_PITCH + (ks * 16 + 8 * h) * 2);
#pragma unroll
            for (int tn = 0; tn < 2; ++tn) {
                const LAS char* pb = sB + (ks * 16 + 8 * h + q) * B_PITCH + (wn * 64 + tn * 32 + 16 * blk) * 2 + 8 * pp;
                s16x4 lo = tr_read(pb), hi = tr_read(pb + 4 * B_PITCH);
                bfr[tn] = __builtin_shufflevector(lo, hi, 0, 1, 2, 3, 4, 5, 6, 7);
            }
#pragma unroll
            for (int tm = 0; tm < 2; ++tm)
#pragma unroll
                for (int tn = 0; tn < 2; ++tn) acc[tm][tn] = __builtin_amdgcn_mfma_f32_32x32x16_bf16(bfr[tn], af[tm], acc[tm][tn], 0, 0, 0);
        }
    };
    gload(0); sstore(0); __syncthreads();
    for (int kt = 0; kt < KT; ++kt) {
        if (kt + 1 < KT) gload(kt + 1);
        compute(kt & 1);
        if (kt + 1 < KT) sstore((kt + 1) & 1);
        __syncthreads();
    }
    epi(acc, wm, wn, r, h);
}
struct EpiBf16 {
    bf16_t* out; size_t ld;
    DI void operator()(const f32x16 (&acc)[2][2], int wm, int wn, int r, int h) const {
#pragma unroll
        for (int tm = 0; tm < 2; ++tm) {
            bf16_t* rp = out + (size_t)(wm * 64 + tm * 32 + r) * ld + wn * 64 + 4 * h;
#pragma unroll
            for (int tn = 0; tn < 2; ++tn)
#pragma unroll
                for (int g = 0; g < 4; ++g) {
                    u32x2 v; v.x = pk2(acc[tm][tn][4 * g], acc[tm][tn][4 * g + 1]); v.y = pk2(acc[tm][tn][4 * g + 2], acc[tm][tn][4 * g + 3]);
                    *(u32x2*)(rp + tn * 32 + 8 * g) = v;
                }
        }
    }
};
struct EpiResid {
    float* out; const float* res; size_t ld;
    DI void operator()(const f32x16 (&acc)[2][2], int wm, int wn, int r, int h) const {
#pragma unroll
        for (int tm = 0; tm < 2; ++tm) {
            const size_t o = (size_t)(wm * 64 + tm * 32 + r) * ld + wn * 64 + 4 * h;
#pragma unroll
            for (int tn = 0; tn < 2; ++tn)
#pragma unroll
                for (int g = 0; g < 4; ++g) {
                    float4 x = *(const float4*)(res + o + tn * 32 + 8 * g);
                    x.x += acc[tm][tn][4 * g]; x.y += acc[tm][tn][4 * g + 1]; x.z += acc[tm][tn][4 * g + 2]; x.w += acc[tm][tn][4 * g + 3];
                    *(float4*)(out + o + tn * 32 + 8 * g) = x;
                }
        }
    }
};
DI float silu_mul(float g, float u) { return g / (1.0f + __expf(-g)) * u; }
struct EpiGateUp {
    bf16_t* out;
    DI void operator()(const f32x16 (&acc)[2][2], int wm, int wn, int r, int h) const {
#pragma unroll
        for (int tm = 0; tm < 2; ++tm) {
            bf16_t* rp = out + (size_t)(wm * 64 + tm * 32 + r) * DE + wn * 32 + 4 * h;
#pragma unroll
            for (int g = 0; g < 4; ++g) {
                u32x2 v;
                v.x = pk2(silu_mul(acc[tm][0][4 * g], acc[tm][1][4 * g]), silu_mul(acc[tm][0][4 * g + 1], acc[tm][1][4 * g + 1]));
                v.y = pk2(silu_mul(acc[tm][0][4 * g + 2], acc[tm][1][4 * g + 2]), silu_mul(acc[tm][0][4 * g + 3], acc[tm][1][4 * g + 3]));
                *(u32x2*)(rp + 8 * g) = v;
            }
        }
    }
};
struct EpiDown {
    bf16_t* out; const float* roww; int nvalid;
    DI void operator()(const f32x16 (&acc)[2][2], int wm, int wn, int r, int h) const {
#pragma unroll
        for (int tm = 0; tm < 2; ++tm) {
            const int row = wm * 64 + tm * 32 + r;
            const float wv = row < nvalid ? roww[row] : 0.f;
            bf16_t* rp = out + (size_t)row * DM + wn * 64 + 4 * h;
#pragma unroll
            for (int tn = 0; tn < 2; ++tn)
#pragma unroll
                for (int g = 0; g < 4; ++g) {
                    u32x2 v; v.x = pk2(acc[tm][tn][4 * g] * wv, acc[tm][tn][4 * g + 1] * wv); v.y = pk2(acc[tm][tn][4 * g + 2] * wv, acc[tm][tn][4 * g + 3] * wv);
                    *(u32x2*)(rp + tn * 32 + 8 * g) = v;
                }
        }
    }
};

DI void moe_prefix(const int* cnt, int* stp  ) {
    __syncthreads();
    if (threadIdx.x == 0) { int a = 0; for (int e = 0; e < NE; ++e) { stp[e] = a; a += (cnt[e] + 127) >> 7; } stp[NE] = a; }
    __syncthreads();
}

__device__ void phase_norm1(const P& p, int l, char* lds) {
    const int lane = threadIdx.x & 63;
    const int gw = blockIdx.x * 4 + (threadIdx.x >> 6), nw = gridDim.x * 4;
    float* xres = (float*)(p.ws + WS_XRES);
    bf16_t* hbuf = (bf16_t*)(p.ws + WS_HBUF);
    float* gates = (float*)(p.ws + WS_GATES);
    const float* g1 = p.in[1] + l * DM;
    const float* win = p.in[2] + (size_t)l * DM * DIN;
    int* stp = (int*)lds;
    const bf16_t* ymoe = (const bf16_t*)(p.ws + WS_YMOE);
    const int4* tinfo = (const int4*)(p.ws + WS_TINFO);
    if (l > 0) moe_prefix((const int*)(p.ws + WS_CTL) + (l - 1) * NE, stp);
    for (int row = gw; row < T; row += nw) {
        float4 v[4];
        const float* xs = (l == 0) ? p.in[0] + (size_t)row * DM : xres + (size_t)row * DM;
#pragma unroll
        for (int i = 0; i < 4; ++i) v[i] = *(const float4*)(xs + i * 256 + lane * 4);
        if (l > 0) {
            int4 ti = tinfo[row];
            const bf16_t* y0 = ymoe + (size_t)(stp[ti.x] * 128 + ti.y) * DM;
            const bf16_t* y1 = ymoe + (size_t)(stp[ti.z] * 128 + ti.w) * DM;
#pragma unroll
            for (int i = 0; i < 4; ++i) {
                uint2 a = *(const uint2*)(y0 + i * 256 + lane * 4), b = *(const uint2*)(y1 + i * 256 + lane * 4);
                v[i].x += bf2f(a.x & 0xffff) + bf2f(b.x & 0xffff); v[i].y += bf2f(a.x >> 16) + bf2f(b.x >> 16);
                v[i].z += bf2f(a.y & 0xffff) + bf2f(b.y & 0xffff); v[i].w += bf2f(a.y >> 16) + bf2f(b.y >> 16);
                *(float4*)(xres + (size_t)row * DM + i * 256 + lane * 4) = v[i];
            }
        }
        float ss = 0.f;
#pragma unroll
        for (int i = 0; i < 4; ++i) ss += v[i].x * v[i].x + v[i].y * v[i].y + v[i].z * v[i].z + v[i].w * v[i].w;
        ss = wave_sum(ss);
        const float rstd = rsqrtf(ss * (1.0f / DM) + EPS);
        float gd[8];
#pragma unroll
        for (int j = 0; j < 8; ++j) gd[j] = 0.f;
#pragma unroll
        for (int i = 0; i < 4; ++i) {
            const int k0 = i * 256 + lane * 4;
            float4 g = *(const float4*)(g1 + k0);
            float hv[4] = {v[i].x * rstd * g.x, v[i].y * rstd * g.y, v[i].z * rstd * g.z, v[i].w * rstd * g.w};
            uint2 o; o.x = pk2(hv[0], hv[1]); o.y = pk2(hv[2], hv[3]);
            *(uint2*)(hbuf + (size_t)row * DM + k0) = o;
#pragma unroll
            for (int e = 0; e < 4; ++e) {
                const float* wr = win + (size_t)(k0 + e) * DIN + 1024;
                float4 w0 = *(const float4*)wr, w1 = *(const float4*)(wr + 4);
                gd[0] += hv[e] * w0.x; gd[1] += hv[e] * w0.y; gd[2] += hv[e] * w0.z; gd[3] += hv[e] * w0.w;
                gd[4] += hv[e] * w1.x; gd[5] += hv[e] * w1.y; gd[6] += hv[e] * w1.z; gd[7] += hv[e] * w1.w;
            }
        }
#pragma unroll
        for (int j = 0; j < 8; ++j) gd[j] = wave_sum(gd[j]);
        if (lane == 0) {
            const float* bi = p.in[3] + l * 4; const float* bf = p.in[4] + l * 4;
            float4 o0 = {gd[0] + bi[0], gd[1] + bi[1], gd[2] + bi[2], gd[3] + bi[3]};
            float4 o1 = {gd[4] + bf[0], gd[5] + bf[1], gd[6] + bf[2], gd[7] + bf[3]};
            *(float4*)(gates + (size_t)row * 8) = o0; *(float4*)(gates + (size_t)row * 8 + 4) = o1;
        }
    }
}

__device__ void phase_inproj(const P& p, int l, char* lds) {
    const int t = threadIdx.x;
    const bf16_t* hbuf = (const bf16_t*)(p.ws + WS_HBUF);
    bf16_t* projb = (bf16_t*)(p.ws + WS_PROJ);
    const float* win = p.in[2] + (size_t)l * DM * DIN;
    for (int tile = blockIdx.x; tile < 128 * 22; tile += gridDim.x) {
        const int mt = tile / 22, vt = tile % 22;
        const int acol = vt < 8 ? vt * 128 : (vt < 20 ? 1032 + (vt - 8) * 128 : 2568 + (vt - 20) * 128);
        const bf16_t* a0 = hbuf + (size_t)(mt * 128 + (t >> 2)) * DM + (t & 3) * 8;
        const float* b0 = win + (size_t)(t >> 5) * DIN + acol + (t & 31) * 4;
        EpiBf16 epi{projb + (size_t)mt * 128 * PJ + vt * 128, (size_t)PJ};
        gemm_tile(a0, a0 + (size_t)64 * DM, b0, DIN, DM / BK, lds, epi);
    }
}

__constant__ float ROPE_INV_REV[8] = {0.15915494309189535f, 0.03086376340470123f, 0.005985185712713705f, 0.001160663641240061f,
                                      0.00022507907903927653f, 4.364795279280289e-05f, 8.464330808241401e-06f, 1.6414262627950345e-06f};
__device__ void phase_qkprep(const P& p, int l) {
    bf16_t* projb = (bf16_t*)(p.ws + WS_PROJ);
    const int nthreads = gridDim.x * 256;
    for (int idx = blockIdx.x * 256 + threadIdx.x; idx < T * 16; idx += nthreads) {
        const int token = idx >> 4, hw = idx & 15, which = hw >> 3, head = hw & 7;
        bf16_t* ptr = projb + (size_t)token * PJ + C_AQ + which * 512 + head * 64;
        const float* g = (which ? p.in[9] : p.in[8]) + l * 64;
        float x[64];
#pragma unroll
        for (int c = 0; c < 8; ++c) {
            uint4 u = *(const uint4*)(ptr + c * 8);
            x[c * 8 + 0] = bf2f(u.x & 0xffff); x[c * 8 + 1] = bf2f(u.x >> 16); x[c * 8 + 2] = bf2f(u.y & 0xffff); x[c * 8 + 3] = bf2f(u.y >> 16);
            x[c * 8 + 4] = bf2f(u.z & 0xffff); x[c * 8 + 5] = bf2f(u.z >> 16); x[c * 8 + 6] = bf2f(u.w & 0xffff); x[c * 8 + 7] = bf2f(u.w >> 16);
        }
        float ss = 0.f;
#pragma unroll
        for (int d = 0; d < 64; ++d) ss += x[d] * x[d];
        const float rstd = rsqrtf(ss * (1.0f / 64.0f) + EPS);
#pragma unroll
        for (int d = 0; d < 64; ++d) x[d] = x[d] * rstd * g[d];
        const int pos = token & (SEQ - 1);
#pragma unroll
        for (int d = 0; d < 8; ++d) {
            double rr = (double)pos * (double)ROPE_INV_REV[d];
            rr -= floor(rr);
            const float sn = __builtin_amdgcn_sinf((float)rr), cs = __builtin_amdgcn_cosf((float)rr);
            const float x1 = x[d], x2 = x[d + 8];
            x[d] = x1 * cs - x2 * sn; x[d + 8] = x2 * cs + x1 * sn;
        }
        const float sc = which ? 1.0f : 0.125f;
#pragma unroll
        for (int c = 0; c < 8; ++c) {
            uint4 u;
            u.x = pk2(x[c * 8 + 0] * sc, x[c * 8 + 1] * sc); u.y = pk2(x[c * 8 + 2] * sc, x[c * 8 + 3] * sc);
            u.z = pk2(x[c * 8 + 4] * sc, x[c * 8 + 5] * sc); u.w = pk2(x[c * 8 + 6] * sc, x[c * 8 + 7] * sc);
            *(uint4*)(ptr + c * 8) = u;
        }
    }
}

__device__ void mlstm_item_simple(const P& p, int l, int item, float* sm) {
    const int b = item >> 4, hd = (item >> 2) & 3, dq = item & 3;
    const int t = threadIdx.x;
    const bf16_t* projb = (const bf16_t*)(p.ws + WS_PROJ);
    const float* gates = (const float*)(p.ws + WS_GATES);
    float* hraw = (float*)(p.ws + WS_HRAW);
    const float* cw = p.in[5] + l * 4 * 512; const float* cb = p.in[6] + l * 512;
    float* Q = sm; float* K = Q + 64 * 65; float* Sm = K + 64 * 65; float* V = Sm + 64 * 65; float* C = V + 64 * 16; float* nv = C + 64 * 16;
    float* bc = nv + 64; float* Mt = bc + 64; float* uu = Mt + 64; float* den = uu + 64; float* misc = den + 64;
    __syncthreads();
    for (int i = t; i < 1024; i += 256) C[i] = 0.f;
    if (t < 64) nv[t] = 0.f;
    if (t == 0) misc[0] = 0.f;
    for (int c = 0; c < 32; ++c) {
        __syncthreads();
        const int row0 = b * SEQ + c * 64;
        for (int i = t; i < 8192; i += 256) {
            const int which = i >> 12, tt = (i >> 6) & 63, d = i & 63, ch = which * 256 + hd * 64 + d;
            float a = cb[ch];
#pragma unroll
            for (int j = 0; j < 4; ++j) { const int ts = c * 64 + tt + j - 3; if (ts >= 0) a += bf2f(projb[(size_t)(b * SEQ + ts) * PJ + ch]) * cw[j * 512 + ch]; }
            float y = a / (1.0f + expf(-a));
            if (which) K[tt * 65 + d] = y * 0.125f; else Q[tt * 65 + d] = y;
        }
        for (int i = t; i < 1024; i += 256) { const int tt = i >> 4, d = i & 15; V[i] = bf2f(projb[(size_t)(row0 + tt) * PJ + C_MV + hd * 64 + dq * 16 + d]); }
        if (t < 64) {
            const float ig = gates[(size_t)(row0 + t) * 8 + hd], fg = gates[(size_t)(row0 + t) * 8 + 4 + hd];
            const float lf = fminf(fg, 0.f) - log1pf(expf(-fabsf(fg)));
            float bs = lf;
#pragma unroll
            for (int o = 1; o < 64; o <<= 1) { float v = __shfl_up(bs, o); if (t >= o) bs += v; }
            const float u = ig - bs; float um = u;
#pragma unroll
            for (int o = 1; o < 64; o <<= 1) { float v = __shfl_up(um, o); if (t >= o) um = fmaxf(um, v); }
            bc[t] = bs; uu[t] = u; Mt[t] = fmaxf(misc[0], um);
        }
        __syncthreads();
        for (int i = t; i < 4096; i += 256) {
            const int tt = i >> 6, s = i & 63; float v = 0.f;
            if (s <= tt) { float dsum = 0.f; for (int d = 0; d < 64; ++d) dsum += Q[tt * 65 + d] * K[s * 65 + d]; v = dsum * expf(uu[s] - Mt[tt]); }
            Sm[tt * 65 + s] = v;
        }
        __syncthreads();
        if (t < 64) {
            const float inter = expf(misc[0] - Mt[t]);
            float qn = 0.f, rs = 0.f;
            for (int d = 0; d < 64; ++d) { qn += Q[t * 65 + d] * nv[d]; rs += Sm[t * 65 + d]; }
            den[t] = fmaxf(fabsf(inter * qn + rs), expf(-(bc[t] + Mt[t])));
        }
        __syncthreads();
        for (int i = t; i < 1024; i += 256) {
            const int tt = i >> 4, d = i & 15;
            const float inter = expf(misc[0] - Mt[tt]);
            float a = 0.f, bsum = 0.f;
            for (int k = 0; k < 64; ++k) { a += Q[tt * 65 + k] * C[k * 16 + d]; bsum += Sm[tt * 65 + k] * V[k * 16 + d]; }
            hraw[(size_t)(row0 + tt) * 256 + hd * 64 + dq * 16 + d] = (inter * a + bsum) / den[tt];
        }
        __syncthreads();
        const float Mlast = Mt[63], decay = expf(misc[0] - Mlast);
        for (int i = t; i < 1024; i += 256) {
            const int dk = i >> 4, d = i & 15; float a = 0.f;
            for (int s = 0; s < 64; ++s) a += expf(uu[s] - Mlast) * K[s * 65 + dk] * V[s * 16 + d];
            C[i] = decay * C[i] + a;
        }
        if (t < 64) { float a = 0.f; for (int s = 0; s < 64; ++s) a += expf(uu[s] - Mlast) * K[s * 65 + t]; nv[t] = decay * nv[t] + a; }
        __syncthreads();
        if (t == 0) misc[0] = bc[63] + Mlast;
    }
}

__device__ void moba_item_simple(const P& p, int l, int item, float* sm) {
    const int b = item >> 6, hd = (item >> 3) & 7, qb = 7 - (item & 7);
    const int t = threadIdx.x;
    const bf16_t* projb = (const bf16_t*)(p.ws + WS_PROJ);
    bf16_t* mix = (bf16_t*)(p.ws + WS_MIX);
    float* kmean = sm;
    float* red = sm + 512;
    float* Kt = sm + 1024;
    float* Vt = Kt + 4096;
    const size_t rowb = (size_t)b * SEQ;
    __syncthreads();
    for (int n = 0; n < qb; ++n) {
        const int d = t & 63, part = t >> 6; float s = 0.f;
        for (int rr = 0; rr < 64; ++rr) s += bf2f(projb[(rowb + n * 256 + part * 64 + rr) * PJ + C_AK + hd * 64 + d]);
        red[part * 64 + d] = s;
        __syncthreads();
        if (t < 64) kmean[n * 64 + t] = (red[t] + red[64 + t] + red[128 + t] + red[192 + t]) * (1.0f / 256.0f);
        __syncthreads();
    }
    const int qpos = qb * 256 + t;
    float q[64], acc[64];
    {
        const bf16_t* qp = projb + (rowb + qpos) * PJ + C_AQ + hd * 64;
#pragma unroll
        for (int c = 0; c < 8; ++c) {
            uint4 u = *(const uint4*)(qp + c * 8);
            q[c * 8 + 0] = bf2f(u.x & 0xffff); q[c * 8 + 1] = bf2f(u.x >> 16); q[c * 8 + 2] = bf2f(u.y & 0xffff); q[c * 8 + 3] = bf2f(u.y >> 16);
            q[c * 8 + 4] = bf2f(u.z & 0xffff); q[c * 8 + 5] = bf2f(u.z >> 16); q[c * 8 + 6] = bf2f(u.w & 0xffff); q[c * 8 + 7] = bf2f(u.w >> 16);
        }
    }
#pragma unroll
    for (int d = 0; d < 64; ++d) acc[d] = 0.f;
    unsigned mask = 0;
    {
        float gate[8];
#pragma unroll
        for (int n = 0; n < 8; ++n) {
            float s = 0.f;
            if (n < qb) {
#pragma unroll
                for (int d = 0; d < 64; ++d) s += q[d] * kmean[n * 64 + d];
            }
            gate[n] = s;
        }
#pragma unroll
        for (int it = 0; it < 3; ++it) {
            int best = -1; float bv = -INFINITY;
#pragma unroll
            for (int n = 0; n < 8; ++n) if (n < qb && !((mask >> n) & 1u) && gate[n] > bv) { bv = gate[n]; best = n; }
            if (best >= 0) mask |= 1u << best;
        }
    }
    float m = -INFINITY, lsum = 0.f;
    for (int n = 0; n <= qb; ++n) {
        const bool active = (n == qb) || ((mask >> n) & 1u);
        for (int kt = 0; kt < 4; ++kt) {
            __syncthreads();
            for (int i = t; i < 4096; i += 256) {
                const int rr = i >> 6, d = i & 63; const size_t ro = (rowb + n * 256 + kt * 64 + rr) * PJ;
                Kt[i] = bf2f(projb[ro + C_AK + hd * 64 + d]); Vt[i] = bf2f(projb[ro + C_AV + hd * 64 + d]);
            }
            __syncthreads();
            if (active) {
                for (int j = 0; j < 64; ++j) {
                    const int key = n * 256 + kt * 64 + j;
                    if (key > qpos) break;
                    float s = 0.f;
#pragma unroll
                    for (int d = 0; d < 64; ++d) s += q[d] * Kt[j * 64 + d];
                    if (s > m) {
                        const float sc = expf(m - s); lsum = lsum * sc + 1.0f; m = s;
#pragma unroll
                        for (int d = 0; d < 64; ++d) acc[d] = acc[d] * sc + Vt[j * 64 + d];
                    } else {
                        const float pj = expf(s - m); lsum += pj;
#pragma unroll
                        for (int d = 0; d < 64; ++d) acc[d] += pj * Vt[j * 64 + d];
                    }
                }
            }
        }
    }
    const float il = 1.0f / lsum; float ss = 0.f;
#pragma unroll
    for (int d = 0; d < 64; ++d) { acc[d] *= il; ss += acc[d] * acc[d]; }
    const float rstd = rsqrtf(ss * (1.0f / 64.0f) + EPS);
    const float* og = p.in[10] + (l * 8 + hd) * 64;
    bf16_t* op = mix + (rowb + qpos) * DM + 256 + hd * 64;
#pragma unroll
    for (int c = 0; c < 8; ++c) {
        uint4 u;
        u.x = pk2(acc[c * 8 + 0] * rstd * og[c * 8 + 0], acc[c * 8 + 1] * rstd * og[c * 8 + 1]);
        u.y = pk2(acc[c * 8 + 2] * rstd * og[c * 8 + 2], acc[c * 8 + 3] * rstd * og[c * 8 + 3]);
        u.z = pk2(acc[c * 8 + 4] * rstd * og[c * 8 + 4], acc[c * 8 + 5] * rstd * og[c * 8 + 5]);
        u.w = pk2(acc[c * 8 + 6] * rstd * og[c * 8 + 6], acc[c * 8 + 7] * rstd * og[c * 8 + 7]);
        *(uint4*)(op + c * 8) = u;
    }
}

__device__ void s5_item_simple(const P& p, int l, int item, float* sm) {
    const int t = threadIdx.x, lane = t & 63, w = t >> 6;
    const int bg = item * 4 + w, b = bg >> 4, g = bg & 15;
    const bf16_t* projb = (const bf16_t*)(p.ws + WS_PROJ);
    float* zbuf = (float*)(p.ws + WS_ZBUF);
    float* xr = sm + w * (2 * 16 * 65); float* xi = xr + 16 * 65;
    const int lg = l * 16 + g;
    const float lr = p.in[11][lg * 64 + lane], li = p.in[12][lg * 64 + lane];
    const float dt = expf(p.in[18][lg]);
    const float mag = expf(lr * dt);
    const float are = mag * cosf(li * dt), aim = mag * sinf(li * dt);
    const float zr = are - 1.0f, zi = aim, dn = lr * lr + li * li;
    const float fr = (zr * lr + zi * li) / dn, fi = (zi * lr - zr * li) / dn;
    float bbr[16], bbi[16];
#pragma unroll
    for (int hh = 0; hh < 16; ++hh) {
        const float br = p.in[13][((size_t)lg * 64 + lane) * 16 + hh], bi = p.in[14][((size_t)lg * 64 + lane) * 16 + hh];
        bbr[hh] = fr * br - fi * bi; bbi[hh] = fr * bi + fi * br;
    }
    const float* cre = p.in[15] + (size_t)lg * 16 * 64; const float* cim = p.in[16] + (size_t)lg * 16 * 64;
    const float* dd = p.in[17] + lg * 16;
    float sr = 0.f, si = 0.f;
    __syncthreads();
    for (int c = 0; c < SEQ / 16; ++c) {
        const size_t row0 = (size_t)b * SEQ + c * 16;
        for (int tt = 0; tt < 16; ++tt) {
            const bf16_t* up = projb + (row0 + tt) * PJ + C_SU + g * 16;
            uint4 u0 = *(const uint4*)up, u1 = *(const uint4*)(up + 8);
            float u[16] = {bf2f(u0.x & 0xffff), bf2f(u0.x >> 16), bf2f(u0.y & 0xffff), bf2f(u0.y >> 16), bf2f(u0.z & 0xffff), bf2f(u0.z >> 16), bf2f(u0.w & 0xffff), bf2f(u0.w >> 16),
                           bf2f(u1.x & 0xffff), bf2f(u1.x >> 16), bf2f(u1.y & 0xffff), bf2f(u1.y >> 16), bf2f(u1.z & 0xffff), bf2f(u1.z >> 16), bf2f(u1.w & 0xffff), bf2f(u1.w >> 16)};
            float br = 0.f, bi = 0.f;
#pragma unroll
            for (int hh = 0; hh < 16; ++hh) { br += bbr[hh] * u[hh]; bi += bbi[hh] * u[hh]; }
            const float nr = are * sr - aim * si + br, ni = are * si + aim * sr + bi;
            sr = nr; si = ni;
            xr[tt * 65 + lane] = sr; xi[tt * 65 + lane] = si;
        }
        __syncthreads();
        {
            const int tt = lane >> 2, hq = lane & 3;
            float y[4] = {0.f, 0.f, 0.f, 0.f};
            for (int pp = 0; pp < 64; ++pp) {
                const float a = xr[tt * 65 + pp], bq = xi[tt * 65 + pp];
#pragma unroll
                for (int j = 0; j < 4; ++j) y[j] += cre[(hq * 4 + j) * 64 + pp] * a - cim[(hq * 4 + j) * 64 + pp] * bq;
            }
#pragma unroll
            for (int j = 0; j < 4; ++j) {
                const int hh = hq * 4 + j;
                float v = y[j] + dd[hh] * bf2f(projb[(row0 + tt) * PJ + C_SU + g * 16 + hh]);
                const float inner = 0.7978845608028654f * (v + 0.044715f * v * v * v);
                const float th = 1.0f - 2.0f / (expf(2.0f * inner) + 1.0f);
                zbuf[(row0 + tt) * 256 + g * 16 + hh] = 0.5f * v * (1.0f + th);
            }
        }
        __syncthreads();
    }
}

__device__ void phase_mix(const P& p, int l, char* lds) {
    for (int item = blockIdx.x; item < 128 + 32 + 512; item += gridDim.x) {
        if (item < 128) mlstm_item_simple(p, l, item, (float*)lds);
        else if (item < 160) s5_item_simple(p, l, item - 128, (float*)lds);
        else {
            const int i2 = item - 160;
            const int qo = i2 >> 6, bh = i2 & 63;
            moba_item_simple(p, l, (bh << 3) | qo, (float*)lds);
        }
    }
}

__device__ void phase_glu(const P& p, int l, char* lds) {
    const int t = threadIdx.x;
    const bf16_t* projb = (const bf16_t*)(p.ws + WS_PROJ);
    bf16_t* mix = (bf16_t*)(p.ws + WS_MIX);
    const float* zbuf = (const float*)(p.ws + WS_ZBUF);
    const float* hraw = (const float*)(p.ws + WS_HRAW);
    const float* gw = p.in[19] + (size_t)l * 256 * 256; const float* gb = p.in[20] + l * 256;
    const float* sg = p.in[21] + l * 256; const float* mg = p.in[7] + l * 256;
    float* zs = (float*)lds; float* ys = zs + 16 * 256;
    for (int tile = blockIdx.x; tile < T / 16; tile += gridDim.x) {
        const size_t row0 = (size_t)tile * 16;
        __syncthreads();
        for (int i = t; i < 4096; i += 256) zs[i] = zbuf[row0 * 256 + i];
        __syncthreads();
        float a[16];
#pragma unroll
        for (int r = 0; r < 16; ++r) a[r] = gb[t];
        for (int k = 0; k < 256; ++k) {
            const float wv = gw[k * 256 + t];
#pragma unroll
            for (int r = 0; r < 16; ++r) a[r] += zs[r * 256 + k] * wv;
        }
#pragma unroll
        for (int r = 0; r < 16; ++r) ys[r * 256 + t] = zs[r * 256 + t] * sigmoidf_(a[r]);
        __syncthreads();
        {
            const int r = t >> 4, g = t & 15; float ss = 0.f;
#pragma unroll
            for (int hh = 0; hh < 16; ++hh) { const float v = ys[r * 256 + g * 16 + hh]; ss += v * v; }
            const float rstd = rsqrtf(ss * (1.0f / 16.0f) + EPS);
#pragma unroll
            for (int hh = 0; hh < 16; ++hh) mix[(row0 + r) * DM + 768 + g * 16 + hh] = f2bf(ys[r * 256 + g * 16 + hh] * rstd * sg[g * 16 + hh]);
        }
        {
            const int pr = t >> 2, qd = t & 3, r = pr >> 2, hd = pr & 3;
            const float* hp = hraw + (row0 + r) * 256 + hd * 64 + qd * 16;
            float v[16]; float ss = 0.f;
#pragma unroll
            for (int d = 0; d < 16; ++d) { v[d] = hp[d]; ss += v[d] * v[d]; }
            ss += __shfl_xor(ss, 1); ss += __shfl_xor(ss, 2);
            const float rstd = rsqrtf(ss * (1.0f / 64.0f) + EPS);
#pragma unroll
            for (int d = 0; d < 16; ++d) {
                const int col = hd * 64 + qd * 16 + d;
                const float o = bf2f(projb[(row0 + r) * PJ + C_MO + col]);
                mix[(row0 + r) * DM + col] = f2bf(v[d] * rstd * mg[col] * sigmoidf_(o));
            }
        }
    }
}

__device__ void phase_outproj(const P& p, int l, char* lds) {
    const int t = threadIdx.x;
    const bf16_t* mix = (const bf16_t*)(p.ws + WS_MIX);
    float* xres = (float*)(p.ws + WS_XRES);
    const float* wout = p.in[22] + (size_t)l * DM * DM;
    const float* xin = (l == 0) ? p.in[0] : xres;
    for (int tile = blockIdx.x; tile < 128 * 8; tile += gridDim.x) {
        const int mt = tile >> 3, nt = tile & 7;
        const bf16_t* a0 = mix + (size_t)(mt * 128 + (t >> 2)) * DM + (t & 3) * 8;
        const float* b0 = wout + (size_t)(t >> 5) * DM + nt * 128 + (t & 31) * 4;
        const size_t o = (size_t)mt * 128 * DM + nt * 128;
        EpiResid epi{xres + o, xin + o, (size_t)DM};
        gemm_tile(a0, a0 + (size_t)64 * DM, b0, DM, DM / BK, lds, epi);
    }
}

__device__ void phase_norm2(const P& p, int l) {
    const int lane = threadIdx.x & 63;
    const int gw = blockIdx.x * 4 + (threadIdx.x >> 6), nw = gridDim.x * 4;
    const float* xres = (const float*)(p.ws + WS_XRES);
    bf16_t* hbuf = (bf16_t*)(p.ws + WS_HBUF);
    const float* g2 = p.in[23] + l * DM;
    const float* wg = p.in[24] + (size_t)l * DM * 4; const float* bg = p.in[25] + l * 4;
    const float* we = p.in[26] + (size_t)l * DM * NE; const float* be = p.in[27] + l * NE;
    int* cnt = (int*)(p.ws + WS_CTL) + l * NE;
    int* tokl = (int*)(p.ws + WS_TOKL); float* wl = (float*)(p.ws + WS_WL); int4* tinfo = (int4*)(p.ws + WS_TINFO);
    for (int row = gw; row < T; row += nw) {
        float4 v[4];
#pragma unroll
        for (int i = 0; i < 4; ++i) v[i] = *(const float4*)(xres + (size_t)row * DM + i * 256 + lane * 4);
        float ss = 0.f;
#pragma unroll
        for (int i = 0; i < 4; ++i) ss += v[i].x * v[i].x + v[i].y * v[i].y + v[i].z * v[i].z + v[i].w * v[i].w;
        ss = wave_sum(ss);
        const float rstd = rsqrtf(ss * (1.0f / DM) + EPS);
        float gl[4] = {0.f, 0.f, 0.f, 0.f};
        float el[32];
#pragma unroll
        for (int j = 0; j < 32; ++j) el[j] = 0.f;
#pragma unroll
        for (int i = 0; i < 4; ++i) {
            const int k0 = i * 256 + lane * 4;
            float4 g = *(const float4*)(g2 + k0);
            float hv[4] = {v[i].x * rstd * g.x, v[i].y * rstd * g.y, v[i].z * rstd * g.z, v[i].w * rstd * g.w};
            uint2 o; o.x = pk2(hv[0], hv[1]); o.y = pk2(hv[2], hv[3]);
            *(uint2*)(hbuf + (size_t)row * DM + k0) = o;
#pragma unroll
            for (int e = 0; e < 4; ++e) {
                float4 w4 = *(const float4*)(wg + (size_t)(k0 + e) * 4);
                gl[0] += hv[e] * w4.x; gl[1] += hv[e] * w4.y; gl[2] += hv[e] * w4.z; gl[3] += hv[e] * w4.w;
                const float* wr = we + (size_t)(k0 + e) * NE;
#pragma unroll
                for (int j = 0; j < 8; ++j) {
                    float4 x4 = *(const float4*)(wr + j * 4);
                    el[j * 4 + 0] += hv[e] * x4.x; el[j * 4 + 1] += hv[e] * x4.y; el[j * 4 + 2] += hv[e] * x4.z; el[j * 4 + 3] += hv[e] * x4.w;
                }
            }
        }
#pragma unroll
        for (int j = 0; j < 4; ++j) gl[j] = wave_sum(gl[j]) + bg[j];
#pragma unroll
        for (int j = 0; j < 32; ++j) el[j] = wave_sum(el[j]) + be[j];
        int gs = 0; float gm = gl[0];
#pragma unroll
        for (int j = 1; j < 4; ++j) if (gl[j] > gm) { gm = gl[j]; gs = j; }
        float se = 0.f;
#pragma unroll
        for (int j = 0; j < 4; ++j) se += expf(gl[j] - gm);
        const float pg = 1.0f / se;
        float ev[8];
#pragma unroll
        for (int j = 0; j < 8; ++j) {
            float x = el[j];
#pragma unroll
            for (int g = 1; g < 4; ++g) x = (gs == g) ? el[g * 8 + j] : x;
            ev[j] = x;
        }
        int i1 = 0; float v1 = ev[0];
#pragma unroll
        for (int j = 1; j < 8; ++j) if (ev[j] > v1) { v1 = ev[j]; i1 = j; }
        int i2 = (i1 + 1) & 7; float v2 = -INFINITY;
#pragma unroll
        for (int j = 0; j < 8; ++j) if (j != i1 && ev[j] > v2) { v2 = ev[j]; i2 = j; }
        const float ex = expf(v2 - v1);
        const float w1 = pg / (1.0f + ex), w2 = pg * ex / (1.0f + ex);
        if (lane == 0) {
            const int e1 = gs * 8 + i1, e2 = gs * 8 + i2;
            int s1 = atomicAdd(&cnt[e1], 1), s2 = atomicAdd(&cnt[e2], 1);
            s1 = min(max(s1, 0), ECAP - 1); s2 = min(max(s2, 0), ECAP - 1);
            tokl[e1 * ECAP + s1] = row; wl[e1 * ECAP + s1] = w1;
            tokl[e2 * ECAP + s2] = row; wl[e2 * ECAP + s2] = w2;
            tinfo[row] = make_int4(e1, s1, e2, s2);
        }
    }
}

__device__ void phase_moe1(const P& p, int l, char* lds) {
    const int t = threadIdx.x;
    const bf16_t* hbuf = (const bf16_t*)(p.ws + WS_HBUF);
    bf16_t* hmoe = (bf16_t*)(p.ws + WS_HMOE);
    const int* cnt = (const int*)(p.ws + WS_CTL) + l * NE;
    const int* tokl = (const int*)(p.ws + WS_TOKL);
    int* stp = (int*)(lds + GEMM_LDS);
    moe_prefix(cnt, stp);
    const int ntiles = stp[NE] * 8;
    for (int tile = blockIdx.x; tile < ntiles; tile += gridDim.x) {
        const int mtg = tile >> 3;
        int e = 0;
        while (stp[e + 1] * 8 <= tile) ++e;
        const int te = stp[e + 1] - stp[e], local = tile - stp[e] * 8, nt = local / te, mt = local % te;
        (void)mtg;
        const int ne = cnt[e];
        const int i0 = mt * 128 + (t >> 2), i1 = i0 + 64;
        const int tok0 = tokl[e * ECAP + (i0 < ne ? i0 : 0)], tok1 = tokl[e * ECAP + (i1 < ne ? i1 : 0)];
        const bf16_t* a0 = hbuf + (size_t)tok0 * DM + (t & 3) * 8;
        const bf16_t* a1 = hbuf + (size_t)tok1 * DM + (t & 3) * 8;
        const int vcol = (t & 31) * 4, wn = vcol >> 6, tn = (vcol >> 5) & 1, rr = vcol & 31;
        const float* wsrc = (tn ? p.in[29] : p.in[28]) + ((size_t)l * NE + e) * DM * DE;
        const float* b0 = wsrc + (size_t)(t >> 5) * DE + nt * 64 + wn * 32 + rr;
        EpiGateUp epi{hmoe + (size_t)(stp[e] + mt) * 128 * DE + nt * 64};
        gemm_tile(a0, a1, b0, DE, DM / BK, lds, epi);
    }
}

__device__ void phase_moe2(const P& p, int l, char* lds) {
    const int t = threadIdx.x;
    const bf16_t* hmoe = (const bf16_t*)(p.ws + WS_HMOE);
    bf16_t* ymoe = (bf16_t*)(p.ws + WS_YMOE);
    const int* cnt = (const int*)(p.ws + WS_CTL) + l * NE;
    const float* wl = (const float*)(p.ws + WS_WL);
    int* stp = (int*)(lds + GEMM_LDS);
    moe_prefix(cnt, stp);
    const int ntiles = stp[NE] * 8;
    for (int tile = blockIdx.x; tile < ntiles; tile += gridDim.x) {
        int e = 0;
        while (stp[e + 1] * 8 <= tile) ++e;
        const int te = stp[e + 1] - stp[e], local = tile - stp[e] * 8, nt = local / te, mt = local % te;
        const int ne = cnt[e];
        const size_t r0 = (size_t)(stp[e] + mt) * 128;
        const bf16_t* a0 = hmoe + (r0 + (t >> 2)) * DE + (t & 3) * 8;
        const float* b0 = p.in[30] + ((size_t)l * NE + e) * DE * DM + (size_t)(t >> 5) * DM + nt * 128 + (t & 31) * 4;
        EpiDown epi{ymoe + r0 * DM + nt * 128, wl + e * ECAP + mt * 128, ne - mt * 128};
        gemm_tile(a0, a0 + (size_t)64 * DE, b0, DM, DE / BK, lds, epi);
    }
}

__device__ void phase_final(const P& p, char* lds) {
    const int lane = threadIdx.x & 63;
    const int gw = blockIdx.x * 4 + (threadIdx.x >> 6), nw = gridDim.x * 4;
    const float* xres = (const float*)(p.ws + WS_XRES);
    const bf16_t* ymoe = (const bf16_t*)(p.ws + WS_YMOE);
    const int4* tinfo = (const int4*)(p.ws + WS_TINFO);
    int* stp = (int*)lds;
    moe_prefix((const int*)(p.ws + WS_CTL) + NE, stp);
    for (int row = gw; row < T; row += nw) {
        int4 ti = tinfo[row];
        const bf16_t* y0 = ymoe + (size_t)(stp[ti.x] * 128 + ti.y) * DM;
        const bf16_t* y1 = ymoe + (size_t)(stp[ti.z] * 128 + ti.w) * DM;
#pragma unroll
        for (int i = 0; i < 4; ++i) {
            float4 v = *(const float4*)(xres + (size_t)row * DM + i * 256 + lane * 4);
            uint2 a = *(const uint2*)(y0 + i * 256 + lane * 4), b = *(const uint2*)(y1 + i * 256 + lane * 4);
            v.x += bf2f(a.x & 0xffff) + bf2f(b.x & 0xffff); v.y += bf2f(a.x >> 16) + bf2f(b.x >> 16);
            v.z += bf2f(a.y & 0xffff) + bf2f(b.y & 0xffff); v.w += bf2f(a.y >> 16) + bf2f(b.y >> 16);
            *(float4*)(p.out + (size_t)row * DM + i * 256 + lane * 4) = v;
        }
    }
}

constexpr int LDS_BYTES = 65536;
constexpr int NPHASE = 9;

DI void run_phase(const P& p, int ph, int l, char* lds) {
    switch (ph) {
        case 0: phase_norm1(p, l, lds); break;
        case 1: phase_inproj(p, l, lds); break;
        case 2: phase_qkprep(p, l); break;
        case 3: phase_mix(p, l, lds); break;
        case 4: phase_glu(p, l, lds); break;
        case 5: phase_outproj(p, l, lds); break;
        case 6: phase_norm2(p, l); break;
        case 7: phase_moe1(p, l, lds); break;
        case 8: phase_moe2(p, l, lds); break;
        default: phase_final(p, lds); break;
    }
}

#if MULTI
__global__ void __launch_bounds__(256) k_phase(P p, int ph, int l) {
    extern __shared__ __attribute__((aligned(16))) char lds[];
    run_phase(p, ph, l, lds);
}
#else
__global__ void __launch_bounds__(256) k_mega(P p) {
    extern __shared__ __attribute__((aligned(16))) char lds[];
    cg::grid_group grid = cg::this_grid();
#ifndef MAXPH
#define MAXPH 9
#endif
#ifndef NLAYER
#define NLAYER 2
#endif
#pragma unroll
    for (int l = 0; l < NLAYER; ++l) {
        if (MAXPH > 0 && (l == 0 || L1PH > 0)) { phase_norm1(p, l, lds); grid.sync(); }
        if (MAXPH > 1 && (l == 0 || L1PH > 1)) { phase_inproj(p, l, lds); grid.sync(); }
        if (MAXPH > 2 && (l == 0 || L1PH > 2)) { phase_qkprep(p, l); grid.sync(); }
        if (MAXPH > 3 && (l == 0 || L1PH > 3)) { phase_mix(p, l, lds); grid.sync(); }
        if (MAXPH > 4 && (l == 0 || L1PH > 4)) { phase_glu(p, l, lds); grid.sync(); }
        if (MAXPH > 5 && (l == 0 || L1PH > 5)) { phase_outproj(p, l, lds); grid.sync(); }
        if (MAXPH > 6 && (l == 0 || L1PH > 6)) { phase_norm2(p, l); grid.sync(); }
        if (MAXPH > 7 && (l == 0 || L1PH > 7)) { phase_moe1(p, l, lds); grid.sync(); }
        if (MAXPH > 8 && (l == 0 || L1PH > 8)) { phase_moe2(p, l, lds); grid.sync(); }
    }
    if (MAXPH > 8) phase_final(p, lds);
}
#endif

extern "C" void kernel_launch(void* const* d_in, const int* in_sizes, int n_in, void* d_out, int out_size, void* d_ws, size_t ws_size, hipStream_t stream) {
    static int grid = 0;
    if (grid == 0) {
        if (n_in != 31 || out_size != T * DM || ws_size < WS_END) { fprintf(stderr, "kernel_launch: unexpected sizes n_in %d out %d ws %zu\n", n_in, out_size, ws_size); grid = -1; return; }
        int dev = 0, cus = 0, per_cu = 0;
        (void)hipGetDevice(&dev);
        (void)hipDeviceGetAttribute(&cus, hipDeviceAttributeMultiprocessorCount, dev);
#if MULTI
        (void)hipFuncSetAttribute((const void*)k_phase, hipFuncAttributeMaxDynamicSharedMemorySize, LDS_BYTES);
        (void)hipOccupancyMaxActiveBlocksPerMultiprocessor(&per_cu, (const void*)k_phase, 256, LDS_BYTES);
#else
        (void)hipFuncSetAttribute((const void*)k_mega, hipFuncAttributeMaxDynamicSharedMemorySize, LDS_BYTES);
        (void)hipOccupancyMaxActiveBlocksPerMultiprocessor(&per_cu, (const void*)k_mega, 256, LDS_BYTES);
#endif
        if (per_cu < 1) { fprintf(stderr, "kernel_launch: occupancy query gave %d\n", per_cu); per_cu = 1; }
        if (per_cu > 2) per_cu = 2;
        grid = cus * per_cu;
        fprintf(stderr, "kernel_launch: cus %d per_cu %d grid %d\n", cus, per_cu, grid);
    }
    if (grid < 0) return;
    (void)hipMemsetAsync((char*)d_ws + WS_CTL, 0, 4096, stream);
    P p{};
    for (int i = 0; i < 31; ++i) p.in[i] = (const float*)d_in[i];
    p.out = (float*)d_out; p.ws = (char*)d_ws;
#if MULTI
    for (int l = 0; l < 2; ++l)
        for (int ph = 0; ph < NPHASE; ++ph) hipLaunchKernelGGL(k_phase, dim3(grid), dim3(256), LDS_BYTES, stream, p, ph, l);
    hipLaunchKernelGGL(k_phase, dim3(grid), dim3(256), LDS_BYTES, stream, p, NPHASE, 0);
#else
    void* args[] = {&p};
    hipError_t e = hipLaunchCooperativeKernel((const void*)k_mega, dim3(grid), dim3(256), args, LDS_BYTES, stream);
    if (e != hipSuccess) fprintf(stderr, "cooperative launch failed: %s (grid %d)\n", hipGetErrorString(e), grid);
#endif
}
```

```cpp
#include <hip/hip_runtime.h>
#include <hip/hip_cooperative_groups.h>
#include <cstdio>
#include <cstdint>
namespace cg = cooperative_groups;

#ifndef MULTI
#define MULTI 0
#define MAXPH 9
#define NLAYER 2
#define L1PH 9
#endif

#define DI __device__ __forceinline__
#define LAS __attribute__((address_space(3)))
typedef unsigned short bf16_t;
typedef short bf16x8 __attribute__((ext_vector_type(8)));
typedef short s16x4 __attribute__((ext_vector_type(4)));
typedef float f32x16 __attribute__((ext_vector_type(16)));
typedef unsigned u32x4 __attribute__((ext_vector_type(4)));
typedef unsigned u32x2 __attribute__((ext_vector_type(2)));

constexpr int T = 16384, DM = 1024, SEQ = 2048, NBATCH = 8;
constexpr int DIN = 2824, PJ = 2816;
constexpr int NE = 32, DE = 512, ECAP = 16384;
constexpr float EPS = 1e-6f;
constexpr int C_MQ = 0, C_MK = 256, C_MV = 512, C_MO = 768, C_AQ = 1024, C_AK = 1536, C_AV = 2048, C_SU = 2560;

constexpr size_t MiB = 1u << 20;
constexpr size_t WS_CTL = 0;
constexpr size_t WS_KMEAN = 512 * 1024;
constexpr size_t WS_XRES = 1 * MiB;
constexpr size_t WS_HBUF = 65 * MiB;
constexpr size_t WS_PROJ = 97 * MiB;
constexpr size_t WS_GATES = 185 * MiB;
constexpr size_t WS_MIX = 186 * MiB;
constexpr size_t WS_HRAW = 218 * MiB;
constexpr size_t WS_ZBUF = 234 * MiB;
constexpr size_t WS_TOKL = 250 * MiB;
constexpr size_t WS_WL = 252 * MiB;
constexpr size_t WS_TINFO = 254 * MiB;
constexpr size_t WS_HMOE = 256 * MiB;
constexpr size_t WS_YMOE = 292 * MiB;
constexpr size_t WS_END = 364 * MiB;

struct P {
    const float* in[31];
    float* out;
    char* ws;
};

DI float bf2f(bf16_t b) { return __uint_as_float(((unsigned)b) << 16); }
DI bf16_t f2bf(float f) { unsigned u = __float_as_uint(f); u += 0x7fffu + ((u >> 16) & 1u); return (bf16_t)(u >> 16); }
DI unsigned pk2(float lo, float hi) { unsigned r; asm("v_cvt_pk_bf16_f32 %0, %1, %2" : "=v"(r) : "v"(lo), "v"(hi)); return r; }
DI float wave_sum(float v) {
#pragma unroll
    for (int o = 32; o > 0; o >>= 1) v += __shfl_xor(v, o);
    return v;
}
DI float sigmoidf_(float x) { return 1.0f / (1.0f + expf(-x)); }
DI s16x4 tr_read(const LAS char* p) {
    typedef short v4i16_t __attribute__((ext_vector_type(4)));
    return __builtin_bit_cast(s16x4, __builtin_amdgcn_ds_read_tr16_b64_v4i16((LAS v4i16_t*)p));
}

constexpr int BK = 32, A_PITCH = 80, B_PITCH = 320, SA_BYTES = 128 * A_PITCH, SB_BYTES = BK * B_PITCH;
constexpr int GEMM_LDS = 2 * SA_BYTES + 2 * SB_BYTES;

template <class Epi>
DI void gemm_tile(const bf16_t* a0, const bf16_t* a1, const float* b0, size_t ldb, int KT, char* lds_generic, const Epi& epi) {
    LAS char* lds = (LAS char*)lds_generic;
    const int t = threadIdx.x, lane = t & 63, w = t >> 6, wm = w >> 1, wn = w & 1;
    const int r = lane & 31, h = lane >> 5;
    const int i16 = lane & 15, q = i16 >> 2, pp = i16 & 3, blk = (lane >> 4) & 1;
    const int arow = t >> 2, akc = t & 3, bk = t >> 5, bn4 = t & 31;
    f32x16 acc[2][2];
#pragma unroll
    for (int i = 0; i < 2; ++i)
#pragma unroll
        for (int j = 0; j < 2; ++j)
#pragma unroll
            for (int e = 0; e < 16; ++e) acc[i][j][e] = 0.f;
    u32x4 ra0, ra1; float4 rb[4];
    auto gload = [&](int kt) {
        ra0 = *(const u32x4*)(a0 + kt * BK);
        ra1 = *(const u32x4*)(a1 + kt * BK);
#pragma unroll
        for (int i = 0; i < 4; ++i) rb[i] = *(const float4*)(b0 + (size_t)(kt * BK + i * 8) * ldb);
    };
    auto sstore = [&](int buf) {
        LAS char* sA = lds + buf * SA_BYTES; LAS char* sB = lds + 2 * SA_BYTES + buf * SB_BYTES;
        *(LAS u32x4*)(sA + arow * A_PITCH + akc * 16) = ra0;
        *(LAS u32x4*)(sA + (arow + 64) * A_PITCH + akc * 16) = ra1;
#pragma unroll
        for (int i = 0; i < 4; ++i) {
            u32x2 v; v.x = pk2(rb[i].x, rb[i].y); v.y = pk2(rb[i].z, rb[i].w);
            *(LAS u32x2*)(sB + (bk + 8 * i) * B_PITCH + bn4 * 8) = v;
        }
    };
    auto compute = [&](int buf) {
        const LAS char* sA = lds + buf * SA_BYTES; const LAS char* sB = lds + 2 * SA_BYTES + buf * SB_BYTES;
#pragma unroll
        for (int ks = 0; ks < 2; ++ks) {
            bf16x8 af[2], bfr[2];
#pragma unroll
            for (int tm = 0; tm < 2; ++tm) af[tm] = *(const LAS bf16x8*)(sA + (wm * 64 + tm * 32 + r) * A_PITCH + (ks * 16 + 8 * h) * 2);
#pragma unroll
            for (int tn = 0; tn < 2; ++tn) {
                const LAS char* pb = sB + (ks * 16 + 8 * h + q) * B_PITCH + (wn * 64 + tn * 32 + 16 * blk) * 2 + 8 * pp;
                s16x4 lo = tr_read(pb), hi = tr_read(pb + 4 * B_PITCH);
                bfr[tn] = __builtin_shufflevector(lo, hi, 0, 1, 2, 3, 4, 5, 6, 7);
            }
#pragma unroll
            for (int tm = 0; tm < 2; ++tm)
#pragma unroll
                for (int tn = 0; tn < 2; ++tn) acc[tm][tn] = __builtin_amdgcn_mfma_f32_32x32x16_bf16(bfr[tn], af[tm], acc[tm][tn], 0, 0, 0);
        }
    };
    gload(0); sstore(0); __syncthreads();
    for (int kt = 0; kt < KT; ++kt) {
        if (kt + 1 < KT) gload(kt + 1);
        compute(kt & 1);
        if (kt + 1 < KT) sstore((kt + 1) & 1);
        __syncthreads();
    }
    epi(acc, wm, wn, r, h);
}
struct EpiBf16 {
    bf16_t* out; size_t ld;
    DI void operator()(const f32x16 (&acc)[2][2], int wm, int wn, int r, int h) const {
#pragma unroll
        for (int tm = 0; tm < 2; ++tm) {
            bf16_t* rp = out + (size_t)(wm * 64 + tm * 32 + r) * ld + wn * 64 + 4 * h;
#pragma unroll
            for (int tn = 0; tn < 2; ++tn)
#pragma unroll
                for (int g = 0; g < 4; ++g) {
                    u32x2 v; v.x = pk2(acc[tm][tn][4 * g], acc[tm][tn][4 * g + 1]); v.y = pk2(acc[tm][tn][4 * g + 2], acc[tm][tn][4 * g + 3]);
                    *(u32x2*)(rp + tn * 32 + 8 * g) = v;
                }
        }
    }
};
struct EpiResid {
    float* out; const float* res; size_t ld;
    DI void operator()(const f32x16 (&acc)[2][2], int wm, int wn, int r, int h) const {
#pragma unroll
        for (int tm = 0; tm < 2; ++tm) {
            const size_t o = (size_t)(wm * 64 + tm * 32 + r) * ld + wn * 64 + 4 * h;
#pragma unroll
            for (int tn = 0; tn < 2; ++tn)
#pragma unroll
                for (int g = 0; g < 4; ++g) {
                    float4 x = *(const float4*)(res + o + tn * 32 + 8 * g);
                    x.x += acc[tm][tn][4 * g]; x.y += acc[tm][tn][4 * g + 1]; x.z += acc[tm][tn][4 * g + 2]; x.w += acc[tm][tn][4 * g + 3];
                    *(float4*)(out + o + tn * 32 + 8 * g) = x;
                }
        }
    }
};
DI float silu_mul(float g, float u) { return g / (1.0f + __expf(-g)) * u; }
struct EpiGateUp {
    bf16_t* out;
    DI void operator()(const f32x16 (&acc)[2][2], int wm, int wn, int r, int h) const {
#pragma unroll
        for (int tm = 0; tm < 2; ++tm) {
            bf16_t* rp = out + (size_t)(wm * 64 + tm * 32 + r) * DE + wn * 32 + 4 * h;
#pragma unroll
            for (int g = 0; g < 4; ++g) {
                u32x2 v;
                v.x = pk2(silu_mul(acc[tm][0][4 * g], acc[tm][1][4 * g]), silu_mul(acc[tm][0][4 * g + 1], acc[tm][1][4 * g + 1]));
                v.y = pk2(silu_mul(acc[tm][0][4 * g + 2], acc[tm][1][4 * g + 2]), silu_mul(acc[tm][0][4 * g + 3], acc[tm][1][4 * g + 3]));
                *(u32x2*)(rp + 8 * g) = v;
            }
        }
    }
};
struct EpiDown {
    bf16_t* out; const float* roww; int nvalid;
    DI void operator()(const f32x16 (&acc)[2][2], int wm, int wn, int r, int h) const {
#pragma unroll
        for (int tm = 0; tm < 2; ++tm) {
            const int row = wm * 64 + tm * 32 + r;
            const float wv = row < nvalid ? roww[row] : 0.f;
            bf16_t* rp = out + (size_t)row * DM + wn * 64 + 4 * h;
#pragma unroll
            for (int tn = 0; tn < 2; ++tn)
#pragma unroll
                for (int g = 0; g < 4; ++g) {
                    u32x2 v; v.x = pk2(acc[tm][tn][4 * g] * wv, acc[tm][tn][4 * g + 1] * wv); v.y = pk2(acc[tm][tn][4 * g + 2] * wv, acc[tm][tn][4 * g + 3] * wv);
                    *(u32x2*)(rp + tn * 32 + 8 * g) = v;
                }
        }
    }
};

DI void moe_prefix(const int* cnt, int* stp  ) {
    __syncthreads();
    if (threadIdx.x == 0) { int a = 0; for (int e = 0; e < NE; ++e) { stp[e] = a; a += (cnt[e] + 127) >> 7; } stp[NE] = a; }
    __syncthreads();
}

__device__ void phase_norm1(const P& p, int l, char* lds) {
    const int lane = threadIdx.x & 63;
    const int gw = blockIdx.x * 4 + (threadIdx.x >> 6), nw = gridDim.x * 4;
    float* xres = (float*)(p.ws + WS_XRES);
    bf16_t* hbuf = (bf16_t*)(p.ws + WS_HBUF);
    float* gates = (float*)(p.ws + WS_GATES);
    const float* g1 = p.in[1] + l * DM;
    const float* win = p.in[2] + (size_t)l * DM * DIN;
    int* stp = (int*)lds;
    const bf16_t* ymoe = (const bf16_t*)(p.ws + WS_YMOE);
    const int4* tinfo = (const int4*)(p.ws + WS_TINFO);
    if (l > 0) moe_prefix((const int*)(p.ws + WS_CTL) + (l - 1) * NE, stp);
    for (int row = gw; row < T; row += nw) {
        float4 v[4];
        const float* xs = (l == 0) ? p.in[0] + (size_t)row * DM : xres + (size_t)row * DM;
#pragma unroll
        for (int i = 0; i < 4; ++i) v[i] = *(const float4*)(xs + i * 256 + lane * 4);
        if (l > 0) {
            int4 ti = tinfo[row];
            const bf16_t* y0 = ymoe + (size_t)(stp[ti.x] * 128 + ti.y) * DM;
            const bf16_t* y1 = ymoe + (size_t)(stp[ti.z] * 128 + ti.w) * DM;
#pragma unroll
            for (int i = 0; i < 4; ++i) {
                uint2 a = *(const uint2*)(y0 + i * 256 + lane * 4), b = *(const uint2*)(y1 + i * 256 + lane * 4);
                v[i].x += bf2f(a.x & 0xffff) + bf2f(b.x & 0xffff); v[i].y += bf2f(a.x >> 16) + bf2f(b.x >> 16);
                v[i].z += bf2f(a.y & 0xffff) + bf2f(b.y & 0xffff); v[i].w += bf2f(a.y >> 16) + bf2f(b.y >> 16);
                *(float4*)(xres + (size_t)row * DM + i * 256 + lane * 4) = v[i];
            }
        }
        float ss = 0.f;
#pragma unroll
        for (int i = 0; i < 4; ++i) ss += v[i].x * v[i].x + v[i].y * v[i].y + v[i].z * v[i].z + v[i].w * v[i].w;
        ss = wave_sum(ss);
        const float rstd = rsqrtf(ss * (1.0f / DM) + EPS);
        float gd[8];
#pragma unroll
        for (int j = 0; j < 8; ++j) gd[j] = 0.f;
#pragma unroll
        for (int i = 0; i < 4; ++i) {
            const int k0 = i * 256 + lane * 4;
            float4 g = *(const float4*)(g1 + k0);
            float hv[4] = {v[i].x * rstd * g.x, v[i].y * rstd * g.y, v[i].z * rstd * g.z, v[i].w * rstd * g.w};
            uint2 o; o.x = pk2(hv[0], hv[1]); o.y = pk2(hv[2], hv[3]);
            *(uint2*)(hbuf + (size_t)row * DM + k0) = o;
#pragma unroll
            for (int e = 0; e < 4; ++e) {
                const float* wr = win + (size_t)(k0 + e) * DIN + 1024;
                float4 w0 = *(const float4*)wr, w1 = *(const float4*)(wr + 4);
                gd[0] += hv[e] * w0.x; gd[1] += hv[e] * w0.y; gd[2] += hv[e] * w0.z; gd[3] += hv[e] * w0.w;
                gd[4] += hv[e] * w1.x; gd[5] += hv[e] * w1.y; gd[6] += hv[e] * w1.z; gd[7] += hv[e] * w1.w;
            }
        }
#pragma unroll
        for (int j = 0; j < 8; ++j) gd[j] = wave_sum(gd[j]);
        if (lane == 0) {
            const float* bi = p.in[3] + l * 4; const float* bf = p.in[4] + l * 4;
            float4 o0 = {gd[0] + bi[0], gd[1] + bi[1], gd[2] + bi[2], gd[3] + bi[3]};
            float4 o1 = {gd[4] + bf[0], gd[5] + bf[1], gd[6] + bf[2], gd[7] + bf[3]};
            *(float4*)(gates + (size_t)row * 8) = o0; *(float4*)(gates + (size_t)row * 8 + 4) = o1;
        }
    }
}

__device__ void phase_inproj(const P& p, int l, char* lds) {
    const int t = threadIdx.x;
    const bf16_t* hbuf = (const bf16_t*)(p.ws + WS_HBUF);
    bf16_t* projb = (bf16_t*)(p.ws + WS_PROJ);
    const float* win = p.in[2] + (size_t)l * DM * DIN;
    for (int tile = blockIdx.x; tile < 128 * 22; tile += gridDim.x) {
        const int mt = tile / 22, vt = tile % 22;
        const int acol = vt < 8 ? vt * 128 : (vt < 20 ? 1032 + (vt - 8) * 128 : 2568 + (vt - 20) * 128);
        const bf16_t* a0 = hbuf + (size_t)(mt * 128 + (t >> 2)) * DM + (t & 3) * 8;
        const float* b0 = win + (size_t)(t >> 5) * DIN + acol + (t & 31) * 4;
        EpiBf16 epi{projb + (size_t)mt * 128 * PJ + vt * 128, (size_t)PJ};
        gemm_tile(a0, a0 + (size_t)64 * DM, b0, DIN, DM / BK, lds, epi);
    }
}

__constant__ float ROPE_INV_REV[8] = {0.15915494309189535f, 0.03086376340470123f, 0.005985185712713705f, 0.001160663641240061f,
                                      0.00022507907903927653f, 4.364795279280289e-05f, 8.464330808241401e-06f, 1.6414262627950345e-06f};
DI void load64(const bf16_t* ptr, float (&x)[64]) {
#pragma unroll
    for (int c = 0; c < 8; ++c) {
        u32x4 u = *(const u32x4*)(ptr + c * 8);
        x[c * 8 + 0] = bf2f(u.x & 0xffff); x[c * 8 + 1] = bf2f(u.x >> 16); x[c * 8 + 2] = bf2f(u.y & 0xffff); x[c * 8 + 3] = bf2f(u.y >> 16);
        x[c * 8 + 4] = bf2f(u.z & 0xffff); x[c * 8 + 5] = bf2f(u.z >> 16); x[c * 8 + 6] = bf2f(u.w & 0xffff); x[c * 8 + 7] = bf2f(u.w >> 16);
    }
}
DI void store64(bf16_t* ptr, const float (&x)[64], float sc) {
#pragma unroll
    for (int c = 0; c < 8; ++c) {
        u32x4 u;
        u.x = pk2(x[c * 8 + 0] * sc, x[c * 8 + 1] * sc); u.y = pk2(x[c * 8 + 2] * sc, x[c * 8 + 3] * sc);
        u.z = pk2(x[c * 8 + 4] * sc, x[c * 8 + 5] * sc); u.w = pk2(x[c * 8 + 6] * sc, x[c * 8 + 7] * sc);
        *(u32x4*)(ptr + c * 8) = u;
    }
}
DI void norm_rope64(float (&x)[64], const float* g, int pos) {
    float ss = 0.f;
#pragma unroll
    for (int d = 0; d < 64; ++d) ss += x[d] * x[d];
    const float rstd = rsqrtf(ss * (1.0f / 64.0f) + EPS);
#pragma unroll
    for (int d = 0; d < 64; ++d) x[d] = x[d] * rstd * g[d];
#pragma unroll
    for (int d = 0; d < 8; ++d) {
        double rr = (double)pos * (double)ROPE_INV_REV[d];
        rr -= floor(rr);
        const float sn = __builtin_amdgcn_sinf((float)rr), cs = __builtin_amdgcn_cosf((float)rr);
        const float x1 = x[d], x2 = x[d + 8];
        x[d] = x1 * cs - x2 * sn; x[d + 8] = x2 * cs + x1 * sn;
    }
}
__device__ void phase_qkprep(const P& p, int l, char* lds) {
    bf16_t* projb = (bf16_t*)(p.ws + WS_PROJ);
    float* kmean = (float*)(p.ws + WS_KMEAN);
    float* red = (float*)lds;
    const int t = threadIdx.x, lane = t & 63, w = t >> 6;
    for (int item = blockIdx.x; item < 512; item += gridDim.x) {
        const int b = item >> 6, n = (item >> 3) & 7, hd = item & 7;
        const int pos = n * 256 + t;
        bf16_t* rowp = projb + ((size_t)b * SEQ + pos) * PJ + hd * 64;
        float x[64];
        load64(rowp + C_AQ, x);
        norm_rope64(x, p.in[8] + l * 64, pos);
        store64(rowp + C_AQ, x, 0.125f * 1.4426950408889634f);
        load64(rowp + C_AK, x);
        norm_rope64(x, p.in[9] + l * 64, pos);
        store64(rowp + C_AK, x, 1.0f);
        __syncthreads();
#pragma unroll
        for (int d = 0; d < 64; ++d) { const float v = wave_sum(x[d]); if (lane == (d & 63)) red[w * 64 + d] = v; }
        __syncthreads();
        if (t < 64) kmean[(size_t)item * 64 + t] = (red[t] + red[64 + t] + red[128 + t] + red[192 + t]) * (1.0f / 256.0f);
    }
}

__device__ void mlstm_item_simple(const P& p, int l, int item, float* sm) {
    const int b = item >> 4, hd = (item >> 2) & 3, dq = item & 3;
    const int t = threadIdx.x;
    const bf16_t* projb = (const bf16_t*)(p.ws + WS_PROJ);
    const float* gates = (const float*)(p.ws + WS_GATES);
    float* hraw = (float*)(p.ws + WS_HRAW);
    const float* cw = p.in[5] + l * 4 * 512; const float* cb = p.in[6] + l * 512;
    float* Q = sm; float* K = Q + 64 * 65; float* Sm = K + 64 * 65; float* V = Sm + 64 * 65; float* C = V + 64 * 16; float* nv = C + 64 * 16;
    float* bc = nv + 64; float* Mt = bc + 64; float* uu = Mt + 64; float* den = uu + 64; float* misc = den + 64;
    __syncthreads();
    for (int i = t; i < 1024; i += 256) C[i] = 0.f;
    if (t < 64) nv[t] = 0.f;
    if (t == 0) misc[0] = 0.f;
    for (int c = 0; c < 32; ++c) {
        __syncthreads();
        const int row0 = b * SEQ + c * 64;
        for (int i = t; i < 8192; i += 256) {
            const int which = i >> 12, tt = (i >> 6) & 63, d = i & 63, ch = which * 256 + hd * 64 + d;
            float a = cb[ch];
#pragma unroll
            for (int j = 0; j < 4; ++j) { const int ts = c * 64 + tt + j - 3; if (ts >= 0) a += bf2f(projb[(size_t)(b * SEQ + ts) * PJ + ch]) * cw[j * 512 + ch]; }
            float y = a / (1.0f + expf(-a));
            if (which) K[tt * 65 + d] = y * 0.125f; else Q[tt * 65 + d] = y;
        }
        for (int i = t; i < 1024; i += 256) { const int tt = i >> 4, d = i & 15; V[i] = bf2f(projb[(size_t)(row0 + tt) * PJ + C_MV + hd * 64 + dq * 16 + d]); }
        if (t < 64) {
            const float ig = gates[(size_t)(row0 + t) * 8 + hd], fg = gates[(size_t)(row0 + t) * 8 + 4 + hd];
            const float lf = fminf(fg, 0.f) - log1pf(expf(-fabsf(fg)));
            float bs = lf;
#pragma unroll
            for (int o = 1; o < 64; o <<= 1) { float v = __shfl_up(bs, o); if (t >= o) bs += v; }
            const float u = ig - bs; float um = u;
#pragma unroll
            for (int o = 1; o < 64; o <<= 1) { float v = __shfl_up(um, o); if (t >= o) um = fmaxf(um, v); }
            bc[t] = bs; uu[t] = u; Mt[t] = fmaxf(misc[0], um);
        }
        __syncthreads();
        for (int i = t; i < 4096; i += 256) {
            const int tt = i >> 6, s = i & 63; float v = 0.f;
            if (s <= tt) { float dsum = 0.f; for (int d = 0; d < 64; ++d) dsum += Q[tt * 65 + d] * K[s * 65 + d]; v = dsum * expf(uu[s] - Mt[tt]); }
            Sm[tt * 65 + s] = v;
        }
        __syncthreads();
        if (t < 64) {
            const float inter = expf(misc[0] - Mt[t]);
            float qn = 0.f, rs = 0.f;
            for (int d = 0; d < 64; ++d) { qn += Q[t * 65 + d] * nv[d]; rs += Sm[t * 65 + d]; }
            den[t] = fmaxf(fabsf(inter * qn + rs), expf(-(bc[t] + Mt[t])));
        }
        __syncthreads();
        for (int i = t; i < 1024; i += 256) {
            const int tt = i >> 4, d = i & 15;
            const float inter = expf(misc[0] - Mt[tt]);
            float a = 0.f, bsum = 0.f;
            for (int k = 0; k < 64; ++k) { a += Q[tt * 65 + k] * C[k * 16 + d]; bsum += Sm[tt * 65 + k] * V[k * 16 + d]; }
            hraw[(size_t)(row0 + tt) * 256 + hd * 64 + dq * 16 + d] = (inter * a + bsum) / den[tt];
        }
        __syncthreads();
        const float Mlast = Mt[63], decay = expf(misc[0] - Mlast);
        for (int i = t; i < 1024; i += 256) {
            const int dk = i >> 4, d = i & 15; float a = 0.f;
            for (int s = 0; s < 64; ++s) a += expf(uu[s] - Mlast) * K[s * 65 + dk] * V[s * 16 + d];
            C[i] = decay * C[i] + a;
        }
        if (t < 64) { float a = 0.f; for (int s = 0; s < 64; ++s) a += expf(uu[s] - Mlast) * K[s * 65 + t]; nv[t] = decay * nv[t] + a; }
        __syncthreads();
        if (t == 0) misc[0] = bc[63] + Mlast;
    }
}

constexpr int KP = 144, VP = 192, ATT_K_BYTES = 64 * KP, ATT_BUF = 64 * KP + 64 * VP;
DI float half_swap_max(float m) {
    auto rr = __builtin_amdgcn_permlane32_swap(__float_as_uint(m), __float_as_uint(m), false, false);
    return fmaxf(__uint_as_float(rr[0]), __uint_as_float(rr[1]));
}
DI float half_swap_sum(float m) {
    auto rr = __builtin_amdgcn_permlane32_swap(__float_as_uint(m), __float_as_uint(m), false, false);
    return __uint_as_float(rr[0]) + __uint_as_float(rr[1]);
}
__device__ void moba_item(const P& p, int l, int item, char* lds_generic) {
    LAS char* lds = (LAS char*)lds_generic;
    const int b = item >> 7, hd = (item >> 4) & 7, qt = item & 15, qb = qt >> 1;
    const int t = threadIdx.x, lane = t & 63, w = t >> 6, r = lane & 31, h = lane >> 5;
    const int i16 = lane & 15, q4 = i16 >> 2, pp = i16 & 3, blk = (lane >> 4) & 1;
    const bf16_t* projb = (const bf16_t*)(p.ws + WS_PROJ);
    bf16_t* mix = (bf16_t*)(p.ws + WS_MIX);
    const float* kmean = (const float*)(p.ws + WS_KMEAN);
    const size_t rowb = (size_t)b * SEQ;
    const int q0 = qt * 128, qpos = q0 + w * 32 + r;
    bf16x8 qf[4];
    {
        const bf16_t* qp = projb + (rowb + qpos) * PJ + C_AQ + hd * 64 + 8 * h;
#pragma unroll
        for (int ks = 0; ks < 4; ++ks) qf[ks] = *(const bf16x8*)(qp + ks * 16);
    }
    unsigned mask = 0;
    {
        float gate[8];
#pragma unroll
        for (int n = 0; n < 8; ++n) {
            float sacc = 0.f;
            if (n < qb) {
                const float* km = kmean + ((size_t)((b * 8 + n) * 8 + hd)) * 64 + 8 * h;
#pragma unroll
                for (int ks = 0; ks < 4; ++ks)
#pragma unroll
                    for (int j = 0; j < 8; ++j) sacc += bf2f((bf16_t)qf[ks][j]) * km[ks * 16 + j];
            }
            gate[n] = half_swap_sum(sacc);
        }
#pragma unroll
        for (int it = 0; it < 3; ++it) {
            int best = -1; float bv = -INFINITY;
#pragma unroll
            for (int n = 0; n < 8; ++n) if (n < qb && !((mask >> n) & 1u) && gate[n] > bv) { bv = gate[n]; best = n; }
            if (best >= 0) mask |= 1u << best;
        }
    }
    const int nown = ((q0 & 255) >> 6) + 2, ntiles = nown + qb * 4;
    f32x16 o0, o1;
#pragma unroll
    for (int e = 0; e < 16; ++e) { o0[e] = 0.f; o1[e] = 0.f; }
    float m = -INFINITY, lsum = 0.f;
    const int srow = t >> 3, sc16 = t & 7;
    u32x4 rk0, rk1, rv0, rv1;
    auto key0_of = [&](int it) { return it < nown ? qb * 256 + it * 64 : ((it - nown) >> 2) * 256 + ((it - nown) & 3) * 64; };
    auto gload = [&](int it) {
        const int key0 = key0_of(it);
        const bf16_t* base = projb + (rowb + key0 + srow) * PJ + hd * 64 + sc16 * 8;
        rk0 = *(const u32x4*)(base + C_AK); rk1 = *(const u32x4*)(base + (size_t)32 * PJ + C_AK);
        rv0 = *(const u32x4*)(base + C_AV); rv1 = *(const u32x4*)(base + (size_t)32 * PJ + C_AV);
    };
    auto sstore = [&](int buf) {
        LAS char* sK = lds + buf * ATT_BUF; LAS char* sV = sK + ATT_K_BYTES;
        *(LAS u32x4*)(sK + srow * KP + sc16 * 16) = rk0; *(LAS u32x4*)(sK + (srow + 32) * KP + sc16 * 16) = rk1;
        *(LAS u32x4*)(sV + srow * VP + sc16 * 16) = rv0; *(LAS u32x4*)(sV + (srow + 32) * VP + sc16 * 16) = rv1;
    };
    __syncthreads();
    gload(0); sstore(0); __syncthreads();
    for (int it = 0; it < ntiles; ++it) {
        if (it + 1 < ntiles) gload(it + 1);
        {
            const LAS char* sK = lds + (it & 1) * ATT_BUF; const LAS char* sV = sK + ATT_K_BYTES;
            const int key0 = key0_of(it), blockn = key0 >> 8;
            f32x16 s0, s1;
#pragma unroll
            for (int e = 0; e < 16; ++e) { s0[e] = 0.f; s1[e] = 0.f; }
#pragma unroll
            for (int ks = 0; ks < 4; ++ks) {
                const bf16x8 k0 = *(const LAS bf16x8*)(sK + r * KP + (ks * 16 + 8 * h) * 2);
                const bf16x8 k1 = *(const LAS bf16x8*)(sK + (32 + r) * KP + (ks * 16 + 8 * h) * 2);
                s0 = __builtin_amdgcn_mfma_f32_32x32x16_bf16(k0, qf[ks], s0, 0, 0, 0);
                s1 = __builtin_amdgcn_mfma_f32_32x32x16_bf16(k1, qf[ks], s1, 0, 0, 0);
            }
            const bool own = (blockn == qb);
            const bool active = own || ((mask >> blockn) & 1u);
            if (!active) {
#pragma unroll
                for (int e = 0; e < 16; ++e) { s0[e] = -INFINITY; s1[e] = -INFINITY; }
            } else if (own && key0 + 63 > q0 + w * 32) {
#pragma unroll
                for (int e = 0; e < 16; ++e) {
                    const int kk = key0 + (e & 3) + 8 * (e >> 2) + 4 * h;
                    if (kk > qpos) s0[e] = -INFINITY;
                    if (kk + 32 > qpos) s1[e] = -INFINITY;
                }
            }
            float mx = fmaxf(s0[0], s1[0]);
#pragma unroll
            for (int e = 1; e < 16; ++e) mx = fmaxf(mx, fmaxf(s0[e], s1[e]));
            mx = half_swap_max(mx);
            const float mn = fmaxf(m, mx);
            const float alpha = __builtin_amdgcn_exp2f(m - mn);
            m = mn;
            float ps = 0.f;
#pragma unroll
            for (int e = 0; e < 16; ++e) { s0[e] = __builtin_amdgcn_exp2f(s0[e] - mn); s1[e] = __builtin_amdgcn_exp2f(s1[e] - mn); ps += s0[e] + s1[e]; }
            lsum = lsum * alpha + ps;
#pragma unroll
            for (int e = 0; e < 16; ++e) { o0[e] *= alpha; o1[e] *= alpha; }
#pragma unroll
            for (int st = 0; st < 2; ++st)
#pragma unroll
                for (int sk = 0; sk < 2; ++sk) {
                    u32x4 pk;
                    if (st == 0) { pk.x = pk2(s0[8 * sk], s0[8 * sk + 1]); pk.y = pk2(s0[8 * sk + 2], s0[8 * sk + 3]); pk.z = pk2(s0[8 * sk + 4], s0[8 * sk + 5]); pk.w = pk2(s0[8 * sk + 6], s0[8 * sk + 7]); }
                    else         { pk.x = pk2(s1[8 * sk], s1[8 * sk + 1]); pk.y = pk2(s1[8 * sk + 2], s1[8 * sk + 3]); pk.z = pk2(s1[8 * sk + 4], s1[8 * sk + 5]); pk.w = pk2(s1[8 * sk + 6], s1[8 * sk + 7]); }
                    const bf16x8 pf = __builtin_bit_cast(bf16x8, pk);
                    const LAS char* vb = sV + (st * 32 + sk * 16 + 4 * h + q4) * VP + (16 * blk) * 2 + 8 * pp;
                    {
                        s16x4 lo = tr_read(vb), hi = tr_read(vb + 8 * VP);
                        const bf16x8 vf = __builtin_shufflevector(lo, hi, 0, 1, 2, 3, 4, 5, 6, 7);
                        o0 = __builtin_amdgcn_mfma_f32_32x32x16_bf16(vf, pf, o0, 0, 0, 0);
                    }
                    {
                        s16x4 lo = tr_read(vb + 64), hi = tr_read(vb + 64 + 8 * VP);
                        const bf16x8 vf = __builtin_shufflevector(lo, hi, 0, 1, 2, 3, 4, 5, 6, 7);
                        o1 = __builtin_amdgcn_mfma_f32_32x32x16_bf16(vf, pf, o1, 0, 0, 0);
                    }
                }
        }
        if (it + 1 < ntiles) sstore((it + 1) & 1);
        __syncthreads();
    }
    const float il = 1.0f / half_swap_sum(lsum);
    float ss = 0.f;
#pragma unroll
    for (int e = 0; e < 16; ++e) { o0[e] *= il; o1[e] *= il; ss += o0[e] * o0[e] + o1[e] * o1[e]; }
    ss = half_swap_sum(ss);
    const float rstd = rsqrtf(ss * (1.0f / 64.0f) + EPS);
    const float* og = p.in[10] + (l * 8 + hd) * 64 + 4 * h;
    bf16_t* op = mix + (rowb + qpos) * DM + 256 + hd * 64 + 4 * h;
#pragma unroll
    for (int g = 0; g < 4; ++g) {
        const float4 g0 = *(const float4*)(og + 8 * g), g1 = *(const float4*)(og + 32 + 8 * g);
        u32x2 v0, v1;
        v0.x = pk2(o0[4 * g] * rstd * g0.x, o0[4 * g + 1] * rstd * g0.y); v0.y = pk2(o0[4 * g + 2] * rstd * g0.z, o0[4 * g + 3] * rstd * g0.w);
        v1.x = pk2(o1[4 * g] * rstd * g1.x, o1[4 * g + 1] * rstd * g1.y); v1.y = pk2(o1[4 * g + 2] * rstd * g1.z, o1[4 * g + 3] * rstd * g1.w);
        *(u32x2*)(op + 8 * g) = v0; *(u32x2*)(op + 32 + 8 * g) = v1;
    }
}

__device__ void s5_item_simple(const P& p, int l, int item, float* sm) {
    const int t = threadIdx.x, lane = t & 63, w = t >> 6;
    const int bg = item * 4 + w, b = bg >> 4, g = bg & 15;
    const bf16_t* projb = (const bf16_t*)(p.ws + WS_PROJ);
    float* zbuf = (float*)(p.ws + WS_ZBUF);
    float* xr = sm + w * (2 * 16 * 65); float* xi = xr + 16 * 65;
    const int lg = l * 16 + g;
    const float lr = p.in[11][lg * 64 + lane], li = p.in[12][lg * 64 + lane];
    const float dt = expf(p.in[18][lg]);
    const float mag = expf(lr * dt);
    const float are = mag * cosf(li * dt), aim = mag * sinf(li * dt);
    const float zr = are - 1.0f, zi = aim, dn = lr * lr + li * li;
    const float fr = (zr * lr + zi * li) / dn, fi = (zi * lr - zr * li) / dn;
    float bbr[16], bbi[16];
#pragma unroll
    for (int hh = 0; hh < 16; ++hh) {
        const float br = p.in[13][((size_t)lg * 64 + lane) * 16 + hh], bi = p.in[14][((size_t)lg * 64 + lane) * 16 + hh];
        bbr[hh] = fr * br - fi * bi; bbi[hh] = fr * bi + fi * br;
    }
    const float* cre = p.in[15] + (size_t)lg * 16 * 64; const float* cim = p.in[16] + (size_t)lg * 16 * 64;
    const float* dd = p.in[17] + lg * 16;
    float sr = 0.f, si = 0.f;
    __syncthreads();
    for (int c = 0; c < SEQ / 16; ++c) {
        const size_t row0 = (size_t)b * SEQ + c * 16;
        for (int tt = 0; tt < 16; ++tt) {
            const bf16_t* up = projb + (row0 + tt) * PJ + C_SU + g * 16;
            uint4 u0 = *(const uint4*)up, u1 = *(const uint4*)(up + 8);
            float u[16] = {bf2f(u0.x & 0xffff), bf2f(u0.x >> 16), bf2f(u0.y & 0xffff), bf2f(u0.y >> 16), bf2f(u0.z & 0xffff), bf2f(u0.z >> 16), bf2f(u0.w & 0xffff), bf2f(u0.w >> 16),
                           bf2f(u1.x & 0xffff), bf2f(u1.x >> 16), bf2f(u1.y & 0xffff), bf2f(u1.y >> 16), bf2f(u1.z & 0xffff), bf2f(u1.z >> 16), bf2f(u1.w & 0xffff), bf2f(u1.w >> 16)};
            float br = 0.f, bi = 0.f;
#pragma unroll
            for (int hh = 0; hh < 16; ++hh) { br += bbr[hh] * u[hh]; bi += bbi[hh] * u[hh]; }
            const float nr = are * sr - aim * si + br, ni = are * si + aim * sr + bi;
            sr = nr; si = ni;
            xr[tt * 65 + lane] = sr; xi[tt * 65 + lane] = si;
        }
        __syncthreads();
        {
            const int tt = lane >> 2, hq = lane & 3;
            float y[4] = {0.f, 0.f, 0.f, 0.f};
            for (int pp = 0; pp < 64; ++pp) {
                const float a = xr[tt * 65 + pp], bq = xi[tt * 65 + pp];
#pragma unroll
                for (int j = 0; j < 4; ++j) y[j] += cre[(hq * 4 + j) * 64 + pp] * a - cim[(hq * 4 + j) * 64 + pp] * bq;
            }
#pragma unroll
            for (int j = 0; j < 4; ++j) {
                const int hh = hq * 4 + j;
                float v = y[j] + dd[hh] * bf2f(projb[(row0 + tt) * PJ + C_SU + g * 16 + hh]);
                const float inner = 0.7978845608028654f * (v + 0.044715f * v * v * v);
                const float th = 1.0f - 2.0f / (expf(2.0f * inner) + 1.0f);
                zbuf[(row0 + tt) * 256 + g * 16 + hh] = 0.5f * v * (1.0f + th);
            }
        }
        __syncthreads();
    }
}

__device__ void phase_mix(const P& p, int l, char* lds) {
    for (int item = blockIdx.x; item < 128 + 32 + 1024; item += gridDim.x) {
        if (item < 128) mlstm_item_simple(p, l, item, (float*)lds);
        else if (item < 160) s5_item_simple(p, l, item - 128, (float*)lds);
        else {
            const int i2 = item - 160;
            const int qo = i2 >> 6, bh = i2 & 63;
            moba_item(p, l, (bh << 4) | (15 - qo), lds);
        }
    }
}

__device__ void phase_glu(const P& p, int l, char* lds) {
    const int t = threadIdx.x;
    const bf16_t* projb = (const bf16_t*)(p.ws + WS_PROJ);
    bf16_t* mix = (bf16_t*)(p.ws + WS_MIX);
    const float* zbuf = (const float*)(p.ws + WS_ZBUF);
    const float* hraw = (const float*)(p.ws + WS_HRAW);
    const float* gw = p.in[19] + (size_t)l * 256 * 256; const float* gb = p.in[20] + l * 256;
    const float* sg = p.in[21] + l * 256; const float* mg = p.in[7] + l * 256;
    float* zs = (float*)lds; float* ys = zs + 16 * 256;
    for (int tile = blockIdx.x; tile < T / 16; tile += gridDim.x) {
        const size_t row0 = (size_t)tile * 16;
        __syncthreads();
        for (int i = t; i < 4096; i += 256) zs[i] = zbuf[row0 * 256 + i];
        __syncthreads();
        float a[16];
#pragma unroll
        for (int r = 0; r < 16; ++r) a[r] = gb[t];
        for (int k = 0; k < 256; ++k) {
            const float wv = gw[k * 256 + t];
#pragma unroll
            for (int r = 0; r < 16; ++r) a[r] += zs[r * 256 + k] * wv;
        }
#pragma unroll
        for (int r = 0; r < 16; ++r) ys[r * 256 + t] = zs[r * 256 + t] * sigmoidf_(a[r]);
        __syncthreads();
        {
            const int r = t >> 4, g = t & 15; float ss = 0.f;
#pragma unroll
            for (int hh = 0; hh < 16; ++hh) { const float v = ys[r * 256 + g * 16 + hh]; ss += v * v; }
            const float rstd = rsqrtf(ss * (1.0f / 16.0f) + EPS);
#pragma unroll
            for (int hh = 0; hh < 16; ++hh) mix[(row0 + r) * DM + 768 + g * 16 + hh] = f2bf(ys[r * 256 + g * 16 + hh] * rstd * sg[g * 16 + hh]);
        }
        {
            const int pr = t >> 2, qd = t & 3, r = pr >> 2, hd = pr & 3;
            const float* hp = hraw + (row0 + r) * 256 + hd * 64 + qd * 16;
            float v[16]; float ss = 0.f;
#pragma unroll
            for (int d = 0; d < 16; ++d) { v[d] = hp[d]; ss += v[d] * v[d]; }
            ss += __shfl_xor(ss, 1); ss += __shfl_xor(ss, 2);
            const float rstd = rsqrtf(ss * (1.0f / 64.0f) + EPS);
#pragma unroll
            for (int d = 0; d < 16; ++d) {
                const int col = hd * 64 + qd * 16 + d;
                const float o = bf2f(projb[(row0 + r) * PJ + C_MO + col]);
                mix[(row0 + r) * DM + col] = f2bf(v[d] * rstd * mg[col] * sigmoidf_(o));
            }
        }
    }
}

__device__ void phase_outproj(const P& p, int l, char* lds) {
    const int t = threadIdx.x;
    const bf16_t* mix = (const bf16_t*)(p.ws + WS_MIX);
    float* xres = (float*)(p.ws + WS_XRES);
    const float* wout = p.in[22] + (size_t)l * DM * DM;
    const float* xin = (l == 0) ? p.in[0] : xres;
    for (int tile = blockIdx.x; tile < 128 * 8; tile += gridDim.x) {
        const int mt = tile >> 3, nt = tile & 7;
        const bf16_t* a0 = mix + (size_t)(mt * 128 + (t >> 2)) * DM + (t & 3) * 8;
        const float* b0 = wout + (size_t)(t >> 5) * DM + nt * 128 + (t & 31) * 4;
        const size_t o = (size_t)mt * 128 * DM + nt * 128;
        EpiResid epi{xres + o, xin + o, (size_t)DM};
        gemm_tile(a0, a0 + (size_t)64 * DM, b0, DM, DM / BK, lds, epi);
    }
}

__device__ void phase_norm2(const P& p, int l) {
    const int lane = threadIdx.x & 63;
    const int gw = blockIdx.x * 4 + (threadIdx.x >> 6), nw = gridDim.x * 4;
    const float* xres = (const float*)(p.ws + WS_XRES);
    bf16_t* hbuf = (bf16_t*)(p.ws + WS_HBUF);
    const float* g2 = p.in[23] + l * DM;
    const float* wg = p.in[24] + (size_t)l * DM * 4; const float* bg = p.in[25] + l * 4;
    const float* we = p.in[26] + (size_t)l * DM * NE; const float* be = p.in[27] + l * NE;
    int* cnt = (int*)(p.ws + WS_CTL) + l * NE;
    int* tokl = (int*)(p.ws + WS_TOKL); float* wl = (float*)(p.ws + WS_WL); int4* tinfo = (int4*)(p.ws + WS_TINFO);
    for (int row = gw; row < T; row += nw) {
        float4 v[4];
#pragma unroll
        for (int i = 0; i < 4; ++i) v[i] = *(const float4*)(xres + (size_t)row * DM + i * 256 + lane * 4);
        float ss = 0.f;
#pragma unroll
        for (int i = 0; i < 4; ++i) ss += v[i].x * v[i].x + v[i].y * v[i].y + v[i].z * v[i].z + v[i].w * v[i].w;
        ss = wave_sum(ss);
        const float rstd = rsqrtf(ss * (1.0f / DM) + EPS);
        float gl[4] = {0.f, 0.f, 0.f, 0.f};
        float el[32];
#pragma unroll
        for (int j = 0; j < 32; ++j) el[j] = 0.f;
#pragma unroll
        for (int i = 0; i < 4; ++i) {
            const int k0 = i * 256 + lane * 4;
            float4 g = *(const float4*)(g2 + k0);
            float hv[4] = {v[i].x * rstd * g.x, v[i].y * rstd * g.y, v[i].z * rstd * g.z, v[i].w * rstd * g.w};
            uint2 o; o.x = pk2(hv[0], hv[1]); o.y = pk2(hv[2], hv[3]);
            *(uint2*)(hbuf + (size_t)row * DM + k0) = o;
#pragma unroll
            for (int e = 0; e < 4; ++e) {
                float4 w4 = *(const float4*)(wg + (size_t)(k0 + e) * 4);
                gl[0] += hv[e] * w4.x; gl[1] += hv[e] * w4.y; gl[2] += hv[e] * w4.z; gl[3] += hv[e] * w4.w;
                const float* wr = we + (size_t)(k0 + e) * NE;
#pragma unroll
                for (int j = 0; j < 8; ++j) {
                    float4 x4 = *(const float4*)(wr + j * 4);
                    el[j * 4 + 0] += hv[e] * x4.x; el[j * 4 + 1] += hv[e] * x4.y; el[j * 4 + 2] += hv[e] * x4.z; el[j * 4 + 3] += hv[e] * x4.w;
                }
            }
        }
#pragma unroll
        for (int j = 0; j < 4; ++j) gl[j] = wave_sum(gl[j]) + bg[j];
#pragma unroll
        for (int j = 0; j < 32; ++j) el[j] = wave_sum(el[j]) + be[j];
        int gs = 0; float gm = gl[0];
#pragma unroll
        for (int j = 1; j < 4; ++j) if (gl[j] > gm) { gm = gl[j]; gs = j; }
        float se = 0.f;
#pragma unroll
        for (int j = 0; j < 4; ++j) se += expf(gl[j] - gm);
        const float pg = 1.0f / se;
        float ev[8];
#pragma unroll
        for (int j = 0; j < 8; ++j) {
            float x = el[j];
#pragma unroll
            for (int g = 1; g < 4; ++g) x = (gs == g) ? el[g * 8 + j] : x;
            ev[j] = x;
        }
        int i1 = 0; float v1 = ev[0];
#pragma unroll
        for (int j = 1; j < 8; ++j) if (ev[j] > v1) { v1 = ev[j]; i1 = j; }
        int i2 = (i1 + 1) & 7; float v2 = -INFINITY;
#pragma unroll
        for (int j = 0; j < 8; ++j) if (j != i1 && ev[j] > v2) { v2 = ev[j]; i2 = j; }
        const float ex = expf(v2 - v1);
        const float w1 = pg / (1.0f + ex), w2 = pg * ex / (1.0f + ex);
        if (lane == 0) {
            const int e1 = gs * 8 + i1, e2 = gs * 8 + i2;
            int s1 = atomicAdd(&cnt[e1], 1), s2 = atomicAdd(&cnt[e2], 1);
            s1 = min(max(s1, 0), ECAP - 1); s2 = min(max(s2, 0), ECAP - 1);
            tokl[e1 * ECAP + s1] = row; wl[e1 * ECAP + s1] = w1;
            tokl[e2 * ECAP + s2] = row; wl[e2 * ECAP + s2] = w2;
            tinfo[row] = make_int4(e1, s1, e2, s2);
        }
    }
}

__device__ void phase_moe1(const P& p, int l, char* lds) {
    const int t = threadIdx.x;
    const bf16_t* hbuf = (const bf16_t*)(p.ws + WS_HBUF);
    bf16_t* hmoe = (bf16_t*)(p.ws + WS_HMOE);
    const int* cnt = (const int*)(p.ws + WS_CTL) + l * NE;
    const int* tokl = (const int*)(p.ws + WS_TOKL);
    int* stp = (int*)(lds + GEMM_LDS);
    moe_prefix(cnt, stp);
    const int ntiles = stp[NE] * 8;
    for (int tile = blockIdx.x; tile < ntiles; tile += gridDim.x) {
        const int mtg = tile >> 3;
        int e = 0;
        while (stp[e + 1] * 8 <= tile) ++e;
        const int te = stp[e + 1] - stp[e], local = tile - stp[e] * 8, nt = local / te, mt = local % te;
        (void)mtg;
        const int ne = cnt[e];
        const int i0 = mt * 128 + (t >> 2), i1 = i0 + 64;
        const int tok0 = tokl[e * ECAP + (i0 < ne ? i0 : 0)], tok1 = tokl[e * ECAP + (i1 < ne ? i1 : 0)];
        const bf16_t* a0 = hbuf + (size_t)tok0 * DM + (t & 3) * 8;
        const bf16_t* a1 = hbuf + (size_t)tok1 * DM + (t & 3) * 8;
        const int vcol = (t & 31) * 4, wn = vcol >> 6, tn = (vcol >> 5) & 1, rr = vcol & 31;
        const float* wsrc = (tn ? p.in[29] : p.in[28]) + ((size_t)l * NE + e) * DM * DE;
        const float* b0 = wsrc + (size_t)(t >> 5) * DE + nt * 64 + wn * 32 + rr;
        EpiGateUp epi{hmoe + (size_t)(stp[e] + mt) * 128 * DE + nt * 64};
        gemm_tile(a0, a1, b0, DE, DM / BK, lds, epi);
    }
}

__device__ void phase_moe2(const P& p, int l, char* lds) {
    const int t = threadIdx.x;
    const bf16_t* hmoe = (const bf16_t*)(p.ws + WS_HMOE);
    bf16_t* ymoe = (bf16_t*)(p.ws + WS_YMOE);
    const int* cnt = (const int*)(p.ws + WS_CTL) + l * NE;
    const float* wl = (const float*)(p.ws + WS_WL);
    int* stp = (int*)(lds + GEMM_LDS);
    moe_prefix(cnt, stp);
    const int ntiles = stp[NE] * 8;
    for (int tile = blockIdx.x; tile < ntiles; tile += gridDim.x) {
        int e = 0;
        while (stp[e + 1] * 8 <= tile) ++e;
        const int te = stp[e + 1] - stp[e], local = tile - stp[e] * 8, nt = local / te, mt = local % te;
        const int ne = cnt[e];
        const size_t r0 = (size_t)(stp[e] + mt) * 128;
        const bf16_t* a0 = hmoe + (r0 + (t >> 2)) * DE + (t & 3) * 8;
        const float* b0 = p.in[30] + ((size_t)l * NE + e) * DE * DM + (size_t)(t >> 5) * DM + nt * 128 + (t & 31) * 4;
        EpiDown epi{ymoe + r0 * DM + nt * 128, wl + e * ECAP + mt * 128, ne - mt * 128};
        gemm_tile(a0, a0 + (size_t)64 * DE, b0, DM, DE / BK, lds, epi);
    }
}

__device__ void phase_final(const P& p, char* lds) {
    const int lane = threadIdx.x & 63;
    const int gw = blockIdx.x * 4 + (threadIdx.x >> 6), nw = gridDim.x * 4;
    const float* xres = (const float*)(p.ws + WS_XRES);
    const bf16_t* ymoe = (const bf16_t*)(p.ws + WS_YMOE);
    const int4* tinfo = (const int4*)(p.ws + WS_TINFO);
    int* stp = (int*)lds;
    moe_prefix((const int*)(p.ws + WS_CTL) + NE, stp);
    for (int row = gw; row < T; row += nw) {
        int4 ti = tinfo[row];
        const bf16_t* y0 = ymoe + (size_t)(stp[ti.x] * 128 + ti.y) * DM;
        const bf16_t* y1 = ymoe + (size_t)(stp[ti.z] * 128 + ti.w) * DM;
#pragma unroll
        for (int i = 0; i < 4; ++i) {
            float4 v = *(const float4*)(xres + (size_t)row * DM + i * 256 + lane * 4);
            uint2 a = *(const uint2*)(y0 + i * 256 + lane * 4), b = *(const uint2*)(y1 + i * 256 + lane * 4);
            v.x += bf2f(a.x & 0xffff) + bf2f(b.x & 0xffff); v.y += bf2f(a.x >> 16) + bf2f(b.x >> 16);
            v.z += bf2f(a.y & 0xffff) + bf2f(b.y & 0xffff); v.w += bf2f(a.y >> 16) + bf2f(b.y >> 16);
            *(float4*)(p.out + (size_t)row * DM + i * 256 + lane * 4) = v;
        }
    }
}

constexpr int LDS_BYTES = 65536;
constexpr int NPHASE = 9;

DI void run_phase(const P& p, int ph, int l, char* lds) {
    switch (ph) {
        case 0: phase_norm1(p, l, lds); break;
        case 1: phase_inproj(p, l, lds); break;
        case 2: phase_qkprep(p, l, lds); break;
        case 3: phase_mix(p, l, lds); break;
        case 4: phase_glu(p, l, lds); break;
        case 5: phase_outproj(p, l, lds); break;
        case 6: phase_norm2(p, l); break;
        case 7: phase_moe1(p, l, lds); break;
        case 8: phase_moe2(p, l, lds); break;
        default: phase_final(p, lds); break;
    }
}

#if MULTI
__global__ void __launch_bounds__(256) k_phase(P p, int ph, int l) {
    extern __shared__ __attribute__((aligned(16))) char lds[];
    run_phase(p, ph, l, lds);
}
#else
__global__ void __launch_bounds__(256) k_mega(P p) {
    extern __shared__ __attribute__((aligned(16))) char lds[];
    cg::grid_group grid = cg::this_grid();
#ifndef MAXPH
#define MAXPH 9
#endif
#ifndef NLAYER
#define NLAYER 2
#endif
#pragma unroll
    for (int l = 0; l < NLAYER; ++l) {
        if (MAXPH > 0 && (l == 0 || L1PH > 0)) { phase_norm1(p, l, lds); grid.sync(); }
        if (MAXPH > 1 && (l == 0 || L1PH > 1)) { phase_inproj(p, l, lds); grid.sync(); }
        if (MAXPH > 2 && (l == 0 || L1PH > 2)) { phase_qkprep(p, l, lds); grid.sync(); }
        if (MAXPH > 3 && (l == 0 || L1PH > 3)) { phase_mix(p, l, lds); grid.sync(); }
        if (MAXPH > 4 && (l == 0 || L1PH > 4)) { phase_glu(p, l, lds); grid.sync(); }
        if (MAXPH > 5 && (l == 0 || L1PH > 5)) { phase_outproj(p, l, lds); grid.sync(); }
        if (MAXPH > 6 && (l == 0 || L1PH > 6)) { phase_norm2(p, l); grid.sync(); }
        if (MAXPH > 7 && (l == 0 || L1PH > 7)) { phase_moe1(p, l, lds); grid.sync(); }
        if (MAXPH > 8 && (l == 0 || L1PH > 8)) { phase_moe2(p, l, lds); grid.sync(); }
    }
    if (MAXPH > 8) phase_final(p, lds);
}
#endif

extern "C" void kernel_launch(void* const* d_in, const int* in_sizes, int n_in, void* d_out, int out_size, void* d_ws, size_t ws_size, hipStream_t stream) {
    static int grid = 0;
    if (grid == 0) {
        if (n_in != 31 || out_size != T * DM || ws_size < WS_END) { fprintf(stderr, "kernel_launch: unexpected sizes n_in %d out %d ws %zu\n", n_in, out_size, ws_size); grid = -1; return; }
        int dev = 0, cus = 0, per_cu = 0;
        (void)hipGetDevice(&dev);
        (void)hipDeviceGetAttribute(&cus, hipDeviceAttributeMultiprocessorCount, dev);
#if MULTI
        (void)hipFuncSetAttribute((const void*)k_phase, hipFuncAttributeMaxDynamicSharedMemorySize, LDS_BYTES);
        (void)hipOccupancyMaxActiveBlocksPerMultiprocessor(&per_cu, (const void*)k_phase, 256, LDS_BYTES);
#else
        (void)hipFuncSetAttribute((const void*)k_mega, hipFuncAttributeMaxDynamicSharedMemorySize, LDS_BYTES);
        (void)hipOccupancyMaxActiveBlocksPerMultiprocessor(&per_cu, (const void*)k_mega, 256, LDS_BYTES);
#endif
        if (per_cu < 1) { fprintf(stderr, "kernel_launch: occupancy query gave %d\n", per_cu); per_cu = 1; }
        if (per_cu > 2) per_cu = 2;
        grid = cus * per_cu;
        fprintf(stderr, "kernel_launch: cus %d per_cu %d grid %d\n", cus, per_cu, grid);
    }
    if (grid < 0) return;
    (void)hipMemsetAsync((char*)d_ws + WS_CTL, 0, 4096, stream);
    P p{};
    for (int i = 0; i < 31; ++i) p.in[i] = (const float*)d_in[i];
    p.out = (float*)d_out; p.ws = (char*)d_ws;
#if MULTI
    for (int l = 0; l < 2; ++l)
        for (int ph = 0; ph < NPHASE; ++ph) hipLaunchKernelGGL(k_phase, dim3(grid), dim3(256), LDS_BYTES, stream, p, ph, l);
    hipLaunchKernelGGL(k_phase, dim3(grid), dim3(256), LDS_BYTES, stream, p, NPHASE, 0);
#else
    void* args[] = {&p};
    hipError_t e = hipLaunchCooperativeKernel((const void*)k_mega, dim3(grid), dim3(256), args, LDS_BYTES, stream);
    if (e != hipSuccess) fprintf(stderr, "cooperative launch failed: %s (grid %d)\n", hipGetErrorString(e), grid);
#endif
}
```

```cpp
#include <hip/hip_runtime.h>
#include <hip/hip_cooperative_groups.h>
#include <cstdio>
#include <cstdint>
namespace cg = cooperative_groups;

#ifndef MULTI
#define MULTI 0
#endif

#define DI __device__ __forceinline__
#define LAS __attribute__((address_space(3)))
typedef unsigned short bf16_t;
typedef short bf16x8 __attribute__((ext_vector_type(8)));
typedef short s16x4 __attribute__((ext_vector_type(4)));
typedef float f32x16 __attribute__((ext_vector_type(16)));
typedef unsigned u32x4 __attribute__((ext_vector_type(4)));
typedef float f32x4 __attribute__((ext_vector_type(4)));
typedef unsigned u32x2 __attribute__((ext_vector_type(2)));

constexpr int T = 16384, DM = 1024, SEQ = 2048, NBATCH = 8;
constexpr int DIN = 2824, PJ = 2816;
constexpr int NE = 32, DE = 512, ECAP = 16384;
constexpr float EPS = 1e-6f;
constexpr int C_MQ = 0, C_MK = 256, C_MV = 512, C_MO = 768, C_AQ = 1024, C_AK = 1536, C_AV = 2048, C_SU = 2560;

constexpr size_t MiB = 1u << 20;
constexpr size_t WS_CTL = 0;
constexpr size_t WS_BAR = 16384;
constexpr size_t WS_KMEAN = 512 * 1024;
constexpr size_t WS_XRES = 1 * MiB;
constexpr size_t WS_HBUF = 65 * MiB;
constexpr size_t WS_PROJ = 97 * MiB;
constexpr size_t WS_GATES = 185 * MiB;
constexpr size_t WS_MIX = 186 * MiB;
constexpr size_t WS_HRAW = 218 * MiB;
constexpr size_t WS_ZBUF = 234 * MiB;
constexpr size_t WS_TOKL = 250 * MiB;
constexpr size_t WS_WL = 252 * MiB;
constexpr size_t WS_TINFO = 254 * MiB;
constexpr size_t WS_HMOE = 256 * MiB;
constexpr size_t WS_YMOE = 292 * MiB;
constexpr size_t WS_MQKC = 364 * MiB;
constexpr size_t WS_S5M = 380 * MiB;
constexpr size_t S5M_LAYER = 8 * MiB, S5M_E = 4 * MiB, S5M_F = 6 * MiB;
constexpr size_t WS_ELOC = 396 * MiB;
constexpr size_t WS_CARR = 412 * MiB;
constexpr size_t WS_END = 420 * MiB;

struct P {
    const float* in[31];
    float* out;
    char* ws;
};

DI int tid_() { int t = threadIdx.x; asm volatile("" : "+v"(t)); return t; }
DI int bid_() { int b = blockIdx.x; asm volatile("" : "+s"(b)); return b; }
DI float bf2f(bf16_t b) { return __uint_as_float(((unsigned)b) << 16); }
DI bf16_t f2bf(float f) { unsigned u = __float_as_uint(f); u += 0x7fffu + ((u >> 16) & 1u); return (bf16_t)(u >> 16); }
typedef float f32x2 __attribute__((ext_vector_type(2)));
typedef __bf16 bf16x2_t __attribute__((ext_vector_type(2)));
DI unsigned pk2(float lo, float hi) { f32x2 v = {lo, hi}; return __builtin_bit_cast(unsigned, __builtin_convertvector(v, bf16x2_t)); }
DI float wave_sum(float v) {
#pragma unroll
    for (int o = 32; o > 0; o >>= 1) v += __shfl_xor(v, o);
    return v;
}
DI float sigmoidf_(float x) { return 1.0f / (1.0f + expf(-x)); }
DI s16x4 tr_read(const LAS char* p) {
    typedef short v4i16_t __attribute__((ext_vector_type(4)));
    return __builtin_bit_cast(s16x4, __builtin_amdgcn_ds_read_tr16_b64_v4i16((LAS v4i16_t*)p));
}

DI float half_swap_max(float m) {
    auto rr = __builtin_amdgcn_permlane32_swap(__float_as_uint(m), __float_as_uint(m), false, false);
    return fmaxf(__uint_as_float(rr[0]), __uint_as_float(rr[1]));
}
DI float half_swap_sum(float m) {
    auto rr = __builtin_amdgcn_permlane32_swap(__float_as_uint(m), __float_as_uint(m), false, false);
    return __uint_as_float(rr[0]) + __uint_as_float(rr[1]);
}

constexpr int BK = 32, A_PITCH = 80, B_PITCH = 320, SA_BYTES = 128 * A_PITCH, SB_BYTES = BK * B_PITCH;
constexpr int GEMM_LDS = 2 * SA_BYTES + 2 * SB_BYTES;

struct GSeg { const bf16_t* a0; const bf16_t* a1; int akstep; const float* b0; size_t ldb; int KT; };
template <class Epi>
DI void gemm_tile2(const GSeg& g1, const GSeg& g2, char* lds_generic, const Epi& epi) {
    const int KT = g1.KT + g2.KT;
    LAS char* lds = (LAS char*)lds_generic;
    const int t = tid_(), lane = t & 63, w = t >> 6, wm = w >> 1, wn = w & 1;
    const int r = lane & 31, h = lane >> 5;
    const int i16 = lane & 15, q = i16 >> 2, pp = i16 & 3, blk = (lane >> 4) & 1;
    const int arow = t >> 2, akc = t & 3, bk = t >> 5, bn4 = t & 31;
    f32x16 acc[2][2];
#pragma unroll
    for (int i = 0; i < 2; ++i)
#pragma unroll
        for (int j = 0; j < 2; ++j)
#pragma unroll
            for (int e = 0; e < 16; ++e) acc[i][j][e] = 0.f;
    u32x4 ra0, ra1; float4 rb[4];
    auto gload = [&](int kt) {
        const bool first = kt < g1.KT;
        const int k2 = first ? kt : kt - g1.KT;
        const bf16_t* pa0 = first ? g1.a0 : g2.a0; const bf16_t* pa1 = first ? g1.a1 : g2.a1;
        const int aks = first ? g1.akstep : g2.akstep;
        const float* pb = first ? g1.b0 : g2.b0; const size_t ldb = first ? g1.ldb : g2.ldb;
        ra0 = *(const u32x4*)(pa0 + (size_t)k2 * aks);
        ra1 = *(const u32x4*)(pa1 + (size_t)k2 * aks);
#pragma unroll
        for (int i = 0; i < 4; ++i) rb[i] = *(const float4*)(pb + (size_t)(k2 * BK + i * 8) * ldb);
    };
    auto sstore = [&](int buf) {
        LAS char* sA = lds + buf * SA_BYTES; LAS char* sB = lds + 2 * SA_BYTES + buf * SB_BYTES;
        *(LAS u32x4*)(sA + arow * A_PITCH + akc * 16) = ra0;
        *(LAS u32x4*)(sA + (arow + 64) * A_PITCH + akc * 16) = ra1;
#pragma unroll
        for (int i = 0; i < 4; ++i) {
            u32x2 v; v.x = pk2(rb[i].x, rb[i].y); v.y = pk2(rb[i].z, rb[i].w);
            *(LAS u32x2*)(sB + (bk + 8 * i) * B_PITCH + bn4 * 8) = v;
        }
    };
    auto compute = [&](int buf) {
        const LAS char* sA = lds + buf * SA_BYTES; const LAS char* sB = lds + 2 * SA_BYTES + buf * SB_BYTES;
#pragma unroll
        for (int ks = 0; ks < 2; ++ks) {
            bf16x8 af[2], bfr[2];
#pragma unroll
            for (int tm = 0; tm < 2; ++tm) af[tm] = *(const LAS bf16x8*)(sA + (wm * 64 + tm * 32 + r) * A_PITCH + (ks * 16 + 8 * h) * 2);
#pragma unroll
            for (int tn = 0; tn < 2; ++tn) {
                const LAS char* pb = sB + (ks * 16 + 8 * h + q) * B_PITCH + (wn * 64 + tn * 32 + 16 * blk) * 2 + 8 * pp;
                s16x4 lo = tr_read(pb), hi = tr_read(pb + 4 * B_PITCH);
                bfr[tn] = __builtin_shufflevector(lo, hi, 0, 1, 2, 3, 4, 5, 6, 7);
            }
#pragma unroll
            for (int tm = 0; tm < 2; ++tm)
#pragma unroll
                for (int tn = 0; tn < 2; ++tn) acc[tm][tn] = __builtin_amdgcn_mfma_f32_32x32x16_bf16(bfr[tn], af[tm], acc[tm][tn], 0, 0, 0);
        }
    };
    gload(0); sstore(0); __syncthreads();
    for (int kt = 0; kt < KT; ++kt) {
        if (kt + 1 < KT) gload(kt + 1);
        compute(kt & 1);
        if (kt + 1 < KT) sstore((kt + 1) & 1);
        __syncthreads();
    }
    epi(acc, wm, wn, r, h);
}
template <class Epi>
DI void gemm_tile(const bf16_t* a0, const bf16_t* a1, const float* b0, size_t ldb, int KT, char* lds_generic, const Epi& epi) {
    GSeg g1{a0, a1, BK, b0, ldb, KT}; GSeg g2{a0, a1, BK, b0, ldb, 0};
    gemm_tile2(g1, g2, lds_generic, epi);
}
struct EpiBf16 {
    bf16_t* out; size_t ld;
    DI void operator()(const f32x16 (&acc)[2][2], int wm, int wn, int r, int h) const {
#pragma unroll
        for (int tm = 0; tm < 2; ++tm) {
            bf16_t* rp = out + (size_t)(wm * 64 + tm * 32 + r) * ld + wn * 64 + 4 * h;
#pragma unroll
            for (int tn = 0; tn < 2; ++tn)
#pragma unroll
                for (int g = 0; g < 4; ++g) {
                    u32x2 v; v.x = pk2(acc[tm][tn][4 * g], acc[tm][tn][4 * g + 1]); v.y = pk2(acc[tm][tn][4 * g + 2], acc[tm][tn][4 * g + 3]);
                    *(u32x2*)(rp + tn * 32 + 8 * g) = v;
                }
        }
    }
};
struct EpiResid {
    float* out; const float* res; size_t ld;
    DI void operator()(const f32x16 (&acc)[2][2], int wm, int wn, int r, int h) const {
#pragma unroll
        for (int tm = 0; tm < 2; ++tm) {
            const size_t o = (size_t)(wm * 64 + tm * 32 + r) * ld + wn * 64 + 4 * h;
#pragma unroll
            for (int tn = 0; tn < 2; ++tn)
#pragma unroll
                for (int g = 0; g < 4; ++g) {
                    float4 x = *(const float4*)(res + o + tn * 32 + 8 * g);
                    x.x += acc[tm][tn][4 * g]; x.y += acc[tm][tn][4 * g + 1]; x.z += acc[tm][tn][4 * g + 2]; x.w += acc[tm][tn][4 * g + 3];
                    *(float4*)(out + o + tn * 32 + 8 * g) = x;
                }
        }
    }
};
DI float silu_mul(float g, float u) { return g / (1.0f + __expf(-g)) * u; }
struct EpiGateUp {
    bf16_t* out;
    DI void operator()(const f32x16 (&acc)[2][2], int wm, int wn, int r, int h) const {
#pragma unroll
        for (int tm = 0; tm < 2; ++tm) {
            bf16_t* rp = out + (size_t)(wm * 64 + tm * 32 + r) * DE + wn * 32 + 4 * h;
#pragma unroll
            for (int g = 0; g < 4; ++g) {
                u32x2 v;
                v.x = pk2(silu_mul(acc[tm][0][4 * g], acc[tm][1][4 * g]), silu_mul(acc[tm][0][4 * g + 1], acc[tm][1][4 * g + 1]));
                v.y = pk2(silu_mul(acc[tm][0][4 * g + 2], acc[tm][1][4 * g + 2]), silu_mul(acc[tm][0][4 * g + 3], acc[tm][1][4 * g + 3]));
                *(u32x2*)(rp + 8 * g) = v;
            }
        }
    }
};
struct EpiDown {
    bf16_t* out; const float* roww; int nvalid;
    DI void operator()(const f32x16 (&acc)[2][2], int wm, int wn, int r, int h) const {
#pragma unroll
        for (int tm = 0; tm < 2; ++tm) {
            const int row = wm * 64 + tm * 32 + r;
            const float wv = row < nvalid ? roww[row] : 0.f;
            bf16_t* rp = out + (size_t)row * DM + wn * 64 + 4 * h;
#pragma unroll
            for (int tn = 0; tn < 2; ++tn)
#pragma unroll
                for (int g = 0; g < 4; ++g) {
                    u32x2 v; v.x = pk2(acc[tm][tn][4 * g] * wv, acc[tm][tn][4 * g + 1] * wv); v.y = pk2(acc[tm][tn][4 * g + 2] * wv, acc[tm][tn][4 * g + 3] * wv);
                    *(u32x2*)(rp + tn * 32 + 8 * g) = v;
                }
        }
    }
};

struct EpiGates {
    float* out; const float* bi; const float* bf;
    DI void operator()(const f32x16 (&acc)[2][2], int wm, int wn, int r, int h) const {
        if (wn == 0) {
#pragma unroll
            for (int tm = 0; tm < 2; ++tm) {
                const float* bb = h ? bf : bi;
                float4 x = {acc[tm][0][0] + bb[0], acc[tm][0][1] + bb[1], acc[tm][0][2] + bb[2], acc[tm][0][3] + bb[3]};
                *(float4*)(out + (size_t)(wm * 64 + tm * 32 + r) * 8 + 4 * h) = x;
            }
        }
    }
};
struct EpiInproj {
    EpiBf16 eb; EpiGates eg; bool isgate;
    DI void operator()(const f32x16 (&acc)[2][2], int wm, int wn, int r, int h) const { if (isgate) eg(acc, wm, wn, r, h); else eb(acc, wm, wn, r, h); }
};
struct EpiF32 {
    float* out; size_t ld;
    DI void operator()(const f32x16 (&acc)[2][2], int wm, int wn, int r, int h) const {
#pragma unroll
        for (int tm = 0; tm < 2; ++tm) {
            float* rp = out + (size_t)(wm * 64 + tm * 32 + r) * ld + wn * 64 + 4 * h;
#pragma unroll
            for (int tn = 0; tn < 2; ++tn)
#pragma unroll
                for (int g = 0; g < 4; ++g) { float4 x = {acc[tm][tn][4 * g], acc[tm][tn][4 * g + 1], acc[tm][tn][4 * g + 2], acc[tm][tn][4 * g + 3]}; *(float4*)(rp + tn * 32 + 8 * g) = x; }
        }
    }
};
DI float gelu_tanh(float v) {
    const float inner = 0.7978845608028654f * (v + 0.044715f * v * v * v);
    const float th = 1.0f - 2.0f / (__expf(2.0f * inner) + 1.0f);
    return 0.5f * v * (1.0f + th);
}
struct EpiS5Y {
    float* zrow0;
    int ncol0;
    DI void operator()(const f32x16 (&acc)[2][2], int wm, int wn, int r, int h) const {
#pragma unroll
        for (int tm = 0; tm < 2; ++tm) {
            const int chunk = wm * 64 + tm * 32 + r;
#pragma unroll
            for (int tn = 0; tn < 2; ++tn)
#pragma unroll
                for (int g = 0; g < 4; ++g) {
                    const int n0 = ncol0 + wn * 64 + tn * 32 + 8 * g + 4 * h;
                    float4 x = {gelu_tanh(acc[tm][tn][4 * g]), gelu_tanh(acc[tm][tn][4 * g + 1]), gelu_tanh(acc[tm][tn][4 * g + 2]), gelu_tanh(acc[tm][tn][4 * g + 3])};
                    *(float4*)(zrow0 + (size_t)(chunk * 16 + (n0 >> 4)) * 256 + (n0 & 15)) = x;
                }
        }
    }
};

DI void moe_prefix(const int* cnt, int* stp  ) {
    __syncthreads();
    if (tid_() == 0) { int a = 0; for (int e = 0; e < NE; ++e) { stp[e] = a; a += (cnt[e] + 127) >> 7; } stp[NE] = a; }
    __syncthreads();
}

constexpr int XS_P = 1028;
template <int NC>
DI void rows_matvec(const float* xs, const float* W, int ldw, float* part  ) {
    constexpr int O = 8 * NC, PARTS = 256 / O, KLEN = 1024 / PARTS;
    const int t = tid_(), o = t % O, prt = t / O, r = o / NC, j = o % NC;
    const float* xr = xs + r * XS_P + prt * KLEN;
    const float* wp = W + (size_t)(prt * KLEN) * ldw + j;
    float a0 = 0.f, a1 = 0.f, a2 = 0.f, a3 = 0.f;
#pragma unroll 4
    for (int k = 0; k < KLEN; k += 4) {
        const float4 x = *(const float4*)(xr + k);
        a0 += x.x * wp[(size_t)k * ldw]; a1 += x.y * wp[(size_t)(k + 1) * ldw]; a2 += x.z * wp[(size_t)(k + 2) * ldw]; a3 += x.w * wp[(size_t)(k + 3) * ldw];
    }
    part[t] = (a0 + a1) + (a2 + a3);
}

DI void phase_norm1(const P& p, int l, char* lds) {
    const int t = tid_(), lane = t & 63, w = t >> 6;
    float* xres = (float*)(p.ws + WS_XRES);
    bf16_t* hbuf = (bf16_t*)(p.ws + WS_HBUF);
    float* gates = (float*)(p.ws + WS_GATES);
    const float* g1 = p.in[1] + l * DM;
    const float* win = p.in[2] + (size_t)l * DM * DIN;
    float* xs = (float*)lds;
    float* part = xs + 8 * XS_P;
    int* stp = (int*)(part + 256);
    const bf16_t* ymoe = (const bf16_t*)(p.ws + WS_YMOE);
    const int4* tinfo = (const int4*)(p.ws + WS_TINFO);
    if (l > 0) moe_prefix((const int*)(p.ws + WS_CTL) + (l - 1) * NE, stp);
    for (int rb = bid_(); rb < T / 8; rb += gridDim.x) {
        __syncthreads();
#pragma unroll
        for (int rr = 0; rr < 2; ++rr) {
            const int lr = w * 2 + rr, row = rb * 8 + lr;
            float4 v[4];
            const float* xsrc = (l == 0) ? p.in[0] + (size_t)row * DM : xres + (size_t)row * DM;
#pragma unroll
            for (int i = 0; i < 4; ++i) v[i] = *(const float4*)(xsrc + i * 256 + lane * 4);
            if (l > 0) {
                int4 ti = tinfo[row];
                const bf16_t* y0 = ymoe + (size_t)(stp[ti.x] * 128 + ti.y) * DM;
                const bf16_t* y1 = ymoe + (size_t)(stp[ti.z] * 128 + ti.w) * DM;
#pragma unroll
                for (int i = 0; i < 4; ++i) {
                    uint2 a = *(const uint2*)(y0 + i * 256 + lane * 4), b2 = *(const uint2*)(y1 + i * 256 + lane * 4);
                    v[i].x += bf2f(a.x & 0xffff) + bf2f(b2.x & 0xffff); v[i].y += bf2f(a.x >> 16) + bf2f(b2.x >> 16);
                    v[i].z += bf2f(a.y & 0xffff) + bf2f(b2.y & 0xffff); v[i].w += bf2f(a.y >> 16) + bf2f(b2.y >> 16);
                    *(float4*)(xres + (size_t)row * DM + i * 256 + lane * 4) = v[i];
                }
            }
            float ss = 0.f;
#pragma unroll
            for (int i = 0; i < 4; ++i) ss += v[i].x * v[i].x + v[i].y * v[i].y + v[i].z * v[i].z + v[i].w * v[i].w;
            ss = wave_sum(ss);
            const float rstd = rsqrtf(ss * (1.0f / DM) + EPS);
#pragma unroll
            for (int i = 0; i < 4; ++i) {
                const int k0 = i * 256 + lane * 4;
                const float4 g = *(const float4*)(g1 + k0);
                float4 hv = {v[i].x * rstd * g.x, v[i].y * rstd * g.y, v[i].z * rstd * g.z, v[i].w * rstd * g.w};
                uint2 o; o.x = pk2(hv.x, hv.y); o.y = pk2(hv.z, hv.w);
                *(uint2*)(hbuf + (size_t)row * DM + k0) = o;
            }
        }
    }
}

DI void phase_inproj(const P& p, int l, char* lds) {
    const int t = tid_();
    const bf16_t* hbuf = (const bf16_t*)(p.ws + WS_HBUF);
    bf16_t* projb = (bf16_t*)(p.ws + WS_PROJ);
    const float* win = p.in[2] + (size_t)l * DM * DIN;
    float* gates = (float*)(p.ws + WS_GATES);
    for (int tile = bid_(); tile < 128 * 23; tile += gridDim.x) {
        const int mt = tile / 23, vt = tile % 23;
        const int acol = vt < 8 ? vt * 128 : (vt < 20 ? 1032 + (vt - 8) * 128 : (vt < 22 ? 2568 + (vt - 20) * 128 : 1024));
        const bf16_t* a0 = hbuf + (size_t)(mt * 128 + (t >> 2)) * DM + (t & 3) * 8;
        const float* b0 = win + (size_t)(t >> 5) * DIN + acol + (t & 31) * 4;
        EpiInproj epi{EpiBf16{projb + (size_t)mt * 128 * PJ + vt * 128, (size_t)PJ}, EpiGates{gates + (size_t)mt * 128 * 8, p.in[3] + l * 4, p.in[4] + l * 4}, vt == 22};
        gemm_tile(a0, a0 + (size_t)64 * DM, b0, DIN, DM / BK, lds, epi);
    }
}

__constant__ float ROPE_INV_REV[8] = {0.15915494309189535f, 0.03086376340470123f, 0.005985185712713705f, 0.001160663641240061f,
                                      0.00022507907903927653f, 4.364795279280289e-05f, 8.464330808241401e-06f, 1.6414262627950345e-06f};
DI void load64(const bf16_t* ptr, float (&x)[64]) {
#pragma unroll
    for (int c = 0; c < 8; ++c) {
        u32x4 u = *(const u32x4*)(ptr + c * 8);
        x[c * 8 + 0] = bf2f(u.x & 0xffff); x[c * 8 + 1] = bf2f(u.x >> 16); x[c * 8 + 2] = bf2f(u.y & 0xffff); x[c * 8 + 3] = bf2f(u.y >> 16);
        x[c * 8 + 4] = bf2f(u.z & 0xffff); x[c * 8 + 5] = bf2f(u.z >> 16); x[c * 8 + 6] = bf2f(u.w & 0xffff); x[c * 8 + 7] = bf2f(u.w >> 16);
    }
}
DI void store64(bf16_t* ptr, const float (&x)[64], float sc) {
#pragma unroll
    for (int c = 0; c < 8; ++c) {
        u32x4 u;
        u.x = pk2(x[c * 8 + 0] * sc, x[c * 8 + 1] * sc); u.y = pk2(x[c * 8 + 2] * sc, x[c * 8 + 3] * sc);
        u.z = pk2(x[c * 8 + 4] * sc, x[c * 8 + 5] * sc); u.w = pk2(x[c * 8 + 6] * sc, x[c * 8 + 7] * sc);
        *(u32x4*)(ptr + c * 8) = u;
    }
}
DI void norm_rope64(float (&x)[64], const float* g, int pos) {
    float ss = 0.f;
#pragma unroll
    for (int d = 0; d < 64; ++d) ss += x[d] * x[d];
    const float rstd = rsqrtf(ss * (1.0f / 64.0f) + EPS);
#pragma unroll
    for (int d = 0; d < 64; ++d) x[d] = x[d] * rstd * g[d];
#pragma unroll
    for (int d = 0; d < 8; ++d) {
        double rr = (double)pos * (double)ROPE_INV_REV[d];
        rr -= floor(rr);
        const float sn = __builtin_amdgcn_sinf((float)rr), cs = __builtin_amdgcn_cosf((float)rr);
        const float x1 = x[d], x2 = x[d + 8];
        x[d] = x1 * cs - x2 * sn; x[d + 8] = x2 * cs + x1 * sn;
    }
}
DI void phase_qkprep(const P& p, int l, char* lds) {
    bf16_t* projb = (bf16_t*)(p.ws + WS_PROJ);
    float* kmean = (float*)(p.ws + WS_KMEAN);
    float* red = (float*)lds;
    const int t = tid_(), lane = t & 63, w = t >> 6;
    for (int item = bid_(); item < 512; item += gridDim.x) {
        const int b = item >> 6, n = (item >> 3) & 7, hd = item & 7;
        const int pos = n * 256 + t;
        bf16_t* rowp = projb + ((size_t)b * SEQ + pos) * PJ + hd * 64;
        float x[64];
        load64(rowp + C_AQ, x);
        norm_rope64(x, p.in[8] + l * 64, pos);
        store64(rowp + C_AQ, x, 0.125f * 1.4426950408889634f);
        load64(rowp + C_AK, x);
        norm_rope64(x, p.in[9] + l * 64, pos);
        store64(rowp + C_AK, x, 1.0f);
        __syncthreads();
#pragma unroll
        for (int d = 0; d < 64; ++d) { const float v = wave_sum(x[d]); if (lane == (d & 63)) red[w * 64 + d] = v; }
        __syncthreads();
        if (t < 64) kmean[(size_t)item * 64 + t] = (red[t] + red[64 + t] + red[128 + t] + red[192 + t]) * (1.0f / 256.0f);
    }
    {
        bf16_t* mqkc = (bf16_t*)(p.ws + WS_MQKC);
        const float* cw = p.in[5] + l * 4 * 512; const float* cb = p.in[6] + l * 512;
        const int nthreads = gridDim.x * 256;
        for (int idx = bid_() * 256 + t; idx < T * 64; idx += nthreads) {
            const int token = idx >> 6, ch = (idx & 63) * 8, pos = token & (SEQ - 1);
            float a[8];
            { const float4 b0 = *(const float4*)(cb + ch), b1 = *(const float4*)(cb + ch + 4); a[0] = b0.x; a[1] = b0.y; a[2] = b0.z; a[3] = b0.w; a[4] = b1.x; a[5] = b1.y; a[6] = b1.z; a[7] = b1.w; }
#pragma unroll
            for (int j = 0; j < 4; ++j) {
                if (pos + j - 3 >= 0) {
                    const u32x4 u = *(const u32x4*)(projb + (size_t)(token + j - 3) * PJ + ch);
                    const float4 w0 = *(const float4*)(cw + j * 512 + ch), w1 = *(const float4*)(cw + j * 512 + ch + 4);
                    a[0] += bf2f(u.x & 0xffff) * w0.x; a[1] += bf2f(u.x >> 16) * w0.y; a[2] += bf2f(u.y & 0xffff) * w0.z; a[3] += bf2f(u.y >> 16) * w0.w;
                    a[4] += bf2f(u.z & 0xffff) * w1.x; a[5] += bf2f(u.z >> 16) * w1.y; a[6] += bf2f(u.w & 0xffff) * w1.z; a[7] += bf2f(u.w >> 16) * w1.w;
                }
            }
            const float sc = ch >= 256 ? 0.125f : 1.0f;
#pragma unroll
            for (int e = 0; e < 8; ++e) a[e] = a[e] / (1.0f + __expf(-a[e])) * sc;
            u32x4 o; o.x = pk2(a[0], a[1]); o.y = pk2(a[2], a[3]); o.z = pk2(a[4], a[5]); o.w = pk2(a[6], a[7]);
            *(u32x4*)(mqkc + (size_t)token * 512 + ch) = o;
        }
    }
    {
        float* Tm = (float*)(p.ws + WS_S5M + (size_t)l * S5M_LAYER);
        float* Em = (float*)(p.ws + WS_S5M + (size_t)l * S5M_LAYER + S5M_E);
        float* Fm = (float*)(p.ws + WS_S5M + (size_t)l * S5M_LAYER + S5M_F);
        float* sp = (float*)lds + 512;
        for (int item = bid_(); item < 256; item += gridDim.x) {
            const int g = item >> 4, tau = item & 15, lg = l * 16 + g;
            Tm += 0;
            float* Tg = Tm + (size_t)g * 256 * 256; float* Eg = Em + (size_t)g * 256 * 128; float* Fg = Fm + (size_t)g * 128 * 256;
            __syncthreads();
            if (t < 64) {
                const float lr = p.in[11][lg * 64 + t], li = p.in[12][lg * 64 + t], dt = expf(p.in[18][lg]);
                const float mag1 = expf(lr * dt), a1r = mag1 * cosf(li * dt), a1i = mag1 * sinf(li * dt);
                const float magt = expf(lr * dt * tau), atr = magt * cosf(li * dt * tau), ati = magt * sinf(li * dt * tau);
                const float zr = a1r - 1.0f, zi = a1i, dn = lr * lr + li * li;
                sp[t] = atr; sp[64 + t] = ati; sp[128 + t] = atr * a1r - ati * a1i; sp[192 + t] = atr * a1i + ati * a1r;
                sp[256 + t] = (zr * lr + zi * li) / dn; sp[320 + t] = (zi * lr - zr * li) / dn;
            }
            __syncthreads();
            {
                const int hh = t >> 4, hp = t & 15;
                const float* cre = p.in[15] + ((size_t)lg * 16 + hh) * 64; const float* cim = p.in[16] + ((size_t)lg * 16 + hh) * 64;
                const float* bre = p.in[13] + (size_t)lg * 64 * 16 + hp; const float* bim = p.in[14] + (size_t)lg * 64 * 16 + hp;
                float kv = 0.f;
                for (int pi = 0; pi < 64; ++pi) {
                    const float fr = sp[256 + pi], fi = sp[320 + pi], br = bre[pi * 16], bi = bim[pi * 16];
                    const float bbr = fr * br - fi * bi, bbi = fr * bi + fi * br;
                    const float cr = cre[pi], ci = cim[pi], ar = sp[pi], ai = sp[64 + pi];
                    kv += (cr * ar - ci * ai) * bbr - (cr * ai + ci * ar) * bbi;
                }
                if (tau == 0 && hh == hp) kv += p.in[17][lg * 16 + hh];
                for (int s_ = 0; s_ + tau < 16; ++s_) {
                    const int t_ = s_ + tau;
                    Tg[(size_t)(s_ * 16 + hp) * 256 + t_ * 16 + hh] = kv;
                    if (tau > 0) Tg[(size_t)(t_ * 16 + hp) * 256 + s_ * 16 + hh] = 0.f;
                }
            }
            for (int idx = t; idx < 1024; idx += 256) {
                const int pi = idx >> 4, x = idx & 15;
                {
                    const float fr = sp[256 + pi], fi = sp[320 + pi];
                    const float br = p.in[13][((size_t)lg * 64 + pi) * 16 + x], bi = p.in[14][((size_t)lg * 64 + pi) * 16 + x];
                    const float bbr = fr * br - fi * bi, bbi = fr * bi + fi * br, ar = sp[pi], ai = sp[64 + pi];
                    const size_t ro = (size_t)((15 - tau) * 16 + x) * 128;
                    Eg[ro + pi] = ar * bbr - ai * bbi; Eg[ro + 64 + pi] = ar * bbi + ai * bbr;
                }
                {
                    const float cr = p.in[15][((size_t)lg * 16 + x) * 64 + pi], ci = p.in[16][((size_t)lg * 16 + x) * 64 + pi];
                    const float ar = sp[128 + pi], ai = sp[192 + pi];
                    Fg[(size_t)pi * 256 + tau * 16 + x] = cr * ar - ci * ai; Fg[(size_t)(64 + pi) * 256 + tau * 16 + x] = -(cr * ai + ci * ar);
                }
            }
        }
    }
}

DI void mlstm_item_simple(const P& p, int l, int item, float* sm) {
    const int b = item >> 4, hd = (item >> 2) & 3, dq = item & 3;
    const int t = tid_();
    const bf16_t* projb = (const bf16_t*)(p.ws + WS_PROJ);
    const float* gates = (const float*)(p.ws + WS_GATES);
    float* hraw = (float*)(p.ws + WS_HRAW);
    const float* cw = p.in[5] + l * 4 * 512; const float* cb = p.in[6] + l * 512;
    float* Q = sm; float* K = Q + 64 * 65; float* Sm = K + 64 * 65; float* V = Sm + 64 * 65; float* C = V + 64 * 16; float* nv = C + 64 * 16;
    float* bc = nv + 64; float* Mt = bc + 64; float* uu = Mt + 64; float* den = uu + 64; float* misc = den + 64;
    __syncthreads();
    for (int i = t; i < 1024; i += 256) C[i] = 0.f;
    if (t < 64) nv[t] = 0.f;
    if (t == 0) misc[0] = 0.f;
    for (int c = 0; c < 32; ++c) {
        __syncthreads();
        const int row0 = b * SEQ + c * 64;
        for (int i = t; i < 8192; i += 256) {
            const int which = i >> 12, tt = (i >> 6) & 63, d = i & 63, ch = which * 256 + hd * 64 + d;
            float a = cb[ch];
#pragma unroll
            for (int j = 0; j < 4; ++j) { const int ts = c * 64 + tt + j - 3; if (ts >= 0) a += bf2f(projb[(size_t)(b * SEQ + ts) * PJ + ch]) * cw[j * 512 + ch]; }
            float y = a / (1.0f + expf(-a));
            if (which) K[tt * 65 + d] = y * 0.125f; else Q[tt * 65 + d] = y;
        }
        for (int i = t; i < 1024; i += 256) { const int tt = i >> 4, d = i & 15; V[i] = bf2f(projb[(size_t)(row0 + tt) * PJ + C_MV + hd * 64 + dq * 16 + d]); }
        if (t < 64) {
            const float ig = gates[(size_t)(row0 + t) * 8 + hd], fg = gates[(size_t)(row0 + t) * 8 + 4 + hd];
            const float lf = fminf(fg, 0.f) - log1pf(expf(-fabsf(fg)));
            float bs = lf;
#pragma unroll
            for (int o = 1; o < 64; o <<= 1) { float v = __shfl_up(bs, o); if (t >= o) bs += v; }
            const float u = ig - bs; float um = u;
#pragma unroll
            for (int o = 1; o < 64; o <<= 1) { float v = __shfl_up(um, o); if (t >= o) um = fmaxf(um, v); }
            bc[t] = bs; uu[t] = u; Mt[t] = fmaxf(misc[0], um);
        }
        __syncthreads();
        for (int i = t; i < 4096; i += 256) {
            const int tt = i >> 6, s = i & 63; float v = 0.f;
            if (s <= tt) { float dsum = 0.f; for (int d = 0; d < 64; ++d) dsum += Q[tt * 65 + d] * K[s * 65 + d]; v = dsum * expf(uu[s] - Mt[tt]); }
            Sm[tt * 65 + s] = v;
        }
        __syncthreads();
        if (t < 64) {
            const float inter = expf(misc[0] - Mt[t]);
            float qn = 0.f, rs = 0.f;
            for (int d = 0; d < 64; ++d) { qn += Q[t * 65 + d] * nv[d]; rs += Sm[t * 65 + d]; }
            den[t] = fmaxf(fabsf(inter * qn + rs), expf(-(bc[t] + Mt[t])));
        }
        __syncthreads();
        for (int i = t; i < 1024; i += 256) {
            const int tt = i >> 4, d = i & 15;
            const float inter = expf(misc[0] - Mt[tt]);
            float a = 0.f, bsum = 0.f;
            for (int k = 0; k < 64; ++k) { a += Q[tt * 65 + k] * C[k * 16 + d]; bsum += Sm[tt * 65 + k] * V[k * 16 + d]; }
            hraw[(size_t)(row0 + tt) * 256 + hd * 64 + dq * 16 + d] = (inter * a + bsum) / den[tt];
        }
        __syncthreads();
        const float Mlast = Mt[63], decay = expf(misc[0] - Mlast);
        for (int i = t; i < 1024; i += 256) {
            const int dk = i >> 4, d = i & 15; float a = 0.f;
            for (int s = 0; s < 64; ++s) a += expf(uu[s] - Mlast) * K[s * 65 + dk] * V[s * 16 + d];
            C[i] = decay * C[i] + a;
        }
        if (t < 64) { float a = 0.f; for (int s = 0; s < 64; ++s) a += expf(uu[s] - Mlast) * K[s * 65 + t]; nv[t] = decay * nv[t] + a; }
        __syncthreads();
        if (t == 0) misc[0] = bc[63] + Mlast;
    }
}

constexpr int ML_QP = 144, ML_TP = 192;
constexpr int ML_Q = 0, ML_K = 9216, ML_KW = 18432, ML_V = 30720, ML_C = 43008, ML_N = 55296, ML_U = 55808, ML_SS = 56832;
DI bf16x8 scale8(u32x4 v, float w) {
    u32x4 o;
    o.x = pk2(bf2f(v.x & 0xffff) * w, bf2f(v.x >> 16) * w); o.y = pk2(bf2f(v.y & 0xffff) * w, bf2f(v.y >> 16) * w);
    o.z = pk2(bf2f(v.z & 0xffff) * w, bf2f(v.z >> 16) * w); o.w = pk2(bf2f(v.w & 0xffff) * w, bf2f(v.w >> 16) * w);
    return __builtin_bit_cast(bf16x8, o);
}
DI bf16x8 tr_frag(const LAS char* p, int hi_off) {
    s16x4 lo = tr_read(p), hi = tr_read(p + hi_off);
    return __builtin_shufflevector(lo, hi, 0, 1, 2, 3, 4, 5, 6, 7);
}
DI void mlstm_item(const P& p, int l, int item, char* lds_generic) {
    LAS char* lds = (LAS char*)lds_generic;
    const int b = item >> 2, hd = item & 3;
    const int t = tid_(), lane = t & 63, w = t >> 6, r = lane & 31, h = lane >> 5;
    const int i16 = lane & 15, q4 = i16 >> 2, pp = i16 & 3, blk = (lane >> 4) & 1;
    const int wd = w & 1, wt = w >> 1;
    const bf16_t* projb = (const bf16_t*)(p.ws + WS_PROJ);
    const bf16_t* mqkc = (const bf16_t*)(p.ws + WS_MQKC);
    const float* gates = (const float*)(p.ws + WS_GATES);
    bf16_t* mix = (bf16_t*)(p.ws + WS_MIX);
    const float* mg = p.in[7] + l * 256 + hd * 64;
    LAS float* nbuf = (LAS float*)(lds + ML_N); LAS float* ubuf = (LAS float*)(lds + ML_U) + w * 64; LAS float* ssbuf = (LAS float*)(lds + ML_SS);
    const int srow = t >> 3, sc16 = t & 7;
    const float LOG2E = 1.4426950408889634f;
    __syncthreads();
    for (int i = t; i < 64 * ML_TP / 4; i += 256) ((LAS unsigned*)(lds + ML_C))[i] = 0u;
    if (t < 128) nbuf[t] = 0.f;
    f32x16 cacc;
#pragma unroll
    for (int e = 0; e < 16; ++e) cacc[e] = 0.f;
    float m = 0.f;
    u32x4 rq0, rq1, rk0, rk1, rv0, rv1; float gi, gf;
    auto gload = [&](int c) {
        const size_t row0 = (size_t)b * SEQ + c * 64;
        const bf16_t* qp = mqkc + (row0 + srow) * 512 + hd * 64 + sc16 * 8;
        rq0 = *(const u32x4*)qp; rq1 = *(const u32x4*)(qp + 32 * 512);
        rk0 = *(const u32x4*)(qp + 256); rk1 = *(const u32x4*)(qp + 32 * 512 + 256);
        const bf16_t* vp = projb + (row0 + srow) * PJ + C_MV + hd * 64 + sc16 * 8;
        rv0 = *(const u32x4*)vp; rv1 = *(const u32x4*)(vp + (size_t)32 * PJ);
        gi = gates[(row0 + lane) * 8 + hd]; gf = gates[(row0 + lane) * 8 + 4 + hd];
    };
    gload(0);
    for (int c = 0; c < 32; ++c) {
        const size_t row0 = (size_t)b * SEQ + c * 64;
        const float lf = fminf(gf, 0.f) - __logf(1.0f + __expf(-fabsf(gf)));
        float bs = lf;
#pragma unroll
        for (int o = 1; o < 64; o <<= 1) { const float v = __shfl_up(bs, o); if (lane >= o) bs += v; }
        const float u = gi - bs; float um = u;
#pragma unroll
        for (int o = 1; o < 64; o <<= 1) { const float v = __shfl_up(um, o); if (lane >= o) um = fmaxf(um, v); }
        const float Mt = fmaxf(m, um);
        const float Mlast = __shfl(Mt, 63), bL = __shfl(bs, 63);
        const float decay = __expf(m - Mlast);
        {
            const float w0 = __expf(__shfl(u, srow) - Mlast), w1 = __expf(__shfl(u, srow + 32) - Mlast);
            *(LAS u32x4*)(lds + ML_Q + srow * ML_QP + sc16 * 16) = rq0; *(LAS u32x4*)(lds + ML_Q + (srow + 32) * ML_QP + sc16 * 16) = rq1;
            *(LAS u32x4*)(lds + ML_K + srow * ML_QP + sc16 * 16) = rk0; *(LAS u32x4*)(lds + ML_K + (srow + 32) * ML_QP + sc16 * 16) = rk1;
            *(LAS u32x4*)(lds + ML_V + srow * ML_TP + sc16 * 16) = rv0; *(LAS u32x4*)(lds + ML_V + (srow + 32) * ML_TP + sc16 * 16) = rv1;
            *(LAS bf16x8*)(lds + ML_KW + srow * ML_TP + sc16 * 16) = scale8(rk0, w0); *(LAS bf16x8*)(lds + ML_KW + (srow + 32) * ML_TP + sc16 * 16) = scale8(rk1, w1);
            ubuf[lane] = u * LOG2E;
        }
        __syncthreads();
        if (c + 1 < 32) gload(c + 1);
        const int tt = wt * 32 + r;
        const float Mt_t = __shfl(Mt, tt), bs_t = __shfl(bs, tt);
        const float inter = __expf(m - Mt_t);
        u32x2 opre[4];
        {
            const bf16_t* op = projb + (row0 + tt) * PJ + C_MO + hd * 64 + wd * 32 + 4 * h;
#pragma unroll
            for (int g = 0; g < 4; ++g) opre[g] = *(const u32x2*)(op + 8 * g);
        }
        bf16x8 qf[4];
#pragma unroll
        for (int ks = 0; ks < 4; ++ks) qf[ks] = *(const LAS bf16x8*)(lds + ML_Q + tt * ML_QP + (ks * 16 + 8 * h) * 2);
        bf16x8 vf[4];
#pragma unroll
        for (int k4 = 0; k4 < 4; ++k4) vf[k4] = tr_frag(lds + ML_V + (k4 * 16 + 4 * h + q4) * ML_TP + (wd * 32 + 16 * blk) * 2 + 8 * pp, 8 * ML_TP);
        f32x16 acca, accb;
#pragma unroll
        for (int e = 0; e < 16; ++e) { acca[e] = 0.f; accb[e] = 0.f; }
        float rs = 0.f;
        const float Mt2 = Mt_t * LOG2E;
#pragma unroll
        for (int st = 0; st < 2; ++st) {
            if (st <= wt) {
                f32x16 sa;
#pragma unroll
                for (int e = 0; e < 16; ++e) sa[e] = 0.f;
#pragma unroll
                for (int ks = 0; ks < 4; ++ks) {
                    const bf16x8 kf = *(const LAS bf16x8*)(lds + ML_K + (st * 32 + r) * ML_QP + (ks * 16 + 8 * h) * 2);
                    sa = __builtin_amdgcn_mfma_f32_32x32x16_bf16(kf, qf[ks], sa, 0, 0, 0);
                }
#pragma unroll
                for (int g = 0; g < 4; ++g) {
                    const f32x4 u4 = *(const LAS f32x4*)(ubuf + st * 32 + 8 * g + 4 * h);
                    const float uu[4] = {u4.x, u4.y, u4.z, u4.w};
#pragma unroll
                    for (int i = 0; i < 4; ++i) {
                        const int sidx = st * 32 + 8 * g + 4 * h + i;
                        const float dv_ = (sidx <= tt) ? sa[4 * g + i] * __builtin_amdgcn_exp2f(uu[i] - Mt2) : 0.f;
                        sa[4 * g + i] = dv_; rs += dv_;
                    }
                }
#pragma unroll
                for (int sk = 0; sk < 2; ++sk) {
                    u32x4 pk; pk.x = pk2(sa[8 * sk], sa[8 * sk + 1]); pk.y = pk2(sa[8 * sk + 2], sa[8 * sk + 3]); pk.z = pk2(sa[8 * sk + 4], sa[8 * sk + 5]); pk.w = pk2(sa[8 * sk + 6], sa[8 * sk + 7]);
                    acca = __builtin_amdgcn_mfma_f32_32x32x16_bf16(vf[st * 2 + sk], __builtin_bit_cast(bf16x8, pk), acca, 0, 0, 0);
                }
            }
        }
#pragma unroll
        for (int ks = 0; ks < 4; ++ks) {
            const bf16x8 cf = tr_frag(lds + ML_C + (ks * 16 + 8 * h + q4) * ML_TP + (wd * 32 + 16 * blk) * 2 + 8 * pp, 4 * ML_TP);
            accb = __builtin_amdgcn_mfma_f32_32x32x16_bf16(cf, qf[ks], accb, 0, 0, 0);
        }
        float qn = 0.f;
        {
            const LAS float* nb = nbuf + (c & 1) * 64;
#pragma unroll
            for (int ks = 0; ks < 4; ++ks) {
                const f32x4 n0 = *(const LAS f32x4*)(nb + ks * 16 + 8 * h), n1 = *(const LAS f32x4*)(nb + ks * 16 + 8 * h + 4);
                qn += bf2f((bf16_t)qf[ks][0]) * n0.x + bf2f((bf16_t)qf[ks][1]) * n0.y + bf2f((bf16_t)qf[ks][2]) * n0.z + bf2f((bf16_t)qf[ks][3]) * n0.w
                    + bf2f((bf16_t)qf[ks][4]) * n1.x + bf2f((bf16_t)qf[ks][5]) * n1.y + bf2f((bf16_t)qf[ks][6]) * n1.z + bf2f((bf16_t)qf[ks][7]) * n1.w;
            }
        }
        qn = half_swap_sum(qn); rs = half_swap_sum(rs);
        const float hden = fmaxf(fabsf(inter * qn + rs), __expf(-(bs_t + Mt_t)));
        const float ihd = 1.0f / hden;
        float ss = 0.f;
#pragma unroll
        for (int e = 0; e < 16; ++e) { acca[e] = (acca[e] + inter * accb[e]) * ihd; ss += acca[e] * acca[e]; }
        ss = half_swap_sum(ss);
        if (h == 0) ssbuf[wd * 64 + tt] = ss;
#pragma unroll
        for (int e = 0; e < 16; ++e) cacc[e] *= decay;
#pragma unroll
        for (int k4 = 0; k4 < 4; ++k4) {
            const bf16x8 kwf = tr_frag(lds + ML_KW + (k4 * 16 + 4 * h + q4) * ML_TP + (wt * 32 + 16 * blk) * 2 + 8 * pp, 8 * ML_TP);
            cacc = __builtin_amdgcn_mfma_f32_32x32x16_bf16(vf[k4], kwf, cacc, 0, 0, 0);
        }
        if (t < 64) {
            float a = 0.f;
            for (int s_ = 0; s_ < 64; ++s_) a += bf2f(*(const LAS bf16_t*)(lds + ML_KW + s_ * ML_TP + t * 2));
            nbuf[((c + 1) & 1) * 64 + t] = decay * nbuf[(c & 1) * 64 + t] + a;
        }
        __syncthreads();
#pragma unroll
        for (int g = 0; g < 4; ++g) {
            u32x2 v; v.x = pk2(cacc[4 * g], cacc[4 * g + 1]); v.y = pk2(cacc[4 * g + 2], cacc[4 * g + 3]);
            *(LAS u32x2*)(lds + ML_C + (wt * 32 + r) * ML_TP + (wd * 32 + 8 * g + 4 * h) * 2) = v;
        }
        {
            const float rstd = rsqrtf((ssbuf[tt] + ssbuf[64 + tt]) * (1.0f / 64.0f) + EPS);
            bf16_t* op = mix + (row0 + tt) * DM + hd * 64 + wd * 32 + 4 * h;
            const float* gp = mg + wd * 32 + 4 * h;
#pragma unroll
            for (int g = 0; g < 4; ++g) {
                const float4 g4 = *(const float4*)(gp + 8 * g);
                const float o0 = bf2f(opre[g].x & 0xffff), o1 = bf2f(opre[g].x >> 16), o2 = bf2f(opre[g].y & 0xffff), o3 = bf2f(opre[g].y >> 16);
                u32x2 v;
                v.x = pk2(acca[4 * g] * rstd * g4.x / (1.0f + __expf(-o0)), acca[4 * g + 1] * rstd * g4.y / (1.0f + __expf(-o1)));
                v.y = pk2(acca[4 * g + 2] * rstd * g4.z / (1.0f + __expf(-o2)), acca[4 * g + 3] * rstd * g4.w / (1.0f + __expf(-o3)));
                *(u32x2*)(op + 8 * g) = v;
            }
        }
        m = bL + Mlast;
    }
}

constexpr int KP = 144, VP = 192, ATT_K_BYTES = 64 * KP, ATT_BUF = 64 * KP + 64 * VP;
DI void moba_item(const P& p, int l, int item, char* lds_generic) {
    LAS char* lds = (LAS char*)lds_generic;
    const int b = item >> 7, hd = (item >> 4) & 7, qt = item & 15, qb = qt >> 1;
    const int t = tid_(), lane = t & 63, w = t >> 6, r = lane & 31, h = lane >> 5;
    const int i16 = lane & 15, q4 = i16 >> 2, pp = i16 & 3, blk = (lane >> 4) & 1;
    const bf16_t* projb = (const bf16_t*)(p.ws + WS_PROJ);
    bf16_t* mix = (bf16_t*)(p.ws + WS_MIX);
    const float* kmean = (const float*)(p.ws + WS_KMEAN);
    const size_t rowb = (size_t)b * SEQ;
    const int q0 = qt * 128, qpos = q0 + w * 32 + r;
    bf16x8 qf[4];
    {
        const bf16_t* qp = projb + (rowb + qpos) * PJ + C_AQ + hd * 64 + 8 * h;
#pragma unroll
        for (int ks = 0; ks < 4; ++ks) qf[ks] = *(const bf16x8*)(qp + ks * 16);
    }
    unsigned mask = 0;
    {
        float gate[8];
#pragma unroll
        for (int n = 0; n < 8; ++n) {
            float sacc = 0.f;
            if (n < qb) {
                const float* km = kmean + ((size_t)((b * 8 + n) * 8 + hd)) * 64 + 8 * h;
#pragma unroll
                for (int ks = 0; ks < 4; ++ks)
#pragma unroll
                    for (int j = 0; j < 8; ++j) sacc += bf2f((bf16_t)qf[ks][j]) * km[ks * 16 + j];
            }
            gate[n] = half_swap_sum(sacc);
        }
#pragma unroll
        for (int it = 0; it < 3; ++it) {
            int best = -1; float bv = -INFINITY;
#pragma unroll
            for (int n = 0; n < 8; ++n) if (n < qb && !((mask >> n) & 1u) && gate[n] > bv) { bv = gate[n]; best = n; }
            if (best >= 0) mask |= 1u << best;
        }
    }
    const int nown = ((q0 & 255) >> 6) + 2, ntiles = nown + qb * 4;
    f32x16 o0, o1;
#pragma unroll
    for (int e = 0; e < 16; ++e) { o0[e] = 0.f; o1[e] = 0.f; }
    float m = -INFINITY, lsum = 0.f;
    const int srow = t >> 3, sc16 = t & 7;
    u32x4 rk0, rk1, rv0, rv1;
    auto key0_of = [&](int it) { return it < nown ? qb * 256 + it * 64 : ((it - nown) >> 2) * 256 + ((it - nown) & 3) * 64; };
    auto gload = [&](int it) {
        const int key0 = key0_of(it);
        const bf16_t* base = projb + (rowb + key0 + srow) * PJ + hd * 64 + sc16 * 8;
        rk0 = *(const u32x4*)(base + C_AK); rk1 = *(const u32x4*)(base + (size_t)32 * PJ + C_AK);
        rv0 = *(const u32x4*)(base + C_AV); rv1 = *(const u32x4*)(base + (size_t)32 * PJ + C_AV);
    };
    auto sstore = [&](int buf) {
        LAS char* sK = lds + buf * ATT_BUF; LAS char* sV = sK + ATT_K_BYTES;
        *(LAS u32x4*)(sK + srow * KP + sc16 * 16) = rk0; *(LAS u32x4*)(sK + (srow + 32) * KP + sc16 * 16) = rk1;
        *(LAS u32x4*)(sV + srow * VP + sc16 * 16) = rv0; *(LAS u32x4*)(sV + (srow + 32) * VP + sc16 * 16) = rv1;
    };
    __syncthreads();
    gload(0); sstore(0); __syncthreads();
    for (int it = 0; it < ntiles; ++it) {
        if (it + 1 < ntiles) gload(it + 1);
        {
            const LAS char* sK = lds + (it & 1) * ATT_BUF; const LAS char* sV = sK + ATT_K_BYTES;
            const int key0 = key0_of(it), blockn = key0 >> 8;
            f32x16 s0, s1;
#pragma unroll
            for (int e = 0; e < 16; ++e) { s0[e] = 0.f; s1[e] = 0.f; }
#pragma unroll
            for (int ks = 0; ks < 4; ++ks) {
                const bf16x8 k0 = *(const LAS bf16x8*)(sK + r * KP + (ks * 16 + 8 * h) * 2);
                const bf16x8 k1 = *(const LAS bf16x8*)(sK + (32 + r) * KP + (ks * 16 + 8 * h) * 2);
                s0 = __builtin_amdgcn_mfma_f32_32x32x16_bf16(k0, qf[ks], s0, 0, 0, 0);
                s1 = __builtin_amdgcn_mfma_f32_32x32x16_bf16(k1, qf[ks], s1, 0, 0, 0);
            }
            const bool own = (blockn == qb);
            const bool active = own || ((mask >> blockn) & 1u);
            if (!active) {
#pragma unroll
                for (int e = 0; e < 16; ++e) { s0[e] = -INFINITY; s1[e] = -INFINITY; }
            } else if (own && key0 + 63 > q0 + w * 32) {
#pragma unroll
                for (int e = 0; e < 16; ++e) {
                    const int kk = key0 + (e & 3) + 8 * (e >> 2) + 4 * h;
                    if (kk > qpos) s0[e] = -INFINITY;
                    if (kk + 32 > qpos) s1[e] = -INFINITY;
                }
            }
            float mx = fmaxf(s0[0], s1[0]);
#pragma unroll
            for (int e = 1; e < 16; ++e) mx = fmaxf(mx, fmaxf(s0[e], s1[e]));
            mx = half_swap_max(mx);
            const float mn = fmaxf(m, mx);
            const float alpha = __builtin_amdgcn_exp2f(m - mn);
            m = mn;
            float ps = 0.f;
#pragma unroll
            for (int e = 0; e < 16; ++e) { s0[e] = __builtin_amdgcn_exp2f(s0[e] - mn); s1[e] = __builtin_amdgcn_exp2f(s1[e] - mn); ps += s0[e] + s1[e]; }
            lsum = lsum * alpha + ps;
#pragma unroll
            for (int e = 0; e < 16; ++e) { o0[e] *= alpha; o1[e] *= alpha; }
#pragma unroll
            for (int st = 0; st < 2; ++st)
#pragma unroll
                for (int sk = 0; sk < 2; ++sk) {
                    u32x4 pk;
                    if (st == 0) { pk.x = pk2(s0[8 * sk], s0[8 * sk + 1]); pk.y = pk2(s0[8 * sk + 2], s0[8 * sk + 3]); pk.z = pk2(s0[8 * sk + 4], s0[8 * sk + 5]); pk.w = pk2(s0[8 * sk + 6], s0[8 * sk + 7]); }
                    else         { pk.x = pk2(s1[8 * sk], s1[8 * sk + 1]); pk.y = pk2(s1[8 * sk + 2], s1[8 * sk + 3]); pk.z = pk2(s1[8 * sk + 4], s1[8 * sk + 5]); pk.w = pk2(s1[8 * sk + 6], s1[8 * sk + 7]); }
                    const bf16x8 pf = __builtin_bit_cast(bf16x8, pk);
                    const LAS char* vb = sV + (st * 32 + sk * 16 + 4 * h + q4) * VP + (16 * blk) * 2 + 8 * pp;
                    {
                        s16x4 lo = tr_read(vb), hi = tr_read(vb + 8 * VP);
                        const bf16x8 vf = __builtin_shufflevector(lo, hi, 0, 1, 2, 3, 4, 5, 6, 7);
                        o0 = __builtin_amdgcn_mfma_f32_32x32x16_bf16(vf, pf, o0, 0, 0, 0);
                    }
                    {
                        s16x4 lo = tr_read(vb + 64), hi = tr_read(vb + 64 + 8 * VP);
                        const bf16x8 vf = __builtin_shufflevector(lo, hi, 0, 1, 2, 3, 4, 5, 6, 7);
                        o1 = __builtin_amdgcn_mfma_f32_32x32x16_bf16(vf, pf, o1, 0, 0, 0);
                    }
                }
        }
        if (it + 1 < ntiles) sstore((it + 1) & 1);
        __syncthreads();
    }
    const float il = 1.0f / half_swap_sum(lsum);
    float ss = 0.f;
#pragma unroll
    for (int e = 0; e < 16; ++e) { o0[e] *= il; o1[e] *= il; ss += o0[e] * o0[e] + o1[e] * o1[e]; }
    ss = half_swap_sum(ss);
    const float rstd = rsqrtf(ss * (1.0f / 64.0f) + EPS);
    const float* og = p.in[10] + (l * 8 + hd) * 64 + 4 * h;
    bf16_t* op = mix + (rowb + qpos) * DM + 256 + hd * 64 + 4 * h;
#pragma unroll
    for (int g = 0; g < 4; ++g) {
        const float4 g0 = *(const float4*)(og + 8 * g), g1 = *(const float4*)(og + 32 + 8 * g);
        u32x2 v0, v1;
        v0.x = pk2(o0[4 * g] * rstd * g0.x, o0[4 * g + 1] * rstd * g0.y); v0.y = pk2(o0[4 * g + 2] * rstd * g0.z, o0[4 * g + 3] * rstd * g0.w);
        v1.x = pk2(o1[4 * g] * rstd * g1.x, o1[4 * g + 1] * rstd * g1.y); v1.y = pk2(o1[4 * g + 2] * rstd * g1.z, o1[4 * g + 3] * rstd * g1.w);
        *(u32x2*)(op + 8 * g) = v0; *(u32x2*)(op + 32 + 8 * g) = v1;
    }
}

DI void s5_item_simple(const P& p, int l, int item, float* sm) {
    const int t = tid_(), lane = t & 63, w = t >> 6;
    const int bg = item * 4 + w, b = bg >> 4, g = bg & 15;
    const bf16_t* projb = (const bf16_t*)(p.ws + WS_PROJ);
    float* zbuf = (float*)(p.ws + WS_ZBUF);
    float* xr = sm + w * (2 * 16 * 65); float* xi = xr + 16 * 65;
    const int lg = l * 16 + g;
    const float lr = p.in[11][lg * 64 + lane], li = p.in[12][lg * 64 + lane];
    const float dt = expf(p.in[18][lg]);
    const float mag = expf(lr * dt);
    const float are = mag * cosf(li * dt), aim = mag * sinf(li * dt);
    const float zr = are - 1.0f, zi = aim, dn = lr * lr + li * li;
    const float fr = (zr * lr + zi * li) / dn, fi = (zi * lr - zr * li) / dn;
    float bbr[16], bbi[16];
#pragma unroll
    for (int hh = 0; hh < 16; ++hh) {
        const float br = p.in[13][((size_t)lg * 64 + lane) * 16 + hh], bi = p.in[14][((size_t)lg * 64 + lane) * 16 + hh];
        bbr[hh] = fr * br - fi * bi; bbi[hh] = fr * bi + fi * br;
    }
    const float* cre = p.in[15] + (size_t)lg * 16 * 64; const float* cim = p.in[16] + (size_t)lg * 16 * 64;
    const float* dd = p.in[17] + lg * 16;
    float sr = 0.f, si = 0.f;
    __syncthreads();
    for (int c = 0; c < SEQ / 16; ++c) {
        const size_t row0 = (size_t)b * SEQ + c * 16;
        for (int tt = 0; tt < 16; ++tt) {
            const bf16_t* up = projb + (row0 + tt) * PJ + C_SU + g * 16;
            uint4 u0 = *(const uint4*)up, u1 = *(const uint4*)(up + 8);
            float u[16] = {bf2f(u0.x & 0xffff), bf2f(u0.x >> 16), bf2f(u0.y & 0xffff), bf2f(u0.y >> 16), bf2f(u0.z & 0xffff), bf2f(u0.z >> 16), bf2f(u0.w & 0xffff), bf2f(u0.w >> 16),
                           bf2f(u1.x & 0xffff), bf2f(u1.x >> 16), bf2f(u1.y & 0xffff), bf2f(u1.y >> 16), bf2f(u1.z & 0xffff), bf2f(u1.z >> 16), bf2f(u1.w & 0xffff), bf2f(u1.w >> 16)};
            float br = 0.f, bi = 0.f;
#pragma unroll
            for (int hh = 0; hh < 16; ++hh) { br += bbr[hh] * u[hh]; bi += bbi[hh] * u[hh]; }
            const float nr = are * sr - aim * si + br, ni = are * si + aim * sr + bi;
            sr = nr; si = ni;
            xr[tt * 65 + lane] = sr; xi[tt * 65 + lane] = si;
        }
        __syncthreads();
        {
            const int tt = lane >> 2, hq = lane & 3;
            float y[4] = {0.f, 0.f, 0.f, 0.f};
            for (int pp = 0; pp < 64; ++pp) {
                const float a = xr[tt * 65 + pp], bq = xi[tt * 65 + pp];
#pragma unroll
                for (int j = 0; j < 4; ++j) y[j] += cre[(hq * 4 + j) * 64 + pp] * a - cim[(hq * 4 + j) * 64 + pp] * bq;
            }
#pragma unroll
            for (int j = 0; j < 4; ++j) {
                const int hh = hq * 4 + j;
                float v = y[j] + dd[hh] * bf2f(projb[(row0 + tt) * PJ + C_SU + g * 16 + hh]);
                const float inner = 0.7978845608028654f * (v + 0.044715f * v * v * v);
                const float th = 1.0f - 2.0f / (expf(2.0f * inner) + 1.0f);
                zbuf[(row0 + tt) * 256 + g * 16 + hh] = 0.5f * v * (1.0f + th);
            }
        }
        __syncthreads();
    }
}

DI void s5_item(const P& p, int l, int item, char* lds) {
    const int b = item >> 4, g = item & 15, lg = l * 16 + g;
    const int t = tid_();
    const bf16_t* projb = (const bf16_t*)(p.ws + WS_PROJ);
    float* zbuf = (float*)(p.ws + WS_ZBUF);
    const float* Tg = (const float*)(p.ws + WS_S5M + (size_t)l * S5M_LAYER) + (size_t)g * 256 * 256;
    const float* Eg = (const float*)(p.ws + WS_S5M + (size_t)l * S5M_LAYER + S5M_E) + (size_t)g * 256 * 128;
    const float* Fg = (const float*)(p.ws + WS_S5M + (size_t)l * S5M_LAYER + S5M_F) + (size_t)g * 128 * 256;
    float* eloc = (float*)(p.ws + WS_ELOC) + ((size_t)l * 128 + item) * 128 * 128;
    bf16_t* carr = (bf16_t*)(p.ws + WS_CARR) + ((size_t)l * 128 + item) * 128 * 128;
    const size_t rowb = (size_t)b * SEQ;
    const bf16_t* ua0 = projb + (rowb + (size_t)(t >> 2) * 16 + ((t & 3) >> 1)) * PJ + C_SU + g * 16 + (t & 1) * 8;
    const bf16_t* ua1 = ua0 + (size_t)64 * 16 * PJ;
    {
        GSeg g1{ua0, ua1, 2 * PJ, Eg + (size_t)(t >> 5) * 128 + (t & 31) * 4, 128, 8}; GSeg g2 = g1; g2.KT = 0;
        EpiF32 epi{eloc, 128};
        gemm_tile2(g1, g2, lds, epi);
    }
    __syncthreads();
    if (t < 64) {
        const float lr = p.in[11][lg * 64 + t], li = p.in[12][lg * 64 + t], dt = expf(p.in[18][lg]);
        const float mag = expf(lr * dt * 16.0f), ar = mag * cosf(li * dt * 16.0f), ai = mag * sinf(li * dt * 16.0f);
        float sr = 0.f, si = 0.f;
        for (int bt = 0; bt < 8; ++bt) {
            float er[16], ei[16];
#pragma unroll
            for (int i = 0; i < 16; ++i) { er[i] = eloc[(size_t)(bt * 16 + i) * 128 + t]; ei[i] = eloc[(size_t)(bt * 16 + i) * 128 + 64 + t]; }
#pragma unroll
            for (int i = 0; i < 16; ++i) {
                carr[(size_t)(bt * 16 + i) * 128 + t] = f2bf(sr); carr[(size_t)(bt * 16 + i) * 128 + 64 + t] = f2bf(si);
                const float nr = ar * sr - ai * si + er[i], ni = ar * si + ai * sr + ei[i];
                sr = nr; si = ni;
            }
        }
    }
    __syncthreads();
    const bf16_t* ca0 = carr + (size_t)(t >> 2) * 128 + (t & 3) * 8;
#pragma unroll 1
    for (int nt = 0; nt < 2; ++nt) {
        GSeg g1{ua0, ua1, 2 * PJ, Tg + (size_t)(t >> 5) * 256 + nt * 128 + (t & 31) * 4, 256, 4 * (nt + 1)};
        GSeg g2{ca0, ca0 + (size_t)64 * 128, BK, Fg + (size_t)(t >> 5) * 256 + nt * 128 + (t & 31) * 4, 256, 4};
        EpiS5Y epi{zbuf + rowb * 256 + g * 16, nt * 128};
        gemm_tile2(g1, g2, lds, epi);
    }
}

DI void phase_mix(const P& p, int l, char* lds) {
    for (int item = bid_(); item < 32 + 128 + 1024; item += gridDim.x) {
        if (item < 32) mlstm_item(p, l, item, lds);
        else if (item < 160) s5_item(p, l, item - 32, lds);
        else {
            const int i2 = item - 160;
            const int qo = i2 >> 6, bh = i2 & 63;
            moba_item(p, l, (bh << 4) | (15 - qo), lds);
        }
    }
}

DI void phase_glu(const P& p, int l, char* lds) {
    const int t = tid_();
    const bf16_t* projb = (const bf16_t*)(p.ws + WS_PROJ);
    bf16_t* mix = (bf16_t*)(p.ws + WS_MIX);
    const float* zbuf = (const float*)(p.ws + WS_ZBUF);
    const float* hraw = (const float*)(p.ws + WS_HRAW);
    const float* gw = p.in[19] + (size_t)l * 256 * 256; const float* gb = p.in[20] + l * 256;
    const float* sg = p.in[21] + l * 256; const float* mg = p.in[7] + l * 256;
    float* zs = (float*)lds; float* ys = zs + 16 * 256;
    for (int tile = bid_(); tile < T / 16; tile += gridDim.x) {
        const size_t row0 = (size_t)tile * 16;
        __syncthreads();
        for (int i = t; i < 4096; i += 256) zs[i] = zbuf[row0 * 256 + i];
        __syncthreads();
        float a[16];
#pragma unroll
        for (int r = 0; r < 16; ++r) a[r] = gb[t];
        for (int k = 0; k < 256; ++k) {
            const float wv = gw[k * 256 + t];
#pragma unroll
            for (int r = 0; r < 16; ++r) a[r] += zs[r * 256 + k] * wv;
        }
#pragma unroll
        for (int r = 0; r < 16; ++r) ys[r * 256 + t] = zs[r * 256 + t] * sigmoidf_(a[r]);
        __syncthreads();
        {
            const int r = t >> 4, g = t & 15; float ss = 0.f;
#pragma unroll
            for (int hh = 0; hh < 16; ++hh) { const float v = ys[r * 256 + g * 16 + hh]; ss += v * v; }
            const float rstd = rsqrtf(ss * (1.0f / 16.0f) + EPS);
#pragma unroll
            for (int hh = 0; hh < 16; ++hh) mix[(row0 + r) * DM + 768 + g * 16 + hh] = f2bf(ys[r * 256 + g * 16 + hh] * rstd * sg[g * 16 + hh]);
        }
    }
}

DI void phase_outproj(const P& p, int l, char* lds) {
    const int t = tid_();
    const bf16_t* mix = (const bf16_t*)(p.ws + WS_MIX);
    float* xres = (float*)(p.ws + WS_XRES);
    const float* wout = p.in[22] + (size_t)l * DM * DM;
    const float* xin = (l == 0) ? p.in[0] : xres;
    for (int tile = bid_(); tile < 128 * 8; tile += gridDim.x) {
        const int mt = tile >> 3, nt = tile & 7;
        const bf16_t* a0 = mix + (size_t)(mt * 128 + (t >> 2)) * DM + (t & 3) * 8;
        const float* b0 = wout + (size_t)(t >> 5) * DM + nt * 128 + (t & 31) * 4;
        const size_t o = (size_t)mt * 128 * DM + nt * 128;
        EpiResid epi{xres + o, xin + o, (size_t)DM};
        gemm_tile(a0, a0 + (size_t)64 * DM, b0, DM, DM / BK, lds, epi);
    }
}

DI void phase_norm2(const P& p, int l, char* lds) {
    const int t = tid_(), lane = t & 63, w = t >> 6;
    const float* xres = (const float*)(p.ws + WS_XRES);
    bf16_t* hbuf = (bf16_t*)(p.ws + WS_HBUF);
    const float* g2 = p.in[23] + l * DM;
    const float* wg = p.in[24] + (size_t)l * DM * 4; const float* bg = p.in[25] + l * 4;
    const float* we = p.in[26] + (size_t)l * DM * NE; const float* be = p.in[27] + l * NE;
    int* cnt = (int*)(p.ws + WS_CTL) + l * NE;
    int* tokl = (int*)(p.ws + WS_TOKL); float* wl = (float*)(p.ws + WS_WL); int4* tinfo = (int4*)(p.ws + WS_TINFO);
    float* xs = (float*)lds;
    float* pe = xs + 8 * XS_P;
    float* pg = pe + 256;
    for (int rb = bid_(); rb < T / 8; rb += gridDim.x) {
        __syncthreads();
#pragma unroll
        for (int rr = 0; rr < 2; ++rr) {
            const int lr = w * 2 + rr, row = rb * 8 + lr;
            float4 v[4];
#pragma unroll
            for (int i = 0; i < 4; ++i) v[i] = *(const float4*)(xres + (size_t)row * DM + i * 256 + lane * 4);
            float ss = 0.f;
#pragma unroll
            for (int i = 0; i < 4; ++i) ss += v[i].x * v[i].x + v[i].y * v[i].y + v[i].z * v[i].z + v[i].w * v[i].w;
            ss = wave_sum(ss);
            const float rstd = rsqrtf(ss * (1.0f / DM) + EPS);
#pragma unroll
            for (int i = 0; i < 4; ++i) {
                const int k0 = i * 256 + lane * 4;
                const float4 g = *(const float4*)(g2 + k0);
                float4 hv = {v[i].x * rstd * g.x, v[i].y * rstd * g.y, v[i].z * rstd * g.z, v[i].w * rstd * g.w};
                uint2 o; o.x = pk2(hv.x, hv.y); o.y = pk2(hv.z, hv.w);
                *(uint2*)(hbuf + (size_t)row * DM + k0) = o;
                *(float4*)(xs + lr * XS_P + k0) = hv;
            }
        }
        __syncthreads();
        {
            float* wbe = pg + 256;
            float* wbg = wbe + 4096;
            const int r = t >> 5, j = t & 31;
            const int gp = t >> 5, gr = (t & 31) >> 2, gj = t & 3;
            float ae = 0.f, ag = 0.f;
            const float* wep = we + t * 4; const float* wgp = wg + (t & 127) * 4;
            float4 re0 = *(const float4*)(wep), re1 = *(const float4*)(wep + 1024), re2 = *(const float4*)(wep + 2048), re3 = *(const float4*)(wep + 3072);
            float4 rg = *(const float4*)(wgp);
#pragma unroll 1
            for (int c = 0; c < 8; ++c) {
                *(float4*)(wbe + t * 4) = re0; *(float4*)(wbe + 1024 + t * 4) = re1; *(float4*)(wbe + 2048 + t * 4) = re2; *(float4*)(wbe + 3072 + t * 4) = re3;
                if (t < 128) *(float4*)(wbg + t * 4) = rg;
                __syncthreads();
                if (c + 1 < 8) {
                    const float* q = wep + (size_t)(c + 1) * 4096;
                    re0 = *(const float4*)(q); re1 = *(const float4*)(q + 1024); re2 = *(const float4*)(q + 2048); re3 = *(const float4*)(q + 3072);
                    rg = *(const float4*)(wgp + (size_t)(c + 1) * 512);
                }
                const float* xr = xs + r * XS_P + c * 128;
#pragma unroll 8
                for (int k = 0; k < 128; k += 4) {
                    const float4 x = *(const float4*)(xr + k);
                    ae += x.x * wbe[k * 32 + j] + x.y * wbe[(k + 1) * 32 + j] + x.z * wbe[(k + 2) * 32 + j] + x.w * wbe[(k + 3) * 32 + j];
                }
                const float* xg = xs + gr * XS_P + c * 128 + gp * 16;
#pragma unroll
                for (int k = 0; k < 16; ++k) ag += xg[k] * wbg[(gp * 16 + k) * 4 + gj];
                __syncthreads();
            }
            pe[t] = ae; pg[t] = ag;
        }
        __syncthreads();
        if (t < 8) {
            const int row = rb * 8 + t;
            float gl[4];
#pragma unroll
            for (int j = 0; j < 4; ++j) {
                float a = bg[j];
#pragma unroll
                for (int q = 0; q < 8; ++q) a += pg[q * 32 + t * 4 + j];
                gl[j] = a;
            }
            int gs = 0; float gm = gl[0];
#pragma unroll
            for (int j = 1; j < 4; ++j) if (gl[j] > gm) { gm = gl[j]; gs = j; }
            float se = 0.f;
#pragma unroll
            for (int j = 0; j < 4; ++j) se += expf(gl[j] - gm);
            const float pgv = 1.0f / se;
            float ev[8];
#pragma unroll
            for (int j = 0; j < 8; ++j) ev[j] = pe[t * 32 + gs * 8 + j] + be[gs * 8 + j];
            int i1 = 0; float v1 = ev[0];
#pragma unroll
            for (int j = 1; j < 8; ++j) if (ev[j] > v1) { v1 = ev[j]; i1 = j; }
            int i2 = (i1 + 1) & 7; float v2 = -INFINITY;
#pragma unroll
            for (int j = 0; j < 8; ++j) if (j != i1 && ev[j] > v2) { v2 = ev[j]; i2 = j; }
            const float ex = expf(v2 - v1);
            const float w1 = pgv / (1.0f + ex), w2 = pgv * ex / (1.0f + ex);
            const int e1 = gs * 8 + i1, e2 = gs * 8 + i2;
            int s1 = atomicAdd(&cnt[e1], 1), s2 = atomicAdd(&cnt[e2], 1);
            s1 = min(max(s1, 0), ECAP - 1); s2 = min(max(s2, 0), ECAP - 1);
            tokl[e1 * ECAP + s1] = row; wl[e1 * ECAP + s1] = w1;
            tokl[e2 * ECAP + s2] = row; wl[e2 * ECAP + s2] = w2;
            tinfo[row] = make_int4(e1, s1, e2, s2);
        }
    }
}

DI void phase_moe1(const P& p, int l, char* lds) {
    const int t = tid_();
    const bf16_t* hbuf = (const bf16_t*)(p.ws + WS_HBUF);
    bf16_t* hmoe = (bf16_t*)(p.ws + WS_HMOE);
    const int* cnt = (const int*)(p.ws + WS_CTL) + l * NE;
    const int* tokl = (const int*)(p.ws + WS_TOKL);
    int* stp = (int*)(lds + GEMM_LDS);
    moe_prefix(cnt, stp);
    const int ntiles = stp[NE] * 8;
    for (int tile = bid_(); tile < ntiles; tile += gridDim.x) {
        const int mtg = tile >> 3;
        int e = 0;
        while (stp[e + 1] * 8 <= tile) ++e;
        const int te = stp[e + 1] - stp[e], local = tile - stp[e] * 8, nt = local / te, mt = local % te;
        (void)mtg;
        const int ne = cnt[e];
        const int i0 = mt * 128 + (t >> 2), i1 = i0 + 64;
        const int tok0 = tokl[e * ECAP + (i0 < ne ? i0 : 0)], tok1 = tokl[e * ECAP + (i1 < ne ? i1 : 0)];
        const bf16_t* a0 = hbuf + (size_t)tok0 * DM + (t & 3) * 8;
        const bf16_t* a1 = hbuf + (size_t)tok1 * DM + (t & 3) * 8;
        const int vcol = (t & 31) * 4, wn = vcol >> 6, tn = (vcol >> 5) & 1, rr = vcol & 31;
        const float* wsrc = (tn ? p.in[29] : p.in[28]) + ((size_t)l * NE + e) * DM * DE;
        const float* b0 = wsrc + (size_t)(t >> 5) * DE + nt * 64 + wn * 32 + rr;
        EpiGateUp epi{hmoe + (size_t)(stp[e] + mt) * 128 * DE + nt * 64};
        gemm_tile(a0, a1, b0, DE, DM / BK, lds, epi);
    }
}

DI void phase_moe2(const P& p, int l, char* lds) {
    const int t = tid_();
    const bf16_t* hmoe = (const bf16_t*)(p.ws + WS_HMOE);
    bf16_t* ymoe = (bf16_t*)(p.ws + WS_YMOE);
    const int* cnt = (const int*)(p.ws + WS_CTL) + l * NE;
    const float* wl = (const float*)(p.ws + WS_WL);
    int* stp = (int*)(lds + GEMM_LDS);
    moe_prefix(cnt, stp);
    const int ntiles = stp[NE] * 8;
    for (int tile = bid_(); tile < ntiles; tile += gridDim.x) {
        int e = 0;
        while (stp[e + 1] * 8 <= tile) ++e;
        const int te = stp[e + 1] - stp[e], local = tile - stp[e] * 8, nt = local / te, mt = local % te;
        const int ne = cnt[e];
        const size_t r0 = (size_t)(stp[e] + mt) * 128;
        const bf16_t* a0 = hmoe + (r0 + (t >> 2)) * DE + (t & 3) * 8;
        const float* b0 = p.in[30] + ((size_t)l * NE + e) * DE * DM + (size_t)(t >> 5) * DM + nt * 128 + (t & 31) * 4;
        EpiDown epi{ymoe + r0 * DM + nt * 128, wl + e * ECAP + mt * 128, ne - mt * 128};
        gemm_tile(a0, a0 + (size_t)64 * DE, b0, DM, DE / BK, lds, epi);
    }
}

DI void phase_final(const P& p, char* lds) {
    const int lane = tid_() & 63;
    const int gw = bid_() * 4 + (tid_() >> 6), nw = gridDim.x * 4;
    const float* xres = (const float*)(p.ws + WS_XRES);
    const bf16_t* ymoe = (const bf16_t*)(p.ws + WS_YMOE);
    const int4* tinfo = (const int4*)(p.ws + WS_TINFO);
    int* stp = (int*)lds;
    moe_prefix((const int*)(p.ws + WS_CTL) + NE, stp);
    for (int row = gw; row < T; row += nw) {
        int4 ti = tinfo[row];
        const bf16_t* y0 = ymoe + (size_t)(stp[ti.x] * 128 + ti.y) * DM;
        const bf16_t* y1 = ymoe + (size_t)(stp[ti.z] * 128 + ti.w) * DM;
#pragma unroll
        for (int i = 0; i < 4; ++i) {
            float4 v = *(const float4*)(xres + (size_t)row * DM + i * 256 + lane * 4);
            uint2 a = *(const uint2*)(y0 + i * 256 + lane * 4), b = *(const uint2*)(y1 + i * 256 + lane * 4);
            v.x += bf2f(a.x & 0xffff) + bf2f(b.x & 0xffff); v.y += bf2f(a.x >> 16) + bf2f(b.x >> 16);
            v.z += bf2f(a.y & 0xffff) + bf2f(b.y & 0xffff); v.w += bf2f(a.y >> 16) + bf2f(b.y >> 16);
            *(float4*)(p.out + (size_t)row * DM + i * 256 + lane * 4) = v;
        }
    }
}

#define XB_TMO      128
#define XB_XCNT(j)  (256  + 64 * (j))
#define XB_XSUB(j)  (1280 + 64 * (j))
#define XB_XGEN(j)  (2304 + 64 * (j))
#define XB_TOP      3328
#define XB_TOPGEN   3392
#define XCD_BAR_WORDS 3456
#define XB_SPIN_CAP (1u << 18)

__device__ __forceinline__ unsigned xb_ld(unsigned* p)              { return __hip_atomic_load(p, __ATOMIC_RELAXED, __HIP_MEMORY_SCOPE_AGENT); }
__device__ __forceinline__ unsigned xb_add(unsigned* p, unsigned v) { return __hip_atomic_fetch_add(p, v, __ATOMIC_RELAXED, __HIP_MEMORY_SCOPE_AGENT); }
__device__ __forceinline__ unsigned xb_xcc_id() { return (unsigned)__builtin_amdgcn_s_getreg((3 << 11) | 20) & 0xFu; }
#define XB_SPIN(cond, bar) do { unsigned _sp = 0; while (cond) { __builtin_amdgcn_s_sleep(1); \
    if ((++_sp & 255u) == 0u) { if (xb_ld(&(bar)[XB_TMO])) break; if (_sp > XB_SPIN_CAP) { atomicAdd(&(bar)[XB_TMO], 1u); break; } } } } while (0)

struct XcdBarrier {
    unsigned* bar; unsigned x;
    volatile LAS unsigned* st;
};

__device__ __forceinline__ XcdBarrier xcd_barrier_post(unsigned* bar, volatile LAS unsigned* st) {
    XcdBarrier b; b.bar = bar; b.x = xb_xcc_id(); b.st = st;
    if (threadIdx.x == 0) (void)xb_add(&bar[XB_XCNT(b.x)], 1u);
    return b;
}
__device__ __forceinline__ void xcd_barrier_complete(unsigned* bar, unsigned x, unsigned& nloc, unsigned& nx) {
    const unsigned G = gridDim.x * gridDim.y * gridDim.z;
    unsigned sum, cnt, mine, sp = 0u;
    for (;;) {
        sum = 0u; cnt = 0u; mine = 0u;
#pragma unroll
        for (unsigned j = 0; j < 16; ++j) { const unsigned c = xb_ld(&bar[XB_XCNT(j)]); sum += c; cnt += (c > 0u) ? 1u : 0u; mine = (j == x) ? c : mine; }
        if (sum == G) break;
        __builtin_amdgcn_s_sleep(1);
        if ((++sp & 255u) == 0u) { if (xb_ld(&bar[XB_TMO])) break; if (sp > XB_SPIN_CAP) { atomicAdd(&bar[XB_TMO], 1u); break; } }
    }
    nloc = mine > 0u ? mine : 1u; nx = cnt > 0u ? cnt : 1u;
}

__device__ __forceinline__ void xcd_barrier(const XcdBarrier& b) {
    asm volatile("s_waitcnt vmcnt(0)" ::: "memory");
    __syncthreads();
    if (threadIdx.x == 0) {
        unsigned* bar = b.bar;
        __builtin_amdgcn_s_waitcnt(0);
        unsigned nloc = b.st[0], nx = b.st[1];
        if (nloc == 0u) { xcd_barrier_complete(bar, b.x, nloc, nx); b.st[0] = nloc; b.st[1] = nx; }
        const unsigned old = xb_add(&bar[XB_XSUB(b.x)], 1u);
        const unsigned gen = old / nloc;
        if (old + 1u == (gen + 1u) * nloc) {
            __builtin_amdgcn_fence(__ATOMIC_RELEASE, "agent");
            asm volatile("s_waitcnt vmcnt(0)" ::: "memory");
            const unsigned og = xb_add(&bar[XB_TOP], 1u);
            const unsigned tg = og / nx;
            if (og + 1u == (tg + 1u) * nx) xb_add(&bar[XB_TOPGEN], 1u);
            else XB_SPIN(xb_ld(&bar[XB_TOPGEN]) == tg, bar);
            __builtin_amdgcn_fence(__ATOMIC_ACQUIRE, "agent");
            xb_add(&bar[XB_XGEN(b.x)], 1u);
            asm volatile("s_waitcnt vmcnt(0)" ::: "memory");
        } else {
            XB_SPIN(xb_ld(&bar[XB_XGEN(b.x)]) == gen, bar);
            __builtin_amdgcn_fence(__ATOMIC_ACQUIRE, "agent");
            asm volatile("s_waitcnt vmcnt(0)" ::: "memory");
        }
    }
    __syncthreads();
}


constexpr int LDS_BYTES = 65536;
constexpr int NPHASE = 9;

DI void run_phase(const P& p, int ph, int l, char* lds) {
    switch (ph) {
        case 0: phase_norm1(p, l, lds); break;
        case 1: phase_inproj(p, l, lds); break;
        case 2: phase_qkprep(p, l, lds); break;
        case 3: phase_mix(p, l, lds); break;
        case 4: phase_glu(p, l, lds); break;
        case 5: phase_outproj(p, l, lds); break;
        case 6: phase_norm2(p, l, lds); break;
        case 7: phase_moe1(p, l, lds); break;
        case 8: phase_moe2(p, l, lds); break;
        default: phase_final(p, lds); break;
    }
}

#if MULTI
__global__ void __launch_bounds__(256) k_phase(P p, int ph, int l) {
    extern __shared__ __attribute__((aligned(16))) char lds[];
    run_phase(p, ph, l, lds);
}
#else
__global__ void __launch_bounds__(256, 2) k_mega(P p) {
    extern __shared__ __attribute__((aligned(16))) char lds[];
    cg::grid_group grid = cg::this_grid();
    volatile LAS unsigned* bst = (volatile LAS unsigned*)((LAS char*)lds + LDS_BYTES - 16);
    if (threadIdx.x < 4) bst[threadIdx.x] = 0u;
    __syncthreads();
    XcdBarrier gbar = xcd_barrier_post((unsigned*)(p.ws + WS_BAR), bst);
    if (p.ws == nullptr) grid.sync();
#define GSYNC() xcd_barrier(gbar)
#ifndef PROBE_MASK
#define PROBE_MASK 0
#endif
#ifndef PROBE_MULT
#define PROBE_MULT 4
#endif
    unsigned long long tacc = 0, tprev = 0;
#define PH_BEGIN() do { if (PROBE_MASK) tprev = wall_clock64(); } while (0)
#define PH_END(ph) do { if (PROBE_MASK & (1 << (ph))) tacc += wall_clock64() - tprev; } while (0)
#pragma unroll
    for (int l = 0; l < 2; ++l) {
        PH_BEGIN(); phase_norm1(p, l, lds); GSYNC(); PH_END(0);
        PH_BEGIN(); phase_inproj(p, l, lds); GSYNC(); PH_END(1);
        PH_BEGIN(); phase_qkprep(p, l, lds); GSYNC(); PH_END(2);
        PH_BEGIN(); phase_mix(p, l, lds); GSYNC(); PH_END(3);
        PH_BEGIN(); phase_glu(p, l, lds); GSYNC(); PH_END(4);
        PH_BEGIN(); phase_outproj(p, l, lds); GSYNC(); PH_END(5);
        PH_BEGIN(); phase_norm2(p, l, lds); GSYNC(); PH_END(6);
        PH_BEGIN(); phase_moe1(p, l, lds); GSYNC(); PH_END(7);
        PH_BEGIN(); phase_moe2(p, l, lds); GSYNC(); PH_END(8);
    }
    PH_BEGIN(); phase_final(p, lds); PH_END(9);
#ifdef PROBE_SYNCS
    for (int i = 0; i < PROBE_SYNCS; ++i) GSYNC();
#endif
    if (PROBE_MASK && blockIdx.x == 0) {
        const unsigned long long t0 = wall_clock64();
        while (wall_clock64() - t0 < (unsigned long long)PROBE_MULT * tacc) __builtin_amdgcn_s_sleep(8);
    }
}
#endif

extern "C" void kernel_launch(void* const* d_in, const int* in_sizes, int n_in, void* d_out, int out_size, void* d_ws, size_t ws_size, hipStream_t stream) {
    static int grid = 0;
    if (grid == 0) {
        if (n_in != 31 || out_size != T * DM || ws_size < WS_END) { fprintf(stderr, "kernel_launch: unexpected sizes n_in %d out %d ws %zu\n", n_in, out_size, ws_size); grid = -1; return; }
        int dev = 0, cus = 0, per_cu = 0;
        (void)hipGetDevice(&dev);
        (void)hipDeviceGetAttribute(&cus, hipDeviceAttributeMultiprocessorCount, dev);
#if MULTI
        (void)hipFuncSetAttribute((const void*)k_phase, hipFuncAttributeMaxDynamicSharedMemorySize, LDS_BYTES);
        (void)hipOccupancyMaxActiveBlocksPerMultiprocessor(&per_cu, (const void*)k_phase, 256, LDS_BYTES);
#else
        (void)hipFuncSetAttribute((const void*)k_mega, hipFuncAttributeMaxDynamicSharedMemorySize, LDS_BYTES);
        (void)hipOccupancyMaxActiveBlocksPerMultiprocessor(&per_cu, (const void*)k_mega, 256, LDS_BYTES);
#endif
        if (per_cu < 1) { fprintf(stderr, "kernel_launch: occupancy query gave %d\n", per_cu); per_cu = 1; }
        if (per_cu > 2) per_cu = 2;
        grid = cus * per_cu;
        fprintf(stderr, "kernel_launch: cus %d per_cu %d grid %d\n", cus, per_cu, grid);
    }
    if (grid < 0) return;
    (void)hipMemsetAsync((char*)d_ws + WS_CTL, 0, 65536, stream);
    P p{};
    for (int i = 0; i < 31; ++i) p.in[i] = (const float*)d_in[i];
    p.out = (float*)d_out; p.ws = (char*)d_ws;
#if MULTI
    for (int l = 0; l < 2; ++l)
        for (int ph = 0; ph < NPHASE; ++ph) hipLaunchKernelGGL(k_phase, dim3(grid), dim3(256), LDS_BYTES, stream, p, ph, l);
    hipLaunchKernelGGL(k_phase, dim3(grid), dim3(256), LDS_BYTES, stream, p, NPHASE, 0);
#else
    void* args[] = {&p};
    hipError_t e = hipLaunchCooperativeKernel((const void*)k_mega, dim3(grid), dim3(256), args, LDS_BYTES, stream);
    if (e != hipSuccess) fprintf(stderr, "cooperative launch failed: %s (grid %d)\n", hipGetErrorString(e), grid);
#endif
}
```

```cpp
#include <hip/hip_runtime.h>
#include <hip/hip_cooperative_groups.h>
#include <cstdio>
#include <cstdint>
namespace cg = cooperative_groups;

#ifndef MULTI
#define MULTI 0
#endif

#define DI __device__ __forceinline__
#define LAS __attribute__((address_space(3)))
typedef unsigned short bf16_t;
typedef short bf16x8 __attribute__((ext_vector_type(8)));
typedef short s16x4 __attribute__((ext_vector_type(4)));
typedef float f32x16 __attribute__((ext_vector_type(16)));
typedef unsigned u32x4 __attribute__((ext_vector_type(4)));
typedef float f32x4 __attribute__((ext_vector_type(4)));
typedef unsigned u32x2 __attribute__((ext_vector_type(2)));

constexpr int T = 16384, DM = 1024, SEQ = 2048, NBATCH = 8;
constexpr int DIN = 2824, PJ = 2816;
constexpr int NE = 32, DE = 512, ECAP = 16384;
constexpr float EPS = 1e-6f;
constexpr int C_MQ = 0, C_MK = 256, C_MV = 512, C_MO = 768, C_AQ = 1024, C_AK = 1536, C_AV = 2048, C_SU = 2560;

constexpr size_t MiB = 1u << 20;
constexpr size_t WS_CTL = 0;
constexpr size_t WS_BAR = 16384;
constexpr size_t WS_KMEAN = 512 * 1024;
constexpr size_t WS_XRES = 1 * MiB;
constexpr size_t WS_HBUF = 65 * MiB;
constexpr size_t WS_PROJ = 97 * MiB;
constexpr size_t WS_GATES = 185 * MiB;
constexpr size_t WS_MIX = 186 * MiB;
constexpr size_t WS_HRAW = 218 * MiB;
constexpr size_t WS_ZBUF = 234 * MiB;
constexpr size_t WS_TOKL = 250 * MiB;
constexpr size_t WS_WL = 252 * MiB;
constexpr size_t WS_TINFO = 254 * MiB;
constexpr size_t WS_HMOE = 256 * MiB;
constexpr size_t WS_YMOE = 292 * MiB;
constexpr size_t WS_MQKC = 364 * MiB;
constexpr size_t WS_S5M = 380 * MiB;
constexpr size_t S5M_LAYER = 8 * MiB, S5M_E = 4 * MiB, S5M_F = 6 * MiB;
constexpr size_t WS_ELOC = 396 * MiB;
constexpr size_t WS_CARR = 412 * MiB;
constexpr size_t WS_RINFO = 420 * MiB;
constexpr size_t WS_HIST = 421 * MiB;
constexpr size_t WS_GSCAN = 422 * MiB;
constexpr size_t WS_END = 424 * MiB;

struct P {
    const float* in[31];
    float* out;
    char* ws;
};

DI int tid_() { int t = threadIdx.x; asm volatile("" : "+v"(t)); return t; }
DI int bid_() { int b = blockIdx.x; asm volatile("" : "+s"(b)); return b; }
DI float bf2f(bf16_t b) { return __uint_as_float(((unsigned)b) << 16); }
DI bf16_t f2bf(float f) { unsigned u = __float_as_uint(f); u += 0x7fffu + ((u >> 16) & 1u); return (bf16_t)(u >> 16); }
typedef float f32x2 __attribute__((ext_vector_type(2)));
typedef __bf16 bf16x2_t __attribute__((ext_vector_type(2)));
DI unsigned pk2(float lo, float hi) { f32x2 v = {lo, hi}; return __builtin_bit_cast(unsigned, __builtin_convertvector(v, bf16x2_t)); }
DI void lds_barrier() { asm volatile("s_waitcnt lgkmcnt(0)" ::: "memory"); __builtin_amdgcn_s_barrier(); asm volatile("" ::: "memory"); }
DI float wave_sum(float v) {
#pragma unroll
    for (int o = 32; o > 0; o >>= 1) v += __shfl_xor(v, o);
    return v;
}
DI float sigmoidf_(float x) { return 1.0f / (1.0f + expf(-x)); }
DI s16x4 tr_read(const LAS char* p) {
    typedef short v4i16_t __attribute__((ext_vector_type(4)));
    return __builtin_bit_cast(s16x4, __builtin_amdgcn_ds_read_tr16_b64_v4i16((LAS v4i16_t*)p));
}

DI float half_swap_max(float m) {
    auto rr = __builtin_amdgcn_permlane32_swap(__float_as_uint(m), __float_as_uint(m), false, false);
    return fmaxf(__uint_as_float(rr[0]), __uint_as_float(rr[1]));
}
DI float half_swap_sum(float m) {
    auto rr = __builtin_amdgcn_permlane32_swap(__float_as_uint(m), __float_as_uint(m), false, false);
    return __uint_as_float(rr[0]) + __uint_as_float(rr[1]);
}

constexpr int BK = 32, A_PITCH = 80, B_PITCH = 320, SA_BYTES = 128 * A_PITCH, SB_BYTES = BK * B_PITCH;
constexpr int GEMM_LDS = 2 * SA_BYTES + 2 * SB_BYTES;

struct GSeg { const bf16_t* a0; const bf16_t* a1; int akstep; const float* b0; size_t ldb; int KT; };
template <class Epi>
DI void gemm_tile2(const GSeg& g1, const GSeg& g2, char* lds_generic, const Epi& epi) {
    const int KT = g1.KT + g2.KT;
    LAS char* lds = (LAS char*)lds_generic;
    const int t = tid_(), lane = t & 63, w = t >> 6, wm = w >> 1, wn = w & 1;
    const int r = lane & 31, h = lane >> 5;
    const int i16 = lane & 15, q = i16 >> 2, pp = i16 & 3, blk = (lane >> 4) & 1;
    const int arow = t >> 2, akc = t & 3, bk = t >> 5, bn4 = t & 31;
    f32x16 acc[2][2];
#pragma unroll
    for (int i = 0; i < 2; ++i)
#pragma unroll
        for (int j = 0; j < 2; ++j)
#pragma unroll
            for (int e = 0; e < 16; ++e) acc[i][j][e] = 0.f;
    struct Stage { u32x4 a0, a1; float4 b0, b1, b2, b3; };
    const bf16_t* pa0 = g1.a0; const bf16_t* pa1 = g1.a1; const float* pb = g1.b0;
    size_t ldb = g1.ldb; int aks = g1.akstep, left = g1.KT, issued = 0;
    auto gload = [&](Stage& S) {
        S.a0 = *(const u32x4*)pa0; S.a1 = *(const u32x4*)pa1;
        S.b0 = *(const float4*)(pb); S.b1 = *(const float4*)(pb + 8 * ldb); S.b2 = *(const float4*)(pb + 16 * ldb); S.b3 = *(const float4*)(pb + 24 * ldb);
        if (++issued < KT) {
            if (--left == 0) { pa0 = g2.a0; pa1 = g2.a1; pb = g2.b0; ldb = g2.ldb; aks = g2.akstep; left = 1 << 30; }
            else { pa0 += aks; pa1 += aks; pb += BK * ldb; }
        }
    };
    auto sstore = [&](const Stage& S, int buf) {
        LAS char* sA = lds + buf * SA_BYTES; LAS char* sB = lds + 2 * SA_BYTES + buf * SB_BYTES;
        *(LAS u32x4*)(sA + arow * A_PITCH + akc * 16) = S.a0;
        *(LAS u32x4*)(sA + (arow + 64) * A_PITCH + akc * 16) = S.a1;
        u32x2 v;
        v.x = pk2(S.b0.x, S.b0.y); v.y = pk2(S.b0.z, S.b0.w); *(LAS u32x2*)(sB + (bk) * B_PITCH + bn4 * 8) = v;
        v.x = pk2(S.b1.x, S.b1.y); v.y = pk2(S.b1.z, S.b1.w); *(LAS u32x2*)(sB + (bk + 8) * B_PITCH + bn4 * 8) = v;
        v.x = pk2(S.b2.x, S.b2.y); v.y = pk2(S.b2.z, S.b2.w); *(LAS u32x2*)(sB + (bk + 16) * B_PITCH + bn4 * 8) = v;
        v.x = pk2(S.b3.x, S.b3.y); v.y = pk2(S.b3.z, S.b3.w); *(LAS u32x2*)(sB + (bk + 24) * B_PITCH + bn4 * 8) = v;
    };
    auto compute = [&](int buf) {
        const LAS char* sA = lds + buf * SA_BYTES; const LAS char* sB = lds + 2 * SA_BYTES + buf * SB_BYTES;
#pragma unroll
        for (int ks = 0; ks < 2; ++ks) {
            bf16x8 af[2], bfr[2];
#pragma unroll
            for (int tm = 0; tm < 2; ++tm) af[tm] = *(const LAS bf16x8*)(sA + (wm * 64 + tm * 32 + r) * A_PITCH + (ks * 16 + 8 * h) * 2);
#pragma unroll
            for (int tn = 0; tn < 2; ++tn) {
                const LAS char* pb = sB + (ks * 16 + 8 * h + q) * B_PITCH + (wn * 64 + tn * 32 + 16 * blk) * 2 + 8 * pp;
                s16x4 lo = tr_read(pb), hi = tr_read(pb + 4 * B_PITCH);
                bfr[tn] = __builtin_shufflevector(lo, hi, 0, 1, 2, 3, 4, 5, 6, 7);
            }
#pragma unroll
            for (int tm = 0; tm < 2; ++tm)
#pragma unroll
                for (int tn = 0; tn < 2; ++tn) acc[tm][tn] = __builtin_amdgcn_mfma_f32_32x32x16_bf16(bfr[tn], af[tm], acc[tm][tn], 0, 0, 0);
        }
    };
    Stage S0, S1;
    gload(S0); gload(S1);
    sstore(S0, 0); __syncthreads();
#define GSTEP(SL, SS) { gload(SL); compute(kt & 1); sstore(SS, (kt + 1) & 1); __syncthreads(); if (++kt >= KT) break; }
    for (int kt = 0;;) {
        GSTEP(S0, S1)
        GSTEP(S1, S0)
    }
#undef GSTEP
    epi(acc, wm, wn, r, h);
}
template <class Epi>
DI void gemm_tile(const bf16_t* a0, const bf16_t* a1, const float* b0, size_t ldb, int KT, char* lds_generic, const Epi& epi) {
    GSeg g1{a0, a1, BK, b0, ldb, KT}; GSeg g2{a0, a1, BK, b0, ldb, 0};
    gemm_tile2(g1, g2, lds_generic, epi);
}
struct EpiBf16 {
    bf16_t* out; size_t ld;
    DI void operator()(const f32x16 (&acc)[2][2], int wm, int wn, int r, int h) const {
#pragma unroll
        for (int tm = 0; tm < 2; ++tm) {
            bf16_t* rp = out + (size_t)(wm * 64 + tm * 32 + r) * ld + wn * 64 + 4 * h;
#pragma unroll
            for (int tn = 0; tn < 2; ++tn)
#pragma unroll
                for (int g = 0; g < 4; ++g) {
                    u32x2 v; v.x = pk2(acc[tm][tn][4 * g], acc[tm][tn][4 * g + 1]); v.y = pk2(acc[tm][tn][4 * g + 2], acc[tm][tn][4 * g + 3]);
                    *(u32x2*)(rp + tn * 32 + 8 * g) = v;
                }
        }
    }
};
struct EpiResid {
    float* out; const float* res; size_t ld;
    DI void operator()(const f32x16 (&acc)[2][2], int wm, int wn, int r, int h) const {
#pragma unroll
        for (int tm = 0; tm < 2; ++tm) {
            const size_t o = (size_t)(wm * 64 + tm * 32 + r) * ld + wn * 64 + 4 * h;
            float4 x[8];
#pragma unroll
            for (int i = 0; i < 8; ++i) x[i] = *(const float4*)(res + o + (i >> 2) * 32 + 8 * (i & 3));
#pragma unroll
            for (int i = 0; i < 8; ++i) {
                const int tn = i >> 2, g = i & 3;
                x[i].x += acc[tm][tn][4 * g]; x[i].y += acc[tm][tn][4 * g + 1]; x[i].z += acc[tm][tn][4 * g + 2]; x[i].w += acc[tm][tn][4 * g + 3];
            }
#pragma unroll
            for (int i = 0; i < 8; ++i) *(float4*)(out + o + (i >> 2) * 32 + 8 * (i & 3)) = x[i];
        }
    }
};
DI float silu_mul(float g, float u) { return g / (1.0f + __expf(-g)) * u; }
struct EpiGateUp {
    bf16_t* out;
    DI void operator()(const f32x16 (&acc)[2][2], int wm, int wn, int r, int h) const {
#pragma unroll
        for (int tm = 0; tm < 2; ++tm) {
            bf16_t* rp = out + (size_t)(wm * 64 + tm * 32 + r) * DE + wn * 32 + 4 * h;
#pragma unroll
            for (int g = 0; g < 4; ++g) {
                u32x2 v;
                v.x = pk2(silu_mul(acc[tm][0][4 * g], acc[tm][1][4 * g]), silu_mul(acc[tm][0][4 * g + 1], acc[tm][1][4 * g + 1]));
                v.y = pk2(silu_mul(acc[tm][0][4 * g + 2], acc[tm][1][4 * g + 2]), silu_mul(acc[tm][0][4 * g + 3], acc[tm][1][4 * g + 3]));
                *(u32x2*)(rp + 8 * g) = v;
            }
        }
    }
};
struct EpiDown {
    bf16_t* out; const float* roww; int nvalid;
    DI void operator()(const f32x16 (&acc)[2][2], int wm, int wn, int r, int h) const {
#pragma unroll
        for (int tm = 0; tm < 2; ++tm) {
            const int row = wm * 64 + tm * 32 + r;
            const float wv = row < nvalid ? roww[row] : 0.f;
            bf16_t* rp = out + (size_t)row * DM + wn * 64 + 4 * h;
#pragma unroll
            for (int tn = 0; tn < 2; ++tn)
#pragma unroll
                for (int g = 0; g < 4; ++g) {
                    u32x2 v; v.x = pk2(acc[tm][tn][4 * g] * wv, acc[tm][tn][4 * g + 1] * wv); v.y = pk2(acc[tm][tn][4 * g + 2] * wv, acc[tm][tn][4 * g + 3] * wv);
                    *(u32x2*)(rp + tn * 32 + 8 * g) = v;
                }
        }
    }
};

struct EpiGates {
    float* out; const float* bi; const float* bf;
    DI void operator()(const f32x16 (&acc)[2][2], int wm, int wn, int r, int h) const {
        if (wn == 0) {
#pragma unroll
            for (int tm = 0; tm < 2; ++tm) {
                const float* bb = h ? bf : bi;
                float4 x = {acc[tm][0][0] + bb[0], acc[tm][0][1] + bb[1], acc[tm][0][2] + bb[2], acc[tm][0][3] + bb[3]};
                *(float4*)(out + (size_t)(wm * 64 + tm * 32 + r) * 8 + 4 * h) = x;
            }
        }
    }
};
struct EpiInproj {
    EpiBf16 eb; EpiGates eg; bool isgate;
    DI void operator()(const f32x16 (&acc)[2][2], int wm, int wn, int r, int h) const { if (isgate) eg(acc, wm, wn, r, h); else eb(acc, wm, wn, r, h); }
};
struct EpiF32 {
    float* out; size_t ld;
    DI void operator()(const f32x16 (&acc)[2][2], int wm, int wn, int r, int h) const {
#pragma unroll
        for (int tm = 0; tm < 2; ++tm) {
            float* rp = out + (size_t)(wm * 64 + tm * 32 + r) * ld + wn * 64 + 4 * h;
#pragma unroll
            for (int tn = 0; tn < 2; ++tn)
#pragma unroll
                for (int g = 0; g < 4; ++g) { float4 x = {acc[tm][tn][4 * g], acc[tm][tn][4 * g + 1], acc[tm][tn][4 * g + 2], acc[tm][tn][4 * g + 3]}; *(float4*)(rp + tn * 32 + 8 * g) = x; }
        }
    }
};
DI float gelu_tanh(float v) {
    const float inner = 0.7978845608028654f * (v + 0.044715f * v * v * v);
    const float th = 1.0f - 2.0f / (__expf(2.0f * inner) + 1.0f);
    return 0.5f * v * (1.0f + th);
}
struct EpiS5Y {
    bf16_t* zrow0;
    int ncol0;
    DI void operator()(const f32x16 (&acc)[2][2], int wm, int wn, int r, int h) const {
#pragma unroll
        for (int tm = 0; tm < 2; ++tm) {
            const int chunk = wm * 64 + tm * 32 + r;
#pragma unroll
            for (int tn = 0; tn < 2; ++tn)
#pragma unroll
                for (int g = 0; g < 4; ++g) {
                    const int n0 = ncol0 + wn * 64 + tn * 32 + 8 * g + 4 * h;
                    u32x2 v; v.x = pk2(gelu_tanh(acc[tm][tn][4 * g]), gelu_tanh(acc[tm][tn][4 * g + 1])); v.y = pk2(gelu_tanh(acc[tm][tn][4 * g + 2]), gelu_tanh(acc[tm][tn][4 * g + 3]));
                    *(u32x2*)(zrow0 + (size_t)(chunk * 16 + (n0 >> 4)) * 256 + (n0 & 15)) = v;
                }
        }
    }
};
struct EpiGlu {
    const bf16_t* z; bf16_t* out; const float* gb; const float* sg;
    DI void operator()(const f32x16 (&acc)[2][2], int wm, int wn, int r, int h) const {
#pragma unroll
        for (int tm = 0; tm < 2; ++tm) {
            const int row = wm * 64 + tm * 32 + r;
#pragma unroll
            for (int tn = 0; tn < 2; ++tn) {
                const int c0 = wn * 64 + tn * 32 + 4 * h;
                float y[16];
#pragma unroll
                for (int g = 0; g < 4; ++g) {
                    const u32x2 zz = *(const u32x2*)(z + (size_t)row * 256 + c0 + 8 * g);
                    const float4 b4 = *(const float4*)(gb + c0 + 8 * g);
                    y[4 * g + 0] = bf2f(zz.x & 0xffff) / (1.0f + __expf(-(acc[tm][tn][4 * g + 0] + b4.x)));
                    y[4 * g + 1] = bf2f(zz.x >> 16) / (1.0f + __expf(-(acc[tm][tn][4 * g + 1] + b4.y)));
                    y[4 * g + 2] = bf2f(zz.y & 0xffff) / (1.0f + __expf(-(acc[tm][tn][4 * g + 2] + b4.z)));
                    y[4 * g + 3] = bf2f(zz.y >> 16) / (1.0f + __expf(-(acc[tm][tn][4 * g + 3] + b4.w)));
                }
#pragma unroll
                for (int q = 0; q < 2; ++q) {
                    float ss = 0.f;
#pragma unroll
                    for (int e = 0; e < 8; ++e) ss += y[8 * q + e] * y[8 * q + e];
                    ss = half_swap_sum(ss);
                    const float rstd = rsqrtf(ss * (1.0f / 16.0f) + EPS);
#pragma unroll
                    for (int g = 2 * q; g < 2 * q + 2; ++g) {
                        const float4 s4 = *(const float4*)(sg + c0 + 8 * g);
                        u32x2 v; v.x = pk2(y[4 * g] * rstd * s4.x, y[4 * g + 1] * rstd * s4.y); v.y = pk2(y[4 * g + 2] * rstd * s4.z, y[4 * g + 3] * rstd * s4.w);
                        *(u32x2*)(out + (size_t)row * DM + c0 + 8 * g) = v;
                    }
                }
            }
        }
    }
};

DI void moe_prefix(const int* cnt, int* stp  ) {
    __syncthreads();
    if (tid_() == 0) { int a = 0; for (int e = 0; e < NE; ++e) { stp[e] = a; a += (cnt[e] + 127) >> 7; } stp[NE] = a; }
    __syncthreads();
}

constexpr int XS_P = 1028;
template <int NC>
DI void rows_matvec(const float* xs, const float* W, int ldw, float* part  ) {
    constexpr int O = 8 * NC, PARTS = 256 / O, KLEN = 1024 / PARTS;
    const int t = tid_(), o = t % O, prt = t / O, r = o / NC, j = o % NC;
    const float* xr = xs + r * XS_P + prt * KLEN;
    const float* wp = W + (size_t)(prt * KLEN) * ldw + j;
    float a0 = 0.f, a1 = 0.f, a2 = 0.f, a3 = 0.f;
#pragma unroll 4
    for (int k = 0; k < KLEN; k += 4) {
        const float4 x = *(const float4*)(xr + k);
        a0 += x.x * wp[(size_t)k * ldw]; a1 += x.y * wp[(size_t)(k + 1) * ldw]; a2 += x.z * wp[(size_t)(k + 2) * ldw]; a3 += x.w * wp[(size_t)(k + 3) * ldw];
    }
    part[t] = (a0 + a1) + (a2 + a3);
}

DI void phase_norm1(const P& p, int l, char* lds) {
    const int t = tid_(), lane = t & 63, w = t >> 6;
    float* xres = (float*)(p.ws + WS_XRES);
    bf16_t* hbuf = (bf16_t*)(p.ws + WS_HBUF);
    float* gates = (float*)(p.ws + WS_GATES);
    const float* g1 = p.in[1] + l * DM;
    const float* win = p.in[2] + (size_t)l * DM * DIN;
    float* xs = (float*)lds;
    float* part = xs + 8 * XS_P;
    int* stp = (int*)(part + 256);
    const bf16_t* ymoe = (const bf16_t*)(p.ws + WS_YMOE);
    const int4* tinfo = (const int4*)(p.ws + WS_TINFO);
    if (l > 0) moe_prefix((const int*)(p.ws + WS_CTL) + (l - 1) * NE, stp);
    for (int rb = bid_(); rb < T / 8; rb += gridDim.x) {
        __syncthreads();
#pragma unroll
        for (int rr = 0; rr < 2; ++rr) {
            const int lr = w * 2 + rr, row = rb * 8 + lr;
            float4 v[4];
            const float* xsrc = (l == 0) ? p.in[0] + (size_t)row * DM : xres + (size_t)row * DM;
#pragma unroll
            for (int i = 0; i < 4; ++i) v[i] = *(const float4*)(xsrc + i * 256 + lane * 4);
            if (l > 0) {
                int4 ti = tinfo[row];
                const bf16_t* y0 = ymoe + (size_t)(stp[ti.x] * 128 + ti.y) * DM;
                const bf16_t* y1 = ymoe + (size_t)(stp[ti.z] * 128 + ti.w) * DM;
#pragma unroll
                for (int i = 0; i < 4; ++i) {
                    uint2 a = *(const uint2*)(y0 + i * 256 + lane * 4), b2 = *(const uint2*)(y1 + i * 256 + lane * 4);
                    v[i].x += bf2f(a.x & 0xffff) + bf2f(b2.x & 0xffff); v[i].y += bf2f(a.x >> 16) + bf2f(b2.x >> 16);
                    v[i].z += bf2f(a.y & 0xffff) + bf2f(b2.y & 0xffff); v[i].w += bf2f(a.y >> 16) + bf2f(b2.y >> 16);
                    *(float4*)(xres + (size_t)row * DM + i * 256 + lane * 4) = v[i];
                }
            }
            float ss = 0.f;
#pragma unroll
            for (int i = 0; i < 4; ++i) ss += v[i].x * v[i].x + v[i].y * v[i].y + v[i].z * v[i].z + v[i].w * v[i].w;
            ss = wave_sum(ss);
            const float rstd = rsqrtf(ss * (1.0f / DM) + EPS);
#pragma unroll
            for (int i = 0; i < 4; ++i) {
                const int k0 = i * 256 + lane * 4;
                const float4 g = *(const float4*)(g1 + k0);
                float4 hv = {v[i].x * rstd * g.x, v[i].y * rstd * g.y, v[i].z * rstd * g.z, v[i].w * rstd * g.w};
                uint2 o; o.x = pk2(hv.x, hv.y); o.y = pk2(hv.z, hv.w);
                *(uint2*)(hbuf + (size_t)row * DM + k0) = o;
            }
        }
    }
}

DI void phase_inproj(const P& p, int l, char* lds) {
    const int t = tid_();
    const bf16_t* hbuf = (const bf16_t*)(p.ws + WS_HBUF);
    bf16_t* projb = (bf16_t*)(p.ws + WS_PROJ);
    const float* win = p.in[2] + (size_t)l * DM * DIN;
    float* gates = (float*)(p.ws + WS_GATES);
    const int vx = bid_() & 7, vj = bid_() >> 3, nj = (gridDim.x - vx + 7) >> 3;
    for (int st = vx; st < 48; st += 8) {
      const int sm = st / 3, sn = st % 3, wdt = sn == 2 ? 7 : 8;
      for (int j = vj; j < 8 * wdt; j += nj) {
        const int mt = sm * 8 + j / wdt, vt = sn * 8 + j % wdt;
        const int acol = vt < 8 ? vt * 128 : (vt < 20 ? 1032 + (vt - 8) * 128 : (vt < 22 ? 2568 + (vt - 20) * 128 : 1024));
        const bf16_t* a0 = hbuf + (size_t)(mt * 128 + (t >> 2)) * DM + (t & 3) * 8;
        const float* b0 = win + (size_t)(t >> 5) * DIN + acol + (t & 31) * 4;
        EpiInproj epi{EpiBf16{projb + (size_t)mt * 128 * PJ + vt * 128, (size_t)PJ}, EpiGates{gates + (size_t)mt * 128 * 8, p.in[3] + l * 4, p.in[4] + l * 4}, vt == 22};
        gemm_tile(a0, a0 + (size_t)64 * DM, b0, DIN, DM / BK, lds, epi);
      }
    }
}

__constant__ float ROPE_INV_REV[8] = {0.15915494309189535f, 0.03086376340470123f, 0.005985185712713705f, 0.001160663641240061f,
                                      0.00022507907903927653f, 4.364795279280289e-05f, 8.464330808241401e-06f, 1.6414262627950345e-06f};
DI void load64(const bf16_t* ptr, float (&x)[64]) {
#pragma unroll
    for (int c = 0; c < 8; ++c) {
        u32x4 u = *(const u32x4*)(ptr + c * 8);
        x[c * 8 + 0] = bf2f(u.x & 0xffff); x[c * 8 + 1] = bf2f(u.x >> 16); x[c * 8 + 2] = bf2f(u.y & 0xffff); x[c * 8 + 3] = bf2f(u.y >> 16);
        x[c * 8 + 4] = bf2f(u.z & 0xffff); x[c * 8 + 5] = bf2f(u.z >> 16); x[c * 8 + 6] = bf2f(u.w & 0xffff); x[c * 8 + 7] = bf2f(u.w >> 16);
    }
}
DI void store64(bf16_t* ptr, const float (&x)[64], float sc) {
#pragma unroll
    for (int c = 0; c < 8; ++c) {
        u32x4 u;
        u.x = pk2(x[c * 8 + 0] * sc, x[c * 8 + 1] * sc); u.y = pk2(x[c * 8 + 2] * sc, x[c * 8 + 3] * sc);
        u.z = pk2(x[c * 8 + 4] * sc, x[c * 8 + 5] * sc); u.w = pk2(x[c * 8 + 6] * sc, x[c * 8 + 7] * sc);
        *(u32x4*)(ptr + c * 8) = u;
    }
}
DI void norm_rope64(float (&x)[64], const float* g, int pos) {
    float ss = 0.f;
#pragma unroll
    for (int d = 0; d < 64; ++d) ss += x[d] * x[d];
    const float rstd = rsqrtf(ss * (1.0f / 64.0f) + EPS);
#pragma unroll
    for (int d = 0; d < 64; ++d) x[d] = x[d] * rstd * g[d];
#pragma unroll
    for (int d = 0; d < 8; ++d) {
        constexpr double RINV[8] = {0.15915494309189535, 0.03086376340470123, 0.005985185712713705, 0.001160663641240061,
                                    0.00022507907903927653, 4.364795279280289e-05, 8.464330808241401e-06, 1.6414262627950345e-06};
        double rr = (double)pos * RINV[d];
        rr -= floor(rr);
        const float sn = __builtin_amdgcn_sinf((float)rr), cs = __builtin_amdgcn_cosf((float)rr);
        const float x1 = x[d], x2 = x[d + 8];
        x[d] = x1 * cs - x2 * sn; x[d + 8] = x2 * cs + x1 * sn;
    }
}
DI void phase_qkprep(const P& p, int l, char* lds) {
    bf16_t* projb = (bf16_t*)(p.ws + WS_PROJ);
    float* kmean = (float*)(p.ws + WS_KMEAN);
    float* red = (float*)lds;
    const int t = tid_(), lane = t & 63, w = t >> 6;
    for (int item = bid_(); item < 512; item += gridDim.x) {
        const int b = item >> 6, n = (item >> 3) & 7, hd = item & 7;
        const int pos = n * 256 + t;
        bf16_t* rowp = projb + ((size_t)b * SEQ + pos) * PJ + hd * 64;
        float x[64];
        load64(rowp + C_AQ, x);
        norm_rope64(x, p.in[8] + l * 64, pos);
        store64(rowp + C_AQ, x, 0.125f * 1.4426950408889634f);
        load64(rowp + C_AK, x);
        norm_rope64(x, p.in[9] + l * 64, pos);
        store64(rowp + C_AK, x, 1.0f);
        __syncthreads();
#pragma unroll
        for (int d = 0; d < 64; ++d) { const float v = wave_sum(x[d]); if (lane == (d & 63)) red[w * 64 + d] = v; }
        __syncthreads();
        if (t < 64) kmean[(size_t)item * 64 + t] = (red[t] + red[64 + t] + red[128 + t] + red[192 + t]) * (1.0f / 256.0f);
    }
    {
        bf16_t* mqkc = (bf16_t*)(p.ws + WS_MQKC);
        const float* cw = p.in[5] + l * 4 * 512; const float* cb = p.in[6] + l * 512;
        const int nthreads = gridDim.x * 256;
        for (int idx = bid_() * 256 + t; idx < T * 64; idx += nthreads) {
            const int token = idx >> 6, ch = (idx & 63) * 8, pos = token & (SEQ - 1);
            float a[8];
            { const float4 b0 = *(const float4*)(cb + ch), b1 = *(const float4*)(cb + ch + 4); a[0] = b0.x; a[1] = b0.y; a[2] = b0.z; a[3] = b0.w; a[4] = b1.x; a[5] = b1.y; a[6] = b1.z; a[7] = b1.w; }
#pragma unroll
            for (int j = 0; j < 4; ++j) {
                if (pos + j - 3 >= 0) {
                    const u32x4 u = *(const u32x4*)(projb + (size_t)(token + j - 3) * PJ + ch);
                    const float4 w0 = *(const float4*)(cw + j * 512 + ch), w1 = *(const float4*)(cw + j * 512 + ch + 4);
                    a[0] += bf2f(u.x & 0xffff) * w0.x; a[1] += bf2f(u.x >> 16) * w0.y; a[2] += bf2f(u.y & 0xffff) * w0.z; a[3] += bf2f(u.y >> 16) * w0.w;
                    a[4] += bf2f(u.z & 0xffff) * w1.x; a[5] += bf2f(u.z >> 16) * w1.y; a[6] += bf2f(u.w & 0xffff) * w1.z; a[7] += bf2f(u.w >> 16) * w1.w;
                }
            }
            const float sc = ch >= 256 ? 0.125f : 1.0f;
#pragma unroll
            for (int e = 0; e < 8; ++e) a[e] = a[e] / (1.0f + __expf(-a[e])) * sc;
            u32x4 o; o.x = pk2(a[0], a[1]); o.y = pk2(a[2], a[3]); o.z = pk2(a[4], a[5]); o.w = pk2(a[6], a[7]);
            *(u32x4*)(mqkc + (size_t)token * 512 + ch) = o;
        }
    }
    {
        const float* gates = (const float*)(p.ws + WS_GATES);
        float4* gscan = (float4*)(p.ws + WS_GSCAN);
        const int lane = t & 63, gwv = bid_() * 4 + (t >> 6), nwv = gridDim.x * 4;
        for (int it = gwv; it < (T / 64) * 4; it += nwv) {
            const int ck = it >> 2, hd = it & 3;
            const size_t row = (size_t)ck * 64 + lane;
            const float gi = gates[row * 8 + hd], gf = gates[row * 8 + 4 + hd];
            const float lf = fminf(gf, 0.f) - log1pf(expf(-fabsf(gf)));
            float bs = lf;
#pragma unroll
            for (int o = 1; o < 64; o <<= 1) { const float v = __shfl_up(bs, o); if (lane >= o) bs += v; }
            const float u = gi - bs; float um = u;
#pragma unroll
            for (int o = 1; o < 64; o <<= 1) { const float v = __shfl_up(um, o); if (lane >= o) um = fmaxf(um, v); }
            gscan[row * 4 + hd] = make_float4(bs, u, um, 0.f);
        }
    }
    {
        float* Tm = (float*)(p.ws + WS_S5M + (size_t)l * S5M_LAYER);
        float* Em = (float*)(p.ws + WS_S5M + (size_t)l * S5M_LAYER + S5M_E);
        float* Fm = (float*)(p.ws + WS_S5M + (size_t)l * S5M_LAYER + S5M_F);
        float* sp = (float*)lds + 512;
        for (int item = bid_(); item < 256; item += gridDim.x) {
            const int g = item >> 4, tau = item & 15, lg = l * 16 + g;
            Tm += 0;
            float* Tg = Tm + (size_t)g * 256 * 256; float* Eg = Em + (size_t)g * 256 * 128; float* Fg = Fm + (size_t)g * 128 * 256;
            __syncthreads();
            if (t < 64) {
                const float lr = p.in[11][lg * 64 + t], li = p.in[12][lg * 64 + t], dt = expf(p.in[18][lg]);
                const float mag1 = expf(lr * dt), a1r = mag1 * cosf(li * dt), a1i = mag1 * sinf(li * dt);
                const float magt = expf(lr * dt * tau), atr = magt * cosf(li * dt * tau), ati = magt * sinf(li * dt * tau);
                const float zr = a1r - 1.0f, zi = a1i, dn = lr * lr + li * li;
                sp[t] = atr; sp[64 + t] = ati; sp[128 + t] = atr * a1r - ati * a1i; sp[192 + t] = atr * a1i + ati * a1r;
                sp[256 + t] = (zr * lr + zi * li) / dn; sp[320 + t] = (zi * lr - zr * li) / dn;
            }
            __syncthreads();
            {
                const int hh = t >> 4, hp = t & 15;
                const float* cre = p.in[15] + ((size_t)lg * 16 + hh) * 64; const float* cim = p.in[16] + ((size_t)lg * 16 + hh) * 64;
                const float* bre = p.in[13] + (size_t)lg * 64 * 16 + hp; const float* bim = p.in[14] + (size_t)lg * 64 * 16 + hp;
                float kv = 0.f;
                for (int pi = 0; pi < 64; ++pi) {
                    const float fr = sp[256 + pi], fi = sp[320 + pi], br = bre[pi * 16], bi = bim[pi * 16];
                    const float bbr = fr * br - fi * bi, bbi = fr * bi + fi * br;
                    const float cr = cre[pi], ci = cim[pi], ar = sp[pi], ai = sp[64 + pi];
                    kv += (cr * ar - ci * ai) * bbr - (cr * ai + ci * ar) * bbi;
                }
                if (tau == 0 && hh == hp) kv += p.in[17][lg * 16 + hh];
                for (int s_ = 0; s_ + tau < 16; ++s_) {
                    const int t_ = s_ + tau;
                    Tg[(size_t)(s_ * 16 + hp) * 256 + t_ * 16 + hh] = kv;
                    if (tau > 0) Tg[(size_t)(t_ * 16 + hp) * 256 + s_ * 16 + hh] = 0.f;
                }
            }
            for (int idx = t; idx < 1024; idx += 256) {
                const int pi = idx >> 4, x = idx & 15;
                {
                    const float fr = sp[256 + pi], fi = sp[320 + pi];
                    const float br = p.in[13][((size_t)lg * 64 + pi) * 16 + x], bi = p.in[14][((size_t)lg * 64 + pi) * 16 + x];
                    const float bbr = fr * br - fi * bi, bbi = fr * bi + fi * br, ar = sp[pi], ai = sp[64 + pi];
                    const size_t ro = (size_t)((15 - tau) * 16 + x) * 128;
                    Eg[ro + pi] = ar * bbr - ai * bbi; Eg[ro + 64 + pi] = ar * bbi + ai * bbr;
                }
                {
                    const float cr = p.in[15][((size_t)lg * 16 + x) * 64 + pi], ci = p.in[16][((size_t)lg * 16 + x) * 64 + pi];
                    const float ar = sp[128 + pi], ai = sp[192 + pi];
                    Fg[(size_t)pi * 256 + tau * 16 + x] = cr * ar - ci * ai; Fg[(size_t)(64 + pi) * 256 + tau * 16 + x] = -(cr * ai + ci * ar);
                }
            }
        }
    }
}

DI void mlstm_item_simple(const P& p, int l, int item, float* sm) {
    const int b = item >> 4, hd = (item >> 2) & 3, dq = item & 3;
    const int t = tid_();
    const bf16_t* projb = (const bf16_t*)(p.ws + WS_PROJ);
    const float* gates = (const float*)(p.ws + WS_GATES);
    float* hraw = (float*)(p.ws + WS_HRAW);
    const float* cw = p.in[5] + l * 4 * 512; const float* cb = p.in[6] + l * 512;
    float* Q = sm; float* K = Q + 64 * 65; float* Sm = K + 64 * 65; float* V = Sm + 64 * 65; float* C = V + 64 * 16; float* nv = C + 64 * 16;
    float* bc = nv + 64; float* Mt = bc + 64; float* uu = Mt + 64; float* den = uu + 64; float* misc = den + 64;
    __syncthreads();
    for (int i = t; i < 1024; i += 256) C[i] = 0.f;
    if (t < 64) nv[t] = 0.f;
    if (t == 0) misc[0] = 0.f;
    for (int c = 0; c < 32; ++c) {
        __syncthreads();
        const int row0 = b * SEQ + c * 64;
        for (int i = t; i < 8192; i += 256) {
            const int which = i >> 12, tt = (i >> 6) & 63, d = i & 63, ch = which * 256 + hd * 64 + d;
            float a = cb[ch];
#pragma unroll
            for (int j = 0; j < 4; ++j) { const int ts = c * 64 + tt + j - 3; if (ts >= 0) a += bf2f(projb[(size_t)(b * SEQ + ts) * PJ + ch]) * cw[j * 512 + ch]; }
            float y = a / (1.0f + expf(-a));
            if (which) K[tt * 65 + d] = y * 0.125f; else Q[tt * 65 + d] = y;
        }
        for (int i = t; i < 1024; i += 256) { const int tt = i >> 4, d = i & 15; V[i] = bf2f(projb[(size_t)(row0 + tt) * PJ + C_MV + hd * 64 + dq * 16 + d]); }
        if (t < 64) {
            const float ig = gates[(size_t)(row0 + t) * 8 + hd], fg = gates[(size_t)(row0 + t) * 8 + 4 + hd];
            const float lf = fminf(fg, 0.f) - log1pf(expf(-fabsf(fg)));
            float bs = lf;
#pragma unroll
            for (int o = 1; o < 64; o <<= 1) { float v = __shfl_up(bs, o); if (t >= o) bs += v; }
            const float u = ig - bs; float um = u;
#pragma unroll
            for (int o = 1; o < 64; o <<= 1) { float v = __shfl_up(um, o); if (t >= o) um = fmaxf(um, v); }
            bc[t] = bs; uu[t] = u; Mt[t] = fmaxf(misc[0], um);
        }
        __syncthreads();
        for (int i = t; i < 4096; i += 256) {
            const int tt = i >> 6, s = i & 63; float v = 0.f;
            if (s <= tt) { float dsum = 0.f; for (int d = 0; d < 64; ++d) dsum += Q[tt * 65 + d] * K[s * 65 + d]; v = dsum * expf(uu[s] - Mt[tt]); }
            Sm[tt * 65 + s] = v;
        }
        __syncthreads();
        if (t < 64) {
            const float inter = expf(misc[0] - Mt[t]);
            float qn = 0.f, rs = 0.f;
            for (int d = 0; d < 64; ++d) { qn += Q[t * 65 + d] * nv[d]; rs += Sm[t * 65 + d]; }
            den[t] = fmaxf(fabsf(inter * qn + rs), expf(-(bc[t] + Mt[t])));
        }
        __syncthreads();
        for (int i = t; i < 1024; i += 256) {
            const int tt = i >> 4, d = i & 15;
            const float inter = expf(misc[0] - Mt[tt]);
            float a = 0.f, bsum = 0.f;
            for (int k = 0; k < 64; ++k) { a += Q[tt * 65 + k] * C[k * 16 + d]; bsum += Sm[tt * 65 + k] * V[k * 16 + d]; }
            hraw[(size_t)(row0 + tt) * 256 + hd * 64 + dq * 16 + d] = (inter * a + bsum) / den[tt];
        }
        __syncthreads();
        const float Mlast = Mt[63], decay = expf(misc[0] - Mlast);
        for (int i = t; i < 1024; i += 256) {
            const int dk = i >> 4, d = i & 15; float a = 0.f;
            for (int s = 0; s < 64; ++s) a += expf(uu[s] - Mlast) * K[s * 65 + dk] * V[s * 16 + d];
            C[i] = decay * C[i] + a;
        }
        if (t < 64) { float a = 0.f; for (int s = 0; s < 64; ++s) a += expf(uu[s] - Mlast) * K[s * 65 + t]; nv[t] = decay * nv[t] + a; }
        __syncthreads();
        if (t == 0) misc[0] = bc[63] + Mlast;
    }
}

constexpr int ML_QP = 144, ML_TP = 192;
constexpr int ML_Q = 0, ML_K = 9216, ML_KW = 18432, ML_V = 30720, ML_C = 43008, ML_N = 55296, ML_U = 55808, ML_NP = 56064, ML_SS = 57088;
DI bf16x8 scale8(u32x4 v, float w) {
    u32x4 o;
    o.x = pk2(bf2f(v.x & 0xffff) * w, bf2f(v.x >> 16) * w); o.y = pk2(bf2f(v.y & 0xffff) * w, bf2f(v.y >> 16) * w);
    o.z = pk2(bf2f(v.z & 0xffff) * w, bf2f(v.z >> 16) * w); o.w = pk2(bf2f(v.w & 0xffff) * w, bf2f(v.w >> 16) * w);
    return __builtin_bit_cast(bf16x8, o);
}
DI bf16x8 tr_frag(const LAS char* p, int hi_off) {
    s16x4 lo = tr_read(p), hi = tr_read(p + hi_off);
    return __builtin_shufflevector(lo, hi, 0, 1, 2, 3, 4, 5, 6, 7);
}
DI void mlstm_item(const P& p, int l, int item, char* lds_generic) {
    LAS char* lds = (LAS char*)lds_generic;
    const int b = item >> 2, hd = item & 3;
    const int t = tid_(), lane = t & 63, w = t >> 6, r = lane & 31, h = lane >> 5;
    const int i16 = lane & 15, q4 = i16 >> 2, pp = i16 & 3, blk = (lane >> 4) & 1;
    const int wd = w & 1, wt = w >> 1;
    const bf16_t* projb = (const bf16_t*)(p.ws + WS_PROJ);
    const bf16_t* mqkc = (const bf16_t*)(p.ws + WS_MQKC);
    const float* gates = (const float*)(p.ws + WS_GATES);
    bf16_t* mix = (bf16_t*)(p.ws + WS_MIX);
    const float* mg = p.in[7] + l * 256 + hd * 64;
    LAS float* nbuf = (LAS float*)(lds + ML_N); LAS float* ubuf2 = (LAS float*)(lds + ML_U); LAS float* npart = (LAS float*)(lds + ML_NP); LAS float* ssbuf = (LAS float*)(lds + ML_SS);
    const int srow = t >> 3, sc16 = t & 7;
    const float LOG2E = 1.4426950408889634f;
    __syncthreads();
    for (int i = t; i < 64 * ML_TP / 4; i += 256) ((LAS unsigned*)(lds + ML_C))[i] = 0u;
    if (t < 128) nbuf[t] = 0.f;
    f32x16 cacc;
#pragma unroll
    for (int e = 0; e < 16; ++e) cacc[e] = 0.f;
    float m = 0.f;
    const float4* gscan = (const float4*)(p.ws + WS_GSCAN);
    struct MlStage { u32x4 q0, q1, k0, k1, v0, v1; float4 g0, g1, gt, gl; u32x2 o0, o1, o2, o3; };
    const int tt = wt * 32 + r;
    auto gload = [&](MlStage& S, int c) {
        c = c < 31 ? c : 31;
        const size_t row0 = (size_t)b * SEQ + c * 64;
        const bf16_t* qp = mqkc + (row0 + srow) * 512 + hd * 64 + sc16 * 8;
        S.q0 = *(const u32x4*)qp; S.q1 = *(const u32x4*)(qp + 32 * 512);
        S.k0 = *(const u32x4*)(qp + 256); S.k1 = *(const u32x4*)(qp + 32 * 512 + 256);
        const bf16_t* vp = projb + (row0 + srow) * PJ + C_MV + hd * 64 + sc16 * 8;
        S.v0 = *(const u32x4*)vp; S.v1 = *(const u32x4*)(vp + (size_t)32 * PJ);
        S.g0 = gscan[(row0 + srow) * 4 + hd]; S.g1 = gscan[(row0 + srow + 32) * 4 + hd];
        S.gt = gscan[(row0 + tt) * 4 + hd]; S.gl = gscan[(row0 + 63) * 4 + hd];
        const bf16_t* op = projb + (row0 + tt) * PJ + C_MO + hd * 64 + wd * 32 + 4 * h;
        S.o0 = *(const u32x2*)(op); S.o1 = *(const u32x2*)(op + 8); S.o2 = *(const u32x2*)(op + 16); S.o3 = *(const u32x2*)(op + 24);
    };
    float4 mgr[4];
#pragma unroll
    for (int g = 0; g < 4; ++g) mgr[g] = *(const float4*)(mg + wd * 32 + 4 * h + 8 * g);
    MlStage SA;
    gload(SA, 0);
    auto chunk = [&](int c, const MlStage& CUR, MlStage& NXT) {
        const size_t row0 = (size_t)b * SEQ + c * 64;
        const u32x4 rq0 = CUR.q0, rq1 = CUR.q1, rk0 = CUR.k0, rk1 = CUR.k1, rv0 = CUR.v0, rv1 = CUR.v1;
        const float4 gl0 = CUR.g0, gl1 = CUR.g1, gtt = CUR.gt, glast = CUR.gl;
        const u32x2 opre[4] = {CUR.o0, CUR.o1, CUR.o2, CUR.o3};
        const float Mlast = fmaxf(m, glast.z), bL = glast.x;
        const float decay = __expf(m - Mlast);
        const float Mt_t = fmaxf(m, gtt.z), bs_t = gtt.x;
        {
            const float w0 = __expf(gl0.y - Mlast), w1 = __expf(gl1.y - Mlast);
            *(LAS u32x4*)(lds + ML_Q + srow * ML_QP + sc16 * 16) = rq0; *(LAS u32x4*)(lds + ML_Q + (srow + 32) * ML_QP + sc16 * 16) = rq1;
            *(LAS u32x4*)(lds + ML_K + srow * ML_QP + sc16 * 16) = rk0; *(LAS u32x4*)(lds + ML_K + (srow + 32) * ML_QP + sc16 * 16) = rk1;
            *(LAS u32x4*)(lds + ML_V + srow * ML_TP + sc16 * 16) = rv0; *(LAS u32x4*)(lds + ML_V + (srow + 32) * ML_TP + sc16 * 16) = rv1;
            *(LAS bf16x8*)(lds + ML_KW + srow * ML_TP + sc16 * 16) = scale8(rk0, w0); *(LAS bf16x8*)(lds + ML_KW + (srow + 32) * ML_TP + sc16 * 16) = scale8(rk1, w1);
            if (sc16 == 0) { ubuf2[srow] = gl0.y * LOG2E; ubuf2[srow + 32] = gl1.y * LOG2E; }
        }
        lds_barrier();
        gload(NXT, c + 1);
        const float inter = __expf(m - Mt_t);
        bf16x8 qf[4];
#pragma unroll
        for (int ks = 0; ks < 4; ++ks) qf[ks] = *(const LAS bf16x8*)(lds + ML_Q + tt * ML_QP + (ks * 16 + 8 * h) * 2);
        bf16x8 vf[4];
#pragma unroll
        for (int k4 = 0; k4 < 4; ++k4) vf[k4] = tr_frag(lds + ML_V + (k4 * 16 + 4 * h + q4) * ML_TP + (wd * 32 + 16 * blk) * 2 + 8 * pp, 8 * ML_TP);
        f32x16 acca, accb;
#pragma unroll
        for (int e = 0; e < 16; ++e) { acca[e] = 0.f; accb[e] = 0.f; }
        float rs = 0.f;
        const float Mt2 = Mt_t * LOG2E;
#pragma unroll
        for (int st = 0; st < 2; ++st) {
            if (st <= wt) {
                f32x16 sa;
#pragma unroll
                for (int e = 0; e < 16; ++e) sa[e] = 0.f;
#pragma unroll
                for (int ks = 0; ks < 4; ++ks) {
                    const bf16x8 kf = *(const LAS bf16x8*)(lds + ML_K + (st * 32 + r) * ML_QP + (ks * 16 + 8 * h) * 2);
                    sa = __builtin_amdgcn_mfma_f32_32x32x16_bf16(kf, qf[ks], sa, 0, 0, 0);
                }
#pragma unroll
                for (int g = 0; g < 4; ++g) {
                    const f32x4 u4 = *(const LAS f32x4*)(ubuf2 + st * 32 + 8 * g + 4 * h);
                    const float uu[4] = {u4.x, u4.y, u4.z, u4.w};
#pragma unroll
                    for (int i = 0; i < 4; ++i) {
                        const int sidx = st * 32 + 8 * g + 4 * h + i;
                        const float dv_ = (sidx <= tt) ? sa[4 * g + i] * __builtin_amdgcn_exp2f(uu[i] - Mt2) : 0.f;
                        sa[4 * g + i] = dv_; rs += dv_;
                    }
                }
#pragma unroll
                for (int sk = 0; sk < 2; ++sk) {
                    u32x4 pk; pk.x = pk2(sa[8 * sk], sa[8 * sk + 1]); pk.y = pk2(sa[8 * sk + 2], sa[8 * sk + 3]); pk.z = pk2(sa[8 * sk + 4], sa[8 * sk + 5]); pk.w = pk2(sa[8 * sk + 6], sa[8 * sk + 7]);
                    acca = __builtin_amdgcn_mfma_f32_32x32x16_bf16(vf[st * 2 + sk], __builtin_bit_cast(bf16x8, pk), acca, 0, 0, 0);
                }
            }
        }
#pragma unroll
        for (int ks = 0; ks < 4; ++ks) {
            const bf16x8 cf = tr_frag(lds + ML_C + (ks * 16 + 8 * h + q4) * ML_TP + (wd * 32 + 16 * blk) * 2 + 8 * pp, 4 * ML_TP);
            accb = __builtin_amdgcn_mfma_f32_32x32x16_bf16(cf, qf[ks], accb, 0, 0, 0);
        }
        float qn = 0.f;
        {
            const LAS float* nb = nbuf + (c & 1) * 64;
#pragma unroll
            for (int ks = 0; ks < 4; ++ks) {
                const f32x4 n0 = *(const LAS f32x4*)(nb + ks * 16 + 8 * h), n1 = *(const LAS f32x4*)(nb + ks * 16 + 8 * h + 4);
                qn += bf2f((bf16_t)qf[ks][0]) * n0.x + bf2f((bf16_t)qf[ks][1]) * n0.y + bf2f((bf16_t)qf[ks][2]) * n0.z + bf2f((bf16_t)qf[ks][3]) * n0.w
                    + bf2f((bf16_t)qf[ks][4]) * n1.x + bf2f((bf16_t)qf[ks][5]) * n1.y + bf2f((bf16_t)qf[ks][6]) * n1.z + bf2f((bf16_t)qf[ks][7]) * n1.w;
            }
        }
        qn = half_swap_sum(qn); rs = half_swap_sum(rs);
        const float hden = fmaxf(fabsf(inter * qn + rs), __expf(-(bs_t + Mt_t)));
        const float ihd = 1.0f / hden;
        float ss = 0.f;
#pragma unroll
        for (int e = 0; e < 16; ++e) { acca[e] = (acca[e] + inter * accb[e]) * ihd; ss += acca[e] * acca[e]; }
        ss = half_swap_sum(ss);
        if (h == 0) ssbuf[wd * 64 + tt] = ss;
#pragma unroll
        for (int e = 0; e < 16; ++e) cacc[e] *= decay;
#pragma unroll
        for (int k4 = 0; k4 < 4; ++k4) {
            const bf16x8 kwf = tr_frag(lds + ML_KW + (k4 * 16 + 4 * h + q4) * ML_TP + (wt * 32 + 16 * blk) * 2 + 8 * pp, 8 * ML_TP);
            cacc = __builtin_amdgcn_mfma_f32_32x32x16_bf16(vf[k4], kwf, cacc, 0, 0, 0);
        }
        {
            const int dk = t & 63, qd = t >> 6; float a = 0.f;
#pragma unroll
            for (int s_ = 0; s_ < 16; ++s_) a += bf2f(*(const LAS bf16_t*)(lds + ML_KW + (qd * 16 + s_) * ML_TP + dk * 2));
            npart[qd * 64 + dk] = a;
        }
        lds_barrier();
        if (t < 64) nbuf[((c + 1) & 1) * 64 + t] = decay * nbuf[(c & 1) * 64 + t] + ((npart[t] + npart[64 + t]) + (npart[128 + t] + npart[192 + t]));
#pragma unroll
        for (int g = 0; g < 4; ++g) {
            u32x2 v; v.x = pk2(cacc[4 * g], cacc[4 * g + 1]); v.y = pk2(cacc[4 * g + 2], cacc[4 * g + 3]);
            *(LAS u32x2*)(lds + ML_C + (wt * 32 + r) * ML_TP + (wd * 32 + 8 * g + 4 * h) * 2) = v;
        }
        {
            const float rstd = rsqrtf((ssbuf[tt] + ssbuf[64 + tt]) * (1.0f / 64.0f) + EPS);
            bf16_t* op = mix + (row0 + tt) * DM + hd * 64 + wd * 32 + 4 * h;
#pragma unroll
            for (int g = 0; g < 4; ++g) {
                const float4 g4 = mgr[g];
                const float o0 = bf2f(opre[g].x & 0xffff), o1 = bf2f(opre[g].x >> 16), o2 = bf2f(opre[g].y & 0xffff), o3 = bf2f(opre[g].y >> 16);
                u32x2 v;
                v.x = pk2(acca[4 * g] * rstd * g4.x * __builtin_amdgcn_rcpf(1.0f + __expf(-o0)), acca[4 * g + 1] * rstd * g4.y * __builtin_amdgcn_rcpf(1.0f + __expf(-o1)));
                v.y = pk2(acca[4 * g + 2] * rstd * g4.z * __builtin_amdgcn_rcpf(1.0f + __expf(-o2)), acca[4 * g + 3] * rstd * g4.w * __builtin_amdgcn_rcpf(1.0f + __expf(-o3)));
                *(u32x2*)(op + 8 * g) = v;
            }
        }
        m = bL + Mlast;
    };
#pragma unroll 1
    for (int c = 0; c < 32; ++c) chunk(c, SA, SA);
}

constexpr int KP = 144, VP = 192, ATT_K_BYTES = 64 * KP, ATT_BUF = 64 * KP + 64 * VP;
DI void moba_item(const P& p, int l, int item, char* lds_generic) {
    LAS char* lds = (LAS char*)lds_generic;
    const int b = item >> 7, hd = (item >> 4) & 7, qt = item & 15, qb = qt >> 1;
    const int t = tid_(), lane = t & 63, w = t >> 6, r = lane & 31, h = lane >> 5;
    const int i16 = lane & 15, q4 = i16 >> 2, pp = i16 & 3, blk = (lane >> 4) & 1;
    const bf16_t* projb = (const bf16_t*)(p.ws + WS_PROJ);
    bf16_t* mix = (bf16_t*)(p.ws + WS_MIX);
    const float* kmean = (const float*)(p.ws + WS_KMEAN);
    const size_t rowb = (size_t)b * SEQ;
    const int q0 = qt * 128, qpos = q0 + w * 32 + r;
    bf16x8 qf[4];
    {
        const bf16_t* qp = projb + (rowb + qpos) * PJ + C_AQ + hd * 64 + 8 * h;
#pragma unroll
        for (int ks = 0; ks < 4; ++ks) qf[ks] = *(const bf16x8*)(qp + ks * 16);
    }
    unsigned mask = 0;
    {
        float gate[8];
#pragma unroll
        for (int n = 0; n < 8; ++n) {
            float sacc = 0.f;
            if (n < qb) {
                const float* km = kmean + ((size_t)((b * 8 + n) * 8 + hd)) * 64 + 8 * h;
#pragma unroll
                for (int ks = 0; ks < 4; ++ks)
#pragma unroll
                    for (int j = 0; j < 8; ++j) sacc += bf2f((bf16_t)qf[ks][j]) * km[ks * 16 + j];
            }
            gate[n] = half_swap_sum(sacc);
        }
#pragma unroll
        for (int it = 0; it < 3; ++it) {
            int best = -1; float bv = -INFINITY;
#pragma unroll
            for (int n = 0; n < 8; ++n) if (n < qb && !((mask >> n) & 1u) && gate[n] > bv) { bv = gate[n]; best = n; }
            if (best >= 0) mask |= 1u << best;
        }
    }
    const int nown = ((q0 & 255) >> 6) + 2, ntiles = nown + qb * 4;
    f32x16 o0, o1;
#pragma unroll
    for (int e = 0; e < 16; ++e) { o0[e] = 0.f; o1[e] = 0.f; }
    float m = -INFINITY, lsum = 0.f;
    const int srow = t >> 3, sc16 = t & 7;
    u32x4 rk0, rk1, rv0, rv1;
    auto key0_of = [&](int it) { return it < nown ? qb * 256 + it * 64 : ((it - nown) >> 2) * 256 + ((it - nown) & 3) * 64; };
    auto gload = [&](int it) {
        const int key0 = key0_of(it);
        const bf16_t* base = projb + (rowb + key0 + srow) * PJ + hd * 64 + sc16 * 8;
        rk0 = *(const u32x4*)(base + C_AK); rk1 = *(const u32x4*)(base + (size_t)32 * PJ + C_AK);
        rv0 = *(const u32x4*)(base + C_AV); rv1 = *(const u32x4*)(base + (size_t)32 * PJ + C_AV);
    };
    auto sstore = [&](int buf) {
        LAS char* sK = lds + buf * ATT_BUF; LAS char* sV = sK + ATT_K_BYTES;
        *(LAS u32x4*)(sK + srow * KP + sc16 * 16) = rk0; *(LAS u32x4*)(sK + (srow + 32) * KP + sc16 * 16) = rk1;
        *(LAS u32x4*)(sV + srow * VP + sc16 * 16) = rv0; *(LAS u32x4*)(sV + (srow + 32) * VP + sc16 * 16) = rv1;
    };
    __syncthreads();
    gload(0); sstore(0); __syncthreads();
    for (int it = 0; it < ntiles; ++it) {
        if (it + 1 < ntiles) gload(it + 1);
        {
            const LAS char* sK = lds + (it & 1) * ATT_BUF; const LAS char* sV = sK + ATT_K_BYTES;
            const int key0 = key0_of(it), blockn = key0 >> 8;
            f32x16 s0, s1;
#pragma unroll
            for (int e = 0; e < 16; ++e) { s0[e] = 0.f; s1[e] = 0.f; }
#pragma unroll
            for (int ks = 0; ks < 4; ++ks) {
                const bf16x8 k0 = *(const LAS bf16x8*)(sK + r * KP + (ks * 16 + 8 * h) * 2);
                const bf16x8 k1 = *(const LAS bf16x8*)(sK + (32 + r) * KP + (ks * 16 + 8 * h) * 2);
                s0 = __builtin_amdgcn_mfma_f32_32x32x16_bf16(k0, qf[ks], s0, 0, 0, 0);
                s1 = __builtin_amdgcn_mfma_f32_32x32x16_bf16(k1, qf[ks], s1, 0, 0, 0);
            }
            const bool own = (blockn == qb);
            const bool active = own || ((mask >> blockn) & 1u);
            if (!active) {
#pragma unroll
                for (int e = 0; e < 16; ++e) { s0[e] = -INFINITY; s1[e] = -INFINITY; }
            } else if (own && key0 + 63 > q0 + w * 32) {
#pragma unroll
                for (int e = 0; e < 16; ++e) {
                    const int kk = key0 + (e & 3) + 8 * (e >> 2) + 4 * h;
                    if (kk > qpos) s0[e] = -INFINITY;
                    if (kk + 32 > qpos) s1[e] = -INFINITY;
                }
            }
            float mx = fmaxf(s0[0], s1[0]);
#pragma unroll
            for (int e = 1; e < 16; ++e) mx = fmaxf(mx, fmaxf(s0[e], s1[e]));
            mx = half_swap_max(mx);
            const float mn = fmaxf(m, mx);
            const float alpha = __builtin_amdgcn_exp2f(m - mn);
            m = mn;
            float ps = 0.f;
#pragma unroll
            for (int e = 0; e < 16; ++e) { s0[e] = __builtin_amdgcn_exp2f(s0[e] - mn); s1[e] = __builtin_amdgcn_exp2f(s1[e] - mn); ps += s0[e] + s1[e]; }
            lsum = lsum * alpha + ps;
#pragma unroll
            for (int e = 0; e < 16; ++e) { o0[e] *= alpha; o1[e] *= alpha; }
#pragma unroll
            for (int st = 0; st < 2; ++st)
#pragma unroll
                for (int sk = 0; sk < 2; ++sk) {
                    u32x4 pk;
                    if (st == 0) { pk.x = pk2(s0[8 * sk], s0[8 * sk + 1]); pk.y = pk2(s0[8 * sk + 2], s0[8 * sk + 3]); pk.z = pk2(s0[8 * sk + 4], s0[8 * sk + 5]); pk.w = pk2(s0[8 * sk + 6], s0[8 * sk + 7]); }
                    else         { pk.x = pk2(s1[8 * sk], s1[8 * sk + 1]); pk.y = pk2(s1[8 * sk + 2], s1[8 * sk + 3]); pk.z = pk2(s1[8 * sk + 4], s1[8 * sk + 5]); pk.w = pk2(s1[8 * sk + 6], s1[8 * sk + 7]); }
                    const bf16x8 pf = __builtin_bit_cast(bf16x8, pk);
                    const LAS char* vb = sV + (st * 32 + sk * 16 + 4 * h + q4) * VP + (16 * blk) * 2 + 8 * pp;
                    {
                        s16x4 lo = tr_read(vb), hi = tr_read(vb + 8 * VP);
                        const bf16x8 vf = __builtin_shufflevector(lo, hi, 0, 1, 2, 3, 4, 5, 6, 7);
                        o0 = __builtin_amdgcn_mfma_f32_32x32x16_bf16(vf, pf, o0, 0, 0, 0);
                    }
                    {
                        s16x4 lo = tr_read(vb + 64), hi = tr_read(vb + 64 + 8 * VP);
                        const bf16x8 vf = __builtin_shufflevector(lo, hi, 0, 1, 2, 3, 4, 5, 6, 7);
                        o1 = __builtin_amdgcn_mfma_f32_32x32x16_bf16(vf, pf, o1, 0, 0, 0);
                    }
                }
        }
        if (it + 1 < ntiles) sstore((it + 1) & 1);
        __syncthreads();
    }
    const float il = 1.0f / half_swap_sum(lsum);
    float ss = 0.f;
#pragma unroll
    for (int e = 0; e < 16; ++e) { o0[e] *= il; o1[e] *= il; ss += o0[e] * o0[e] + o1[e] * o1[e]; }
    ss = half_swap_sum(ss);
    const float rstd = rsqrtf(ss * (1.0f / 64.0f) + EPS);
    const float* og = p.in[10] + (l * 8 + hd) * 64 + 4 * h;
    bf16_t* op = mix + (rowb + qpos) * DM + 256 + hd * 64 + 4 * h;
#pragma unroll
    for (int g = 0; g < 4; ++g) {
        const float4 g0 = *(const float4*)(og + 8 * g), g1 = *(const float4*)(og + 32 + 8 * g);
        u32x2 v0, v1;
        v0.x = pk2(o0[4 * g] * rstd * g0.x, o0[4 * g + 1] * rstd * g0.y); v0.y = pk2(o0[4 * g + 2] * rstd * g0.z, o0[4 * g + 3] * rstd * g0.w);
        v1.x = pk2(o1[4 * g] * rstd * g1.x, o1[4 * g + 1] * rstd * g1.y); v1.y = pk2(o1[4 * g + 2] * rstd * g1.z, o1[4 * g + 3] * rstd * g1.w);
        *(u32x2*)(op + 8 * g) = v0; *(u32x2*)(op + 32 + 8 * g) = v1;
    }
}

DI void s5_item_simple(const P& p, int l, int item, float* sm) {
    const int t = tid_(), lane = t & 63, w = t >> 6;
    const int bg = item * 4 + w, b = bg >> 4, g = bg & 15;
    const bf16_t* projb = (const bf16_t*)(p.ws + WS_PROJ);
    float* zbuf = (float*)(p.ws + WS_ZBUF);
    float* xr = sm + w * (2 * 16 * 65); float* xi = xr + 16 * 65;
    const int lg = l * 16 + g;
    const float lr = p.in[11][lg * 64 + lane], li = p.in[12][lg * 64 + lane];
    const float dt = expf(p.in[18][lg]);
    const float mag = expf(lr * dt);
    const float are = mag * cosf(li * dt), aim = mag * sinf(li * dt);
    const float zr = are - 1.0f, zi = aim, dn = lr * lr + li * li;
    const float fr = (zr * lr + zi * li) / dn, fi = (zi * lr - zr * li) / dn;
    float bbr[16], bbi[16];
#pragma unroll
    for (int hh = 0; hh < 16; ++hh) {
        const float br = p.in[13][((size_t)lg * 64 + lane) * 16 + hh], bi = p.in[14][((size_t)lg * 64 + lane) * 16 + hh];
        bbr[hh] = fr * br - fi * bi; bbi[hh] = fr * bi + fi * br;
    }
    const float* cre = p.in[15] + (size_t)lg * 16 * 64; const float* cim = p.in[16] + (size_t)lg * 16 * 64;
    const float* dd = p.in[17] + lg * 16;
    float sr = 0.f, si = 0.f;
    __syncthreads();
    for (int c = 0; c < SEQ / 16; ++c) {
        const size_t row0 = (size_t)b * SEQ + c * 16;
        for (int tt = 0; tt < 16; ++tt) {
            const bf16_t* up = projb + (row0 + tt) * PJ + C_SU + g * 16;
            uint4 u0 = *(const uint4*)up, u1 = *(const uint4*)(up + 8);
            float u[16] = {bf2f(u0.x & 0xffff), bf2f(u0.x >> 16), bf2f(u0.y & 0xffff), bf2f(u0.y >> 16), bf2f(u0.z & 0xffff), bf2f(u0.z >> 16), bf2f(u0.w & 0xffff), bf2f(u0.w >> 16),
                           bf2f(u1.x & 0xffff), bf2f(u1.x >> 16), bf2f(u1.y & 0xffff), bf2f(u1.y >> 16), bf2f(u1.z & 0xffff), bf2f(u1.z >> 16), bf2f(u1.w & 0xffff), bf2f(u1.w >> 16)};
            float br = 0.f, bi = 0.f;
#pragma unroll
            for (int hh = 0; hh < 16; ++hh) { br += bbr[hh] * u[hh]; bi += bbi[hh] * u[hh]; }
            const float nr = are * sr - aim * si + br, ni = are * si + aim * sr + bi;
            sr = nr; si = ni;
            xr[tt * 65 + lane] = sr; xi[tt * 65 + lane] = si;
        }
        __syncthreads();
        {
            const int tt = lane >> 2, hq = lane & 3;
            float y[4] = {0.f, 0.f, 0.f, 0.f};
            for (int pp = 0; pp < 64; ++pp) {
                const float a = xr[tt * 65 + pp], bq = xi[tt * 65 + pp];
#pragma unroll
                for (int j = 0; j < 4; ++j) y[j] += cre[(hq * 4 + j) * 64 + pp] * a - cim[(hq * 4 + j) * 64 + pp] * bq;
            }
#pragma unroll
            for (int j = 0; j < 4; ++j) {
                const int hh = hq * 4 + j;
                float v = y[j] + dd[hh] * bf2f(projb[(row0 + tt) * PJ + C_SU + g * 16 + hh]);
                const float inner = 0.7978845608028654f * (v + 0.044715f * v * v * v);
                const float th = 1.0f - 2.0f / (expf(2.0f * inner) + 1.0f);
                zbuf[(row0 + tt) * 256 + g * 16 + hh] = 0.5f * v * (1.0f + th);
            }
        }
        __syncthreads();
    }
}

DI void s5_item(const P& p, int l, int item, char* lds) {
    const int b = item >> 4, g = item & 15, lg = l * 16 + g;
    const int t = tid_();
    const bf16_t* projb = (const bf16_t*)(p.ws + WS_PROJ);
    bf16_t* zbuf = (bf16_t*)(p.ws + WS_ZBUF);
    const float* Tg = (const float*)(p.ws + WS_S5M + (size_t)l * S5M_LAYER) + (size_t)g * 256 * 256;
    const float* Eg = (const float*)(p.ws + WS_S5M + (size_t)l * S5M_LAYER + S5M_E) + (size_t)g * 256 * 128;
    const float* Fg = (const float*)(p.ws + WS_S5M + (size_t)l * S5M_LAYER + S5M_F) + (size_t)g * 128 * 256;
    float* eloc = (float*)(p.ws + WS_ELOC) + ((size_t)l * 128 + item) * 128 * 128;
    bf16_t* carr = (bf16_t*)(p.ws + WS_CARR) + ((size_t)l * 128 + item) * 128 * 128;
    const size_t rowb = (size_t)b * SEQ;
    const bf16_t* ua0 = projb + (rowb + (size_t)(t >> 2) * 16 + ((t & 3) >> 1)) * PJ + C_SU + g * 16 + (t & 1) * 8;
    const bf16_t* ua1 = ua0 + (size_t)64 * 16 * PJ;
    {
        GSeg g1{ua0, ua1, 2 * PJ, Eg + (size_t)(t >> 5) * 128 + (t & 31) * 4, 128, 8}; GSeg g2 = g1; g2.KT = 0;
        EpiF32 epi{eloc, 128};
        gemm_tile2(g1, g2, lds, epi);
    }
    __syncthreads();
    if (t < 64) {
        const float lr = p.in[11][lg * 64 + t], li = p.in[12][lg * 64 + t], dt = expf(p.in[18][lg]);
        const float mag = expf(lr * dt * 16.0f), ar = mag * cosf(li * dt * 16.0f), ai = mag * sinf(li * dt * 16.0f);
        float sr = 0.f, si = 0.f;
        for (int bt = 0; bt < 8; ++bt) {
            float er[16], ei[16];
#pragma unroll
            for (int i = 0; i < 16; ++i) { er[i] = eloc[(size_t)(bt * 16 + i) * 128 + t]; ei[i] = eloc[(size_t)(bt * 16 + i) * 128 + 64 + t]; }
#pragma unroll
            for (int i = 0; i < 16; ++i) {
                carr[(size_t)(bt * 16 + i) * 128 + t] = f2bf(sr); carr[(size_t)(bt * 16 + i) * 128 + 64 + t] = f2bf(si);
                const float nr = ar * sr - ai * si + er[i], ni = ar * si + ai * sr + ei[i];
                sr = nr; si = ni;
            }
        }
    }
    __syncthreads();
    const bf16_t* ca0 = carr + (size_t)(t >> 2) * 128 + (t & 3) * 8;
#pragma unroll 1
    for (int nt = 0; nt < 2; ++nt) {
        GSeg g1{ua0, ua1, 2 * PJ, Tg + (size_t)(t >> 5) * 256 + nt * 128 + (t & 31) * 4, 256, 4 * (nt + 1)};
        GSeg g2{ca0, ca0 + (size_t)64 * 128, BK, Fg + (size_t)(t >> 5) * 256 + nt * 128 + (t & 31) * 4, 256, 4};
        EpiS5Y epi{zbuf + rowb * 256 + g * 16, nt * 128};
        gemm_tile2(g1, g2, lds, epi);
    }
}

#ifndef PROBE_SUB
#define PROBE_SUB 0
#endif
DI void phase_mix(const P& p, int l, char* lds, unsigned long long& tsub) {
    for (int item = bid_(); item < 32 + 128 + 1024; item += gridDim.x) {
        const unsigned long long ts0 = PROBE_SUB ? wall_clock64() : 0ull;
        const int kind = item < 32 ? 1 : (item < 160 ? 2 : 4);
        if (item < 32) mlstm_item(p, l, item, lds);
        else if (item < 160) s5_item(p, l, item - 32, lds);
        else {
            const int i2 = item - 160;
            const int qo = i2 >> 6, bh = i2 & 63;
            moba_item(p, l, (bh << 4) | (15 - qo), lds);
        }
        if (PROBE_SUB & kind) tsub += wall_clock64() - ts0;
    }
}

DI void phase_glu(const P& p, int l, char* lds) {
    const int t = tid_();
    const bf16_t* zb = (const bf16_t*)(p.ws + WS_ZBUF);
    bf16_t* mix = (bf16_t*)(p.ws + WS_MIX);
    const float* gw = p.in[19] + (size_t)l * 256 * 256; const float* gb = p.in[20] + l * 256; const float* sg = p.in[21] + l * 256;
    for (int tile = bid_(); tile < 128 * 2; tile += gridDim.x) {
        const int mt = tile >> 1, nt = tile & 1;
        const bf16_t* a0 = zb + (size_t)(mt * 128 + (t >> 2)) * 256 + (t & 3) * 8;
        const float* b0 = gw + (size_t)(t >> 5) * 256 + nt * 128 + (t & 31) * 4;
        EpiGlu epi{zb + (size_t)mt * 128 * 256 + nt * 128, mix + (size_t)mt * 128 * DM + 768 + nt * 128, gb + nt * 128, sg + nt * 128};
        gemm_tile(a0, a0 + (size_t)64 * 256, b0, 256, 256 / BK, lds, epi);
    }
}

DI void phase_outproj(const P& p, int l, char* lds) {
    const int t = tid_();
    const bf16_t* mix = (const bf16_t*)(p.ws + WS_MIX);
    float* xres = (float*)(p.ws + WS_XRES);
    const float* wout = p.in[22] + (size_t)l * DM * DM;
    const float* xin = (l == 0) ? p.in[0] : xres;
    const int vx = bid_() & 7, vj = bid_() >> 3, nj = (gridDim.x - vx + 7) >> 3;
    for (int st = vx; st < 16; st += 8)
    for (int j = vj; j < 64; j += nj) {
        const int mt = st * 8 + (j >> 3), nt = j & 7;
        const bf16_t* a0 = mix + (size_t)(mt * 128 + (t >> 2)) * DM + (t & 3) * 8;
        const float* b0 = wout + (size_t)(t >> 5) * DM + nt * 128 + (t & 31) * 4;
        const size_t o = (size_t)mt * 128 * DM + nt * 128;
        EpiResid epi{xres + o, xin + o, (size_t)DM};
        gemm_tile(a0, a0 + (size_t)64 * DM, b0, DM, DM / BK, lds, epi);
    }
}

DI void phase_norm2(const P& p, int l, char* lds) {
    const int t = tid_(), lane = t & 63, w = t >> 6;
    const float* xres = (const float*)(p.ws + WS_XRES);
    bf16_t* hbuf = (bf16_t*)(p.ws + WS_HBUF);
    const float* g2 = p.in[23] + l * DM;
    const float* wg = p.in[24] + (size_t)l * DM * 4; const float* bg = p.in[25] + l * 4;
    const float* we = p.in[26] + (size_t)l * DM * NE; const float* be = p.in[27] + l * NE;
    int4* rinfo = (int4*)(p.ws + WS_RINFO); int* hist = (int*)(p.ws + WS_HIST);
    int* lh = (int*)(lds + 65536 - 16 - 128);
    if (t < NE) lh[t] = 0;
    float* xs = (float*)lds;
    float* pe = xs + 8 * XS_P;
    for (int rb = bid_(); rb < T / 8; rb += gridDim.x) {
        __syncthreads();
#pragma unroll
        for (int rr = 0; rr < 2; ++rr) {
            const int lr = w * 2 + rr, row = rb * 8 + lr;
            float4 v[4];
#pragma unroll
            for (int i = 0; i < 4; ++i) v[i] = *(const float4*)(xres + (size_t)row * DM + i * 256 + lane * 4);
            float ss = 0.f;
#pragma unroll
            for (int i = 0; i < 4; ++i) ss += v[i].x * v[i].x + v[i].y * v[i].y + v[i].z * v[i].z + v[i].w * v[i].w;
            ss = wave_sum(ss);
            const float rstd = rsqrtf(ss * (1.0f / DM) + EPS);
#pragma unroll
            for (int i = 0; i < 4; ++i) {
                const int k0 = i * 256 + lane * 4;
                const float4 g = *(const float4*)(g2 + k0);
                float4 hv = {v[i].x * rstd * g.x, v[i].y * rstd * g.y, v[i].z * rstd * g.z, v[i].w * rstd * g.w};
                uint2 o; o.x = pk2(hv.x, hv.y); o.y = pk2(hv.z, hv.w);
                *(uint2*)(hbuf + (size_t)row * DM + k0) = o;
                *(float4*)(xs + lr * XS_P + k0) = hv;
            }
        }
        __syncthreads();
        {
            float* wb = pe + 1536;
            const float* wep = we + t * 4; const float* wgp = wg + (t & 127) * 4;
            float4 re0 = *(const float4*)(wep), re1 = *(const float4*)(wep + 1024), re2 = *(const float4*)(wep + 2048), re3 = *(const float4*)(wep + 3072);
            float4 rg = *(const float4*)(wgp);
            const int kq = lane >> 4, jc = lane & 15;
            f32x4 d0 = {0.f, 0.f, 0.f, 0.f}, d1 = d0, d2 = d0;
#pragma unroll 1
            for (int c = 0; c < 8; ++c) {
                {
                    const int e0 = t * 4;
#pragma unroll
                    for (int i = 0; i < 4; ++i) {
                        const int e = e0 + i * 1024, kk = e >> 5, jj = e & 31;
                        *(float4*)(wb + kk * 48 + jj) = (i == 0 ? re0 : i == 1 ? re1 : i == 2 ? re2 : re3);
                    }
                    if (t < 128) *(float4*)(wb + t * 48 + 32) = rg;
                }
                __syncthreads();
                if (c + 1 < 8) {
                    const float* q = wep + (size_t)(c + 1) * 4096;
                    re0 = *(const float4*)(q); re1 = *(const float4*)(q + 1024); re2 = *(const float4*)(q + 2048); re3 = *(const float4*)(q + 3072);
                    rg = *(const float4*)(wgp + (size_t)(c + 1) * 512);
                }
                const float* xa = xs + (lane & 7) * XS_P + c * 128 + w * 32 + kq;
                const float* wbp = wb + (w * 32 + kq) * 48 + jc;
#pragma unroll
                for (int ks = 0; ks < 8; ++ks) {
                    const float av = xa[ks * 4];
                    const float b0 = wbp[ks * 4 * 48], b1 = wbp[ks * 4 * 48 + 16], b2 = wbp[ks * 4 * 48 + 32];
                    d0 = __builtin_amdgcn_mfma_f32_16x16x4f32(av, b0, d0, 0, 0, 0);
                    d1 = __builtin_amdgcn_mfma_f32_16x16x4f32(av, b1, d1, 0, 0, 0);
                    d2 = __builtin_amdgcn_mfma_f32_16x16x4f32(av, b2, d2, 0, 0, 0);
                }
                __syncthreads();
            }
            if (lane < 32) {
#pragma unroll
                for (int rg_ = 0; rg_ < 4; ++rg_) {
                    const int row = 4 * kq + rg_;
                    pe[(w * 8 + row) * 48 + jc] = d0[rg_]; pe[(w * 8 + row) * 48 + 16 + jc] = d1[rg_]; pe[(w * 8 + row) * 48 + 32 + jc] = d2[rg_];
                }
            }
        }
        __syncthreads();
        if (t < 8) {
            const int row = rb * 8 + t;
            float gl[4];
#pragma unroll
            for (int j = 0; j < 4; ++j) {
                gl[j] = bg[j] + ((pe[(0 * 8 + t) * 48 + 32 + j] + pe[(1 * 8 + t) * 48 + 32 + j]) + (pe[(2 * 8 + t) * 48 + 32 + j] + pe[(3 * 8 + t) * 48 + 32 + j]));
            }
            int gs = 0; float gm = gl[0];
#pragma unroll
            for (int j = 1; j < 4; ++j) if (gl[j] > gm) { gm = gl[j]; gs = j; }
            float se = 0.f;
#pragma unroll
            for (int j = 0; j < 4; ++j) se += expf(gl[j] - gm);
            const float pgv = 1.0f / se;
            float ev[8];
#pragma unroll
            for (int j = 0; j < 8; ++j) { const int cj = gs * 8 + j; ev[j] = be[cj] + ((pe[(0 * 8 + t) * 48 + cj] + pe[(1 * 8 + t) * 48 + cj]) + (pe[(2 * 8 + t) * 48 + cj] + pe[(3 * 8 + t) * 48 + cj])); }
            int i1 = 0; float v1 = ev[0];
#pragma unroll
            for (int j = 1; j < 8; ++j) if (ev[j] > v1) { v1 = ev[j]; i1 = j; }
            int i2 = (i1 + 1) & 7; float v2 = -INFINITY;
#pragma unroll
            for (int j = 0; j < 8; ++j) if (j != i1 && ev[j] > v2) { v2 = ev[j]; i2 = j; }
            const float ex = expf(v2 - v1);
            const float w1 = pgv / (1.0f + ex), w2 = pgv * ex / (1.0f + ex);
            const int e1 = gs * 8 + i1, e2 = gs * 8 + i2;
            atomicAdd(&lh[e1], 1); atomicAdd(&lh[e2], 1);
            rinfo[row] = make_int4(e1, e2, __float_as_int(w1), __float_as_int(w2));
        }
    }
    __syncthreads();
    if (t < NE) hist[((size_t)l * 1024 + bid_()) * NE + t] = lh[t];
}

DI void phase_assign(const P& p, int l, char* lds) {
    const int t = tid_(), myb = bid_(), nb = gridDim.x;
    const int* hist = (const int*)(p.ws + WS_HIST) + (size_t)l * 1024 * NE;
    const int4* rinfo = (const int4*)(p.ws + WS_RINFO);
    int* cnt = (int*)(p.ws + WS_CTL) + l * NE;
    int* tokl = (int*)(p.ws + WS_TOKL); float* wl = (float*)(p.ws + WS_WL); int4* tinfo = (int4*)(p.ws + WS_TINFO);
    int* part = (int*)lds;
    int* pre = part + 512;
    int* le1 = pre + 32;
    int* le2 = le1 + 64;
    {
        const int e = t & 31, prt = t >> 5;
        int a = 0, tot = 0;
        for (int b = prt; b < nb; b += 8) { const int v = hist[(size_t)b * NE + e]; tot += v; if (b < myb) a += v; }
        part[prt * 32 + e] = a; part[256 + prt * 32 + e] = tot;
    }
    __syncthreads();
    if (t < 32) {
        int a = 0, tot = 0;
#pragma unroll
        for (int q = 0; q < 8; ++q) { a += part[q * 32 + t]; tot += part[256 + q * 32 + t]; }
        pre[t] = a;
        if (myb == 0) cnt[t] = tot;
    }
    const int nit = (T / 8 - myb + nb - 1) / nb;
    int4 ri = make_int4(0, 0, 0, 0); int row = -1;
    if (t < nit * 8 && t < 64) { row = (myb + (t >> 3) * nb) * 8 + (t & 7); ri = rinfo[row]; le1[t] = ri.x; le2[t] = ri.y; }
    __syncthreads();
    if (row >= 0) {
        int r1 = 0, r2 = 0;
        for (int j = 0; j < t; ++j) { const int a = le1[j], b2 = le2[j]; r1 += (a == ri.x) + (b2 == ri.x); r2 += (a == ri.y) + (b2 == ri.y); }
        const int s1 = pre[ri.x] + r1, s2 = pre[ri.y] + r2;
        tokl[ri.x * ECAP + s1] = row; wl[ri.x * ECAP + s1] = __int_as_float(ri.z);
        tokl[ri.y * ECAP + s2] = row; wl[ri.y * ECAP + s2] = __int_as_float(ri.w);
        tinfo[row] = make_int4(ri.x, s1, ri.y, s2);
    }
}

DI void phase_moe1(const P& p, int l, char* lds) {
    const int t = tid_();
    const bf16_t* hbuf = (const bf16_t*)(p.ws + WS_HBUF);
    bf16_t* hmoe = (bf16_t*)(p.ws + WS_HMOE);
    const int* cnt = (const int*)(p.ws + WS_CTL) + l * NE;
    const int* tokl = (const int*)(p.ws + WS_TOKL);
    int* stp = (int*)(lds + GEMM_LDS);
    moe_prefix(cnt, stp);
    const int vx = bid_() & 7, vj = bid_() >> 3, nj = (gridDim.x - vx + 7) >> 3;
    int tx[5]; tx[0] = 0;
#pragma unroll
    for (int i = 0; i < 4; ++i) tx[i + 1] = tx[i] + (stp[vx + 8 * i + 1] - stp[vx + 8 * i]) * 8;
    for (int tile = vj; tile < tx[4]; tile += nj) {
        const int ei = (tile >= tx[1]) + (tile >= tx[2]) + (tile >= tx[3]);
        const int e = vx + 8 * ei, tbase = ei == 0 ? 0 : (ei == 1 ? tx[1] : (ei == 2 ? tx[2] : tx[3]));
        const int te = stp[e + 1] - stp[e], local = tile - tbase, nt = local / te, mt = local % te;
        const int ne = cnt[e];
        const int i0 = mt * 128 + (t >> 2), i1 = i0 + 64;
        const int tok0 = tokl[e * ECAP + (i0 < ne ? i0 : 0)], tok1 = tokl[e * ECAP + (i1 < ne ? i1 : 0)];
        const bf16_t* a0 = hbuf + (size_t)tok0 * DM + (t & 3) * 8;
        const bf16_t* a1 = hbuf + (size_t)tok1 * DM + (t & 3) * 8;
        const int vcol = (t & 31) * 4, wn = vcol >> 6, tn = (vcol >> 5) & 1, rr = vcol & 31;
        const float* wsrc = (tn ? p.in[29] : p.in[28]) + ((size_t)l * NE + e) * DM * DE;
        const float* b0 = wsrc + (size_t)(t >> 5) * DE + nt * 64 + wn * 32 + rr;
        EpiGateUp epi{hmoe + (size_t)(stp[e] + mt) * 128 * DE + nt * 64};
        gemm_tile(a0, a1, b0, DE, DM / BK, lds, epi);
    }
}

DI void phase_moe2(const P& p, int l, char* lds) {
    const int t = tid_();
    const bf16_t* hmoe = (const bf16_t*)(p.ws + WS_HMOE);
    bf16_t* ymoe = (bf16_t*)(p.ws + WS_YMOE);
    const int* cnt = (const int*)(p.ws + WS_CTL) + l * NE;
    const float* wl = (const float*)(p.ws + WS_WL);
    int* stp = (int*)(lds + GEMM_LDS);
    moe_prefix(cnt, stp);
    const int vx = bid_() & 7, vj = bid_() >> 3, nj = (gridDim.x - vx + 7) >> 3;
    int tx[5]; tx[0] = 0;
#pragma unroll
    for (int i = 0; i < 4; ++i) tx[i + 1] = tx[i] + (stp[vx + 8 * i + 1] - stp[vx + 8 * i]) * 8;
    for (int tile = vj; tile < tx[4]; tile += nj) {
        const int ei = (tile >= tx[1]) + (tile >= tx[2]) + (tile >= tx[3]);
        const int e = vx + 8 * ei, tbase = ei == 0 ? 0 : (ei == 1 ? tx[1] : (ei == 2 ? tx[2] : tx[3]));
        const int te = stp[e + 1] - stp[e], local = tile - tbase, nt = local / te, mt = local % te;
        const int ne = cnt[e];
        const size_t r0 = (size_t)(stp[e] + mt) * 128;
        const bf16_t* a0 = hmoe + (r0 + (t >> 2)) * DE + (t & 3) * 8;
        const float* b0 = p.in[30] + ((size_t)l * NE + e) * DE * DM + (size_t)(t >> 5) * DM + nt * 128 + (t & 31) * 4;
        EpiDown epi{ymoe + r0 * DM + nt * 128, wl + e * ECAP + mt * 128, ne - mt * 128};
        gemm_tile(a0, a0 + (size_t)64 * DE, b0, DM, DE / BK, lds, epi);
    }
}

DI void phase_final(const P& p, char* lds) {
    const int lane = tid_() & 63;
    const int gw = bid_() * 4 + (tid_() >> 6), nw = gridDim.x * 4;
    const float* xres = (const float*)(p.ws + WS_XRES);
    const bf16_t* ymoe = (const bf16_t*)(p.ws + WS_YMOE);
    const int4* tinfo = (const int4*)(p.ws + WS_TINFO);
    int* stp = (int*)lds;
    moe_prefix((const int*)(p.ws + WS_CTL) + NE, stp);
    for (int row = gw; row < T; row += nw) {
        int4 ti = tinfo[row];
        const bf16_t* y0 = ymoe + (size_t)(stp[ti.x] * 128 + ti.y) * DM;
        const bf16_t* y1 = ymoe + (size_t)(stp[ti.z] * 128 + ti.w) * DM;
#pragma unroll
        for (int i = 0; i < 4; ++i) {
            float4 v = *(const float4*)(xres + (size_t)row * DM + i * 256 + lane * 4);
            uint2 a = *(const uint2*)(y0 + i * 256 + lane * 4), b = *(const uint2*)(y1 + i * 256 + lane * 4);
            v.x += bf2f(a.x & 0xffff) + bf2f(b.x & 0xffff); v.y += bf2f(a.x >> 16) + bf2f(b.x >> 16);
            v.z += bf2f(a.y & 0xffff) + bf2f(b.y & 0xffff); v.w += bf2f(a.y >> 16) + bf2f(b.y >> 16);
            *(float4*)(p.out + (size_t)row * DM + i * 256 + lane * 4) = v;
        }
    }
}

#define XB_TMO      128
#define XB_XCNT(j)  (256  + 64 * (j))
#define XB_XSUB(j)  (1280 + 64 * (j))
#define XB_XGEN(j)  (2304 + 64 * (j))
#define XB_TOP      3328
#define XB_TOPGEN   3392
#define XCD_BAR_WORDS 3456
#define XB_SPIN_CAP (1u << 18)

__device__ __forceinline__ unsigned xb_ld(unsigned* p)              { return __hip_atomic_load(p, __ATOMIC_RELAXED, __HIP_MEMORY_SCOPE_AGENT); }
__device__ __forceinline__ unsigned xb_add(unsigned* p, unsigned v) { return __hip_atomic_fetch_add(p, v, __ATOMIC_RELAXED, __HIP_MEMORY_SCOPE_AGENT); }
__device__ __forceinline__ unsigned xb_xcc_id() { return (unsigned)__builtin_amdgcn_s_getreg((3 << 11) | 20) & 0xFu; }
#define XB_SPIN(cond, bar) do { unsigned _sp = 0; while (cond) { __builtin_amdgcn_s_sleep(1); \
    if ((++_sp & 255u) == 0u) { if (xb_ld(&(bar)[XB_TMO])) break; if (_sp > XB_SPIN_CAP) { atomicAdd(&(bar)[XB_TMO], 1u); break; } } } } while (0)

struct XcdBarrier {
    unsigned* bar; unsigned x;
    volatile LAS unsigned* st;
};

__device__ __forceinline__ XcdBarrier xcd_barrier_post(unsigned* bar, volatile LAS unsigned* st) {
    XcdBarrier b; b.bar = bar; b.x = xb_xcc_id(); b.st = st;
    if (threadIdx.x == 0) (void)xb_add(&bar[XB_XCNT(b.x)], 1u);
    return b;
}
__device__ __forceinline__ void xcd_barrier_complete(unsigned* bar, unsigned x, unsigned& nloc, unsigned& nx) {
    const unsigned G = gridDim.x * gridDim.y * gridDim.z;
    unsigned sum, cnt, mine, sp = 0u;
    for (;;) {
        sum = 0u; cnt = 0u; mine = 0u;
#pragma unroll
        for (unsigned j = 0; j < 16; ++j) { const unsigned c = xb_ld(&bar[XB_XCNT(j)]); sum += c; cnt += (c > 0u) ? 1u : 0u; mine = (j == x) ? c : mine; }
        if (sum == G) break;
        __builtin_amdgcn_s_sleep(1);
        if ((++sp & 255u) == 0u) { if (xb_ld(&bar[XB_TMO])) break; if (sp > XB_SPIN_CAP) { atomicAdd(&bar[XB_TMO], 1u); break; } }
    }
    nloc = mine > 0u ? mine : 1u; nx = cnt > 0u ? cnt : 1u;
}

__device__ __forceinline__ void xcd_barrier(const XcdBarrier& b) {
    asm volatile("s_waitcnt vmcnt(0)" ::: "memory");
    __syncthreads();
    if (threadIdx.x == 0) {
        unsigned* bar = b.bar;
        __builtin_amdgcn_s_waitcnt(0);
        unsigned nloc = b.st[0], nx = b.st[1];
        if (nloc == 0u) { xcd_barrier_complete(bar, b.x, nloc, nx); b.st[0] = nloc; b.st[1] = nx; }
        const unsigned old = xb_add(&bar[XB_XSUB(b.x)], 1u);
        const unsigned gen = old / nloc;
        if (old + 1u == (gen + 1u) * nloc) {
            __builtin_amdgcn_fence(__ATOMIC_RELEASE, "agent");
            asm volatile("s_waitcnt vmcnt(0)" ::: "memory");
            const unsigned og = xb_add(&bar[XB_TOP], 1u);
            const unsigned tg = og / nx;
            if (og + 1u == (tg + 1u) * nx) xb_add(&bar[XB_TOPGEN], 1u);
            else XB_SPIN(xb_ld(&bar[XB_TOPGEN]) == tg, bar);
            __builtin_amdgcn_fence(__ATOMIC_ACQUIRE, "agent");
            xb_add(&bar[XB_XGEN(b.x)], 1u);
            asm volatile("s_waitcnt vmcnt(0)" ::: "memory");
        } else {
            XB_SPIN(xb_ld(&bar[XB_XGEN(b.x)]) == gen, bar);
            __builtin_amdgcn_fence(__ATOMIC_ACQUIRE, "agent");
            asm volatile("s_waitcnt vmcnt(0)" ::: "memory");
        }
    }
    __syncthreads();
}


constexpr int LDS_BYTES = 65536;
constexpr int NPHASE = 9;

DI void run_phase(const P& p, int ph, int l, char* lds) {
    switch (ph) {
        case 0: phase_norm1(p, l, lds); break;
        case 1: phase_inproj(p, l, lds); break;
        case 2: phase_qkprep(p, l, lds); break;
        case 3: { unsigned long long dummy = 0; phase_mix(p, l, lds, dummy); } break;
        case 4: phase_glu(p, l, lds); break;
        case 5: phase_outproj(p, l, lds); break;
        case 6: phase_norm2(p, l, lds); break;
        case 7: phase_moe1(p, l, lds); break;
        case 8: phase_moe2(p, l, lds); break;
        default: phase_final(p, lds); break;
    }
}

#if MULTI
__global__ void __launch_bounds__(256) k_phase(P p, int ph, int l) {
    extern __shared__ __attribute__((aligned(16))) char lds[];
    run_phase(p, ph, l, lds);
}
#else
__global__ void __launch_bounds__(256, 2) k_mega(P p) {
    extern __shared__ __attribute__((aligned(16))) char lds[];
    cg::grid_group grid = cg::this_grid();
    volatile LAS unsigned* bst = (volatile LAS unsigned*)((LAS char*)lds + LDS_BYTES - 16);
    if (threadIdx.x < 4) bst[threadIdx.x] = 0u;
    __syncthreads();
    XcdBarrier gbar = xcd_barrier_post((unsigned*)(p.ws + WS_BAR), bst);
    if (p.ws == nullptr) grid.sync();
#define GSYNC() xcd_barrier(gbar)
#ifndef PROBE_MASK
#define PROBE_MASK 0
#endif
#ifndef PROBE_MULT
#define PROBE_MULT 4
#endif
#ifndef PROBE_BLK
#define PROBE_BLK 0
#endif
    unsigned long long tacc = 0, tprev = 0;
#define PH_BEGIN() do { if (PROBE_MASK) tprev = wall_clock64(); } while (0)
#define PH_END(ph) do { if (PROBE_MASK & (1 << (ph))) tacc += wall_clock64() - tprev; } while (0)
#pragma unroll
    for (int l = 0; l < 2; ++l) {
        PH_BEGIN(); phase_norm1(p, l, lds); GSYNC(); PH_END(0);
        PH_BEGIN(); phase_inproj(p, l, lds); GSYNC(); PH_END(1);
        PH_BEGIN(); phase_qkprep(p, l, lds); GSYNC(); PH_END(2);
        PH_BEGIN(); phase_mix(p, l, lds, tacc); GSYNC(); PH_END(3);
        PH_BEGIN(); phase_glu(p, l, lds); GSYNC(); PH_END(4);
        PH_BEGIN(); phase_outproj(p, l, lds); GSYNC(); PH_END(5);
        PH_BEGIN(); phase_norm2(p, l, lds); GSYNC(); phase_assign(p, l, lds); GSYNC(); PH_END(6);
        PH_BEGIN(); phase_moe1(p, l, lds); GSYNC(); PH_END(7);
        PH_BEGIN(); phase_moe2(p, l, lds); GSYNC(); PH_END(8);
    }
    PH_BEGIN(); phase_final(p, lds); PH_END(9);
#ifdef PROBE_SYNCS
    for (int i = 0; i < PROBE_SYNCS; ++i) GSYNC();
#endif
    if ((PROBE_MASK || PROBE_SUB) && blockIdx.x == PROBE_BLK) {
        const unsigned long long t0 = wall_clock64();
        while (wall_clock64() - t0 < (unsigned long long)PROBE_MULT * tacc) __builtin_amdgcn_s_sleep(8);
    }
}
#endif

extern "C" void kernel_launch(void* const* d_in, const int* in_sizes, int n_in, void* d_out, int out_size, void* d_ws, size_t ws_size, hipStream_t stream) {
    static int grid = 0;
    if (grid == 0) {
        if (n_in != 31 || out_size != T * DM || ws_size < WS_END) { fprintf(stderr, "kernel_launch: unexpected sizes n_in %d out %d ws %zu\n", n_in, out_size, ws_size); grid = -1; return; }
        int dev = 0, cus = 0, per_cu = 0;
        (void)hipGetDevice(&dev);
        (void)hipDeviceGetAttribute(&cus, hipDeviceAttributeMultiprocessorCount, dev);
#if MULTI
        (void)hipFuncSetAttribute((const void*)k_phase, hipFuncAttributeMaxDynamicSharedMemorySize, LDS_BYTES);
        (void)hipOccupancyMaxActiveBlocksPerMultiprocessor(&per_cu, (const void*)k_phase, 256, LDS_BYTES);
#else
        (void)hipFuncSetAttribute((const void*)k_mega, hipFuncAttributeMaxDynamicSharedMemorySize, LDS_BYTES);
        (void)hipOccupancyMaxActiveBlocksPerMultiprocessor(&per_cu, (const void*)k_mega, 256, LDS_BYTES);
#endif
        if (per_cu < 1) { fprintf(stderr, "kernel_launch: occupancy query gave %d\n", per_cu); per_cu = 1; }
        if (per_cu > 2) per_cu = 2;
        grid = cus * per_cu;
        fprintf(stderr, "kernel_launch: cus %d per_cu %d grid %d\n", cus, per_cu, grid);
    }
    if (grid < 0) return;
    (void)hipMemsetAsync((char*)d_ws + WS_CTL, 0, 65536, stream);
    P p{};
    for (int i = 0; i < 31; ++i) p.in[i] = (const float*)d_in[i];
    p.out = (float*)d_out; p.ws = (char*)d_ws;
#if MULTI
    for (int l = 0; l < 2; ++l)
        for (int ph = 0; ph < NPHASE; ++ph) hipLaunchKernelGGL(k_phase, dim3(grid), dim3(256), LDS_BYTES, stream, p, ph, l);
    hipLaunchKernelGGL(k_phase, dim3(grid), dim3(256), LDS_BYTES, stream, p, NPHASE, 0);
#else
    void* args[] = {&p};
    hipError_t e = hipLaunchCooperativeKernel((const void*)k_mega, dim3(grid), dim3(256), args, LDS_BYTES, stream);
    if (e != hipSuccess) fprintf(stderr, "cooperative launch failed: %s (grid %d)\n", hipGetErrorString(e), grid);
#endif
}
```

```cpp
#include <hip/hip_runtime.h>
#include <hip/hip_cooperative_groups.h>
#include <cstdio>
#include <cstdint>
namespace cg = cooperative_groups;

#ifndef MULTI
#define MULTI 0
#endif

#define DI __device__ __forceinline__
#define LAS __attribute__((address_space(3)))
typedef unsigned short bf16_t;
typedef short bf16x8 __attribute__((ext_vector_type(8)));
typedef short s16x4 __attribute__((ext_vector_type(4)));
typedef float f32x16 __attribute__((ext_vector_type(16)));
typedef unsigned u32x4 __attribute__((ext_vector_type(4)));
typedef float f32x4 __attribute__((ext_vector_type(4)));
typedef unsigned u32x2 __attribute__((ext_vector_type(2)));

constexpr int T = 16384, DM = 1024, SEQ = 2048, NBATCH = 8;
constexpr int DIN = 2824, PJ = 2816;
constexpr int NE = 32, DE = 512, ECAP = 16384;
constexpr float EPS = 1e-6f;
constexpr int C_MQ = 0, C_MK = 256, C_MV = 512, C_MO = 768, C_AQ = 1024, C_AK = 1536, C_AV = 2048, C_SU = 2560;

constexpr size_t MiB = 1u << 20;
constexpr size_t WS_CTL = 0;
constexpr size_t WS_BAR = 16384;
constexpr size_t WS_KMEAN = 512 * 1024;
constexpr size_t WS_XRES = 1 * MiB;
constexpr size_t WS_HBUF = 65 * MiB;
constexpr size_t WS_PROJ = 97 * MiB;
constexpr size_t WS_GATES = 185 * MiB;
constexpr size_t WS_MIX = 186 * MiB;
constexpr size_t WS_HRAW = 218 * MiB;
constexpr size_t WS_ZBUF = 234 * MiB;
constexpr size_t WS_TOKL = 250 * MiB;
constexpr size_t WS_WL = 252 * MiB;
constexpr size_t WS_TINFO = 254 * MiB;
constexpr size_t WS_HMOE = 256 * MiB;
constexpr size_t WS_YMOE = 292 * MiB;
constexpr size_t WS_MQKC = 364 * MiB;
constexpr size_t WS_S5M = 380 * MiB;
constexpr size_t S5M_LAYER = 8 * MiB, S5M_E = 4 * MiB, S5M_F = 6 * MiB;
constexpr size_t WS_ELOC = 396 * MiB;
constexpr size_t WS_CARR = 412 * MiB;
constexpr size_t WS_RINFO = 420 * MiB;
constexpr size_t WS_HIST = 421 * MiB;
constexpr size_t WS_GSCAN = 422 * MiB;
constexpr size_t WS_WINB = 424 * MiB;
constexpr size_t WS_WOUTB = 436 * MiB;
constexpr size_t WS_END = 440 * MiB;

struct P {
    const float* in[31];
    float* out;
    char* ws;
};

DI int tid_() { int t = threadIdx.x; asm volatile("" : "+v"(t)); return t; }
DI int bid_() { int b = blockIdx.x; asm volatile("" : "+s"(b)); return b; }
DI float bf2f(bf16_t b) { return __uint_as_float(((unsigned)b) << 16); }
DI bf16_t f2bf(float f) { unsigned u = __float_as_uint(f); u += 0x7fffu + ((u >> 16) & 1u); return (bf16_t)(u >> 16); }
typedef float f32x2 __attribute__((ext_vector_type(2)));
typedef __bf16 bf16x2_t __attribute__((ext_vector_type(2)));
DI unsigned pk2(float lo, float hi) { f32x2 v = {lo, hi}; return __builtin_bit_cast(unsigned, __builtin_convertvector(v, bf16x2_t)); }
DI void lds_barrier() { asm volatile("s_waitcnt lgkmcnt(0)" ::: "memory"); __builtin_amdgcn_s_barrier(); asm volatile("" ::: "memory"); }
DI float wave_sum(float v) {
#pragma unroll
    for (int o = 32; o > 0; o >>= 1) v += __shfl_xor(v, o);
    return v;
}
DI float sigmoidf_(float x) { return 1.0f / (1.0f + expf(-x)); }
DI s16x4 tr_read(const LAS char* p) {
    typedef short v4i16_t __attribute__((ext_vector_type(4)));
    return __builtin_bit_cast(s16x4, __builtin_amdgcn_ds_read_tr16_b64_v4i16((LAS v4i16_t*)p));
}

DI float half_swap_max(float m) {
    auto rr = __builtin_amdgcn_permlane32_swap(__float_as_uint(m), __float_as_uint(m), false, false);
    return fmaxf(__uint_as_float(rr[0]), __uint_as_float(rr[1]));
}
DI float half_swap_sum(float m) {
    auto rr = __builtin_amdgcn_permlane32_swap(__float_as_uint(m), __float_as_uint(m), false, false);
    return __uint_as_float(rr[0]) + __uint_as_float(rr[1]);
}

constexpr int BK = 32, A_PITCH = 80, B_PITCH = 320, SA_BYTES = 128 * A_PITCH, SB_BYTES = BK * B_PITCH;
constexpr int GEMM_LDS = 2 * SA_BYTES + 2 * SB_BYTES;

struct GSeg { const bf16_t* a0; const bf16_t* a1; int akstep; const float* b0; size_t ldb; int KT; };
template <class Epi>
DI void gemm_tile2(const GSeg& g1, const GSeg& g2, char* lds_generic, const Epi& epi) {
    const int KT = g1.KT + g2.KT;
    LAS char* lds = (LAS char*)lds_generic;
    const int t = tid_(), lane = t & 63, w = t >> 6, wm = w >> 1, wn = w & 1;
    const int r = lane & 31, h = lane >> 5;
    const int i16 = lane & 15, q = i16 >> 2, pp = i16 & 3, blk = (lane >> 4) & 1;
    const int arow = t >> 2, akc = t & 3, bk = t >> 5, bn4 = t & 31;
    f32x16 acc[2][2];
#pragma unroll
    for (int i = 0; i < 2; ++i)
#pragma unroll
        for (int j = 0; j < 2; ++j)
#pragma unroll
            for (int e = 0; e < 16; ++e) acc[i][j][e] = 0.f;
    struct Stage { u32x4 a0, a1; float4 b0, b1, b2, b3; };
    const bf16_t* pa0 = g1.a0; const bf16_t* pa1 = g1.a1; const float* pb = g1.b0;
    size_t ldb = g1.ldb; int aks = g1.akstep, left = g1.KT, issued = 0;
    auto gload = [&](Stage& S) {
        S.a0 = *(const u32x4*)pa0; S.a1 = *(const u32x4*)pa1;
        S.b0 = *(const float4*)(pb); S.b1 = *(const float4*)(pb + 8 * ldb); S.b2 = *(const float4*)(pb + 16 * ldb); S.b3 = *(const float4*)(pb + 24 * ldb);
        if (++issued < KT) {
            if (--left == 0) { pa0 = g2.a0; pa1 = g2.a1; pb = g2.b0; ldb = g2.ldb; aks = g2.akstep; left = 1 << 30; }
            else { pa0 += aks; pa1 += aks; pb += BK * ldb; }
        }
    };
    auto sstore = [&](const Stage& S, int buf) {
        LAS char* sA = lds + buf * SA_BYTES; LAS char* sB = lds + 2 * SA_BYTES + buf * SB_BYTES;
        *(LAS u32x4*)(sA + arow * A_PITCH + akc * 16) = S.a0;
        *(LAS u32x4*)(sA + (arow + 64) * A_PITCH + akc * 16) = S.a1;
        u32x2 v;
        v.x = pk2(S.b0.x, S.b0.y); v.y = pk2(S.b0.z, S.b0.w); *(LAS u32x2*)(sB + (bk) * B_PITCH + bn4 * 8) = v;
        v.x = pk2(S.b1.x, S.b1.y); v.y = pk2(S.b1.z, S.b1.w); *(LAS u32x2*)(sB + (bk + 8) * B_PITCH + bn4 * 8) = v;
        v.x = pk2(S.b2.x, S.b2.y); v.y = pk2(S.b2.z, S.b2.w); *(LAS u32x2*)(sB + (bk + 16) * B_PITCH + bn4 * 8) = v;
        v.x = pk2(S.b3.x, S.b3.y); v.y = pk2(S.b3.z, S.b3.w); *(LAS u32x2*)(sB + (bk + 24) * B_PITCH + bn4 * 8) = v;
    };
    auto compute = [&](int buf) {
        const LAS char* sA = lds + buf * SA_BYTES; const LAS char* sB = lds + 2 * SA_BYTES + buf * SB_BYTES;
#pragma unroll
        for (int ks = 0; ks < 2; ++ks) {
            bf16x8 af[2], bfr[2];
#pragma unroll
            for (int tm = 0; tm < 2; ++tm) af[tm] = *(const LAS bf16x8*)(sA + (wm * 64 + tm * 32 + r) * A_PITCH + (ks * 16 + 8 * h) * 2);
#pragma unroll
            for (int tn = 0; tn < 2; ++tn) {
                const LAS char* pb = sB + (ks * 16 + 8 * h + q) * B_PITCH + (wn * 64 + tn * 32 + 16 * blk) * 2 + 8 * pp;
                s16x4 lo = tr_read(pb), hi = tr_read(pb + 4 * B_PITCH);
                bfr[tn] = __builtin_shufflevector(lo, hi, 0, 1, 2, 3, 4, 5, 6, 7);
            }
#pragma unroll
            for (int tm = 0; tm < 2; ++tm)
#pragma unroll
                for (int tn = 0; tn < 2; ++tn) acc[tm][tn] = __builtin_amdgcn_mfma_f32_32x32x16_bf16(bfr[tn], af[tm], acc[tm][tn], 0, 0, 0);
        }
    };
    Stage S0, S1;
    gload(S0); gload(S1);
    sstore(S0, 0); __syncthreads();
#define GSTEP(SL, SS) { gload(SL); compute(kt & 1); sstore(SS, (kt + 1) & 1); __syncthreads(); if (++kt >= KT) break; }
    for (int kt = 0;;) {
        GSTEP(S0, S1)
        GSTEP(S1, S0)
    }
#undef GSTEP
    epi(acc, wm, wn, r, h);
}
#ifdef LAB
template <class Epi>
DI void gemm_lab(const GSeg& g1, const GSeg& g2, char* lds_generic, const Epi& epi) {
    const int KT = g1.KT + g2.KT;
    LAS char* lds = (LAS char*)lds_generic;
    const int t = tid_(), lane = t & 63, w = t >> 6, wm = w >> 1, wn = w & 1;
    const int r = lane & 31, h = lane >> 5;
    const int i16 = lane & 15, q = i16 >> 2, pp = i16 & 3, blk = (lane >> 4) & 1;
    const int arow = t >> 2, akc = t & 3, bk = t >> 5, bn4 = t & 31;
    f32x16 acc[2][2];
#pragma unroll
    for (int i = 0; i < 2; ++i)
#pragma unroll
        for (int j = 0; j < 2; ++j)
#pragma unroll
            for (int e = 0; e < 16; ++e) acc[i][j][e] = 0.f;
    struct Stage { u32x4 a0, a1; float4 b0, b1, b2, b3; };
    const bf16_t* pa0 = g1.a0; const bf16_t* pa1 = g1.a1; const float* pb = g1.b0;
    size_t ldb = g1.ldb; int aks = g1.akstep, left = g1.KT, issued = 0;
    auto gload = [&](Stage& S) {
        if (LAB != 5 && LAB != 15) { S.a0 = *(const u32x4*)pa0; S.a1 = *(const u32x4*)pa1; }
        if (LAB != 6 && LAB != 16) { S.b0 = *(const float4*)(pb); S.b1 = *(const float4*)(pb + 8 * ldb); S.b2 = *(const float4*)(pb + 16 * ldb); S.b3 = *(const float4*)(pb + 24 * ldb); }
        if (++issued < KT) {
            if (--left == 0) { pa0 = g2.a0; pa1 = g2.a1; pb = g2.b0; ldb = g2.ldb; aks = g2.akstep; left = 1 << 30; }
            else { pa0 += aks; pa1 += aks; pb += BK * ldb; }
        }
    };
    auto sstore = [&](const Stage& S, int buf) {
        LAS char* sA = lds + buf * SA_BYTES; LAS char* sB = lds + 2 * SA_BYTES + buf * SB_BYTES;
        *(LAS u32x4*)(sA + arow * A_PITCH + akc * 16) = S.a0;
        *(LAS u32x4*)(sA + (arow + 64) * A_PITCH + akc * 16) = S.a1;
        u32x2 v;
        v.x = pk2(S.b0.x, S.b0.y); v.y = pk2(S.b0.z, S.b0.w); *(LAS u32x2*)(sB + (bk) * B_PITCH + bn4 * 8) = v;
        v.x = pk2(S.b1.x, S.b1.y); v.y = pk2(S.b1.z, S.b1.w); *(LAS u32x2*)(sB + (bk + 8) * B_PITCH + bn4 * 8) = v;
        v.x = pk2(S.b2.x, S.b2.y); v.y = pk2(S.b2.z, S.b2.w); *(LAS u32x2*)(sB + (bk + 16) * B_PITCH + bn4 * 8) = v;
        v.x = pk2(S.b3.x, S.b3.y); v.y = pk2(S.b3.z, S.b3.w); *(LAS u32x2*)(sB + (bk + 24) * B_PITCH + bn4 * 8) = v;
    };
    auto compute = [&](int buf) {
        const LAS char* sA = lds + buf * SA_BYTES; const LAS char* sB = lds + 2 * SA_BYTES + buf * SB_BYTES;
#pragma unroll
        for (int ks = 0; ks < 2; ++ks) {
            bf16x8 af[2], bfr[2];
#pragma unroll
            for (int tm = 0; tm < 2; ++tm) af[tm] = *(const LAS bf16x8*)(sA + (wm * 64 + tm * 32 + r) * A_PITCH + (ks * 16 + 8 * h) * 2);
#pragma unroll
            for (int tn = 0; tn < 2; ++tn) {
                const LAS char* pb = sB + (ks * 16 + 8 * h + q) * B_PITCH + (wn * 64 + tn * 32 + 16 * blk) * 2 + 8 * pp;
                s16x4 lo = tr_read(pb), hi = tr_read(pb + 4 * B_PITCH);
                bfr[tn] = __builtin_shufflevector(lo, hi, 0, 1, 2, 3, 4, 5, 6, 7);
            }
#pragma unroll
            for (int tm = 0; tm < 2; ++tm)
#pragma unroll
                for (int tn = 0; tn < 2; ++tn) acc[tm][tn] = __builtin_amdgcn_mfma_f32_32x32x16_bf16(bfr[tn], af[tm], acc[tm][tn], 0, 0, 0);
        }
    };
    Stage S0, S1;
    gload(S0); gload(S1);
    sstore(S0, 0); __syncthreads();
#define GSTEP(SL, SS) { if (LAB != 1 && LAB != 3) gload(SL); if (LAB != 4 && LAB != 5 && LAB != 6) compute(kt & 1); if (LAB != 2 && LAB != 3) sstore(SS, (kt + 1) & 1); __syncthreads(); if (++kt >= KT) break; }
    for (int kt = 0;;) {
        GSTEP(S0, S1)
        GSTEP(S1, S0)
    }
#undef GSTEP
    epi(acc, wm, wn, r, h);
}
#endif
template <class Epi>
DI void gemm_tile(const bf16_t* a0, const bf16_t* a1, const float* b0, size_t ldb, int KT, char* lds_generic, const Epi& epi) {
    GSeg g1{a0, a1, BK, b0, ldb, KT}; GSeg g2{a0, a1, BK, b0, ldb, 0};
    gemm_tile2(g1, g2, lds_generic, epi);
}
struct GSeg2 { const bf16_t* a[4]; int askip; const bf16_t* b0; size_t ldb; int KT; };
constexpr int A2_PITCH = 144, SA2_BYTES = 128 * A2_PITCH, G2_LDS = 2 * SA2_BYTES + 2 * SB_BYTES;
template <class Epi>
DI void gemm2(const GSeg2& g1, const GSeg2& g2, char* lds_generic, const Epi& epi) {
    const int KT = g1.KT + g2.KT;
    LAS char* lds = (LAS char*)lds_generic;
    const int t = tid_(), lane = t & 63, w = t >> 6, wm = w >> 1, wn = w & 1;
    const int r = lane & 31, h = lane >> 5;
    const int i16 = lane & 15, q = i16 >> 2, pp = i16 & 3, blk = (lane >> 4) & 1;
    const int arow = t >> 3, akc = t & 7, bk = t >> 4, bc = t & 15;
    f32x16 acc[2][2];
#pragma unroll
    for (int i = 0; i < 2; ++i)
#pragma unroll
        for (int j = 0; j < 2; ++j)
#pragma unroll
            for (int e = 0; e < 16; ++e) acc[i][j][e] = 0.f;
    struct AStage { u32x4 a0, a1, a2, a3; };
    struct BStage { u32x4 b0, b1; };
    const bf16_t* pa0 = g1.a[0]; const bf16_t* pa1 = g1.a[1]; const bf16_t* pa2 = g1.a[2]; const bf16_t* pa3 = g1.a[3];
    const bf16_t* pb = g1.b0; size_t ldb = g1.ldb; int askip = g1.askip, aleft = g1.KT >> 1, bleft = g1.KT, aiss = 0, biss = 0;
    auto aload = [&](AStage& S) {
        S.a0 = *(const u32x4*)pa0; S.a1 = *(const u32x4*)pa1; S.a2 = *(const u32x4*)pa2; S.a3 = *(const u32x4*)pa3;
        if (++aiss < (KT >> 1)) {
            if (--aleft == 0) { pa0 = g2.a[0]; pa1 = g2.a[1]; pa2 = g2.a[2]; pa3 = g2.a[3]; askip = g2.askip; aleft = 1 << 30; }
            else { pa0 += askip; pa1 += askip; pa2 += askip; pa3 += askip; }
        }
    };
    auto bload = [&](BStage& S) {
        S.b0 = *(const u32x4*)pb; S.b1 = *(const u32x4*)(pb + 16 * ldb);
        if (++biss < KT) {
            if (--bleft == 0) { pb = g2.b0; ldb = g2.ldb; bleft = 1 << 30; }
            else pb += 32 * ldb;
        }
    };
    auto astore = [&](const AStage& S, int buf) {
        LAS char* sA = lds + buf * SA2_BYTES + arow * A2_PITCH + akc * 16;
        *(LAS u32x4*)(sA) = S.a0; *(LAS u32x4*)(sA + 32 * A2_PITCH) = S.a1; *(LAS u32x4*)(sA + 64 * A2_PITCH) = S.a2; *(LAS u32x4*)(sA + 96 * A2_PITCH) = S.a3;
    };
    auto bstore = [&](const BStage& S, int buf) {
        LAS char* sB = lds + 2 * SA2_BYTES + buf * SB_BYTES + bk * B_PITCH + bc * 16;
        *(LAS u32x4*)(sB) = S.b0; *(LAS u32x4*)(sB + 16 * B_PITCH) = S.b1;
    };
    auto compute = [&](int abuf, int half, int bbuf) {
        const LAS char* sA = lds + abuf * SA2_BYTES + half * 64; const LAS char* sB = lds + 2 * SA2_BYTES + bbuf * SB_BYTES;
#pragma unroll
        for (int ks = 0; ks < 2; ++ks) {
            bf16x8 af[2], bfr[2];
#pragma unroll
            for (int tm = 0; tm < 2; ++tm) af[tm] = *(const LAS bf16x8*)(sA + (wm * 64 + tm * 32 + r) * A2_PITCH + (ks * 16 + 8 * h) * 2);
#pragma unroll
            for (int tn = 0; tn < 2; ++tn) {
                const LAS char* pbb = sB + (ks * 16 + 8 * h + q) * B_PITCH + (wn * 64 + tn * 32 + 16 * blk) * 2 + 8 * pp;
                s16x4 lo = tr_read(pbb), hi = tr_read(pbb + 4 * B_PITCH);
                bfr[tn] = __builtin_shufflevector(lo, hi, 0, 1, 2, 3, 4, 5, 6, 7);
            }
#pragma unroll
            for (int tm = 0; tm < 2; ++tm)
#pragma unroll
                for (int tn = 0; tn < 2; ++tn) acc[tm][tn] = __builtin_amdgcn_mfma_f32_32x32x16_bf16(bfr[tn], af[tm], acc[tm][tn], 0, 0, 0);
        }
    };
    AStage RA; BStage RB0, RB1;
    aload(RA); bload(RB0); bload(RB1);
    astore(RA, 0); bstore(RB0, 0); __syncthreads();
    for (int sl = 0;; ++sl) {
#ifndef LAB
#define LAB 0
#define LAB_UNDEF
#endif
        if (LAB != 22) { aload(RA); bload(RB0); }
        if (LAB != 21) compute(sl & 1, 0, 0);
        bstore(RB1, 1);
        __syncthreads();
        if (LAB != 22) bload(RB1);
        if (LAB != 21) compute(sl & 1, 1, 1);
#ifdef LAB_UNDEF
#undef LAB
#undef LAB_UNDEF
#endif
        astore(RA, (sl + 1) & 1); bstore(RB0, 0);
        __syncthreads();
        if (2 * sl + 2 >= KT) break;
    }
    epi(acc, wm, wn, r, h);
}
struct GSeg3 { const bf16_t* a[4]; int askip; const float* b0; size_t ldb; int KT; };
template <class Epi>
DI void gemm3(const GSeg3& g1, const GSeg3& g2, char* lds_generic, const Epi& epi) {
    const int KT = g1.KT + g2.KT;
    LAS char* lds = (LAS char*)lds_generic;
    const int t = tid_(), lane = t & 63, w = t >> 6, wm = w >> 1, wn = w & 1;
    const int r = lane & 31, h = lane >> 5;
    const int i16 = lane & 15, q = i16 >> 2, pp = i16 & 3, blk = (lane >> 4) & 1;
    const int arow = t >> 3, akc = t & 7, bk = t >> 5, bn4 = t & 31;
    f32x16 acc[2][2];
#pragma unroll
    for (int i = 0; i < 2; ++i)
#pragma unroll
        for (int j = 0; j < 2; ++j)
#pragma unroll
            for (int e = 0; e < 16; ++e) acc[i][j][e] = 0.f;
    struct AStage { u32x4 a0, a1, a2, a3; };
    struct BStage { float4 b0, b1, b2, b3; };
    const bf16_t* pa0 = g1.a[0]; const bf16_t* pa1 = g1.a[1]; const bf16_t* pa2 = g1.a[2]; const bf16_t* pa3 = g1.a[3];
    const float* pb = g1.b0; size_t ldb = g1.ldb; int askip = g1.askip, aleft = g1.KT >> 1, bleft = g1.KT, aiss = 0, biss = 0;
    auto aload = [&](AStage& S) {
        S.a0 = *(const u32x4*)pa0; S.a1 = *(const u32x4*)pa1; S.a2 = *(const u32x4*)pa2; S.a3 = *(const u32x4*)pa3;
        if (++aiss < (KT >> 1)) {
            if (--aleft == 0) { pa0 = g2.a[0]; pa1 = g2.a[1]; pa2 = g2.a[2]; pa3 = g2.a[3]; askip = g2.askip; aleft = 1 << 30; }
            else { pa0 += askip; pa1 += askip; pa2 += askip; pa3 += askip; }
        }
    };
    auto bload = [&](BStage& S) {
        S.b0 = *(const float4*)(pb); S.b1 = *(const float4*)(pb + 8 * ldb); S.b2 = *(const float4*)(pb + 16 * ldb); S.b3 = *(const float4*)(pb + 24 * ldb);
        if (++biss < KT) {
            if (--bleft == 0) { pb = g2.b0; ldb = g2.ldb; bleft = 1 << 30; }
            else pb += 32 * ldb;
        }
    };
    auto astore = [&](const AStage& S, int buf) {
        LAS char* sA = lds + buf * SA2_BYTES + arow * A2_PITCH + akc * 16;
        *(LAS u32x4*)(sA) = S.a0; *(LAS u32x4*)(sA + 32 * A2_PITCH) = S.a1; *(LAS u32x4*)(sA + 64 * A2_PITCH) = S.a2; *(LAS u32x4*)(sA + 96 * A2_PITCH) = S.a3;
    };
    auto bstore = [&](const BStage& S, int buf) {
        LAS char* sB = lds + 2 * SA2_BYTES + buf * SB_BYTES + bk * B_PITCH + bn4 * 8;
        u32x2 v;
        v.x = pk2(S.b0.x, S.b0.y); v.y = pk2(S.b0.z, S.b0.w); *(LAS u32x2*)(sB) = v;
        v.x = pk2(S.b1.x, S.b1.y); v.y = pk2(S.b1.z, S.b1.w); *(LAS u32x2*)(sB + 8 * B_PITCH) = v;
        v.x = pk2(S.b2.x, S.b2.y); v.y = pk2(S.b2.z, S.b2.w); *(LAS u32x2*)(sB + 16 * B_PITCH) = v;
        v.x = pk2(S.b3.x, S.b3.y); v.y = pk2(S.b3.z, S.b3.w); *(LAS u32x2*)(sB + 24 * B_PITCH) = v;
    };
    auto compute = [&](int abuf, int half, int bbuf) {
        const LAS char* sA = lds + abuf * SA2_BYTES + half * 64; const LAS char* sB = lds + 2 * SA2_BYTES + bbuf * SB_BYTES;
#pragma unroll
        for (int ks = 0; ks < 2; ++ks) {
            bf16x8 af[2], bfr[2];
#pragma unroll
            for (int tm = 0; tm < 2; ++tm) af[tm] = *(const LAS bf16x8*)(sA + (wm * 64 + tm * 32 + r) * A2_PITCH + (ks * 16 + 8 * h) * 2);
#pragma unroll
            for (int tn = 0; tn < 2; ++tn) {
                const LAS char* pbb = sB + (ks * 16 + 8 * h + q) * B_PITCH + (wn * 64 + tn * 32 + 16 * blk) * 2 + 8 * pp;
                s16x4 lo = tr_read(pbb), hi = tr_read(pbb + 4 * B_PITCH);
                bfr[tn] = __builtin_shufflevector(lo, hi, 0, 1, 2, 3, 4, 5, 6, 7);
            }
#pragma unroll
            for (int tm = 0; tm < 2; ++tm)
#pragma unroll
                for (int tn = 0; tn < 2; ++tn) acc[tm][tn] = __builtin_amdgcn_mfma_f32_32x32x16_bf16(bfr[tn], af[tm], acc[tm][tn], 0, 0, 0);
        }
    };
    AStage RA; BStage RB0, RB1;
    aload(RA); bload(RB0); bload(RB1);
    astore(RA, 0); bstore(RB0, 0); __syncthreads();
    for (int sl = 0;; ++sl) {
        aload(RA); bload(RB0);
        compute(sl & 1, 0, 0);
        bstore(RB1, 1);
        __syncthreads();
        bload(RB1);
        compute(sl & 1, 1, 1);
        astore(RA, (sl + 1) & 1); bstore(RB0, 0);
        __syncthreads();
        if (2 * sl + 2 >= KT) break;
    }
    epi(acc, wm, wn, r, h);
}
struct GSeg4 { const bf16_t* a0; const bf16_t* a1; int akstep; const bf16_t* b0; size_t ldb; int KT; };
constexpr int B4_PITCH = 576, SB4_BYTES = 32 * B4_PITCH, G4_LDS = 2 * SA_BYTES + 2 * SB4_BYTES;
template <class Epi>
DI void gemm4(const GSeg4& g1, const GSeg4& g2, char* lds_generic, const Epi& epi) {
    const int KT = g1.KT + g2.KT;
    LAS char* lds = (LAS char*)lds_generic;
    const int t = tid_(), lane = t & 63, w = t >> 6, wm = w >> 1, wn = w & 1;
    const int r = lane & 31, h = lane >> 5;
    const int i16 = lane & 15, q = i16 >> 2, pp = i16 & 3, blk = (lane >> 4) & 1;
    const int arow = t >> 2, akc = t & 3, bk = t >> 5, bc = t & 31;
    f32x16 acc[2][4];
#pragma unroll
    for (int i = 0; i < 2; ++i)
#pragma unroll
        for (int j = 0; j < 4; ++j)
#pragma unroll
            for (int e = 0; e < 16; ++e) acc[i][j][e] = 0.f;
    struct Stage { u32x4 a0, a1, b0, b1, b2, b3; };
    const bf16_t* pa0 = g1.a0; const bf16_t* pa1 = g1.a1; const bf16_t* pb = g1.b0;
    size_t ldb = g1.ldb; int aks = g1.akstep, left = g1.KT, issued = 0;
    auto gload = [&](Stage& S) {
        S.a0 = *(const u32x4*)pa0; S.a1 = *(const u32x4*)pa1;
        S.b0 = *(const u32x4*)(pb); S.b1 = *(const u32x4*)(pb + 8 * ldb); S.b2 = *(const u32x4*)(pb + 16 * ldb); S.b3 = *(const u32x4*)(pb + 24 * ldb);
        if (++issued < KT) {
            if (--left == 0) { pa0 = g2.a0; pa1 = g2.a1; pb = g2.b0; ldb = g2.ldb; aks = g2.akstep; left = 1 << 30; }
            else { pa0 += aks; pa1 += aks; pb += 32 * ldb; }
        }
    };
    auto sstore = [&](const Stage& S, int buf) {
        LAS char* sA = lds + buf * SA_BYTES; LAS char* sB = lds + 2 * SA_BYTES + buf * SB4_BYTES + bk * B4_PITCH + bc * 16;
        *(LAS u32x4*)(sA + arow * A_PITCH + akc * 16) = S.a0;
        *(LAS u32x4*)(sA + (arow + 64) * A_PITCH + akc * 16) = S.a1;
        *(LAS u32x4*)(sB) = S.b0; *(LAS u32x4*)(sB + 8 * B4_PITCH) = S.b1; *(LAS u32x4*)(sB + 16 * B4_PITCH) = S.b2; *(LAS u32x4*)(sB + 24 * B4_PITCH) = S.b3;
    };
    auto compute = [&](int buf) {
        const LAS char* sA = lds + buf * SA_BYTES; const LAS char* sB = lds + 2 * SA_BYTES + buf * SB4_BYTES;
#pragma unroll
        for (int ks = 0; ks < 2; ++ks) {
            bf16x8 af[2], bfr[4];
#pragma unroll
            for (int tm = 0; tm < 2; ++tm) af[tm] = *(const LAS bf16x8*)(sA + (wm * 64 + tm * 32 + r) * A_PITCH + (ks * 16 + 8 * h) * 2);
#pragma unroll
            for (int tn = 0; tn < 4; ++tn) {
                const LAS char* pbb = sB + (ks * 16 + 8 * h + q) * B4_PITCH + (wn * 128 + tn * 32 + 16 * blk) * 2 + 8 * pp;
                s16x4 lo = tr_read(pbb), hi = tr_read(pbb + 4 * B4_PITCH);
                bfr[tn] = __builtin_shufflevector(lo, hi, 0, 1, 2, 3, 4, 5, 6, 7);
            }
#pragma unroll
            for (int tm = 0; tm < 2; ++tm)
#pragma unroll
                for (int tn = 0; tn < 4; ++tn) acc[tm][tn] = __builtin_amdgcn_mfma_f32_32x32x16_bf16(bfr[tn], af[tm], acc[tm][tn], 0, 0, 0);
        }
    };
    Stage S0, S1;
    gload(S0); gload(S1);
    sstore(S0, 0); __syncthreads();
#define GSTEP(SL, SS) { gload(SL); compute(kt & 1); sstore(SS, (kt + 1) & 1); __syncthreads(); if (++kt >= KT) break; }
    for (int kt = 0;;) {
        GSTEP(S0, S1)
        GSTEP(S1, S0)
    }
#undef GSTEP
    epi(acc, wm, wn, r, h);
}
struct Epi4Bf16 {
    bf16_t* out; size_t ld;
    DI void operator()(const f32x16 (&acc)[2][4], int wm, int wn, int r, int h) const {
#pragma unroll
        for (int tm = 0; tm < 2; ++tm) {
            bf16_t* rp = out + (size_t)(wm * 64 + tm * 32 + r) * ld + wn * 128 + 4 * h;
#pragma unroll
            for (int tn = 0; tn < 4; ++tn)
#pragma unroll
                for (int g = 0; g < 4; ++g) {
                    u32x2 v; v.x = pk2(acc[tm][tn][4 * g], acc[tm][tn][4 * g + 1]); v.y = pk2(acc[tm][tn][4 * g + 2], acc[tm][tn][4 * g + 3]);
                    *(u32x2*)(rp + tn * 32 + 8 * g) = v;
                }
        }
    }
};
struct Epi4Resid {
    float* out; const float* res; size_t ld;
    DI void operator()(const f32x16 (&acc)[2][4], int wm, int wn, int r, int h) const {
#pragma unroll
        for (int tm = 0; tm < 2; ++tm) {
            const size_t o = (size_t)(wm * 64 + tm * 32 + r) * ld + wn * 128 + 4 * h;
#pragma unroll
            for (int hf = 0; hf < 2; ++hf) {
                float4 x[8];
#pragma unroll
                for (int i = 0; i < 8; ++i) x[i] = *(const float4*)(res + o + (hf * 2 + (i >> 2)) * 32 + 8 * (i & 3));
#pragma unroll
                for (int i = 0; i < 8; ++i) {
                    const int tn = hf * 2 + (i >> 2), g = i & 3;
                    x[i].x += acc[tm][tn][4 * g]; x[i].y += acc[tm][tn][4 * g + 1]; x[i].z += acc[tm][tn][4 * g + 2]; x[i].w += acc[tm][tn][4 * g + 3];
                }
#pragma unroll
                for (int i = 0; i < 8; ++i) *(float4*)(out + o + (hf * 2 + (i >> 2)) * 32 + 8 * (i & 3)) = x[i];
            }
        }
    }
};
struct Epi4Inproj {
    Epi4Bf16 eb; float* gout; const float* bi; const float* bf; bool isgate;
    DI void operator()(const f32x16 (&acc)[2][4], int wm, int wn, int r, int h) const {
        if (!isgate) { eb(acc, wm, wn, r, h); return; }
        if (wn == 0) {
#pragma unroll
            for (int tm = 0; tm < 2; ++tm) {
                const float* bb = h ? bf : bi;
                float4 x = {acc[tm][0][0] + bb[0], acc[tm][0][1] + bb[1], acc[tm][0][2] + bb[2], acc[tm][0][3] + bb[3]};
                *(float4*)(gout + (size_t)(wm * 64 + tm * 32 + r) * 8 + 4 * h) = x;
            }
        }
    }
};
struct EpiBf16 {
    bf16_t* out; size_t ld;
    DI void operator()(const f32x16 (&acc)[2][2], int wm, int wn, int r, int h) const {
#pragma unroll
        for (int tm = 0; tm < 2; ++tm) {
            bf16_t* rp = out + (size_t)(wm * 64 + tm * 32 + r) * ld + wn * 64 + 4 * h;
#pragma unroll
            for (int tn = 0; tn < 2; ++tn)
#pragma unroll
                for (int g = 0; g < 4; ++g) {
                    u32x2 v; v.x = pk2(acc[tm][tn][4 * g], acc[tm][tn][4 * g + 1]); v.y = pk2(acc[tm][tn][4 * g + 2], acc[tm][tn][4 * g + 3]);
                    *(u32x2*)(rp + tn * 32 + 8 * g) = v;
                }
        }
    }
};
struct EpiResid {
    float* out; const float* res; size_t ld;
    DI void operator()(const f32x16 (&acc)[2][2], int wm, int wn, int r, int h) const {
#pragma unroll
        for (int tm = 0; tm < 2; ++tm) {
            const size_t o = (size_t)(wm * 64 + tm * 32 + r) * ld + wn * 64 + 4 * h;
            float4 x[8];
#pragma unroll
            for (int i = 0; i < 8; ++i) x[i] = *(const float4*)(res + o + (i >> 2) * 32 + 8 * (i & 3));
#pragma unroll
            for (int i = 0; i < 8; ++i) {
                const int tn = i >> 2, g = i & 3;
                x[i].x += acc[tm][tn][4 * g]; x[i].y += acc[tm][tn][4 * g + 1]; x[i].z += acc[tm][tn][4 * g + 2]; x[i].w += acc[tm][tn][4 * g + 3];
            }
#pragma unroll
            for (int i = 0; i < 8; ++i) *(float4*)(out + o + (i >> 2) * 32 + 8 * (i & 3)) = x[i];
        }
    }
};
DI float silu_mul(float g, float u) { return g / (1.0f + __expf(-g)) * u; }
struct EpiGateUp {
    bf16_t* out;
    DI void operator()(const f32x16 (&acc)[2][2], int wm, int wn, int r, int h) const {
#pragma unroll
        for (int tm = 0; tm < 2; ++tm) {
            bf16_t* rp = out + (size_t)(wm * 64 + tm * 32 + r) * DE + wn * 32 + 4 * h;
#pragma unroll
            for (int g = 0; g < 4; ++g) {
                u32x2 v;
                v.x = pk2(silu_mul(acc[tm][0][4 * g], acc[tm][1][4 * g]), silu_mul(acc[tm][0][4 * g + 1], acc[tm][1][4 * g + 1]));
                v.y = pk2(silu_mul(acc[tm][0][4 * g + 2], acc[tm][1][4 * g + 2]), silu_mul(acc[tm][0][4 * g + 3], acc[tm][1][4 * g + 3]));
                *(u32x2*)(rp + 8 * g) = v;
            }
        }
    }
};
struct EpiDown {
    bf16_t* out; const float* roww; int nvalid;
    DI void operator()(const f32x16 (&acc)[2][2], int wm, int wn, int r, int h) const {
#pragma unroll
        for (int tm = 0; tm < 2; ++tm) {
            const int row = wm * 64 + tm * 32 + r;
            const float wv = row < nvalid ? roww[row] : 0.f;
            bf16_t* rp = out + (size_t)row * DM + wn * 64 + 4 * h;
#pragma unroll
            for (int tn = 0; tn < 2; ++tn)
#pragma unroll
                for (int g = 0; g < 4; ++g) {
                    u32x2 v; v.x = pk2(acc[tm][tn][4 * g] * wv, acc[tm][tn][4 * g + 1] * wv); v.y = pk2(acc[tm][tn][4 * g + 2] * wv, acc[tm][tn][4 * g + 3] * wv);
                    *(u32x2*)(rp + tn * 32 + 8 * g) = v;
                }
        }
    }
};

struct EpiGates {
    float* out; const float* bi; const float* bf;
    DI void operator()(const f32x16 (&acc)[2][2], int wm, int wn, int r, int h) const {
        if (wn == 0) {
#pragma unroll
            for (int tm = 0; tm < 2; ++tm) {
                const float* bb = h ? bf : bi;
                float4 x = {acc[tm][0][0] + bb[0], acc[tm][0][1] + bb[1], acc[tm][0][2] + bb[2], acc[tm][0][3] + bb[3]};
                *(float4*)(out + (size_t)(wm * 64 + tm * 32 + r) * 8 + 4 * h) = x;
            }
        }
    }
};
struct EpiInproj {
    EpiBf16 eb; EpiGates eg; bool isgate;
    DI void operator()(const f32x16 (&acc)[2][2], int wm, int wn, int r, int h) const { if (isgate) eg(acc, wm, wn, r, h); else eb(acc, wm, wn, r, h); }
};
struct EpiF32 {
    float* out; size_t ld;
    DI void operator()(const f32x16 (&acc)[2][2], int wm, int wn, int r, int h) const {
#pragma unroll
        for (int tm = 0; tm < 2; ++tm) {
            float* rp = out + (size_t)(wm * 64 + tm * 32 + r) * ld + wn * 64 + 4 * h;
#pragma unroll
            for (int tn = 0; tn < 2; ++tn)
#pragma unroll
                for (int g = 0; g < 4; ++g) { float4 x = {acc[tm][tn][4 * g], acc[tm][tn][4 * g + 1], acc[tm][tn][4 * g + 2], acc[tm][tn][4 * g + 3]}; *(float4*)(rp + tn * 32 + 8 * g) = x; }
        }
    }
};
DI float gelu_tanh(float v) {
    const float inner = 0.7978845608028654f * (v + 0.044715f * v * v * v);
    const float th = 1.0f - 2.0f / (__expf(2.0f * inner) + 1.0f);
    return 0.5f * v * (1.0f + th);
}
struct EpiS5Y {
    bf16_t* zrow0;
    int ncol0;
    DI void operator()(const f32x16 (&acc)[2][2], int wm, int wn, int r, int h) const {
#pragma unroll
        for (int tm = 0; tm < 2; ++tm) {
            const int chunk = wm * 64 + tm * 32 + r;
#pragma unroll
            for (int tn = 0; tn < 2; ++tn)
#pragma unroll
                for (int g = 0; g < 4; ++g) {
                    const int n0 = ncol0 + wn * 64 + tn * 32 + 8 * g + 4 * h;
                    u32x2 v; v.x = pk2(gelu_tanh(acc[tm][tn][4 * g]), gelu_tanh(acc[tm][tn][4 * g + 1])); v.y = pk2(gelu_tanh(acc[tm][tn][4 * g + 2]), gelu_tanh(acc[tm][tn][4 * g + 3]));
                    *(u32x2*)(zrow0 + (size_t)(chunk * 16 + (n0 >> 4)) * 256 + (n0 & 15)) = v;
                }
        }
    }
};
struct EpiGlu {
    const bf16_t* z; bf16_t* out; const float* gb; const float* sg;
    DI void operator()(const f32x16 (&acc)[2][2], int wm, int wn, int r, int h) const {
#pragma unroll
        for (int tm = 0; tm < 2; ++tm) {
            const int row = wm * 64 + tm * 32 + r;
#pragma unroll
            for (int tn = 0; tn < 2; ++tn) {
                const int c0 = wn * 64 + tn * 32 + 4 * h;
                float y[16];
#pragma unroll
                for (int g = 0; g < 4; ++g) {
                    const u32x2 zz = *(const u32x2*)(z + (size_t)row * 256 + c0 + 8 * g);
                    const float4 b4 = *(const float4*)(gb + c0 + 8 * g);
                    y[4 * g + 0] = bf2f(zz.x & 0xffff) / (1.0f + __expf(-(acc[tm][tn][4 * g + 0] + b4.x)));
                    y[4 * g + 1] = bf2f(zz.x >> 16) / (1.0f + __expf(-(acc[tm][tn][4 * g + 1] + b4.y)));
                    y[4 * g + 2] = bf2f(zz.y & 0xffff) / (1.0f + __expf(-(acc[tm][tn][4 * g + 2] + b4.z)));
                    y[4 * g + 3] = bf2f(zz.y >> 16) / (1.0f + __expf(-(acc[tm][tn][4 * g + 3] + b4.w)));
                }
#pragma unroll
                for (int q = 0; q < 2; ++q) {
                    float ss = 0.f;
#pragma unroll
                    for (int e = 0; e < 8; ++e) ss += y[8 * q + e] * y[8 * q + e];
                    ss = half_swap_sum(ss);
                    const float rstd = rsqrtf(ss * (1.0f / 16.0f) + EPS);
#pragma unroll
                    for (int g = 2 * q; g < 2 * q + 2; ++g) {
                        const float4 s4 = *(const float4*)(sg + c0 + 8 * g);
                        u32x2 v; v.x = pk2(y[4 * g] * rstd * s4.x, y[4 * g + 1] * rstd * s4.y); v.y = pk2(y[4 * g + 2] * rstd * s4.z, y[4 * g + 3] * rstd * s4.w);
                        *(u32x2*)(out + (size_t)row * DM + c0 + 8 * g) = v;
                    }
                }
            }
        }
    }
};

DI void moe_prefix(const int* cnt, int* stp  ) {
    __syncthreads();
    if (tid_() == 0) { int a = 0; for (int e = 0; e < NE; ++e) { stp[e] = a; a += (cnt[e] + 127) >> 7; } stp[NE] = a; }
    __syncthreads();
}

constexpr int XS_P = 1028;
template <int NC>
DI void rows_matvec(const float* xs, const float* W, int ldw, float* part  ) {
    constexpr int O = 8 * NC, PARTS = 256 / O, KLEN = 1024 / PARTS;
    const int t = tid_(), o = t % O, prt = t / O, r = o / NC, j = o % NC;
    const float* xr = xs + r * XS_P + prt * KLEN;
    const float* wp = W + (size_t)(prt * KLEN) * ldw + j;
    float a0 = 0.f, a1 = 0.f, a2 = 0.f, a3 = 0.f;
#pragma unroll 4
    for (int k = 0; k < KLEN; k += 4) {
        const float4 x = *(const float4*)(xr + k);
        a0 += x.x * wp[(size_t)k * ldw]; a1 += x.y * wp[(size_t)(k + 1) * ldw]; a2 += x.z * wp[(size_t)(k + 2) * ldw]; a3 += x.w * wp[(size_t)(k + 3) * ldw];
    }
    part[t] = (a0 + a1) + (a2 + a3);
}

DI void phase_norm1(const P& p, int l, char* lds) {
    const int t = tid_(), lane = t & 63, w = t >> 6;
    float* xres = (float*)(p.ws + WS_XRES);
    bf16_t* hbuf = (bf16_t*)(p.ws + WS_HBUF);
    float* gates = (float*)(p.ws + WS_GATES);
    const float* g1 = p.in[1] + l * DM;
    const float* win = p.in[2] + (size_t)l * DM * DIN;
    float* xs = (float*)lds;
    float* part = xs + 8 * XS_P;
    int* stp = (int*)(part + 256);
    const bf16_t* ymoe = (const bf16_t*)(p.ws + WS_YMOE);
    const int4* tinfo = (const int4*)(p.ws + WS_TINFO);
    if (l > 0) moe_prefix((const int*)(p.ws + WS_CTL) + (l - 1) * NE, stp);
    if (l == 0) {
        const size_t stride = (size_t)gridDim.x * 256, i0 = (size_t)bid_() * 256 + t;
        const float4* s1 = (const float4*)p.in[2]; u32x2* d1 = (u32x2*)(p.ws + WS_WINB);
        for (size_t i = i0; i < (size_t)2 * DM * DIN / 4; i += stride) { const float4 v = s1[i]; u32x2 o; o.x = pk2(v.x, v.y); o.y = pk2(v.z, v.w); d1[i] = o; }
        const float4* s2 = (const float4*)p.in[22]; u32x2* d2 = (u32x2*)(p.ws + WS_WOUTB);
        for (size_t i = i0; i < (size_t)2 * DM * DM / 4; i += stride) { const float4 v = s2[i]; u32x2 o; o.x = pk2(v.x, v.y); o.y = pk2(v.z, v.w); d2[i] = o; }
    }
    for (int rb = bid_(); rb < T / 8; rb += gridDim.x) {
        __syncthreads();
#pragma unroll
        for (int rr = 0; rr < 2; ++rr) {
            const int lr = w * 2 + rr, row = rb * 8 + lr;
            float4 v[4];
            const float* xsrc = (l == 0) ? p.in[0] + (size_t)row * DM : xres + (size_t)row * DM;
#pragma unroll
            for (int i = 0; i < 4; ++i) v[i] = *(const float4*)(xsrc + i * 256 + lane * 4);
            if (l > 0) {
                int4 ti = tinfo[row];
                const bf16_t* y0 = ymoe + (size_t)(stp[ti.x] * 128 + ti.y) * DM;
                const bf16_t* y1 = ymoe + (size_t)(stp[ti.z] * 128 + ti.w) * DM;
#pragma unroll
                for (int i = 0; i < 4; ++i) {
                    uint2 a = *(const uint2*)(y0 + i * 256 + lane * 4), b2 = *(const uint2*)(y1 + i * 256 + lane * 4);
                    v[i].x += bf2f(a.x & 0xffff) + bf2f(b2.x & 0xffff); v[i].y += bf2f(a.x >> 16) + bf2f(b2.x >> 16);
                    v[i].z += bf2f(a.y & 0xffff) + bf2f(b2.y & 0xffff); v[i].w += bf2f(a.y >> 16) + bf2f(b2.y >> 16);
                    *(float4*)(xres + (size_t)row * DM + i * 256 + lane * 4) = v[i];
                }
            }
            float ss = 0.f;
#pragma unroll
            for (int i = 0; i < 4; ++i) ss += v[i].x * v[i].x + v[i].y * v[i].y + v[i].z * v[i].z + v[i].w * v[i].w;
            ss = wave_sum(ss);
            const float rstd = rsqrtf(ss * (1.0f / DM) + EPS);
#pragma unroll
            for (int i = 0; i < 4; ++i) {
                const int k0 = i * 256 + lane * 4;
                const float4 g = *(const float4*)(g1 + k0);
                float4 hv = {v[i].x * rstd * g.x, v[i].y * rstd * g.y, v[i].z * rstd * g.z, v[i].w * rstd * g.w};
                uint2 o; o.x = pk2(hv.x, hv.y); o.y = pk2(hv.z, hv.w);
                *(uint2*)(hbuf + (size_t)row * DM + k0) = o;
            }
        }
    }
}

DI void phase_inproj(const P& p, int l, char* lds) {
    const int t = tid_();
    const bf16_t* hbuf = (const bf16_t*)(p.ws + WS_HBUF);
    bf16_t* projb = (bf16_t*)(p.ws + WS_PROJ);
    const bf16_t* winb = (const bf16_t*)(p.ws + WS_WINB) + (size_t)l * DM * DIN;
    float* gates = (float*)(p.ws + WS_GATES);
    const int vx = bid_() & 7, vj = bid_() >> 3, nj = (gridDim.x - vx + 7) >> 3;
    for (int st = vx; st < 16; st += 8)
      for (int j = vj; j < 96; j += nj) {
        const int mt = st * 8 + j / 12, vt = j % 12;
        const int acol = vt < 4 ? vt * 256 : (vt < 10 ? 1032 + (vt - 4) * 256 : (vt == 10 ? 2568 : 1024));
        const bf16_t* ar = hbuf + (size_t)(mt * 128 + (t >> 2)) * DM + (t & 3) * 8;
        GSeg4 g1{ar, ar + (size_t)64 * DM, 32, winb + (size_t)(t >> 5) * DIN + acol + (t & 31) * 8, DIN, DM / 32}; GSeg4 g2 = g1; g2.KT = 0;
        Epi4Inproj epi{Epi4Bf16{projb + (size_t)mt * 128 * PJ + (vt % 11) * 256, (size_t)PJ}, gates + (size_t)mt * 128 * 8, p.in[3] + l * 4, p.in[4] + l * 4, vt == 11};
        gemm4(g1, g2, lds, epi);
      }
}

__constant__ float ROPE_INV_REV[8] = {0.15915494309189535f, 0.03086376340470123f, 0.005985185712713705f, 0.001160663641240061f,
                                      0.00022507907903927653f, 4.364795279280289e-05f, 8.464330808241401e-06f, 1.6414262627950345e-06f};
DI void load64(const bf16_t* ptr, float (&x)[64]) {
#pragma unroll
    for (int c = 0; c < 8; ++c) {
        u32x4 u = *(const u32x4*)(ptr + c * 8);
        x[c * 8 + 0] = bf2f(u.x & 0xffff); x[c * 8 + 1] = bf2f(u.x >> 16); x[c * 8 + 2] = bf2f(u.y & 0xffff); x[c * 8 + 3] = bf2f(u.y >> 16);
        x[c * 8 + 4] = bf2f(u.z & 0xffff); x[c * 8 + 5] = bf2f(u.z >> 16); x[c * 8 + 6] = bf2f(u.w & 0xffff); x[c * 8 + 7] = bf2f(u.w >> 16);
    }
}
DI void store64(bf16_t* ptr, const float (&x)[64], float sc) {
#pragma unroll
    for (int c = 0; c < 8; ++c) {
        u32x4 u;
        u.x = pk2(x[c * 8 + 0] * sc, x[c * 8 + 1] * sc); u.y = pk2(x[c * 8 + 2] * sc, x[c * 8 + 3] * sc);
        u.z = pk2(x[c * 8 + 4] * sc, x[c * 8 + 5] * sc); u.w = pk2(x[c * 8 + 6] * sc, x[c * 8 + 7] * sc);
        *(u32x4*)(ptr + c * 8) = u;
    }
}
DI void norm_rope64(float (&x)[64], const float* g, int pos) {
    float ss = 0.f;
#pragma unroll
    for (int d = 0; d < 64; ++d) ss += x[d] * x[d];
    const float rstd = rsqrtf(ss * (1.0f / 64.0f) + EPS);
#pragma unroll
    for (int d = 0; d < 64; ++d) x[d] = x[d] * rstd * g[d];
#pragma unroll
    for (int d = 0; d < 8; ++d) {
        constexpr double RINV[8] = {0.15915494309189535, 0.03086376340470123, 0.005985185712713705, 0.001160663641240061,
                                    0.00022507907903927653, 4.364795279280289e-05, 8.464330808241401e-06, 1.6414262627950345e-06};
        double rr = (double)pos * RINV[d];
        rr -= floor(rr);
        const float sn = __builtin_amdgcn_sinf((float)rr), cs = __builtin_amdgcn_cosf((float)rr);
        const float x1 = x[d], x2 = x[d + 8];
        x[d] = x1 * cs - x2 * sn; x[d + 8] = x2 * cs + x1 * sn;
    }
}
DI void phase_qkprep(const P& p, int l, char* lds) {
    bf16_t* projb = (bf16_t*)(p.ws + WS_PROJ);
    float* kmean = (float*)(p.ws + WS_KMEAN);
    float* red = (float*)lds;
    const int t = tid_(), lane = t & 63, w = t >> 6;
    for (int item = bid_(); item < 512; item += gridDim.x) {
        const int b = item >> 6, n = (item >> 3) & 7, hd = item & 7;
        const int pos = n * 256 + t;
        bf16_t* rowp = projb + ((size_t)b * SEQ + pos) * PJ + hd * 64;
        float x[64];
        load64(rowp + C_AQ, x);
        norm_rope64(x, p.in[8] + l * 64, pos);
        store64(rowp + C_AQ, x, 0.125f * 1.4426950408889634f);
        load64(rowp + C_AK, x);
        norm_rope64(x, p.in[9] + l * 64, pos);
        store64(rowp + C_AK, x, 1.0f);
        __syncthreads();
#pragma unroll
        for (int d = 0; d < 64; ++d) { const float v = wave_sum(x[d]); if (lane == (d & 63)) red[w * 64 + d] = v; }
        __syncthreads();
        if (t < 64) kmean[(size_t)item * 64 + t] = (red[t] + red[64 + t] + red[128 + t] + red[192 + t]) * (1.0f / 256.0f);
    }
    {
        bf16_t* mqkc = (bf16_t*)(p.ws + WS_MQKC);
        const float* cw = p.in[5] + l * 4 * 512; const float* cb = p.in[6] + l * 512;
        const int nthreads = gridDim.x * 256;
        for (int idx = bid_() * 256 + t; idx < T * 64; idx += nthreads) {
            const int token = idx >> 6, ch = (idx & 63) * 8, pos = token & (SEQ - 1);
            float a[8];
            { const float4 b0 = *(const float4*)(cb + ch), b1 = *(const float4*)(cb + ch + 4); a[0] = b0.x; a[1] = b0.y; a[2] = b0.z; a[3] = b0.w; a[4] = b1.x; a[5] = b1.y; a[6] = b1.z; a[7] = b1.w; }
#pragma unroll
            for (int j = 0; j < 4; ++j) {
                if (pos + j - 3 >= 0) {
                    const u32x4 u = *(const u32x4*)(projb + (size_t)(token + j - 3) * PJ + ch);
                    const float4 w0 = *(const float4*)(cw + j * 512 + ch), w1 = *(const float4*)(cw + j * 512 + ch + 4);
                    a[0] += bf2f(u.x & 0xffff) * w0.x; a[1] += bf2f(u.x >> 16) * w0.y; a[2] += bf2f(u.y & 0xffff) * w0.z; a[3] += bf2f(u.y >> 16) * w0.w;
                    a[4] += bf2f(u.z & 0xffff) * w1.x; a[5] += bf2f(u.z >> 16) * w1.y; a[6] += bf2f(u.w & 0xffff) * w1.z; a[7] += bf2f(u.w >> 16) * w1.w;
                }
            }
            const float sc = ch >= 256 ? 0.125f : 1.0f;
#pragma unroll
            for (int e = 0; e < 8; ++e) a[e] = a[e] / (1.0f + __expf(-a[e])) * sc;
            u32x4 o; o.x = pk2(a[0], a[1]); o.y = pk2(a[2], a[3]); o.z = pk2(a[4], a[5]); o.w = pk2(a[6], a[7]);
            *(u32x4*)(mqkc + (size_t)token * 512 + ch) = o;
        }
    }
    {
        const float* gates = (const float*)(p.ws + WS_GATES);
        float4* gscan = (float4*)(p.ws + WS_GSCAN);
        const int lane = t & 63, gwv = bid_() * 4 + (t >> 6), nwv = gridDim.x * 4;
        for (int it = gwv; it < (T / 64) * 4; it += nwv) {
            const int ck = it >> 2, hd = it & 3;
            const size_t row = (size_t)ck * 64 + lane;
            const float gi = gates[row * 8 + hd], gf = gates[row * 8 + 4 + hd];
            const float lf = fminf(gf, 0.f) - log1pf(expf(-fabsf(gf)));
            float bs = lf;
#pragma unroll
            for (int o = 1; o < 64; o <<= 1) { const float v = __shfl_up(bs, o); if (lane >= o) bs += v; }
            const float u = gi - bs; float um = u;
#pragma unroll
            for (int o = 1; o < 64; o <<= 1) { const float v = __shfl_up(um, o); if (lane >= o) um = fmaxf(um, v); }
            gscan[row * 4 + hd] = make_float4(bs, u, um, 0.f);
        }
    }
    {
        float* Tm = (float*)(p.ws + WS_S5M + (size_t)l * S5M_LAYER);
        float* Em = (float*)(p.ws + WS_S5M + (size_t)l * S5M_LAYER + S5M_E);
        float* Fm = (float*)(p.ws + WS_S5M + (size_t)l * S5M_LAYER + S5M_F);
        float* sp = (float*)lds + 512;
        for (int item = bid_(); item < 256; item += gridDim.x) {
            const int g = item >> 4, tau = item & 15, lg = l * 16 + g;
            Tm += 0;
            float* Tg = Tm + (size_t)g * 256 * 256; float* Eg = Em + (size_t)g * 256 * 128; float* Fg = Fm + (size_t)g * 128 * 256;
            __syncthreads();
            if (t < 64) {
                const float lr = p.in[11][lg * 64 + t], li = p.in[12][lg * 64 + t], dt = expf(p.in[18][lg]);
                const float mag1 = expf(lr * dt), a1r = mag1 * cosf(li * dt), a1i = mag1 * sinf(li * dt);
                const float magt = expf(lr * dt * tau), atr = magt * cosf(li * dt * tau), ati = magt * sinf(li * dt * tau);
                const float zr = a1r - 1.0f, zi = a1i, dn = lr * lr + li * li;
                sp[t] = atr; sp[64 + t] = ati; sp[128 + t] = atr * a1r - ati * a1i; sp[192 + t] = atr * a1i + ati * a1r;
                sp[256 + t] = (zr * lr + zi * li) / dn; sp[320 + t] = (zi * lr - zr * li) / dn;
            }
            __syncthreads();
            {
                const int hh = t >> 4, hp = t & 15;
                const float* cre = p.in[15] + ((size_t)lg * 16 + hh) * 64; const float* cim = p.in[16] + ((size_t)lg * 16 + hh) * 64;
                const float* bre = p.in[13] + (size_t)lg * 64 * 16 + hp; const float* bim = p.in[14] + (size_t)lg * 64 * 16 + hp;
                float kv = 0.f;
                for (int pi = 0; pi < 64; ++pi) {
                    const float fr = sp[256 + pi], fi = sp[320 + pi], br = bre[pi * 16], bi = bim[pi * 16];
                    const float bbr = fr * br - fi * bi, bbi = fr * bi + fi * br;
                    const float cr = cre[pi], ci = cim[pi], ar = sp[pi], ai = sp[64 + pi];
                    kv += (cr * ar - ci * ai) * bbr - (cr * ai + ci * ar) * bbi;
                }
                if (tau == 0 && hh == hp) kv += p.in[17][lg * 16 + hh];
                for (int s_ = 0; s_ + tau < 16; ++s_) {
                    const int t_ = s_ + tau;
                    Tg[(size_t)(s_ * 16 + hp) * 256 + t_ * 16 + hh] = kv;
                    if (tau > 0) Tg[(size_t)(t_ * 16 + hp) * 256 + s_ * 16 + hh] = 0.f;
                }
            }
            for (int idx = t; idx < 1024; idx += 256) {
                const int pi = idx >> 4, x = idx & 15;
                {
                    const float fr = sp[256 + pi], fi = sp[320 + pi];
                    const float br = p.in[13][((size_t)lg * 64 + pi) * 16 + x], bi = p.in[14][((size_t)lg * 64 + pi) * 16 + x];
                    const float bbr = fr * br - fi * bi, bbi = fr * bi + fi * br, ar = sp[pi], ai = sp[64 + pi];
                    const size_t ro = (size_t)((15 - tau) * 16 + x) * 128;
                    Eg[ro + pi] = ar * bbr - ai * bbi; Eg[ro + 64 + pi] = ar * bbi + ai * bbr;
                }
                {
                    const float cr = p.in[15][((size_t)lg * 16 + x) * 64 + pi], ci = p.in[16][((size_t)lg * 16 + x) * 64 + pi];
                    const float ar = sp[128 + pi], ai = sp[192 + pi];
                    Fg[(size_t)pi * 256 + tau * 16 + x] = cr * ar - ci * ai; Fg[(size_t)(64 + pi) * 256 + tau * 16 + x] = -(cr * ai + ci * ar);
                }
            }
        }
    }
}

DI void mlstm_item_simple(const P& p, int l, int item, float* sm) {
    const int b = item >> 4, hd = (item >> 2) & 3, dq = item & 3;
    const int t = tid_();
    const bf16_t* projb = (const bf16_t*)(p.ws + WS_PROJ);
    const float* gates = (const float*)(p.ws + WS_GATES);
    float* hraw = (float*)(p.ws + WS_HRAW);
    const float* cw = p.in[5] + l * 4 * 512; const float* cb = p.in[6] + l * 512;
    float* Q = sm; float* K = Q + 64 * 65; float* Sm = K + 64 * 65; float* V = Sm + 64 * 65; float* C = V + 64 * 16; float* nv = C + 64 * 16;
    float* bc = nv + 64; float* Mt = bc + 64; float* uu = Mt + 64; float* den = uu + 64; float* misc = den + 64;
    __syncthreads();
    for (int i = t; i < 1024; i += 256) C[i] = 0.f;
    if (t < 64) nv[t] = 0.f;
    if (t == 0) misc[0] = 0.f;
    for (int c = 0; c < 32; ++c) {
        __syncthreads();
        const int row0 = b * SEQ + c * 64;
        for (int i = t; i < 8192; i += 256) {
            const int which = i >> 12, tt = (i >> 6) & 63, d = i & 63, ch = which * 256 + hd * 64 + d;
            float a = cb[ch];
#pragma unroll
            for (int j = 0; j < 4; ++j) { const int ts = c * 64 + tt + j - 3; if (ts >= 0) a += bf2f(projb[(size_t)(b * SEQ + ts) * PJ + ch]) * cw[j * 512 + ch]; }
            float y = a / (1.0f + expf(-a));
            if (which) K[tt * 65 + d] = y * 0.125f; else Q[tt * 65 + d] = y;
        }
        for (int i = t; i < 1024; i += 256) { const int tt = i >> 4, d = i & 15; V[i] = bf2f(projb[(size_t)(row0 + tt) * PJ + C_MV + hd * 64 + dq * 16 + d]); }
        if (t < 64) {
            const float ig = gates[(size_t)(row0 + t) * 8 + hd], fg = gates[(size_t)(row0 + t) * 8 + 4 + hd];
            const float lf = fminf(fg, 0.f) - log1pf(expf(-fabsf(fg)));
            float bs = lf;
#pragma unroll
            for (int o = 1; o < 64; o <<= 1) { float v = __shfl_up(bs, o); if (t >= o) bs += v; }
            const float u = ig - bs; float um = u;
#pragma unroll
            for (int o = 1; o < 64; o <<= 1) { float v = __shfl_up(um, o); if (t >= o) um = fmaxf(um, v); }
            bc[t] = bs; uu[t] = u; Mt[t] = fmaxf(misc[0], um);
        }
        __syncthreads();
        for (int i = t; i < 4096; i += 256) {
            const int tt = i >> 6, s = i & 63; float v = 0.f;
            if (s <= tt) { float dsum = 0.f; for (int d = 0; d < 64; ++d) dsum += Q[tt * 65 + d] * K[s * 65 + d]; v = dsum * expf(uu[s] - Mt[tt]); }
            Sm[tt * 65 + s] = v;
        }
        __syncthreads();
        if (t < 64) {
            const float inter = expf(misc[0] - Mt[t]);
            float qn = 0.f, rs = 0.f;
            for (int d = 0; d < 64; ++d) { qn += Q[t * 65 + d] * nv[d]; rs += Sm[t * 65 + d]; }
            den[t] = fmaxf(fabsf(inter * qn + rs), expf(-(bc[t] + Mt[t])));
        }
        __syncthreads();
        for (int i = t; i < 1024; i += 256) {
            const int tt = i >> 4, d = i & 15;
            const float inter = expf(misc[0] - Mt[tt]);
            float a = 0.f, bsum = 0.f;
            for (int k = 0; k < 64; ++k) { a += Q[tt * 65 + k] * C[k * 16 + d]; bsum += Sm[tt * 65 + k] * V[k * 16 + d]; }
            hraw[(size_t)(row0 + tt) * 256 + hd * 64 + dq * 16 + d] = (inter * a + bsum) / den[tt];
        }
        __syncthreads();
        const float Mlast = Mt[63], decay = expf(misc[0] - Mlast);
        for (int i = t; i < 1024; i += 256) {
            const int dk = i >> 4, d = i & 15; float a = 0.f;
            for (int s = 0; s < 64; ++s) a += expf(uu[s] - Mlast) * K[s * 65 + dk] * V[s * 16 + d];
            C[i] = decay * C[i] + a;
        }
        if (t < 64) { float a = 0.f; for (int s = 0; s < 64; ++s) a += expf(uu[s] - Mlast) * K[s * 65 + t]; nv[t] = decay * nv[t] + a; }
        __syncthreads();
        if (t == 0) misc[0] = bc[63] + Mlast;
    }
}

constexpr int ML_QP = 144, ML_TP = 192;
constexpr int ML_Q = 0, ML_K = 9216, ML_KW = 18432, ML_V = 30720, ML_C = 43008, ML_N = 55296, ML_U = 55808, ML_NP = 56064, ML_SS = 57088, ML_DEC = 57600;
DI bf16x8 scale8(u32x4 v, float w) {
    u32x4 o;
    o.x = pk2(bf2f(v.x & 0xffff) * w, bf2f(v.x >> 16) * w); o.y = pk2(bf2f(v.y & 0xffff) * w, bf2f(v.y >> 16) * w);
    o.z = pk2(bf2f(v.z & 0xffff) * w, bf2f(v.z >> 16) * w); o.w = pk2(bf2f(v.w & 0xffff) * w, bf2f(v.w >> 16) * w);
    return __builtin_bit_cast(bf16x8, o);
}
DI bf16x8 tr_frag(const LAS char* p, int hi_off) {
    s16x4 lo = tr_read(p), hi = tr_read(p + hi_off);
    return __builtin_shufflevector(lo, hi, 0, 1, 2, 3, 4, 5, 6, 7);
}
DI void mlstm_mscan(const float4* gscan, size_t rowb, int hd, int lane, float& m_in, float& decay) {
    const int ci = lane & 31;
    const float4 gl = gscan[(rowb + ci * 64 + 63) * 4 + hd];
    float A = gl.x, B = gl.z + gl.x;
#pragma unroll
    for (int o = 1; o < 32; o <<= 1) {
        const float Ap = __shfl_up(A, o), Bp = __shfl_up(B, o);
        if (ci >= o) { B = fmaxf(Bp + A, B); A = Ap + A; }
    }
    const float mafter = fmaxf(A, B);
    const float mprev = __shfl_up(mafter, 1);
    m_in = ci == 0 ? 0.f : mprev;
    decay = __expf(m_in - fmaxf(m_in, gl.z));
}
DI void mlstm_state_item(const P& p, int l, int item, char* lds_generic) {
    LAS char* lds = (LAS char*)lds_generic;
    const int bh = item >> 5, c = item & 31, b = bh >> 2, hd = bh & 3;
    const int t = tid_(), lane = t & 63, w = t >> 6, r = lane & 31, h = lane >> 5;
    const int i16 = lane & 15, q4 = i16 >> 2, pp = i16 & 3, blk = (lane >> 4) & 1;
    const int wd = w & 1, wt = w >> 1;
    const bf16_t* projb = (const bf16_t*)(p.ws + WS_PROJ);
    const bf16_t* mqkc = (const bf16_t*)(p.ws + WS_MQKC);
    const float4* gscan = (const float4*)(p.ws + WS_GSCAN);
    float* dC = (float*)(p.ws + WS_HRAW) + (size_t)item * 4096;
    float* dn = (float*)(p.ws + WS_ZBUF + 8 * MiB) + (size_t)item * 64;
    LAS float* npart = (LAS float*)(lds + ML_NP);
    const int srow = t >> 3, sc16 = t & 7;
    const size_t rowb = (size_t)b * SEQ, row0 = rowb + c * 64;
    const bf16_t* kp = mqkc + (row0 + srow) * 512 + 256 + hd * 64 + sc16 * 8;
    const u32x4 rk0 = *(const u32x4*)kp, rk1 = *(const u32x4*)(kp + 32 * 512);
    const bf16_t* vp = projb + (row0 + srow) * PJ + C_MV + hd * 64 + sc16 * 8;
    const u32x4 rv0 = *(const u32x4*)vp, rv1 = *(const u32x4*)(vp + (size_t)32 * PJ);
    const float4 gl0 = gscan[(row0 + srow) * 4 + hd], gl1 = gscan[(row0 + srow + 32) * 4 + hd], glast = gscan[(row0 + 63) * 4 + hd];
    float m_in, dec; mlstm_mscan(gscan, rowb, hd, lane, m_in, dec);
    const float m = __shfl(m_in, c);
    const float Mlast = fmaxf(m, glast.z);
    __syncthreads();
    {
        const float w0 = __expf(gl0.y - Mlast), w1 = __expf(gl1.y - Mlast);
        *(LAS u32x4*)(lds + ML_V + srow * ML_TP + sc16 * 16) = rv0; *(LAS u32x4*)(lds + ML_V + (srow + 32) * ML_TP + sc16 * 16) = rv1;
        *(LAS bf16x8*)(lds + ML_KW + srow * ML_TP + sc16 * 16) = scale8(rk0, w0); *(LAS bf16x8*)(lds + ML_KW + (srow + 32) * ML_TP + sc16 * 16) = scale8(rk1, w1);
    }
    __syncthreads();
    f32x16 cacc;
#pragma unroll
    for (int e = 0; e < 16; ++e) cacc[e] = 0.f;
#pragma unroll
    for (int k4 = 0; k4 < 4; ++k4) {
        const bf16x8 vf = tr_frag(lds + ML_V + (k4 * 16 + 4 * h + q4) * ML_TP + (wd * 32 + 16 * blk) * 2 + 8 * pp, 8 * ML_TP);
        const bf16x8 kwf = tr_frag(lds + ML_KW + (k4 * 16 + 4 * h + q4) * ML_TP + (wt * 32 + 16 * blk) * 2 + 8 * pp, 8 * ML_TP);
        cacc = __builtin_amdgcn_mfma_f32_32x32x16_bf16(vf, kwf, cacc, 0, 0, 0);
    }
    {
        const int dk = t & 63, qd = t >> 6; float a = 0.f;
#pragma unroll
        for (int s_ = 0; s_ < 16; ++s_) a += bf2f(*(const LAS bf16_t*)(lds + ML_KW + (qd * 16 + s_) * ML_TP + dk * 2));
        npart[qd * 64 + dk] = a;
    }
#pragma unroll
    for (int g = 0; g < 4; ++g) { float4 x = {cacc[4 * g], cacc[4 * g + 1], cacc[4 * g + 2], cacc[4 * g + 3]}; *(float4*)(dC + (wt * 32 + r) * 64 + wd * 32 + 8 * g + 4 * h) = x; }
    __syncthreads();
    if (t < 64) dn[t] = (npart[t] + npart[64 + t]) + (npart[128 + t] + npart[192 + t]);
}
DI void mlstm_out_item(const P& p, int l, int item, char* lds_generic) {
    LAS char* lds = (LAS char*)lds_generic;
    const int bh = item >> 5, c = item & 31, b = bh >> 2, hd = bh & 3;
    const int t = tid_(), lane = t & 63, w = t >> 6, r = lane & 31, h = lane >> 5;
    const int i16 = lane & 15, q4 = i16 >> 2, pp = i16 & 3, blk = (lane >> 4) & 1;
    const int wd = w & 1, wt = w >> 1;
    const bf16_t* projb = (const bf16_t*)(p.ws + WS_PROJ);
    const bf16_t* mqkc = (const bf16_t*)(p.ws + WS_MQKC);
    const float4* gscan = (const float4*)(p.ws + WS_GSCAN);
    const float* dCb = (const float*)(p.ws + WS_HRAW) + (size_t)bh * 32 * 4096;
    const float* dnb = (const float*)(p.ws + WS_ZBUF + 8 * MiB) + (size_t)bh * 32 * 64;
    bf16_t* mix = (bf16_t*)(p.ws + WS_MIX);
    const float* mg = p.in[7] + l * 256 + hd * 64;
    LAS float* nbuf = (LAS float*)(lds + ML_N); LAS float* ubuf2 = (LAS float*)(lds + ML_U); LAS float* ssbuf = (LAS float*)(lds + ML_SS); LAS float* decs = (LAS float*)(lds + ML_DEC);
    const int srow = t >> 3, sc16 = t & 7;
    const float LOG2E = 1.4426950408889634f;
    const size_t rowb = (size_t)b * SEQ, row0 = rowb + c * 64;
    const int tt = wt * 32 + r;
    const bf16_t* qp = mqkc + (row0 + srow) * 512 + hd * 64 + sc16 * 8;
    const u32x4 rq0 = *(const u32x4*)qp, rq1 = *(const u32x4*)(qp + 32 * 512), rk0 = *(const u32x4*)(qp + 256), rk1 = *(const u32x4*)(qp + 32 * 512 + 256);
    const bf16_t* vp = projb + (row0 + srow) * PJ + C_MV + hd * 64 + sc16 * 8;
    const u32x4 rv0 = *(const u32x4*)vp, rv1 = *(const u32x4*)(vp + (size_t)32 * PJ);
    const float4 gl0 = gscan[(row0 + srow) * 4 + hd], gl1 = gscan[(row0 + srow + 32) * 4 + hd], gtt = gscan[(row0 + tt) * 4 + hd];
    const bf16_t* opp = projb + (row0 + tt) * PJ + C_MO + hd * 64 + wd * 32 + 4 * h;
    const u32x2 opre[4] = {*(const u32x2*)(opp), *(const u32x2*)(opp + 8), *(const u32x2*)(opp + 16), *(const u32x2*)(opp + 24)};
    float4 mgr[4];
#pragma unroll
    for (int g = 0; g < 4; ++g) mgr[g] = *(const float4*)(mg + wd * 32 + 4 * h + 8 * g);
    float m_in, dec; mlstm_mscan(gscan, rowb, hd, lane, m_in, dec);
    const float m = __shfl(m_in, c);
    __syncthreads();
    if (t < 32) decs[t] = dec;
    __syncthreads();
    {
        float4 c0 = {0.f, 0.f, 0.f, 0.f}, c1 = c0, c2 = c0, c3 = c0; float nacc = 0.f;
        const float* src = dCb + (t >> 2) * 64 + (t & 3) * 16;
#pragma unroll 4
        for (int cc = 0; cc < c; ++cc) {
            const float d = decs[cc];
            const float4 x0 = *(const float4*)(src), x1 = *(const float4*)(src + 4), x2 = *(const float4*)(src + 8), x3 = *(const float4*)(src + 12);
            c0.x = c0.x * d + x0.x; c0.y = c0.y * d + x0.y; c0.z = c0.z * d + x0.z; c0.w = c0.w * d + x0.w;
            c1.x = c1.x * d + x1.x; c1.y = c1.y * d + x1.y; c1.z = c1.z * d + x1.z; c1.w = c1.w * d + x1.w;
            c2.x = c2.x * d + x2.x; c2.y = c2.y * d + x2.y; c2.z = c2.z * d + x2.z; c2.w = c2.w * d + x2.w;
            c3.x = c3.x * d + x3.x; c3.y = c3.y * d + x3.y; c3.z = c3.z * d + x3.z; c3.w = c3.w * d + x3.w;
            if (t < 64) nacc = nacc * d + dnb[cc * 64 + t];
            src += 4096;
        }
        u32x4 o0, o1;
        o0.x = pk2(c0.x, c0.y); o0.y = pk2(c0.z, c0.w); o0.z = pk2(c1.x, c1.y); o0.w = pk2(c1.z, c1.w);
        o1.x = pk2(c2.x, c2.y); o1.y = pk2(c2.z, c2.w); o1.z = pk2(c3.x, c3.y); o1.w = pk2(c3.z, c3.w);
        *(LAS u32x4*)(lds + ML_C + (t >> 2) * ML_TP + (t & 3) * 32) = o0; *(LAS u32x4*)(lds + ML_C + (t >> 2) * ML_TP + (t & 3) * 32 + 16) = o1;
        if (t < 64) nbuf[t] = nacc;
    }
    const float Mt_t = fmaxf(m, gtt.z), bs_t = gtt.x;
    {
        *(LAS u32x4*)(lds + ML_Q + srow * ML_QP + sc16 * 16) = rq0; *(LAS u32x4*)(lds + ML_Q + (srow + 32) * ML_QP + sc16 * 16) = rq1;
        *(LAS u32x4*)(lds + ML_K + srow * ML_QP + sc16 * 16) = rk0; *(LAS u32x4*)(lds + ML_K + (srow + 32) * ML_QP + sc16 * 16) = rk1;
        *(LAS u32x4*)(lds + ML_V + srow * ML_TP + sc16 * 16) = rv0; *(LAS u32x4*)(lds + ML_V + (srow + 32) * ML_TP + sc16 * 16) = rv1;
        if (sc16 == 0) { ubuf2[srow] = gl0.y * LOG2E; ubuf2[srow + 32] = gl1.y * LOG2E; }
    }
    __syncthreads();
    const float inter = __expf(m - Mt_t);
    bf16x8 qf[4];
#pragma unroll
    for (int ks = 0; ks < 4; ++ks) qf[ks] = *(const LAS bf16x8*)(lds + ML_Q + tt * ML_QP + (ks * 16 + 8 * h) * 2);
    f32x16 acca, accb;
#pragma unroll
    for (int e = 0; e < 16; ++e) { acca[e] = 0.f; accb[e] = 0.f; }
    float rs = 0.f;
    const float Mt2 = Mt_t * LOG2E;
#pragma unroll
    for (int st = 0; st < 2; ++st) {
        if (st <= wt) {
            f32x16 sa;
#pragma unroll
            for (int e = 0; e < 16; ++e) sa[e] = 0.f;
#pragma unroll
            for (int ks = 0; ks < 4; ++ks) {
                const bf16x8 kf = *(const LAS bf16x8*)(lds + ML_K + (st * 32 + r) * ML_QP + (ks * 16 + 8 * h) * 2);
                sa = __builtin_amdgcn_mfma_f32_32x32x16_bf16(kf, qf[ks], sa, 0, 0, 0);
            }
#pragma unroll
            for (int g = 0; g < 4; ++g) {
                const f32x4 u4 = *(const LAS f32x4*)(ubuf2 + st * 32 + 8 * g + 4 * h);
                const float uu[4] = {u4.x, u4.y, u4.z, u4.w};
#pragma unroll
                for (int i = 0; i < 4; ++i) {
                    const int sidx = st * 32 + 8 * g + 4 * h + i;
                    const float dv_ = (sidx <= tt) ? sa[4 * g + i] * __builtin_amdgcn_exp2f(uu[i] - Mt2) : 0.f;
                    sa[4 * g + i] = dv_; rs += dv_;
                }
            }
#pragma unroll
            for (int sk = 0; sk < 2; ++sk) {
                u32x4 pk; pk.x = pk2(sa[8 * sk], sa[8 * sk + 1]); pk.y = pk2(sa[8 * sk + 2], sa[8 * sk + 3]); pk.z = pk2(sa[8 * sk + 4], sa[8 * sk + 5]); pk.w = pk2(sa[8 * sk + 6], sa[8 * sk + 7]);
                const bf16x8 vf = tr_frag(lds + ML_V + ((st * 2 + sk) * 16 + 4 * h + q4) * ML_TP + (wd * 32 + 16 * blk) * 2 + 8 * pp, 8 * ML_TP);
                acca = __builtin_amdgcn_mfma_f32_32x32x16_bf16(vf, __builtin_bit_cast(bf16x8, pk), acca, 0, 0, 0);
            }
        }
    }
#pragma unroll
    for (int ks = 0; ks < 4; ++ks) {
        const bf16x8 cf = tr_frag(lds + ML_C + (ks * 16 + 8 * h + q4) * ML_TP + (wd * 32 + 16 * blk) * 2 + 8 * pp, 4 * ML_TP);
        accb = __builtin_amdgcn_mfma_f32_32x32x16_bf16(cf, qf[ks], accb, 0, 0, 0);
    }
    float qn = 0.f;
#pragma unroll
    for (int ks = 0; ks < 4; ++ks) {
        const f32x4 n0 = *(const LAS f32x4*)(nbuf + ks * 16 + 8 * h), n1 = *(const LAS f32x4*)(nbuf + ks * 16 + 8 * h + 4);
        qn += bf2f((bf16_t)qf[ks][0]) * n0.x + bf2f((bf16_t)qf[ks][1]) * n0.y + bf2f((bf16_t)qf[ks][2]) * n0.z + bf2f((bf16_t)qf[ks][3]) * n0.w
            + bf2f((bf16_t)qf[ks][4]) * n1.x + bf2f((bf16_t)qf[ks][5]) * n1.y + bf2f((bf16_t)qf[ks][6]) * n1.z + bf2f((bf16_t)qf[ks][7]) * n1.w;
    }
    qn = half_swap_sum(qn); rs = half_swap_sum(rs);
    const float hden = fmaxf(fabsf(inter * qn + rs), __expf(-(bs_t + Mt_t)));
    const float ihd = 1.0f / hden;
    float ss = 0.f;
#pragma unroll
    for (int e = 0; e < 16; ++e) { acca[e] = (acca[e] + inter * accb[e]) * ihd; ss += acca[e] * acca[e]; }
    ss = half_swap_sum(ss);
    if (h == 0) ssbuf[wd * 64 + tt] = ss;
    __syncthreads();
    {
        const float rstd = rsqrtf((ssbuf[tt] + ssbuf[64 + tt]) * (1.0f / 64.0f) + EPS);
        bf16_t* op = mix + (row0 + tt) * DM + hd * 64 + wd * 32 + 4 * h;
#pragma unroll
        for (int g = 0; g < 4; ++g) {
            const float4 g4 = mgr[g];
            const float o0 = bf2f(opre[g].x & 0xffff), o1 = bf2f(opre[g].x >> 16), o2 = bf2f(opre[g].y & 0xffff), o3 = bf2f(opre[g].y >> 16);
            u32x2 v;
            v.x = pk2(acca[4 * g] * rstd * g4.x * __builtin_amdgcn_rcpf(1.0f + __expf(-o0)), acca[4 * g + 1] * rstd * g4.y * __builtin_amdgcn_rcpf(1.0f + __expf(-o1)));
            v.y = pk2(acca[4 * g + 2] * rstd * g4.z * __builtin_amdgcn_rcpf(1.0f + __expf(-o2)), acca[4 * g + 3] * rstd * g4.w * __builtin_amdgcn_rcpf(1.0f + __expf(-o3)));
            *(u32x2*)(op + 8 * g) = v;
        }
    }
}

constexpr int KP = 144, VP = 192, ATT_K_BYTES = 64 * KP, ATT_BUF = 64 * KP + 64 * VP;
DI void moba_item(const P& p, int l, int item, char* lds_generic) {
    LAS char* lds = (LAS char*)lds_generic;
    const int b = item >> 7, hd = (item >> 4) & 7, qt = item & 15, qb = qt >> 1;
    const int t = tid_(), lane = t & 63, w = t >> 6, r = lane & 31, h = lane >> 5;
    const int i16 = lane & 15, q4 = i16 >> 2, pp = i16 & 3, blk = (lane >> 4) & 1;
    const bf16_t* projb = (const bf16_t*)(p.ws + WS_PROJ);
    bf16_t* mix = (bf16_t*)(p.ws + WS_MIX);
    const float* kmean = (const float*)(p.ws + WS_KMEAN);
    const size_t rowb = (size_t)b * SEQ;
    const int q0 = qt * 128, qpos = q0 + w * 32 + r;
    bf16x8 qf[4];
    {
        const bf16_t* qp = projb + (rowb + qpos) * PJ + C_AQ + hd * 64 + 8 * h;
#pragma unroll
        for (int ks = 0; ks < 4; ++ks) qf[ks] = *(const bf16x8*)(qp + ks * 16);
    }
    unsigned mask = 0;
    {
        float gate[8];
#pragma unroll
        for (int n = 0; n < 8; ++n) {
            float sacc = 0.f;
            if (n < qb) {
                const float* km = kmean + ((size_t)((b * 8 + n) * 8 + hd)) * 64 + 8 * h;
#pragma unroll
                for (int ks = 0; ks < 4; ++ks)
#pragma unroll
                    for (int j = 0; j < 8; ++j) sacc += bf2f((bf16_t)qf[ks][j]) * km[ks * 16 + j];
            }
            gate[n] = half_swap_sum(sacc);
        }
#pragma unroll
        for (int it = 0; it < 3; ++it) {
            int best = -1; float bv = -INFINITY;
#pragma unroll
            for (int n = 0; n < 8; ++n) if (n < qb && !((mask >> n) & 1u) && gate[n] > bv) { bv = gate[n]; best = n; }
            if (best >= 0) mask |= 1u << best;
        }
    }
    const int nown = ((q0 & 255) >> 6) + 2, ntiles = nown + qb * 4;
    f32x16 o0, o1;
#pragma unroll
    for (int e = 0; e < 16; ++e) { o0[e] = 0.f; o1[e] = 0.f; }
    float m = -INFINITY, lsum = 0.f;
    const int srow = t >> 3, sc16 = t & 7;
    u32x4 rk0, rk1, rv0, rv1;
    auto key0_of = [&](int it) { return it < nown ? qb * 256 + it * 64 : ((it - nown) >> 2) * 256 + ((it - nown) & 3) * 64; };
    auto gload = [&](int it) {
        const int key0 = key0_of(it);
        const bf16_t* base = projb + (rowb + key0 + srow) * PJ + hd * 64 + sc16 * 8;
        rk0 = *(const u32x4*)(base + C_AK); rk1 = *(const u32x4*)(base + (size_t)32 * PJ + C_AK);
        rv0 = *(const u32x4*)(base + C_AV); rv1 = *(const u32x4*)(base + (size_t)32 * PJ + C_AV);
    };
    auto sstore = [&](int buf) {
        LAS char* sK = lds + buf * ATT_BUF; LAS char* sV = sK + ATT_K_BYTES;
        *(LAS u32x4*)(sK + srow * KP + sc16 * 16) = rk0; *(LAS u32x4*)(sK + (srow + 32) * KP + sc16 * 16) = rk1;
        *(LAS u32x4*)(sV + srow * VP + sc16 * 16) = rv0; *(LAS u32x4*)(sV + (srow + 32) * VP + sc16 * 16) = rv1;
    };
    __syncthreads();
    gload(0); sstore(0); __syncthreads();
    for (int it = 0; it < ntiles; ++it) {
        if (it + 1 < ntiles) gload(it + 1);
        {
            const LAS char* sK = lds + (it & 1) * ATT_BUF; const LAS char* sV = sK + ATT_K_BYTES;
            const int key0 = key0_of(it), blockn = key0 >> 8;
            f32x16 s0, s1;
#pragma unroll
            for (int e = 0; e < 16; ++e) { s0[e] = 0.f; s1[e] = 0.f; }
#pragma unroll
            for (int ks = 0; ks < 4; ++ks) {
                const bf16x8 k0 = *(const LAS bf16x8*)(sK + r * KP + (ks * 16 + 8 * h) * 2);
                const bf16x8 k1 = *(const LAS bf16x8*)(sK + (32 + r) * KP + (ks * 16 + 8 * h) * 2);
                s0 = __builtin_amdgcn_mfma_f32_32x32x16_bf16(k0, qf[ks], s0, 0, 0, 0);
                s1 = __builtin_amdgcn_mfma_f32_32x32x16_bf16(k1, qf[ks], s1, 0, 0, 0);
            }
            const bool own = (blockn == qb);
            const bool active = own || ((mask >> blockn) & 1u);
            if (!active) {
#pragma unroll
                for (int e = 0; e < 16; ++e) { s0[e] = -INFINITY; s1[e] = -INFINITY; }
            } else if (own && key0 + 63 > q0 + w * 32) {
#pragma unroll
                for (int e = 0; e < 16; ++e) {
                    const int kk = key0 + (e & 3) + 8 * (e >> 2) + 4 * h;
                    if (kk > qpos) s0[e] = -INFINITY;
                    if (kk + 32 > qpos) s1[e] = -INFINITY;
                }
            }
            float mx = fmaxf(s0[0], s1[0]);
#pragma unroll
            for (int e = 1; e < 16; ++e) mx = fmaxf(mx, fmaxf(s0[e], s1[e]));
            mx = half_swap_max(mx);
            const float mn = fmaxf(m, mx);
            const float alpha = __builtin_amdgcn_exp2f(m - mn);
            m = mn;
            float ps = 0.f;
#pragma unroll
            for (int e = 0; e < 16; ++e) { s0[e] = __builtin_amdgcn_exp2f(s0[e] - mn); s1[e] = __builtin_amdgcn_exp2f(s1[e] - mn); ps += s0[e] + s1[e]; }
            lsum = lsum * alpha + ps;
#pragma unroll
            for (int e = 0; e < 16; ++e) { o0[e] *= alpha; o1[e] *= alpha; }
#pragma unroll
            for (int st = 0; st < 2; ++st)
#pragma unroll
                for (int sk = 0; sk < 2; ++sk) {
                    u32x4 pk;
                    if (st == 0) { pk.x = pk2(s0[8 * sk], s0[8 * sk + 1]); pk.y = pk2(s0[8 * sk + 2], s0[8 * sk + 3]); pk.z = pk2(s0[8 * sk + 4], s0[8 * sk + 5]); pk.w = pk2(s0[8 * sk + 6], s0[8 * sk + 7]); }
                    else         { pk.x = pk2(s1[8 * sk], s1[8 * sk + 1]); pk.y = pk2(s1[8 * sk + 2], s1[8 * sk + 3]); pk.z = pk2(s1[8 * sk + 4], s1[8 * sk + 5]); pk.w = pk2(s1[8 * sk + 6], s1[8 * sk + 7]); }
                    const bf16x8 pf = __builtin_bit_cast(bf16x8, pk);
                    const LAS char* vb = sV + (st * 32 + sk * 16 + 4 * h + q4) * VP + (16 * blk) * 2 + 8 * pp;
                    {
                        s16x4 lo = tr_read(vb), hi = tr_read(vb + 8 * VP);
                        const bf16x8 vf = __builtin_shufflevector(lo, hi, 0, 1, 2, 3, 4, 5, 6, 7);
                        o0 = __builtin_amdgcn_mfma_f32_32x32x16_bf16(vf, pf, o0, 0, 0, 0);
                    }
                    {
                        s16x4 lo = tr_read(vb + 64), hi = tr_read(vb + 64 + 8 * VP);
                        const bf16x8 vf = __builtin_shufflevector(lo, hi, 0, 1, 2, 3, 4, 5, 6, 7);
                        o1 = __builtin_amdgcn_mfma_f32_32x32x16_bf16(vf, pf, o1, 0, 0, 0);
                    }
                }
        }
        if (it + 1 < ntiles) sstore((it + 1) & 1);
        __syncthreads();
    }
    const float il = 1.0f / half_swap_sum(lsum);
    float ss = 0.f;
#pragma unroll
    for (int e = 0; e < 16; ++e) { o0[e] *= il; o1[e] *= il; ss += o0[e] * o0[e] + o1[e] * o1[e]; }
    ss = half_swap_sum(ss);
    const float rstd = rsqrtf(ss * (1.0f / 64.0f) + EPS);
    const float* og = p.in[10] + (l * 8 + hd) * 64 + 4 * h;
    bf16_t* op = mix + (rowb + qpos) * DM + 256 + hd * 64 + 4 * h;
#pragma unroll
    for (int g = 0; g < 4; ++g) {
        const float4 g0 = *(const float4*)(og + 8 * g), g1 = *(const float4*)(og + 32 + 8 * g);
        u32x2 v0, v1;
        v0.x = pk2(o0[4 * g] * rstd * g0.x, o0[4 * g + 1] * rstd * g0.y); v0.y = pk2(o0[4 * g + 2] * rstd * g0.z, o0[4 * g + 3] * rstd * g0.w);
        v1.x = pk2(o1[4 * g] * rstd * g1.x, o1[4 * g + 1] * rstd * g1.y); v1.y = pk2(o1[4 * g + 2] * rstd * g1.z, o1[4 * g + 3] * rstd * g1.w);
        *(u32x2*)(op + 8 * g) = v0; *(u32x2*)(op + 32 + 8 * g) = v1;
    }
}

DI void s5_item_simple(const P& p, int l, int item, float* sm) {
    const int t = tid_(), lane = t & 63, w = t >> 6;
    const int bg = item * 4 + w, b = bg >> 4, g = bg & 15;
    const bf16_t* projb = (const bf16_t*)(p.ws + WS_PROJ);
    float* zbuf = (float*)(p.ws + WS_ZBUF);
    float* xr = sm + w * (2 * 16 * 65); float* xi = xr + 16 * 65;
    const int lg = l * 16 + g;
    const float lr = p.in[11][lg * 64 + lane], li = p.in[12][lg * 64 + lane];
    const float dt = expf(p.in[18][lg]);
    const float mag = expf(lr * dt);
    const float are = mag * cosf(li * dt), aim = mag * sinf(li * dt);
    const float zr = are - 1.0f, zi = aim, dn = lr * lr + li * li;
    const float fr = (zr * lr + zi * li) / dn, fi = (zi * lr - zr * li) / dn;
    float bbr[16], bbi[16];
#pragma unroll
    for (int hh = 0; hh < 16; ++hh) {
        const float br = p.in[13][((size_t)lg * 64 + lane) * 16 + hh], bi = p.in[14][((size_t)lg * 64 + lane) * 16 + hh];
        bbr[hh] = fr * br - fi * bi; bbi[hh] = fr * bi + fi * br;
    }
    const float* cre = p.in[15] + (size_t)lg * 16 * 64; const float* cim = p.in[16] + (size_t)lg * 16 * 64;
    const float* dd = p.in[17] + lg * 16;
    float sr = 0.f, si = 0.f;
    __syncthreads();
    for (int c = 0; c < SEQ / 16; ++c) {
        const size_t row0 = (size_t)b * SEQ + c * 16;
        for (int tt = 0; tt < 16; ++tt) {
            const bf16_t* up = projb + (row0 + tt) * PJ + C_SU + g * 16;
            uint4 u0 = *(const uint4*)up, u1 = *(const uint4*)(up + 8);
            float u[16] = {bf2f(u0.x & 0xffff), bf2f(u0.x >> 16), bf2f(u0.y & 0xffff), bf2f(u0.y >> 16), bf2f(u0.z & 0xffff), bf2f(u0.z >> 16), bf2f(u0.w & 0xffff), bf2f(u0.w >> 16),
                           bf2f(u1.x & 0xffff), bf2f(u1.x >> 16), bf2f(u1.y & 0xffff), bf2f(u1.y >> 16), bf2f(u1.z & 0xffff), bf2f(u1.z >> 16), bf2f(u1.w & 0xffff), bf2f(u1.w >> 16)};
            float br = 0.f, bi = 0.f;
#pragma unroll
            for (int hh = 0; hh < 16; ++hh) { br += bbr[hh] * u[hh]; bi += bbi[hh] * u[hh]; }
            const float nr = are * sr - aim * si + br, ni = are * si + aim * sr + bi;
            sr = nr; si = ni;
            xr[tt * 65 + lane] = sr; xi[tt * 65 + lane] = si;
        }
        __syncthreads();
        {
            const int tt = lane >> 2, hq = lane & 3;
            float y[4] = {0.f, 0.f, 0.f, 0.f};
            for (int pp = 0; pp < 64; ++pp) {
                const float a = xr[tt * 65 + pp], bq = xi[tt * 65 + pp];
#pragma unroll
                for (int j = 0; j < 4; ++j) y[j] += cre[(hq * 4 + j) * 64 + pp] * a - cim[(hq * 4 + j) * 64 + pp] * bq;
            }
#pragma unroll
            for (int j = 0; j < 4; ++j) {
                const int hh = hq * 4 + j;
                float v = y[j] + dd[hh] * bf2f(projb[(row0 + tt) * PJ + C_SU + g * 16 + hh]);
                const float inner = 0.7978845608028654f * (v + 0.044715f * v * v * v);
                const float th = 1.0f - 2.0f / (expf(2.0f * inner) + 1.0f);
                zbuf[(row0 + tt) * 256 + g * 16 + hh] = 0.5f * v * (1.0f + th);
            }
        }
        __syncthreads();
    }
}

DI void s5_item(const P& p, int l, int item, char* lds) {
    const int b = item >> 4, g = item & 15, lg = l * 16 + g;
    const int t = tid_();
    const bf16_t* projb = (const bf16_t*)(p.ws + WS_PROJ);
    bf16_t* zbuf = (bf16_t*)(p.ws + WS_ZBUF);
    const float* Tg = (const float*)(p.ws + WS_S5M + (size_t)l * S5M_LAYER) + (size_t)g * 256 * 256;
    const float* Eg = (const float*)(p.ws + WS_S5M + (size_t)l * S5M_LAYER + S5M_E) + (size_t)g * 256 * 128;
    const float* Fg = (const float*)(p.ws + WS_S5M + (size_t)l * S5M_LAYER + S5M_F) + (size_t)g * 128 * 256;
    float* eloc = (float*)(p.ws + WS_ELOC) + ((size_t)l * 128 + item) * 128 * 128;
    bf16_t* carr = (bf16_t*)(p.ws + WS_CARR) + ((size_t)l * 128 + item) * 128 * 128;
    const size_t rowb = (size_t)b * SEQ;
    const bf16_t* ua0 = projb + (rowb + (size_t)(t >> 2) * 16 + ((t & 3) >> 1)) * PJ + C_SU + g * 16 + (t & 1) * 8;
    const bf16_t* ua1 = ua0 + (size_t)64 * 16 * PJ;
    {
        GSeg g1{ua0, ua1, 2 * PJ, Eg + (size_t)(t >> 5) * 128 + (t & 31) * 4, 128, 8}; GSeg g2 = g1; g2.KT = 0;
        EpiF32 epi{eloc, 128};
        gemm_tile2(g1, g2, lds, epi);
    }
    __syncthreads();
    if (t < 64) {
        const float lr = p.in[11][lg * 64 + t], li = p.in[12][lg * 64 + t], dt = expf(p.in[18][lg]);
        const float mag = expf(lr * dt * 16.0f), ar = mag * cosf(li * dt * 16.0f), ai = mag * sinf(li * dt * 16.0f);
        float sr = 0.f, si = 0.f;
        for (int bt = 0; bt < 8; ++bt) {
            float er[16], ei[16];
#pragma unroll
            for (int i = 0; i < 16; ++i) { er[i] = eloc[(size_t)(bt * 16 + i) * 128 + t]; ei[i] = eloc[(size_t)(bt * 16 + i) * 128 + 64 + t]; }
#pragma unroll
            for (int i = 0; i < 16; ++i) {
                carr[(size_t)(bt * 16 + i) * 128 + t] = f2bf(sr); carr[(size_t)(bt * 16 + i) * 128 + 64 + t] = f2bf(si);
                const float nr = ar * sr - ai * si + er[i], ni = ar * si + ai * sr + ei[i];
                sr = nr; si = ni;
            }
        }
    }
    __syncthreads();
    const bf16_t* ca0 = carr + (size_t)(t >> 2) * 128 + (t & 3) * 8;
#pragma unroll 1
    for (int nt = 0; nt < 2; ++nt) {
        GSeg g1{ua0, ua1, 2 * PJ, Tg + (size_t)(t >> 5) * 256 + nt * 128 + (t & 31) * 4, 256, 4 * (nt + 1)};
        GSeg g2{ca0, ca0 + (size_t)64 * 128, BK, Fg + (size_t)(t >> 5) * 256 + nt * 128 + (t & 31) * 4, 256, 4};
        EpiS5Y epi{zbuf + rowb * 256 + g * 16, nt * 128};
        gemm_tile2(g1, g2, lds, epi);
    }
}

#ifndef PROBE_SUB
#define PROBE_SUB 0
#endif
DI void phase_mix(const P& p, int l, char* lds, unsigned long long& tsub) {
    for (int item = bid_(); item < 128 + 1024 + 1024; item += gridDim.x) {
        const unsigned long long ts0 = PROBE_SUB ? wall_clock64() : 0ull;
        const int kind = item >= 1152 ? 1 : (item < 128 ? 2 : 4);
        if (item >= 1152) mlstm_state_item(p, l, item - 1152, lds);
        else if (item < 128) s5_item(p, l, item, lds);
        else {
            const int i2 = item - 128;
            const int qo = i2 >> 6, bh = i2 & 63;
            moba_item(p, l, (bh << 4) | (15 - qo), lds);
        }
        if (PROBE_SUB & kind) tsub += wall_clock64() - ts0;
    }
}

DI void phase_glu(const P& p, int l, char* lds) {
    const int t = tid_();
    const bf16_t* zb = (const bf16_t*)(p.ws + WS_ZBUF);
    bf16_t* mix = (bf16_t*)(p.ws + WS_MIX);
    const float* gw = p.in[19] + (size_t)l * 256 * 256; const float* gb = p.in[20] + l * 256; const float* sg = p.in[21] + l * 256;
    for (int tile = bid_(); tile < 128 * 2; tile += gridDim.x) {
        const int mt = tile >> 1, nt = tile & 1;
        const bf16_t* a0 = zb + (size_t)(mt * 128 + (t >> 2)) * 256 + (t & 3) * 8;
        const float* b0 = gw + (size_t)(t >> 5) * 256 + nt * 128 + (t & 31) * 4;
        EpiGlu epi{zb + (size_t)mt * 128 * 256 + nt * 128, mix + (size_t)mt * 128 * DM + 768 + nt * 128, gb + nt * 128, sg + nt * 128};
        gemm_tile(a0, a0 + (size_t)64 * 256, b0, 256, 256 / BK, lds, epi);
    }
    for (int item = bid_(); item < 1024; item += gridDim.x) mlstm_out_item(p, l, ((item & 31) << 5) | (31 - (item >> 5)), lds);
}

DI void phase_outproj(const P& p, int l, char* lds) {
    const int t = tid_();
    const bf16_t* mix = (const bf16_t*)(p.ws + WS_MIX);
    float* xres = (float*)(p.ws + WS_XRES);
    const bf16_t* woutb = (const bf16_t*)(p.ws + WS_WOUTB) + (size_t)l * DM * DM;
    const float* xin = (l == 0) ? p.in[0] : xres;
    const int vx = bid_() & 7, vj = bid_() >> 3, nj = (gridDim.x - vx + 7) >> 3;
    for (int j = vj; j < 64; j += nj) {
        const int mt = vx * 16 + (j >> 2), nt = j & 3;
        const bf16_t* ar = mix + (size_t)(mt * 128 + (t >> 2)) * DM + (t & 3) * 8;
        GSeg4 g1{ar, ar + (size_t)64 * DM, 32, woutb + (size_t)(t >> 5) * DM + nt * 256 + (t & 31) * 8, DM, DM / 32}; GSeg4 g2 = g1; g2.KT = 0;
        const size_t o = (size_t)mt * 128 * DM + nt * 256;
        Epi4Resid epi{xres + o, xin + o, (size_t)DM};
        gemm4(g1, g2, lds, epi);
    }
}

DI void phase_norm2(const P& p, int l, char* lds) {
    const int t = tid_(), lane = t & 63, w = t >> 6;
    const float* xres = (const float*)(p.ws + WS_XRES);
    bf16_t* hbuf = (bf16_t*)(p.ws + WS_HBUF);
    const float* g2 = p.in[23] + l * DM;
    const float* wg = p.in[24] + (size_t)l * DM * 4; const float* bg = p.in[25] + l * 4;
    const float* we = p.in[26] + (size_t)l * DM * NE; const float* be = p.in[27] + l * NE;
    int4* rinfo = (int4*)(p.ws + WS_RINFO); int* hist = (int*)(p.ws + WS_HIST);
    int* lh = (int*)(lds + 65536 - 16 - 128);
    if (t < NE) lh[t] = 0;
    float* xs = (float*)lds;
    float* pe = xs + 8 * XS_P;
    for (int rb = bid_(); rb < T / 8; rb += gridDim.x) {
        __syncthreads();
#pragma unroll
        for (int rr = 0; rr < 2; ++rr) {
            const int lr = w * 2 + rr, row = rb * 8 + lr;
            float4 v[4];
#pragma unroll
            for (int i = 0; i < 4; ++i) v[i] = *(const float4*)(xres + (size_t)row * DM + i * 256 + lane * 4);
            float ss = 0.f;
#pragma unroll
            for (int i = 0; i < 4; ++i) ss += v[i].x * v[i].x + v[i].y * v[i].y + v[i].z * v[i].z + v[i].w * v[i].w;
            ss = wave_sum(ss);
            const float rstd = rsqrtf(ss * (1.0f / DM) + EPS);
#pragma unroll
            for (int i = 0; i < 4; ++i) {
                const int k0 = i * 256 + lane * 4;
                const float4 g = *(const float4*)(g2 + k0);
                float4 hv = {v[i].x * rstd * g.x, v[i].y * rstd * g.y, v[i].z * rstd * g.z, v[i].w * rstd * g.w};
                uint2 o; o.x = pk2(hv.x, hv.y); o.y = pk2(hv.z, hv.w);
                *(uint2*)(hbuf + (size_t)row * DM + k0) = o;
                *(float4*)(xs + lr * XS_P + k0) = hv;
            }
        }
        __syncthreads();
        {
            float* wb = pe + 1536;
            const float* wep = we + t * 4; const float* wgp = wg + (t & 127) * 4;
            float4 re0 = *(const float4*)(wep), re1 = *(const float4*)(wep + 1024), re2 = *(const float4*)(wep + 2048), re3 = *(const float4*)(wep + 3072);
            float4 rg = *(const float4*)(wgp);
            const int kq = lane >> 4, jc = lane & 15;
            f32x4 d0 = {0.f, 0.f, 0.f, 0.f}, d1 = d0, d2 = d0;
#pragma unroll 1
            for (int c = 0; c < 8; ++c) {
                {
                    const int e0 = t * 4;
#pragma unroll
                    for (int i = 0; i < 4; ++i) {
                        const int e = e0 + i * 1024, kk = e >> 5, jj = e & 31;
                        *(float4*)(wb + kk * 48 + jj) = (i == 0 ? re0 : i == 1 ? re1 : i == 2 ? re2 : re3);
                    }
                    if (t < 128) *(float4*)(wb + t * 48 + 32) = rg;
                }
                __syncthreads();
                if (c + 1 < 8) {
                    const float* q = wep + (size_t)(c + 1) * 4096;
                    re0 = *(const float4*)(q); re1 = *(const float4*)(q + 1024); re2 = *(const float4*)(q + 2048); re3 = *(const float4*)(q + 3072);
                    rg = *(const float4*)(wgp + (size_t)(c + 1) * 512);
                }
                const float* xa = xs + (lane & 7) * XS_P + c * 128 + w * 32 + kq;
                const float* wbp = wb + (w * 32 + kq) * 48 + jc;
#pragma unroll
                for (int ks = 0; ks < 8; ++ks) {
                    const float av = xa[ks * 4];
                    const float b0 = wbp[ks * 4 * 48], b1 = wbp[ks * 4 * 48 + 16], b2 = wbp[ks * 4 * 48 + 32];
                    d0 = __builtin_amdgcn_mfma_f32_16x16x4f32(av, b0, d0, 0, 0, 0);
                    d1 = __builtin_amdgcn_mfma_f32_16x16x4f32(av, b1, d1, 0, 0, 0);
                    d2 = __builtin_amdgcn_mfma_f32_16x16x4f32(av, b2, d2, 0, 0, 0);
                }
                __syncthreads();
            }
            if (lane < 32) {
#pragma unroll
                for (int rg_ = 0; rg_ < 4; ++rg_) {
                    const int row = 4 * kq + rg_;
                    pe[(w * 8 + row) * 48 + jc] = d0[rg_]; pe[(w * 8 + row) * 48 + 16 + jc] = d1[rg_]; pe[(w * 8 + row) * 48 + 32 + jc] = d2[rg_];
                }
            }
        }
        __syncthreads();
        if (t < 8) {
            const int row = rb * 8 + t;
            float gl[4];
#pragma unroll
            for (int j = 0; j < 4; ++j) {
                gl[j] = bg[j] + ((pe[(0 * 8 + t) * 48 + 32 + j] + pe[(1 * 8 + t) * 48 + 32 + j]) + (pe[(2 * 8 + t) * 48 + 32 + j] + pe[(3 * 8 + t) * 48 + 32 + j]));
            }
            int gs = 0; float gm = gl[0];
#pragma unroll
            for (int j = 1; j < 4; ++j) if (gl[j] > gm) { gm = gl[j]; gs = j; }
            float se = 0.f;
#pragma unroll
            for (int j = 0; j < 4; ++j) se += expf(gl[j] - gm);
            const float pgv = 1.0f / se;
            float ev[8];
#pragma unroll
            for (int j = 0; j < 8; ++j) { const int cj = gs * 8 + j; ev[j] = be[cj] + ((pe[(0 * 8 + t) * 48 + cj] + pe[(1 * 8 + t) * 48 + cj]) + (pe[(2 * 8 + t) * 48 + cj] + pe[(3 * 8 + t) * 48 + cj])); }
            int i1 = 0; float v1 = ev[0];
#pragma unroll
            for (int j = 1; j < 8; ++j) if (ev[j] > v1) { v1 = ev[j]; i1 = j; }
            int i2 = (i1 + 1) & 7; float v2 = -INFINITY;
#pragma unroll
            for (int j = 0; j < 8; ++j) if (j != i1 && ev[j] > v2) { v2 = ev[j]; i2 = j; }
            const float ex = expf(v2 - v1);
            const float w1 = pgv / (1.0f + ex), w2 = pgv * ex / (1.0f + ex);
            const int e1 = gs * 8 + i1, e2 = gs * 8 + i2;
            atomicAdd(&lh[e1], 1); atomicAdd(&lh[e2], 1);
            rinfo[row] = make_int4(e1, e2, __float_as_int(w1), __float_as_int(w2));
        }
    }
    __syncthreads();
    if (t < NE) hist[((size_t)l * 1024 + bid_()) * NE + t] = lh[t];
}

DI void phase_assign(const P& p, int l, char* lds) {
    const int t = tid_(), myb = bid_(), nb = gridDim.x;
    const int* hist = (const int*)(p.ws + WS_HIST) + (size_t)l * 1024 * NE;
    const int4* rinfo = (const int4*)(p.ws + WS_RINFO);
    int* cnt = (int*)(p.ws + WS_CTL) + l * NE;
    int* tokl = (int*)(p.ws + WS_TOKL); float* wl = (float*)(p.ws + WS_WL); int4* tinfo = (int4*)(p.ws + WS_TINFO);
    int* part = (int*)lds;
    int* pre = part + 512;
    int* le1 = pre + 32;
    int* le2 = le1 + 64;
    {
        const int e = t & 31, prt = t >> 5;
        int a = 0, tot = 0;
        for (int b = prt; b < nb; b += 8) { const int v = hist[(size_t)b * NE + e]; tot += v; if (b < myb) a += v; }
        part[prt * 32 + e] = a; part[256 + prt * 32 + e] = tot;
    }
    __syncthreads();
    if (t < 32) {
        int a = 0, tot = 0;
#pragma unroll
        for (int q = 0; q < 8; ++q) { a += part[q * 32 + t]; tot += part[256 + q * 32 + t]; }
        pre[t] = a;
        if (myb == 0) cnt[t] = tot;
    }
    const int nit = (T / 8 - myb + nb - 1) / nb;
    int4 ri = make_int4(0, 0, 0, 0); int row = -1;
    if (t < nit * 8 && t < 64) { row = (myb + (t >> 3) * nb) * 8 + (t & 7); ri = rinfo[row]; le1[t] = ri.x; le2[t] = ri.y; }
    __syncthreads();
    if (row >= 0) {
        int r1 = 0, r2 = 0;
        for (int j = 0; j < t; ++j) { const int a = le1[j], b2 = le2[j]; r1 += (a == ri.x) + (b2 == ri.x); r2 += (a == ri.y) + (b2 == ri.y); }
        const int s1 = pre[ri.x] + r1, s2 = pre[ri.y] + r2;
        tokl[ri.x * ECAP + s1] = row; wl[ri.x * ECAP + s1] = __int_as_float(ri.z);
        tokl[ri.y * ECAP + s2] = row; wl[ri.y * ECAP + s2] = __int_as_float(ri.w);
        tinfo[row] = make_int4(ri.x, s1, ri.y, s2);
    }
}

DI void phase_moe1(const P& p, int l, char* lds) {
    const int t = tid_();
    const bf16_t* hbuf = (const bf16_t*)(p.ws + WS_HBUF);
    bf16_t* hmoe = (bf16_t*)(p.ws + WS_HMOE);
    const int* cnt = (const int*)(p.ws + WS_CTL) + l * NE;
    const int* tokl = (const int*)(p.ws + WS_TOKL);
    int* stp = (int*)(lds + GEMM_LDS);
    moe_prefix(cnt, stp);
    const int vx = bid_() & 7, vj = bid_() >> 3, nj = (gridDim.x - vx + 7) >> 3;
    int tx[5]; tx[0] = 0;
#pragma unroll
    for (int i = 0; i < 4; ++i) tx[i + 1] = tx[i] + (stp[vx + 8 * i + 1] - stp[vx + 8 * i]) * 8;
    for (int tile = vj; tile < tx[4]; tile += nj) {
        const int ei = (tile >= tx[1]) + (tile >= tx[2]) + (tile >= tx[3]);
        const int e = vx + 8 * ei, tbase = ei == 0 ? 0 : (ei == 1 ? tx[1] : (ei == 2 ? tx[2] : tx[3]));
        const int te = stp[e + 1] - stp[e], local = tile - tbase, nt = local / te, mt = local % te;
        const int ne = cnt[e];
        const int i0 = mt * 128 + (t >> 2), i1 = i0 + 64;
        const int tok0 = tokl[e * ECAP + (i0 < ne ? i0 : 0)], tok1 = tokl[e * ECAP + (i1 < ne ? i1 : 0)];
        const bf16_t* a0 = hbuf + (size_t)tok0 * DM + (t & 3) * 8;
        const bf16_t* a1 = hbuf + (size_t)tok1 * DM + (t & 3) * 8;
        const int vcol = (t & 31) * 4, wn = vcol >> 6, tn = (vcol >> 5) & 1, rr = vcol & 31;
        const float* wsrc = (tn ? p.in[29] : p.in[28]) + ((size_t)l * NE + e) * DM * DE;
        const float* b0 = wsrc + (size_t)(t >> 5) * DE + nt * 64 + wn * 32 + rr;
        EpiGateUp epi{hmoe + (size_t)(stp[e] + mt) * 128 * DE + nt * 64};
        gemm_tile(a0, a1, b0, DE, DM / BK, lds, epi);
    }
}

DI void phase_moe2(const P& p, int l, char* lds) {
    const int t = tid_();
    const bf16_t* hmoe = (const bf16_t*)(p.ws + WS_HMOE);
    bf16_t* ymoe = (bf16_t*)(p.ws + WS_YMOE);
    const int* cnt = (const int*)(p.ws + WS_CTL) + l * NE;
    const float* wl = (const float*)(p.ws + WS_WL);
    int* stp = (int*)(lds + GEMM_LDS);
    moe_prefix(cnt, stp);
    const int vx = bid_() & 7, vj = bid_() >> 3, nj = (gridDim.x - vx + 7) >> 3;
    int tx[5]; tx[0] = 0;
#pragma unroll
    for (int i = 0; i < 4; ++i) tx[i + 1] = tx[i] + (stp[vx + 8 * i + 1] - stp[vx + 8 * i]) * 8;
    for (int tile = vj; tile < tx[4]; tile += nj) {
        const int ei = (tile >= tx[1]) + (tile >= tx[2]) + (tile >= tx[3]);
        const int e = vx + 8 * ei, tbase = ei == 0 ? 0 : (ei == 1 ? tx[1] : (ei == 2 ? tx[2] : tx[3]));
        const int te = stp[e + 1] - stp[e], local = tile - tbase, nt = local / te, mt = local % te;
        const int ne = cnt[e];
        const size_t r0 = (size_t)(stp[e] + mt) * 128;
        const bf16_t* a0 = hmoe + (r0 + (t >> 2)) * DE + (t & 3) * 8;
        const float* b0 = p.in[30] + ((size_t)l * NE + e) * DE * DM + (size_t)(t >> 5) * DM + nt * 128 + (t & 31) * 4;
        EpiDown epi{ymoe + r0 * DM + nt * 128, wl + e * ECAP + mt * 128, ne - mt * 128};
        gemm_tile(a0, a0 + (size_t)64 * DE, b0, DM, DE / BK, lds, epi);
    }
}

DI void phase_final(const P& p, char* lds) {
    const int lane = tid_() & 63;
    const int gw = bid_() * 4 + (tid_() >> 6), nw = gridDim.x * 4;
    const float* xres = (const float*)(p.ws + WS_XRES);
    const bf16_t* ymoe = (const bf16_t*)(p.ws + WS_YMOE);
    const int4* tinfo = (const int4*)(p.ws + WS_TINFO);
    int* stp = (int*)lds;
    moe_prefix((const int*)(p.ws + WS_CTL) + NE, stp);
    for (int row = gw; row < T; row += nw) {
        int4 ti = tinfo[row];
        const bf16_t* y0 = ymoe + (size_t)(stp[ti.x] * 128 + ti.y) * DM;
        const bf16_t* y1 = ymoe + (size_t)(stp[ti.z] * 128 + ti.w) * DM;
#pragma unroll
        for (int i = 0; i < 4; ++i) {
            float4 v = *(const float4*)(xres + (size_t)row * DM + i * 256 + lane * 4);
            uint2 a = *(const uint2*)(y0 + i * 256 + lane * 4), b = *(const uint2*)(y1 + i * 256 + lane * 4);
            v.x += bf2f(a.x & 0xffff) + bf2f(b.x & 0xffff); v.y += bf2f(a.x >> 16) + bf2f(b.x >> 16);
            v.z += bf2f(a.y & 0xffff) + bf2f(b.y & 0xffff); v.w += bf2f(a.y >> 16) + bf2f(b.y >> 16);
            *(float4*)(p.out + (size_t)row * DM + i * 256 + lane * 4) = v;
        }
    }
}

#define XB_TMO      128
#define XB_XCNT(j)  (256  + 64 * (j))
#define XB_XSUB(j)  (1280 + 64 * (j))
#define XB_XGEN(j)  (2304 + 64 * (j))
#define XB_TOP      3328
#define XB_TOPGEN   3392
#define XCD_BAR_WORDS 3456
#define XB_SPIN_CAP (1u << 18)

__device__ __forceinline__ unsigned xb_ld(unsigned* p)              { return __hip_atomic_load(p, __ATOMIC_RELAXED, __HIP_MEMORY_SCOPE_AGENT); }
__device__ __forceinline__ unsigned xb_add(unsigned* p, unsigned v) { return __hip_atomic_fetch_add(p, v, __ATOMIC_RELAXED, __HIP_MEMORY_SCOPE_AGENT); }
__device__ __forceinline__ unsigned xb_xcc_id() { return (unsigned)__builtin_amdgcn_s_getreg((3 << 11) | 20) & 0xFu; }
#define XB_SPIN(cond, bar) do { unsigned _sp = 0; while (cond) { __builtin_amdgcn_s_sleep(1); \
    if ((++_sp & 255u) == 0u) { if (xb_ld(&(bar)[XB_TMO])) break; if (_sp > XB_SPIN_CAP) { atomicAdd(&(bar)[XB_TMO], 1u); break; } } } } while (0)

struct XcdBarrier {
    unsigned* bar; unsigned x;
    volatile LAS unsigned* st;
};

__device__ __forceinline__ XcdBarrier xcd_barrier_post(unsigned* bar, volatile LAS unsigned* st) {
    XcdBarrier b; b.bar = bar; b.x = xb_xcc_id(); b.st = st;
    if (threadIdx.x == 0) (void)xb_add(&bar[XB_XCNT(b.x)], 1u);
    return b;
}
__device__ __forceinline__ void xcd_barrier_complete(unsigned* bar, unsigned x, unsigned& nloc, unsigned& nx) {
    const unsigned G = gridDim.x * gridDim.y * gridDim.z;
    unsigned sum, cnt, mine, sp = 0u;
    for (;;) {
        sum = 0u; cnt = 0u; mine = 0u;
#pragma unroll
        for (unsigned j = 0; j < 16; ++j) { const unsigned c = xb_ld(&bar[XB_XCNT(j)]); sum += c; cnt += (c > 0u) ? 1u : 0u; mine = (j == x) ? c : mine; }
        if (sum == G) break;
        __builtin_amdgcn_s_sleep(1);
        if ((++sp & 255u) == 0u) { if (xb_ld(&bar[XB_TMO])) break; if (sp > XB_SPIN_CAP) { atomicAdd(&bar[XB_TMO], 1u); break; } }
    }
    nloc = mine > 0u ? mine : 1u; nx = cnt > 0u ? cnt : 1u;
}

__device__ __forceinline__ void xcd_barrier(const XcdBarrier& b) {
    asm volatile("s_waitcnt vmcnt(0)" ::: "memory");
    __syncthreads();
    if (threadIdx.x == 0) {
        unsigned* bar = b.bar;
        __builtin_amdgcn_s_waitcnt(0);
        unsigned nloc = b.st[0], nx = b.st[1];
        if (nloc == 0u) { xcd_barrier_complete(bar, b.x, nloc, nx); b.st[0] = nloc; b.st[1] = nx; }
        const unsigned old = xb_add(&bar[XB_XSUB(b.x)], 1u);
        const unsigned gen = old / nloc;
        if (old + 1u == (gen + 1u) * nloc) {
            __builtin_amdgcn_fence(__ATOMIC_RELEASE, "agent");
            asm volatile("s_waitcnt vmcnt(0)" ::: "memory");
            const unsigned og = xb_add(&bar[XB_TOP], 1u);
            const unsigned tg = og / nx;
            if (og + 1u == (tg + 1u) * nx) xb_add(&bar[XB_TOPGEN], 1u);
            else XB_SPIN(xb_ld(&bar[XB_TOPGEN]) == tg, bar);
            __builtin_amdgcn_fence(__ATOMIC_ACQUIRE, "agent");
            xb_add(&bar[XB_XGEN(b.x)], 1u);
            asm volatile("s_waitcnt vmcnt(0)" ::: "memory");
        } else {
            XB_SPIN(xb_ld(&bar[XB_XGEN(b.x)]) == gen, bar);
            __builtin_amdgcn_fence(__ATOMIC_ACQUIRE, "agent");
            asm volatile("s_waitcnt vmcnt(0)" ::: "memory");
        }
    }
    __syncthreads();
}


#ifdef LAB
constexpr size_t WS_LAB = 440 * MiB;
DI void phase_lab(const P& p, char* lds) {
    const int t = tid_();
    const bf16_t* hbuf = (const bf16_t*)(p.ws + WS_HBUF);
    bf16_t* outb = (bf16_t*)(p.ws + WS_LAB);
    const float* win = p.in[2];
#if LAB == 40
    {
        const bf16_t* wb = (const bf16_t*)(p.ws + WS_HRAW);
        const int vx = bid_() & 7, vj = bid_() >> 3, nj = (gridDim.x - vx + 7) >> 3;
        for (int st = vx; st < 16; st += 8)
          for (int j = vj; j < 88; j += nj) {
            const int mt = st * 8 + j / 11, vt = j % 11;
            const int acol = vt < 4 ? vt * 256 : (vt < 10 ? 1032 + (vt - 4) * 256 : 2568);
            const bf16_t* ar = hbuf + (size_t)(mt * 128 + (t >> 2)) * DM + (t & 3) * 8;
            GSeg4 h1{ar, ar + (size_t)64 * DM, 32, wb + (size_t)(t >> 5) * DIN + acol + (t & 31) * 8, DIN, DM / 32}; GSeg4 h2 = h1; h2.KT = 0;
            Epi4Bf16 epi{outb + (size_t)mt * 128 * PJ + vt * 256, (size_t)PJ};
            gemm4(h1, h2, lds, epi);
          }
        return;
    }
#endif
    const int vx = bid_() & 7, vj = bid_() >> 3, nj = (gridDim.x - vx + 7) >> 3;
    for (int st = vx; st < 48; st += 8) {
      const int sm = st / 3, sn = st % 3, wdt = sn == 2 ? 7 : 8;
      for (int j = vj; j < 8 * wdt; j += nj) {
        const int mt = sm * 8 + j / wdt, vt = sn * 8 + j % wdt;
        const int acol = vt < 8 ? vt * 128 : (vt < 20 ? 1032 + (vt - 8) * 128 : (vt < 22 ? 2568 + (vt - 20) * 128 : 1024));
        const bf16_t* a0 = hbuf + (size_t)(mt * 128 + (t >> 2)) * DM + (t & 3) * 8;
        const float* b0 = win + (size_t)(t >> 5) * DIN + acol + (t & 31) * 4;
        EpiBf16 epi{outb + (size_t)mt * 128 * PJ + (vt % 22) * 128, (size_t)PJ};
#if LAB == 40
        (void)a0; (void)b0;
#elif LAB == 30
        const bf16_t* ar = hbuf + (size_t)(mt * 128 + (t >> 3)) * DM + (t & 7) * 8;
        GSeg3 h1{{ar, ar + (size_t)32 * DM, ar + (size_t)64 * DM, ar + (size_t)96 * DM}, 64, b0, DIN, DM / 32}; GSeg3 h2 = h1; h2.KT = 0;
        gemm3(h1, h2, lds, epi);
#elif LAB >= 20
        const bf16_t* wb = (const bf16_t*)(p.ws + WS_HRAW);
        const bf16_t* ar = hbuf + (size_t)(mt * 128 + (t >> 3)) * DM + (t & 7) * 8;
        GSeg2 h1{{ar, ar + (size_t)32 * DM, ar + (size_t)64 * DM, ar + (size_t)96 * DM}, 64, wb + (size_t)(t >> 4) * DIN + acol + (t & 15) * 8, DIN, DM / 32}; GSeg2 h2 = h1; h2.KT = 0;
        gemm2(h1, h2, lds, epi);
#else
        GSeg g1{a0, a0 + (size_t)64 * DM, BK, b0, DIN, DM / BK}; GSeg g2 = g1; g2.KT = 0;
        gemm_lab(g1, g2, lds, epi);
#endif
      }
    }
}
#endif
constexpr int LDS_BYTES = 65536;
constexpr int NPHASE = 9;

DI void run_phase(const P& p, int ph, int l, char* lds) {
    switch (ph) {
        case 0: phase_norm1(p, l, lds); break;
        case 1: phase_inproj(p, l, lds); break;
        case 2: phase_qkprep(p, l, lds); break;
        case 3: { unsigned long long dummy = 0; phase_mix(p, l, lds, dummy); } break;
        case 4: phase_glu(p, l, lds); break;
        case 5: phase_outproj(p, l, lds); break;
        case 6: phase_norm2(p, l, lds); break;
        case 7: phase_moe1(p, l, lds); break;
        case 8: phase_moe2(p, l, lds); break;
        default: phase_final(p, lds); break;
    }
}

#if MULTI
__global__ void __launch_bounds__(256) k_phase(P p, int ph, int l) {
    extern __shared__ __attribute__((aligned(16))) char lds[];
    run_phase(p, ph, l, lds);
}
#else
__global__ void __launch_bounds__(256, 2) k_mega(P p) {
    extern __shared__ __attribute__((aligned(16))) char lds[];
    cg::grid_group grid = cg::this_grid();
    volatile LAS unsigned* bst = (volatile LAS unsigned*)((LAS char*)lds + LDS_BYTES - 16);
    if (threadIdx.x < 4) bst[threadIdx.x] = 0u;
    __syncthreads();
    XcdBarrier gbar = xcd_barrier_post((unsigned*)(p.ws + WS_BAR), bst);
    if (p.ws == nullptr) grid.sync();
#define GSYNC() xcd_barrier(gbar)
#ifndef PROBE_MASK
#define PROBE_MASK 0
#endif
#ifndef PROBE_MULT
#define PROBE_MULT 4
#endif
#ifndef PROBE_BLK
#define PROBE_BLK 0
#endif
    unsigned long long tacc = 0, tprev = 0;
#define PH_BEGIN() do { if (PROBE_MASK) tprev = wall_clock64(); } while (0)
#define PH_END(ph) do { if (PROBE_MASK & (1 << (ph))) tacc += wall_clock64() - tprev; } while (0)
#pragma unroll
    for (int l = 0; l < 2; ++l) {
        PH_BEGIN(); phase_norm1(p, l, lds); GSYNC(); PH_END(0);
        PH_BEGIN(); phase_inproj(p, l, lds); GSYNC(); PH_END(1);
        PH_BEGIN(); phase_qkprep(p, l, lds); GSYNC(); PH_END(2);
        PH_BEGIN(); phase_mix(p, l, lds, tacc); GSYNC(); PH_END(3);
        PH_BEGIN(); phase_glu(p, l, lds); GSYNC(); PH_END(4);
        PH_BEGIN(); phase_outproj(p, l, lds); GSYNC(); PH_END(5);
        PH_BEGIN(); phase_norm2(p, l, lds); GSYNC(); phase_assign(p, l, lds); GSYNC(); PH_END(6);
        PH_BEGIN(); phase_moe1(p, l, lds); GSYNC(); PH_END(7);
        PH_BEGIN(); phase_moe2(p, l, lds); GSYNC(); PH_END(8);
    }
    PH_BEGIN(); phase_final(p, lds); PH_END(9);
#ifdef LAB
#if LAB >= 20
    {
        const float* src = p.in[2]; bf16_t* dst = (bf16_t*)(p.ws + WS_HRAW);
        const size_t n4 = (size_t)DM * DIN / 4, stride = (size_t)gridDim.x * 256;
        for (size_t i = (size_t)blockIdx.x * 256 + threadIdx.x; i < n4; i += stride) { const float4 v = ((const float4*)src)[i]; u32x2 o; o.x = pk2(v.x, v.y); o.y = pk2(v.z, v.w); ((u32x2*)dst)[i] = o; }
    }
#endif
    GSYNC(); phase_lab(p, lds);
#endif
#ifdef PROBE_SYNCS
    for (int i = 0; i < PROBE_SYNCS; ++i) GSYNC();
#endif
    if ((PROBE_MASK || PROBE_SUB) && blockIdx.x == PROBE_BLK) {
        const unsigned long long t0 = wall_clock64();
        while (wall_clock64() - t0 < (unsigned long long)PROBE_MULT * tacc) __builtin_amdgcn_s_sleep(8);
    }
}
#endif

extern "C" void kernel_launch(void* const* d_in, const int* in_sizes, int n_in, void* d_out, int out_size, void* d_ws, size_t ws_size, hipStream_t stream) {
    static int grid = 0;
    if (grid == 0) {
        if (n_in != 31 || out_size != T * DM || ws_size < WS_END) { fprintf(stderr, "kernel_launch: unexpected sizes n_in %d out %d ws %zu\n", n_in, out_size, ws_size); grid = -1; return; }
        int dev = 0, cus = 0, per_cu = 0;
        (void)hipGetDevice(&dev);
        (void)hipDeviceGetAttribute(&cus, hipDeviceAttributeMultiprocessorCount, dev);
#if MULTI
        (void)hipFuncSetAttribute((const void*)k_phase, hipFuncAttributeMaxDynamicSharedMemorySize, LDS_BYTES);
        (void)hipOccupancyMaxActiveBlocksPerMultiprocessor(&per_cu, (const void*)k_phase, 256, LDS_BYTES);
#else
        (void)hipFuncSetAttribute((const void*)k_mega, hipFuncAttributeMaxDynamicSharedMemorySize, LDS_BYTES);
        (void)hipOccupancyMaxActiveBlocksPerMultiprocessor(&per_cu, (const void*)k_mega, 256, LDS_BYTES);
#endif
        if (per_cu < 1) { fprintf(stderr, "kernel_launch: occupancy query gave %d\n", per_cu); per_cu = 1; }
        if (per_cu > 2) per_cu = 2;
        grid = cus * per_cu;
        fprintf(stderr, "kernel_launch: cus %d per_cu %d grid %d\n", cus, per_cu, grid);
    }
    if (grid < 0) return;
    (void)hipMemsetAsync((char*)d_ws + WS_CTL, 0, 65536, stream);
    P p{};
    for (int i = 0; i < 31; ++i) p.in[i] = (const float*)d_in[i];
    p.out = (float*)d_out; p.ws = (char*)d_ws;
#if MULTI
    for (int l = 0; l < 2; ++l)
        for (int ph = 0; ph < NPHASE; ++ph) hipLaunchKernelGGL(k_phase, dim3(grid), dim3(256), LDS_BYTES, stream, p, ph, l);
    hipLaunchKernelGGL(k_phase, dim3(grid), dim3(256), LDS_BYTES, stream, p, NPHASE, 0);
#else
    void* args[] = {&p};
    hipError_t e = hipLaunchCooperativeKernel((const void*)k_mega, dim3(grid), dim3(256), args, LDS_BYTES, stream);
    if (e != hipSuccess) fprintf(stderr, "cooperative launch failed: %s (grid %d)\n", hipGetErrorString(e), grid);
#endif
}
```

```cpp
#include <hip/hip_runtime.h>
#include <hip/hip_cooperative_groups.h>
#include <cstdio>
#include <cstdint>
namespace cg = cooperative_groups;

#ifndef MULTI
#define MULTI 0
#endif

#define DI __device__ __forceinline__
#define LAS __attribute__((address_space(3)))
typedef unsigned short bf16_t;
typedef short bf16x8 __attribute__((ext_vector_type(8)));
typedef short s16x4 __attribute__((ext_vector_type(4)));
typedef float f32x16 __attribute__((ext_vector_type(16)));
typedef unsigned u32x4 __attribute__((ext_vector_type(4)));
typedef float f32x4 __attribute__((ext_vector_type(4)));
typedef unsigned u32x2 __attribute__((ext_vector_type(2)));

constexpr int T = 16384, DM = 1024, SEQ = 2048, NBATCH = 8;
constexpr int DIN = 2824, PJ = 2816;
constexpr int NE = 32, DE = 512, ECAP = 16384;
constexpr float EPS = 1e-6f;
constexpr int C_MQ = 0, C_MK = 256, C_MV = 512, C_MO = 768, C_AQ = 1024, C_AK = 1536, C_AV = 2048, C_SU = 2560;

constexpr size_t MiB = 1u << 20;
constexpr size_t WS_CTL = 0;
constexpr size_t WS_BAR = 16384;
constexpr size_t WS_KMEAN = 512 * 1024;
constexpr size_t WS_XRES = 1 * MiB;
constexpr size_t WS_HBUF = 65 * MiB;
constexpr size_t WS_PROJ = 97 * MiB;
constexpr size_t WS_GATES = 185 * MiB;
constexpr size_t WS_MIX = 186 * MiB;
constexpr size_t WS_HRAW = 218 * MiB;
constexpr size_t WS_ZBUF = 234 * MiB;
constexpr size_t WS_TOKL = 250 * MiB;
constexpr size_t WS_WL = 252 * MiB;
constexpr size_t WS_TINFO = 254 * MiB;
constexpr size_t WS_HMOE = 256 * MiB;
constexpr size_t WS_YMOE = 292 * MiB;
constexpr size_t WS_MQKC = 364 * MiB;
constexpr size_t WS_S5M = 380 * MiB;
constexpr size_t S5M_LAYER = 8 * MiB, S5M_E = 4 * MiB, S5M_F = 6 * MiB;
constexpr size_t WS_ELOC = 396 * MiB;
constexpr size_t WS_CARR = 412 * MiB;
constexpr size_t WS_RINFO = 420 * MiB;
constexpr size_t WS_HIST = 421 * MiB;
constexpr size_t WS_GSCAN = 422 * MiB;
constexpr size_t WS_WINB = 424 * MiB;
constexpr size_t WS_WOUTB = 436 * MiB;
constexpr size_t WS_END = 440 * MiB;

struct P {
    const float* in[31];
    float* out;
    char* ws;
};

DI int tid_() { int t = threadIdx.x; asm volatile("" : "+v"(t)); return t; }
DI int bid_() { int b = blockIdx.x; asm volatile("" : "+s"(b)); return b; }
DI float bf2f(bf16_t b) { return __uint_as_float(((unsigned)b) << 16); }
DI bf16_t f2bf(float f) { unsigned u = __float_as_uint(f); u += 0x7fffu + ((u >> 16) & 1u); return (bf16_t)(u >> 16); }
typedef float f32x2 __attribute__((ext_vector_type(2)));
typedef __bf16 bf16x2_t __attribute__((ext_vector_type(2)));
DI unsigned pk2(float lo, float hi) { f32x2 v = {lo, hi}; return __builtin_bit_cast(unsigned, __builtin_convertvector(v, bf16x2_t)); }
DI void lds_barrier() { asm volatile("s_waitcnt lgkmcnt(0)" ::: "memory"); __builtin_amdgcn_s_barrier(); asm volatile("" ::: "memory"); }
DI float wave_sum(float v) {
#pragma unroll
    for (int o = 32; o > 0; o >>= 1) v += __shfl_xor(v, o);
    return v;
}
DI float sigmoidf_(float x) { return 1.0f / (1.0f + expf(-x)); }
DI s16x4 tr_read(const LAS char* p) {
    typedef short v4i16_t __attribute__((ext_vector_type(4)));
    return __builtin_bit_cast(s16x4, __builtin_amdgcn_ds_read_tr16_b64_v4i16((LAS v4i16_t*)p));
}

DI float half_swap_max(float m) {
    auto rr = __builtin_amdgcn_permlane32_swap(__float_as_uint(m), __float_as_uint(m), false, false);
    return fmaxf(__uint_as_float(rr[0]), __uint_as_float(rr[1]));
}
DI float half_swap_sum(float m) {
    auto rr = __builtin_amdgcn_permlane32_swap(__float_as_uint(m), __float_as_uint(m), false, false);
    return __uint_as_float(rr[0]) + __uint_as_float(rr[1]);
}

constexpr int BK = 32, A_PITCH = 80, B_PITCH = 320, SA_BYTES = 128 * A_PITCH, SB_BYTES = BK * B_PITCH;
constexpr int GEMM_LDS = 2 * SA_BYTES + 2 * SB_BYTES;

struct GSeg { const bf16_t* a0; const bf16_t* a1; int akstep; const float* b0; size_t ldb; int KT; };
template <class Epi>
DI void gemm_tile2(const GSeg& g1, const GSeg& g2, char* lds_generic, const Epi& epi) {
    const int KT = g1.KT + g2.KT;
    LAS char* lds = (LAS char*)lds_generic;
    const int t = tid_(), lane = t & 63, w = t >> 6, wm = w >> 1, wn = w & 1;
    const int r = lane & 31, h = lane >> 5;
    const int i16 = lane & 15, q = i16 >> 2, pp = i16 & 3, blk = (lane >> 4) & 1;
    const int arow = t >> 2, akc = t & 3, bk = t >> 5, bn4 = t & 31;
    f32x16 acc[2][2];
#pragma unroll
    for (int i = 0; i < 2; ++i)
#pragma unroll
        for (int j = 0; j < 2; ++j)
#pragma unroll
            for (int e = 0; e < 16; ++e) acc[i][j][e] = 0.f;
    struct Stage { u32x4 a0, a1; float4 b0, b1, b2, b3; };
    const bf16_t* pa0 = g1.a0; const bf16_t* pa1 = g1.a1; const float* pb = g1.b0;
    size_t ldb = g1.ldb; int aks = g1.akstep, left = g1.KT, issued = 0;
    auto gload = [&](Stage& S) {
        S.a0 = *(const u32x4*)pa0; S.a1 = *(const u32x4*)pa1;
        S.b0 = *(const float4*)(pb); S.b1 = *(const float4*)(pb + 8 * ldb); S.b2 = *(const float4*)(pb + 16 * ldb); S.b3 = *(const float4*)(pb + 24 * ldb);
        if (++issued < KT) {
            if (--left == 0) { pa0 = g2.a0; pa1 = g2.a1; pb = g2.b0; ldb = g2.ldb; aks = g2.akstep; left = 1 << 30; }
            else { pa0 += aks; pa1 += aks; pb += BK * ldb; }
        }
    };
    auto sstore = [&](const Stage& S, int buf) {
        LAS char* sA = lds + buf * SA_BYTES; LAS char* sB = lds + 2 * SA_BYTES + buf * SB_BYTES;
        *(LAS u32x4*)(sA + arow * A_PITCH + akc * 16) = S.a0;
        *(LAS u32x4*)(sA + (arow + 64) * A_PITCH + akc * 16) = S.a1;
        u32x2 v;
        v.x = pk2(S.b0.x, S.b0.y); v.y = pk2(S.b0.z, S.b0.w); *(LAS u32x2*)(sB + (bk) * B_PITCH + bn4 * 8) = v;
        v.x = pk2(S.b1.x, S.b1.y); v.y = pk2(S.b1.z, S.b1.w); *(LAS u32x2*)(sB + (bk + 8) * B_PITCH + bn4 * 8) = v;
        v.x = pk2(S.b2.x, S.b2.y); v.y = pk2(S.b2.z, S.b2.w); *(LAS u32x2*)(sB + (bk + 16) * B_PITCH + bn4 * 8) = v;
        v.x = pk2(S.b3.x, S.b3.y); v.y = pk2(S.b3.z, S.b3.w); *(LAS u32x2*)(sB + (bk + 24) * B_PITCH + bn4 * 8) = v;
    };
    auto compute = [&](int buf) {
        const LAS char* sA = lds + buf * SA_BYTES; const LAS char* sB = lds + 2 * SA_BYTES + buf * SB_BYTES;
#pragma unroll
        for (int ks = 0; ks < 2; ++ks) {
            bf16x8 af[2], bfr[2];
#pragma unroll
            for (int tm = 0; tm < 2; ++tm) af[tm] = *(const LAS bf16x8*)(sA + (wm * 64 + tm * 32 + r) * A_PITCH + (ks * 16 + 8 * h) * 2);
#pragma unroll
            for (int tn = 0; tn < 2; ++tn) {
                const LAS char* pb = sB + (ks * 16 + 8 * h + q) * B_PITCH + (wn * 64 + tn * 32 + 16 * blk) * 2 + 8 * pp;
                s16x4 lo = tr_read(pb), hi = tr_read(pb + 4 * B_PITCH);
                bfr[tn] = __builtin_shufflevector(lo, hi, 0, 1, 2, 3, 4, 5, 6, 7);
            }
#pragma unroll
            for (int tm = 0; tm < 2; ++tm)
#pragma unroll
                for (int tn = 0; tn < 2; ++tn) acc[tm][tn] = __builtin_amdgcn_mfma_f32_32x32x16_bf16(bfr[tn], af[tm], acc[tm][tn], 0, 0, 0);
        }
    };
    Stage S0, S1;
    gload(S0); gload(S1);
    sstore(S0, 0); __syncthreads();
#define GSTEP(SL, SS) { gload(SL); compute(kt & 1); sstore(SS, (kt + 1) & 1); __syncthreads(); if (++kt >= KT) break; }
    for (int kt = 0;;) {
        GSTEP(S0, S1)
        GSTEP(S1, S0)
    }
#undef GSTEP
    epi(acc, wm, wn, r, h);
}
#ifdef LAB
template <class Epi>
DI void gemm_lab(const GSeg& g1, const GSeg& g2, char* lds_generic, const Epi& epi) {
    const int KT = g1.KT + g2.KT;
    LAS char* lds = (LAS char*)lds_generic;
    const int t = tid_(), lane = t & 63, w = t >> 6, wm = w >> 1, wn = w & 1;
    const int r = lane & 31, h = lane >> 5;
    const int i16 = lane & 15, q = i16 >> 2, pp = i16 & 3, blk = (lane >> 4) & 1;
    const int arow = t >> 2, akc = t & 3, bk = t >> 5, bn4 = t & 31;
    f32x16 acc[2][2];
#pragma unroll
    for (int i = 0; i < 2; ++i)
#pragma unroll
        for (int j = 0; j < 2; ++j)
#pragma unroll
            for (int e = 0; e < 16; ++e) acc[i][j][e] = 0.f;
    struct Stage { u32x4 a0, a1; float4 b0, b1, b2, b3; };
    const bf16_t* pa0 = g1.a0; const bf16_t* pa1 = g1.a1; const float* pb = g1.b0;
    size_t ldb = g1.ldb; int aks = g1.akstep, left = g1.KT, issued = 0;
    auto gload = [&](Stage& S) {
        if (LAB != 5 && LAB != 15) { S.a0 = *(const u32x4*)pa0; S.a1 = *(const u32x4*)pa1; }
        if (LAB != 6 && LAB != 16) { S.b0 = *(const float4*)(pb); S.b1 = *(const float4*)(pb + 8 * ldb); S.b2 = *(const float4*)(pb + 16 * ldb); S.b3 = *(const float4*)(pb + 24 * ldb); }
        if (++issued < KT) {
            if (--left == 0) { pa0 = g2.a0; pa1 = g2.a1; pb = g2.b0; ldb = g2.ldb; aks = g2.akstep; left = 1 << 30; }
            else { pa0 += aks; pa1 += aks; pb += BK * ldb; }
        }
    };
    auto sstore = [&](const Stage& S, int buf) {
        LAS char* sA = lds + buf * SA_BYTES; LAS char* sB = lds + 2 * SA_BYTES + buf * SB_BYTES;
        *(LAS u32x4*)(sA + arow * A_PITCH + akc * 16) = S.a0;
        *(LAS u32x4*)(sA + (arow + 64) * A_PITCH + akc * 16) = S.a1;
        u32x2 v;
        v.x = pk2(S.b0.x, S.b0.y); v.y = pk2(S.b0.z, S.b0.w); *(LAS u32x2*)(sB + (bk) * B_PITCH + bn4 * 8) = v;
        v.x = pk2(S.b1.x, S.b1.y); v.y = pk2(S.b1.z, S.b1.w); *(LAS u32x2*)(sB + (bk + 8) * B_PITCH + bn4 * 8) = v;
        v.x = pk2(S.b2.x, S.b2.y); v.y = pk2(S.b2.z, S.b2.w); *(LAS u32x2*)(sB + (bk + 16) * B_PITCH + bn4 * 8) = v;
        v.x = pk2(S.b3.x, S.b3.y); v.y = pk2(S.b3.z, S.b3.w); *(LAS u32x2*)(sB + (bk + 24) * B_PITCH + bn4 * 8) = v;
    };
    auto compute = [&](int buf) {
        const LAS char* sA = lds + buf * SA_BYTES; const LAS char* sB = lds + 2 * SA_BYTES + buf * SB_BYTES;
#pragma unroll
        for (int ks = 0; ks < 2; ++ks) {
            bf16x8 af[2], bfr[2];
#pragma unroll
            for (int tm = 0; tm < 2; ++tm) af[tm] = *(const LAS bf16x8*)(sA + (wm * 64 + tm * 32 + r) * A_PITCH + (ks * 16 + 8 * h) * 2);
#pragma unroll
            for (int tn = 0; tn < 2; ++tn) {
                const LAS char* pb = sB + (ks * 16 + 8 * h + q) * B_PITCH + (wn * 64 + tn * 32 + 16 * blk) * 2 + 8 * pp;
                s16x4 lo = tr_read(pb), hi = tr_read(pb + 4 * B_PITCH);
                bfr[tn] = __builtin_shufflevector(lo, hi, 0, 1, 2, 3, 4, 5, 6, 7);
            }
#pragma unroll
            for (int tm = 0; tm < 2; ++tm)
#pragma unroll
                for (int tn = 0; tn < 2; ++tn) acc[tm][tn] = __builtin_amdgcn_mfma_f32_32x32x16_bf16(bfr[tn], af[tm], acc[tm][tn], 0, 0, 0);
        }
    };
    Stage S0, S1;
    gload(S0); gload(S1);
    sstore(S0, 0); __syncthreads();
#define GSTEP(SL, SS) { if (LAB != 1 && LAB != 3) gload(SL); if (LAB != 4 && LAB != 5 && LAB != 6) compute(kt & 1); if (LAB != 2 && LAB != 3) sstore(SS, (kt + 1) & 1); __syncthreads(); if (++kt >= KT) break; }
    for (int kt = 0;;) {
        GSTEP(S0, S1)
        GSTEP(S1, S0)
    }
#undef GSTEP
    epi(acc, wm, wn, r, h);
}
#endif
template <class Epi>
DI void gemm_tile(const bf16_t* a0, const bf16_t* a1, const float* b0, size_t ldb, int KT, char* lds_generic, const Epi& epi) {
    GSeg g1{a0, a1, BK, b0, ldb, KT}; GSeg g2{a0, a1, BK, b0, ldb, 0};
    gemm_tile2(g1, g2, lds_generic, epi);
}
struct GSeg2 { const bf16_t* a[4]; int askip; const bf16_t* b0; size_t ldb; int KT; };
constexpr int A2_PITCH = 144, SA2_BYTES = 128 * A2_PITCH, G2_LDS = 2 * SA2_BYTES + 2 * SB_BYTES;
template <class Epi>
DI void gemm2(const GSeg2& g1, const GSeg2& g2, char* lds_generic, const Epi& epi) {
    const int KT = g1.KT + g2.KT;
    LAS char* lds = (LAS char*)lds_generic;
    const int t = tid_(), lane = t & 63, w = t >> 6, wm = w >> 1, wn = w & 1;
    const int r = lane & 31, h = lane >> 5;
    const int i16 = lane & 15, q = i16 >> 2, pp = i16 & 3, blk = (lane >> 4) & 1;
    const int arow = t >> 3, akc = t & 7, bk = t >> 4, bc = t & 15;
    f32x16 acc[2][2];
#pragma unroll
    for (int i = 0; i < 2; ++i)
#pragma unroll
        for (int j = 0; j < 2; ++j)
#pragma unroll
            for (int e = 0; e < 16; ++e) acc[i][j][e] = 0.f;
    struct AStage { u32x4 a0, a1, a2, a3; };
    struct BStage { u32x4 b0, b1; };
    const bf16_t* pa0 = g1.a[0]; const bf16_t* pa1 = g1.a[1]; const bf16_t* pa2 = g1.a[2]; const bf16_t* pa3 = g1.a[3];
    const bf16_t* pb = g1.b0; size_t ldb = g1.ldb; int askip = g1.askip, aleft = g1.KT >> 1, bleft = g1.KT, aiss = 0, biss = 0;
    auto aload = [&](AStage& S) {
        S.a0 = *(const u32x4*)pa0; S.a1 = *(const u32x4*)pa1; S.a2 = *(const u32x4*)pa2; S.a3 = *(const u32x4*)pa3;
        if (++aiss < (KT >> 1)) {
            if (--aleft == 0) { pa0 = g2.a[0]; pa1 = g2.a[1]; pa2 = g2.a[2]; pa3 = g2.a[3]; askip = g2.askip; aleft = 1 << 30; }
            else { pa0 += askip; pa1 += askip; pa2 += askip; pa3 += askip; }
        }
    };
    auto bload = [&](BStage& S) {
        S.b0 = *(const u32x4*)pb; S.b1 = *(const u32x4*)(pb + 16 * ldb);
        if (++biss < KT) {
            if (--bleft == 0) { pb = g2.b0; ldb = g2.ldb; bleft = 1 << 30; }
            else pb += 32 * ldb;
        }
    };
    auto astore = [&](const AStage& S, int buf) {
        LAS char* sA = lds + buf * SA2_BYTES + arow * A2_PITCH + akc * 16;
        *(LAS u32x4*)(sA) = S.a0; *(LAS u32x4*)(sA + 32 * A2_PITCH) = S.a1; *(LAS u32x4*)(sA + 64 * A2_PITCH) = S.a2; *(LAS u32x4*)(sA + 96 * A2_PITCH) = S.a3;
    };
    auto bstore = [&](const BStage& S, int buf) {
        LAS char* sB = lds + 2 * SA2_BYTES + buf * SB_BYTES + bk * B_PITCH + bc * 16;
        *(LAS u32x4*)(sB) = S.b0; *(LAS u32x4*)(sB + 16 * B_PITCH) = S.b1;
    };
    auto compute = [&](int abuf, int half, int bbuf) {
        const LAS char* sA = lds + abuf * SA2_BYTES + half * 64; const LAS char* sB = lds + 2 * SA2_BYTES + bbuf * SB_BYTES;
#pragma unroll
        for (int ks = 0; ks < 2; ++ks) {
            bf16x8 af[2], bfr[2];
#pragma unroll
            for (int tm = 0; tm < 2; ++tm) af[tm] = *(const LAS bf16x8*)(sA + (wm * 64 + tm * 32 + r) * A2_PITCH + (ks * 16 + 8 * h) * 2);
#pragma unroll
            for (int tn = 0; tn < 2; ++tn) {
                const LAS char* pbb = sB + (ks * 16 + 8 * h + q) * B_PITCH + (wn * 64 + tn * 32 + 16 * blk) * 2 + 8 * pp;
                s16x4 lo = tr_read(pbb), hi = tr_read(pbb + 4 * B_PITCH);
                bfr[tn] = __builtin_shufflevector(lo, hi, 0, 1, 2, 3, 4, 5, 6, 7);
            }
#pragma unroll
            for (int tm = 0; tm < 2; ++tm)
#pragma unroll
                for (int tn = 0; tn < 2; ++tn) acc[tm][tn] = __builtin_amdgcn_mfma_f32_32x32x16_bf16(bfr[tn], af[tm], acc[tm][tn], 0, 0, 0);
        }
    };
    AStage RA; BStage RB0, RB1;
    aload(RA); bload(RB0); bload(RB1);
    astore(RA, 0); bstore(RB0, 0); __syncthreads();
    for (int sl = 0;; ++sl) {
#ifndef LAB
#define LAB 0
#define LAB_UNDEF
#endif
        if (LAB != 22) { aload(RA); bload(RB0); }
        if (LAB != 21) compute(sl & 1, 0, 0);
        bstore(RB1, 1);
        __syncthreads();
        if (LAB != 22) bload(RB1);
        if (LAB != 21) compute(sl & 1, 1, 1);
#ifdef LAB_UNDEF
#undef LAB
#undef LAB_UNDEF
#endif
        astore(RA, (sl + 1) & 1); bstore(RB0, 0);
        __syncthreads();
        if (2 * sl + 2 >= KT) break;
    }
    epi(acc, wm, wn, r, h);
}
struct GSeg3 { const bf16_t* a[4]; int askip; const float* b0; size_t ldb; int KT; };
template <class Epi>
DI void gemm3(const GSeg3& g1, const GSeg3& g2, char* lds_generic, const Epi& epi) {
    const int KT = g1.KT + g2.KT;
    LAS char* lds = (LAS char*)lds_generic;
    const int t = tid_(), lane = t & 63, w = t >> 6, wm = w >> 1, wn = w & 1;
    const int r = lane & 31, h = lane >> 5;
    const int i16 = lane & 15, q = i16 >> 2, pp = i16 & 3, blk = (lane >> 4) & 1;
    const int arow = t >> 3, akc = t & 7, bk = t >> 5, bn4 = t & 31;
    f32x16 acc[2][2];
#pragma unroll
    for (int i = 0; i < 2; ++i)
#pragma unroll
        for (int j = 0; j < 2; ++j)
#pragma unroll
            for (int e = 0; e < 16; ++e) acc[i][j][e] = 0.f;
    struct AStage { u32x4 a0, a1, a2, a3; };
    struct BStage { float4 b0, b1, b2, b3; };
    const bf16_t* pa0 = g1.a[0]; const bf16_t* pa1 = g1.a[1]; const bf16_t* pa2 = g1.a[2]; const bf16_t* pa3 = g1.a[3];
    const float* pb = g1.b0; size_t ldb = g1.ldb; int askip = g1.askip, aleft = g1.KT >> 1, bleft = g1.KT, aiss = 0, biss = 0;
    auto aload = [&](AStage& S) {
        S.a0 = *(const u32x4*)pa0; S.a1 = *(const u32x4*)pa1; S.a2 = *(const u32x4*)pa2; S.a3 = *(const u32x4*)pa3;
        if (++aiss < (KT >> 1)) {
            if (--aleft == 0) { pa0 = g2.a[0]; pa1 = g2.a[1]; pa2 = g2.a[2]; pa3 = g2.a[3]; askip = g2.askip; aleft = 1 << 30; }
            else { pa0 += askip; pa1 += askip; pa2 += askip; pa3 += askip; }
        }
    };
    auto bload = [&](BStage& S) {
        S.b0 = *(const float4*)(pb); S.b1 = *(const float4*)(pb + 8 * ldb); S.b2 = *(const float4*)(pb + 16 * ldb); S.b3 = *(const float4*)(pb + 24 * ldb);
        if (++biss < KT) {
            if (--bleft == 0) { pb = g2.b0; ldb = g2.ldb; bleft = 1 << 30; }
            else pb += 32 * ldb;
        }
    };
    auto astore = [&](const AStage& S, int buf) {
        LAS char* sA = lds + buf * SA2_BYTES + arow * A2_PITCH + akc * 16;
        *(LAS u32x4*)(sA) = S.a0; *(LAS u32x4*)(sA + 32 * A2_PITCH) = S.a1; *(LAS u32x4*)(sA + 64 * A2_PITCH) = S.a2; *(LAS u32x4*)(sA + 96 * A2_PITCH) = S.a3;
    };
    auto bstore = [&](const BStage& S, int buf) {
        LAS char* sB = lds + 2 * SA2_BYTES + buf * SB_BYTES + bk * B_PITCH + bn4 * 8;
        u32x2 v;
        v.x = pk2(S.b0.x, S.b0.y); v.y = pk2(S.b0.z, S.b0.w); *(LAS u32x2*)(sB) = v;
        v.x = pk2(S.b1.x, S.b1.y); v.y = pk2(S.b1.z, S.b1.w); *(LAS u32x2*)(sB + 8 * B_PITCH) = v;
        v.x = pk2(S.b2.x, S.b2.y); v.y = pk2(S.b2.z, S.b2.w); *(LAS u32x2*)(sB + 16 * B_PITCH) = v;
        v.x = pk2(S.b3.x, S.b3.y); v.y = pk2(S.b3.z, S.b3.w); *(LAS u32x2*)(sB + 24 * B_PITCH) = v;
    };
    auto compute = [&](int abuf, int half, int bbuf) {
        const LAS char* sA = lds + abuf * SA2_BYTES + half * 64; const LAS char* sB = lds + 2 * SA2_BYTES + bbuf * SB_BYTES;
#pragma unroll
        for (int ks = 0; ks < 2; ++ks) {
            bf16x8 af[2], bfr[2];
#pragma unroll
            for (int tm = 0; tm < 2; ++tm) af[tm] = *(const LAS bf16x8*)(sA + (wm * 64 + tm * 32 + r) * A2_PITCH + (ks * 16 + 8 * h) * 2);
#pragma unroll
            for (int tn = 0; tn < 2; ++tn) {
                const LAS char* pbb = sB + (ks * 16 + 8 * h + q) * B_PITCH + (wn * 64 + tn * 32 + 16 * blk) * 2 + 8 * pp;
                s16x4 lo = tr_read(pbb), hi = tr_read(pbb + 4 * B_PITCH);
                bfr[tn] = __builtin_shufflevector(lo, hi, 0, 1, 2, 3, 4, 5, 6, 7);
            }
#pragma unroll
            for (int tm = 0; tm < 2; ++tm)
#pragma unroll
                for (int tn = 0; tn < 2; ++tn) acc[tm][tn] = __builtin_amdgcn_mfma_f32_32x32x16_bf16(bfr[tn], af[tm], acc[tm][tn], 0, 0, 0);
        }
    };
    AStage RA; BStage RB0, RB1;
    aload(RA); bload(RB0); bload(RB1);
    astore(RA, 0); bstore(RB0, 0); __syncthreads();
    for (int sl = 0;; ++sl) {
        aload(RA); bload(RB0);
        compute(sl & 1, 0, 0);
        bstore(RB1, 1);
        __syncthreads();
        bload(RB1);
        compute(sl & 1, 1, 1);
        astore(RA, (sl + 1) & 1); bstore(RB0, 0);
        __syncthreads();
        if (2 * sl + 2 >= KT) break;
    }
    epi(acc, wm, wn, r, h);
}
struct GSeg4 { const bf16_t* a0; const bf16_t* a1; int akstep; const bf16_t* b0; size_t ldb; int KT; };
constexpr int B4_PITCH = 576, SB4_BYTES = 32 * B4_PITCH, G4_LDS = 2 * SA_BYTES + 2 * SB4_BYTES;
template <class Epi>
DI void gemm4(const GSeg4& g1, const GSeg4& g2, char* lds_generic, const Epi& epi) {
    const int KT = g1.KT + g2.KT;
    LAS char* lds = (LAS char*)lds_generic;
    const int t = tid_(), lane = t & 63, w = t >> 6, wm = w >> 1, wn = w & 1;
    const int r = lane & 31, h = lane >> 5;
    const int i16 = lane & 15, q = i16 >> 2, pp = i16 & 3, blk = (lane >> 4) & 1;
    const int arow = t >> 2, akc = t & 3, bk = t >> 5, bc = t & 31;
    f32x16 acc[2][4];
#pragma unroll
    for (int i = 0; i < 2; ++i)
#pragma unroll
        for (int j = 0; j < 4; ++j)
#pragma unroll
            for (int e = 0; e < 16; ++e) acc[i][j][e] = 0.f;
    struct Stage { u32x4 a0, a1, b0, b1, b2, b3; };
    const bf16_t* pa0 = g1.a0; const bf16_t* pa1 = g1.a1; const bf16_t* pb = g1.b0;
    size_t ldb = g1.ldb; int aks = g1.akstep, left = g1.KT, issued = 0;
    auto gload = [&](Stage& S) {
        S.a0 = *(const u32x4*)pa0; S.a1 = *(const u32x4*)pa1;
        S.b0 = *(const u32x4*)(pb); S.b1 = *(const u32x4*)(pb + 8 * ldb); S.b2 = *(const u32x4*)(pb + 16 * ldb); S.b3 = *(const u32x4*)(pb + 24 * ldb);
        if (++issued < KT) {
            if (--left == 0) { pa0 = g2.a0; pa1 = g2.a1; pb = g2.b0; ldb = g2.ldb; aks = g2.akstep; left = 1 << 30; }
            else { pa0 += aks; pa1 += aks; pb += 32 * ldb; }
        }
    };
    auto sstore = [&](const Stage& S, int buf) {
        LAS char* sA = lds + buf * SA_BYTES; LAS char* sB = lds + 2 * SA_BYTES + buf * SB4_BYTES + bk * B4_PITCH + bc * 16;
        *(LAS u32x4*)(sA + arow * A_PITCH + akc * 16) = S.a0;
        *(LAS u32x4*)(sA + (arow + 64) * A_PITCH + akc * 16) = S.a1;
        *(LAS u32x4*)(sB) = S.b0; *(LAS u32x4*)(sB + 8 * B4_PITCH) = S.b1; *(LAS u32x4*)(sB + 16 * B4_PITCH) = S.b2; *(LAS u32x4*)(sB + 24 * B4_PITCH) = S.b3;
    };
    auto compute = [&](int buf) {
        const LAS char* sA = lds + buf * SA_BYTES; const LAS char* sB = lds + 2 * SA_BYTES + buf * SB4_BYTES;
#pragma unroll
        for (int ks = 0; ks < 2; ++ks) {
            bf16x8 af[2], bfr[4];
#pragma unroll
            for (int tm = 0; tm < 2; ++tm) af[tm] = *(const LAS bf16x8*)(sA + (wm * 64 + tm * 32 + r) * A_PITCH + (ks * 16 + 8 * h) * 2);
#pragma unroll
            for (int tn = 0; tn < 4; ++tn) {
                const LAS char* pbb = sB + (ks * 16 + 8 * h + q) * B4_PITCH + (wn * 128 + tn * 32 + 16 * blk) * 2 + 8 * pp;
                s16x4 lo = tr_read(pbb), hi = tr_read(pbb + 4 * B4_PITCH);
                bfr[tn] = __builtin_shufflevector(lo, hi, 0, 1, 2, 3, 4, 5, 6, 7);
            }
#pragma unroll
            for (int tm = 0; tm < 2; ++tm)
#pragma unroll
                for (int tn = 0; tn < 4; ++tn) acc[tm][tn] = __builtin_amdgcn_mfma_f32_32x32x16_bf16(bfr[tn], af[tm], acc[tm][tn], 0, 0, 0);
        }
    };
    Stage S0, S1;
    gload(S0); gload(S1);
    sstore(S0, 0); __syncthreads();
#define GSTEP(SL, SS) { gload(SL); compute(kt & 1); sstore(SS, (kt + 1) & 1); __syncthreads(); if (++kt >= KT) break; }
    for (int kt = 0;;) {
        GSTEP(S0, S1)
        GSTEP(S1, S0)
    }
#undef GSTEP
    epi(acc, wm, wn, r, h);
}
struct Epi4Bf16 {
    bf16_t* out; size_t ld;
    DI void operator()(const f32x16 (&acc)[2][4], int wm, int wn, int r, int h) const {
#pragma unroll
        for (int tm = 0; tm < 2; ++tm) {
            bf16_t* rp = out + (size_t)(wm * 64 + tm * 32 + r) * ld + wn * 128 + 4 * h;
#pragma unroll
            for (int tn = 0; tn < 4; ++tn)
#pragma unroll
                for (int g = 0; g < 4; ++g) {
                    u32x2 v; v.x = pk2(acc[tm][tn][4 * g], acc[tm][tn][4 * g + 1]); v.y = pk2(acc[tm][tn][4 * g + 2], acc[tm][tn][4 * g + 3]);
                    *(u32x2*)(rp + tn * 32 + 8 * g) = v;
                }
        }
    }
};
struct Epi4Resid {
    float* out; const float* res; size_t ld;
    DI void operator()(const f32x16 (&acc)[2][4], int wm, int wn, int r, int h) const {
#pragma unroll
        for (int tm = 0; tm < 2; ++tm) {
            const size_t o = (size_t)(wm * 64 + tm * 32 + r) * ld + wn * 128 + 4 * h;
#pragma unroll
            for (int hf = 0; hf < 2; ++hf) {
                float4 x[8];
#pragma unroll
                for (int i = 0; i < 8; ++i) x[i] = *(const float4*)(res + o + (hf * 2 + (i >> 2)) * 32 + 8 * (i & 3));
#pragma unroll
                for (int i = 0; i < 8; ++i) {
                    const int tn = hf * 2 + (i >> 2), g = i & 3;
                    x[i].x += acc[tm][tn][4 * g]; x[i].y += acc[tm][tn][4 * g + 1]; x[i].z += acc[tm][tn][4 * g + 2]; x[i].w += acc[tm][tn][4 * g + 3];
                }
#pragma unroll
                for (int i = 0; i < 8; ++i) *(float4*)(out + o + (hf * 2 + (i >> 2)) * 32 + 8 * (i & 3)) = x[i];
            }
        }
    }
};
struct Epi4Inproj {
    Epi4Bf16 eb; float* gout; const float* bi; const float* bf; bool isgate;
    DI void operator()(const f32x16 (&acc)[2][4], int wm, int wn, int r, int h) const {
        if (!isgate) { eb(acc, wm, wn, r, h); return; }
        if (wn == 0) {
#pragma unroll
            for (int tm = 0; tm < 2; ++tm) {
                const float* bb = h ? bf : bi;
                float4 x = {acc[tm][0][0] + bb[0], acc[tm][0][1] + bb[1], acc[tm][0][2] + bb[2], acc[tm][0][3] + bb[3]};
                *(float4*)(gout + (size_t)(wm * 64 + tm * 32 + r) * 8 + 4 * h) = x;
            }
        }
    }
};
struct EpiBf16 {
    bf16_t* out; size_t ld;
    DI void operator()(const f32x16 (&acc)[2][2], int wm, int wn, int r, int h) const {
#pragma unroll
        for (int tm = 0; tm < 2; ++tm) {
            bf16_t* rp = out + (size_t)(wm * 64 + tm * 32 + r) * ld + wn * 64 + 4 * h;
#pragma unroll
            for (int tn = 0; tn < 2; ++tn)
#pragma unroll
                for (int g = 0; g < 4; ++g) {
                    u32x2 v; v.x = pk2(acc[tm][tn][4 * g], acc[tm][tn][4 * g + 1]); v.y = pk2(acc[tm][tn][4 * g + 2], acc[tm][tn][4 * g + 3]);
                    *(u32x2*)(rp + tn * 32 + 8 * g) = v;
                }
        }
    }
};
struct EpiResid {
    float* out; const float* res; size_t ld;
    DI void operator()(const f32x16 (&acc)[2][2], int wm, int wn, int r, int h) const {
#pragma unroll
        for (int tm = 0; tm < 2; ++tm) {
            const size_t o = (size_t)(wm * 64 + tm * 32 + r) * ld + wn * 64 + 4 * h;
            float4 x[8];
#pragma unroll
            for (int i = 0; i < 8; ++i) x[i] = *(const float4*)(res + o + (i >> 2) * 32 + 8 * (i & 3));
#pragma unroll
            for (int i = 0; i < 8; ++i) {
                const int tn = i >> 2, g = i & 3;
                x[i].x += acc[tm][tn][4 * g]; x[i].y += acc[tm][tn][4 * g + 1]; x[i].z += acc[tm][tn][4 * g + 2]; x[i].w += acc[tm][tn][4 * g + 3];
            }
#pragma unroll
            for (int i = 0; i < 8; ++i) *(float4*)(out + o + (i >> 2) * 32 + 8 * (i & 3)) = x[i];
        }
    }
};
DI float silu_mul(float g, float u) { return g / (1.0f + __expf(-g)) * u; }
struct EpiGateUp {
    bf16_t* out;
    DI void operator()(const f32x16 (&acc)[2][2], int wm, int wn, int r, int h) const {
#pragma unroll
        for (int tm = 0; tm < 2; ++tm) {
            bf16_t* rp = out + (size_t)(wm * 64 + tm * 32 + r) * DE + wn * 32 + 4 * h;
#pragma unroll
            for (int g = 0; g < 4; ++g) {
                u32x2 v;
                v.x = pk2(silu_mul(acc[tm][0][4 * g], acc[tm][1][4 * g]), silu_mul(acc[tm][0][4 * g + 1], acc[tm][1][4 * g + 1]));
                v.y = pk2(silu_mul(acc[tm][0][4 * g + 2], acc[tm][1][4 * g + 2]), silu_mul(acc[tm][0][4 * g + 3], acc[tm][1][4 * g + 3]));
                *(u32x2*)(rp + 8 * g) = v;
            }
        }
    }
};
struct EpiDown {
    bf16_t* out; const float* roww; int nvalid;
    DI void operator()(const f32x16 (&acc)[2][2], int wm, int wn, int r, int h) const {
#pragma unroll
        for (int tm = 0; tm < 2; ++tm) {
            const int row = wm * 64 + tm * 32 + r;
            const float wv = row < nvalid ? roww[row] : 0.f;
            bf16_t* rp = out + (size_t)row * DM + wn * 64 + 4 * h;
#pragma unroll
            for (int tn = 0; tn < 2; ++tn)
#pragma unroll
                for (int g = 0; g < 4; ++g) {
                    u32x2 v; v.x = pk2(acc[tm][tn][4 * g] * wv, acc[tm][tn][4 * g + 1] * wv); v.y = pk2(acc[tm][tn][4 * g + 2] * wv, acc[tm][tn][4 * g + 3] * wv);
                    *(u32x2*)(rp + tn * 32 + 8 * g) = v;
                }
        }
    }
};

struct EpiGates {
    float* out; const float* bi; const float* bf;
    DI void operator()(const f32x16 (&acc)[2][2], int wm, int wn, int r, int h) const {
        if (wn == 0) {
#pragma unroll
            for (int tm = 0; tm < 2; ++tm) {
                const float* bb = h ? bf : bi;
                float4 x = {acc[tm][0][0] + bb[0], acc[tm][0][1] + bb[1], acc[tm][0][2] + bb[2], acc[tm][0][3] + bb[3]};
                *(float4*)(out + (size_t)(wm * 64 + tm * 32 + r) * 8 + 4 * h) = x;
            }
        }
    }
};
struct EpiInproj {
    EpiBf16 eb; EpiGates eg; bool isgate;
    DI void operator()(const f32x16 (&acc)[2][2], int wm, int wn, int r, int h) const { if (isgate) eg(acc, wm, wn, r, h); else eb(acc, wm, wn, r, h); }
};
struct EpiF32 {
    float* out; size_t ld;
    DI void operator()(const f32x16 (&acc)[2][2], int wm, int wn, int r, int h) const {
#pragma unroll
        for (int tm = 0; tm < 2; ++tm) {
            float* rp = out + (size_t)(wm * 64 + tm * 32 + r) * ld + wn * 64 + 4 * h;
#pragma unroll
            for (int tn = 0; tn < 2; ++tn)
#pragma unroll
                for (int g = 0; g < 4; ++g) { float4 x = {acc[tm][tn][4 * g], acc[tm][tn][4 * g + 1], acc[tm][tn][4 * g + 2], acc[tm][tn][4 * g + 3]}; *(float4*)(rp + tn * 32 + 8 * g) = x; }
        }
    }
};
DI float gelu_tanh(float v) {
    const float inner = 0.7978845608028654f * (v + 0.044715f * v * v * v);
    const float th = 1.0f - 2.0f / (__expf(2.0f * inner) + 1.0f);
    return 0.5f * v * (1.0f + th);
}
struct EpiS5Y {
    bf16_t* zrow0;
    int ncol0;
    DI void operator()(const f32x16 (&acc)[2][2], int wm, int wn, int r, int h) const {
#pragma unroll
        for (int tm = 0; tm < 2; ++tm) {
            const int chunk = wm * 64 + tm * 32 + r;
#pragma unroll
            for (int tn = 0; tn < 2; ++tn)
#pragma unroll
                for (int g = 0; g < 4; ++g) {
                    const int n0 = ncol0 + wn * 64 + tn * 32 + 8 * g + 4 * h;
                    u32x2 v; v.x = pk2(gelu_tanh(acc[tm][tn][4 * g]), gelu_tanh(acc[tm][tn][4 * g + 1])); v.y = pk2(gelu_tanh(acc[tm][tn][4 * g + 2]), gelu_tanh(acc[tm][tn][4 * g + 3]));
                    *(u32x2*)(zrow0 + (size_t)(chunk * 16 + (n0 >> 4)) * 256 + (n0 & 15)) = v;
                }
        }
    }
};
struct EpiGlu {
    const bf16_t* z; bf16_t* out; const float* gb; const float* sg;
    DI void operator()(const f32x16 (&acc)[2][2], int wm, int wn, int r, int h) const {
#pragma unroll
        for (int tm = 0; tm < 2; ++tm) {
            const int row = wm * 64 + tm * 32 + r;
#pragma unroll
            for (int tn = 0; tn < 2; ++tn) {
                const int c0 = wn * 64 + tn * 32 + 4 * h;
                float y[16];
#pragma unroll
                for (int g = 0; g < 4; ++g) {
                    const u32x2 zz = *(const u32x2*)(z + (size_t)row * 256 + c0 + 8 * g);
                    const float4 b4 = *(const float4*)(gb + c0 + 8 * g);
                    y[4 * g + 0] = bf2f(zz.x & 0xffff) / (1.0f + __expf(-(acc[tm][tn][4 * g + 0] + b4.x)));
                    y[4 * g + 1] = bf2f(zz.x >> 16) / (1.0f + __expf(-(acc[tm][tn][4 * g + 1] + b4.y)));
                    y[4 * g + 2] = bf2f(zz.y & 0xffff) / (1.0f + __expf(-(acc[tm][tn][4 * g + 2] + b4.z)));
                    y[4 * g + 3] = bf2f(zz.y >> 16) / (1.0f + __expf(-(acc[tm][tn][4 * g + 3] + b4.w)));
                }
#pragma unroll
                for (int q = 0; q < 2; ++q) {
                    float ss = 0.f;
#pragma unroll
                    for (int e = 0; e < 8; ++e) ss += y[8 * q + e] * y[8 * q + e];
                    ss = half_swap_sum(ss);
                    const float rstd = rsqrtf(ss * (1.0f / 16.0f) + EPS);
#pragma unroll
                    for (int g = 2 * q; g < 2 * q + 2; ++g) {
                        const float4 s4 = *(const float4*)(sg + c0 + 8 * g);
                        u32x2 v; v.x = pk2(y[4 * g] * rstd * s4.x, y[4 * g + 1] * rstd * s4.y); v.y = pk2(y[4 * g + 2] * rstd * s4.z, y[4 * g + 3] * rstd * s4.w);
                        *(u32x2*)(out + (size_t)row * DM + c0 + 8 * g) = v;
                    }
                }
            }
        }
    }
};

DI void moe_prefix(const int* cnt, int* stp  ) {
    __syncthreads();
    if (tid_() == 0) { int a = 0; for (int e = 0; e < NE; ++e) { stp[e] = a; a += (cnt[e] + 127) >> 7; } stp[NE] = a; }
    __syncthreads();
}

constexpr int XS_P = 1028;
template <int NC>
DI void rows_matvec(const float* xs, const float* W, int ldw, float* part  ) {
    constexpr int O = 8 * NC, PARTS = 256 / O, KLEN = 1024 / PARTS;
    const int t = tid_(), o = t % O, prt = t / O, r = o / NC, j = o % NC;
    const float* xr = xs + r * XS_P + prt * KLEN;
    const float* wp = W + (size_t)(prt * KLEN) * ldw + j;
    float a0 = 0.f, a1 = 0.f, a2 = 0.f, a3 = 0.f;
#pragma unroll 4
    for (int k = 0; k < KLEN; k += 4) {
        const float4 x = *(const float4*)(xr + k);
        a0 += x.x * wp[(size_t)k * ldw]; a1 += x.y * wp[(size_t)(k + 1) * ldw]; a2 += x.z * wp[(size_t)(k + 2) * ldw]; a3 += x.w * wp[(size_t)(k + 3) * ldw];
    }
    part[t] = (a0 + a1) + (a2 + a3);
}

DI void phase_norm1(const P& p, int l, char* lds) {
    const int t = tid_(), lane = t & 63, w = t >> 6;
    float* xres = (float*)(p.ws + WS_XRES);
    bf16_t* hbuf = (bf16_t*)(p.ws + WS_HBUF);
    float* gates = (float*)(p.ws + WS_GATES);
    const float* g1 = p.in[1] + l * DM;
    const float* win = p.in[2] + (size_t)l * DM * DIN;
    float* xs = (float*)lds;
    float* part = xs + 8 * XS_P;
    int* stp = (int*)(part + 256);
    const bf16_t* ymoe = (const bf16_t*)(p.ws + WS_YMOE);
    const int4* tinfo = (const int4*)(p.ws + WS_TINFO);
    if (l > 0) moe_prefix((const int*)(p.ws + WS_CTL) + (l - 1) * NE, stp);
    if (l == 0) {
        const size_t stride = (size_t)gridDim.x * 256, i0 = (size_t)bid_() * 256 + t;
        const float4* s1 = (const float4*)p.in[2]; u32x2* d1 = (u32x2*)(p.ws + WS_WINB);
        for (size_t i = i0; i < (size_t)2 * DM * DIN / 4; i += stride) { const float4 v = s1[i]; u32x2 o; o.x = pk2(v.x, v.y); o.y = pk2(v.z, v.w); d1[i] = o; }
        const float4* s2 = (const float4*)p.in[22]; u32x2* d2 = (u32x2*)(p.ws + WS_WOUTB);
        for (size_t i = i0; i < (size_t)2 * DM * DM / 4; i += stride) { const float4 v = s2[i]; u32x2 o; o.x = pk2(v.x, v.y); o.y = pk2(v.z, v.w); d2[i] = o; }
    }
    for (int rb = bid_(); rb < T / 8; rb += gridDim.x) {
        __syncthreads();
#pragma unroll
        for (int rr = 0; rr < 2; ++rr) {
            const int lr = w * 2 + rr, row = rb * 8 + lr;
            float4 v[4];
            const float* xsrc = (l == 0) ? p.in[0] + (size_t)row * DM : xres + (size_t)row * DM;
#pragma unroll
            for (int i = 0; i < 4; ++i) v[i] = *(const float4*)(xsrc + i * 256 + lane * 4);
            if (l > 0) {
                int4 ti = tinfo[row];
                const bf16_t* y0 = ymoe + (size_t)(stp[ti.x] * 128 + ti.y) * DM;
                const bf16_t* y1 = ymoe + (size_t)(stp[ti.z] * 128 + ti.w) * DM;
#pragma unroll
                for (int i = 0; i < 4; ++i) {
                    uint2 a = *(const uint2*)(y0 + i * 256 + lane * 4), b2 = *(const uint2*)(y1 + i * 256 + lane * 4);
                    v[i].x += bf2f(a.x & 0xffff) + bf2f(b2.x & 0xffff); v[i].y += bf2f(a.x >> 16) + bf2f(b2.x >> 16);
                    v[i].z += bf2f(a.y & 0xffff) + bf2f(b2.y & 0xffff); v[i].w += bf2f(a.y >> 16) + bf2f(b2.y >> 16);
                    *(float4*)(xres + (size_t)row * DM + i * 256 + lane * 4) = v[i];
                }
            }
            float ss = 0.f;
#pragma unroll
            for (int i = 0; i < 4; ++i) ss += v[i].x * v[i].x + v[i].y * v[i].y + v[i].z * v[i].z + v[i].w * v[i].w;
            ss = wave_sum(ss);
            const float rstd = rsqrtf(ss * (1.0f / DM) + EPS);
#pragma unroll
            for (int i = 0; i < 4; ++i) {
                const int k0 = i * 256 + lane * 4;
                const float4 g = *(const float4*)(g1 + k0);
                float4 hv = {v[i].x * rstd * g.x, v[i].y * rstd * g.y, v[i].z * rstd * g.z, v[i].w * rstd * g.w};
                uint2 o; o.x = pk2(hv.x, hv.y); o.y = pk2(hv.z, hv.w);
                *(uint2*)(hbuf + (size_t)row * DM + k0) = o;
            }
        }
    }
}

DI void phase_inproj(const P& p, int l, char* lds) {
    const int t = tid_();
    const bf16_t* hbuf = (const bf16_t*)(p.ws + WS_HBUF);
    bf16_t* projb = (bf16_t*)(p.ws + WS_PROJ);
    const bf16_t* winb = (const bf16_t*)(p.ws + WS_WINB) + (size_t)l * DM * DIN;
    float* gates = (float*)(p.ws + WS_GATES);
    const int vx = bid_() & 7, vj = bid_() >> 3, nj = (gridDim.x - vx + 7) >> 3;
    for (int st = vx; st < 16; st += 8)
      for (int j = vj; j < 96; j += nj) {
        const int mt = st * 8 + j / 12, vt = j % 12;
        const int acol = vt < 4 ? vt * 256 : (vt < 10 ? 1032 + (vt - 4) * 256 : (vt == 10 ? 2568 : 1024));
        const bf16_t* ar = hbuf + (size_t)(mt * 128 + (t >> 2)) * DM + (t & 3) * 8;
        GSeg4 g1{ar, ar + (size_t)64 * DM, 32, winb + (size_t)(t >> 5) * DIN + acol + (t & 31) * 8, DIN, DM / 32}; GSeg4 g2 = g1; g2.KT = 0;
        Epi4Inproj epi{Epi4Bf16{projb + (size_t)mt * 128 * PJ + (vt % 11) * 256, (size_t)PJ}, gates + (size_t)mt * 128 * 8, p.in[3] + l * 4, p.in[4] + l * 4, vt == 11};
        gemm4(g1, g2, lds, epi);
      }
}

__constant__ float ROPE_INV_REV[8] = {0.15915494309189535f, 0.03086376340470123f, 0.005985185712713705f, 0.001160663641240061f,
                                      0.00022507907903927653f, 4.364795279280289e-05f, 8.464330808241401e-06f, 1.6414262627950345e-06f};
DI void load64(const bf16_t* ptr, float (&x)[64]) {
#pragma unroll
    for (int c = 0; c < 8; ++c) {
        u32x4 u = *(const u32x4*)(ptr + c * 8);
        x[c * 8 + 0] = bf2f(u.x & 0xffff); x[c * 8 + 1] = bf2f(u.x >> 16); x[c * 8 + 2] = bf2f(u.y & 0xffff); x[c * 8 + 3] = bf2f(u.y >> 16);
        x[c * 8 + 4] = bf2f(u.z & 0xffff); x[c * 8 + 5] = bf2f(u.z >> 16); x[c * 8 + 6] = bf2f(u.w & 0xffff); x[c * 8 + 7] = bf2f(u.w >> 16);
    }
}
DI void store64(bf16_t* ptr, const float (&x)[64], float sc) {
#pragma unroll
    for (int c = 0; c < 8; ++c) {
        u32x4 u;
        u.x = pk2(x[c * 8 + 0] * sc, x[c * 8 + 1] * sc); u.y = pk2(x[c * 8 + 2] * sc, x[c * 8 + 3] * sc);
        u.z = pk2(x[c * 8 + 4] * sc, x[c * 8 + 5] * sc); u.w = pk2(x[c * 8 + 6] * sc, x[c * 8 + 7] * sc);
        *(u32x4*)(ptr + c * 8) = u;
    }
}
DI void norm_rope64(float (&x)[64], const float* g, int pos) {
    float ss = 0.f;
#pragma unroll
    for (int d = 0; d < 64; ++d) ss += x[d] * x[d];
    const float rstd = rsqrtf(ss * (1.0f / 64.0f) + EPS);
#pragma unroll
    for (int d = 0; d < 64; ++d) x[d] = x[d] * rstd * g[d];
#pragma unroll
    for (int d = 0; d < 8; ++d) {
        constexpr double RINV[8] = {0.15915494309189535, 0.03086376340470123, 0.005985185712713705, 0.001160663641240061,
                                    0.00022507907903927653, 4.364795279280289e-05, 8.464330808241401e-06, 1.6414262627950345e-06};
        double rr = (double)pos * RINV[d];
        rr -= floor(rr);
        const float sn = __builtin_amdgcn_sinf((float)rr), cs = __builtin_amdgcn_cosf((float)rr);
        const float x1 = x[d], x2 = x[d + 8];
        x[d] = x1 * cs - x2 * sn; x[d + 8] = x2 * cs + x1 * sn;
    }
}
DI void phase_qkprep(const P& p, int l, char* lds) {
    bf16_t* projb = (bf16_t*)(p.ws + WS_PROJ);
    float* kmean = (float*)(p.ws + WS_KMEAN);
    float* red = (float*)lds;
    const int t = tid_(), lane = t & 63, w = t >> 6;
    for (int item = bid_(); item < 512; item += gridDim.x) {
        const int b = item >> 6, n = (item >> 3) & 7, hd = item & 7;
        const int pos = n * 256 + t;
        bf16_t* rowp = projb + ((size_t)b * SEQ + pos) * PJ + hd * 64;
        float x[64];
        load64(rowp + C_AQ, x);
        norm_rope64(x, p.in[8] + l * 64, pos);
        store64(rowp + C_AQ, x, 0.125f * 1.4426950408889634f);
        load64(rowp + C_AK, x);
        norm_rope64(x, p.in[9] + l * 64, pos);
        store64(rowp + C_AK, x, 1.0f);
        __syncthreads();
#pragma unroll
        for (int d = 0; d < 64; ++d) { const float v = wave_sum(x[d]); if (lane == (d & 63)) red[w * 64 + d] = v; }
        __syncthreads();
        if (t < 64) kmean[(size_t)item * 64 + t] = (red[t] + red[64 + t] + red[128 + t] + red[192 + t]) * (1.0f / 256.0f);
    }
    {
        bf16_t* mqkc = (bf16_t*)(p.ws + WS_MQKC);
        const float* cw = p.in[5] + l * 4 * 512; const float* cb = p.in[6] + l * 512;
        const int nthreads = gridDim.x * 256;
        for (int idx = bid_() * 256 + t; idx < T * 64; idx += nthreads) {
            const int token = idx >> 6, ch = (idx & 63) * 8, pos = token & (SEQ - 1);
            float a[8];
            { const float4 b0 = *(const float4*)(cb + ch), b1 = *(const float4*)(cb + ch + 4); a[0] = b0.x; a[1] = b0.y; a[2] = b0.z; a[3] = b0.w; a[4] = b1.x; a[5] = b1.y; a[6] = b1.z; a[7] = b1.w; }
#pragma unroll
            for (int j = 0; j < 4; ++j) {
                if (pos + j - 3 >= 0) {
                    const u32x4 u = *(const u32x4*)(projb + (size_t)(token + j - 3) * PJ + ch);
                    const float4 w0 = *(const float4*)(cw + j * 512 + ch), w1 = *(const float4*)(cw + j * 512 + ch + 4);
                    a[0] += bf2f(u.x & 0xffff) * w0.x; a[1] += bf2f(u.x >> 16) * w0.y; a[2] += bf2f(u.y & 0xffff) * w0.z; a[3] += bf2f(u.y >> 16) * w0.w;
                    a[4] += bf2f(u.z & 0xffff) * w1.x; a[5] += bf2f(u.z >> 16) * w1.y; a[6] += bf2f(u.w & 0xffff) * w1.z; a[7] += bf2f(u.w >> 16) * w1.w;
                }
            }
            const float sc = ch >= 256 ? 0.125f : 1.0f;
#pragma unroll
            for (int e = 0; e < 8; ++e) a[e] = a[e] / (1.0f + __expf(-a[e])) * sc;
            u32x4 o; o.x = pk2(a[0], a[1]); o.y = pk2(a[2], a[3]); o.z = pk2(a[4], a[5]); o.w = pk2(a[6], a[7]);
            *(u32x4*)(mqkc + (size_t)token * 512 + ch) = o;
        }
    }
    {
        const float* gates = (const float*)(p.ws + WS_GATES);
        float4* gscan = (float4*)(p.ws + WS_GSCAN);
        const int lane = t & 63, gwv = bid_() * 4 + (t >> 6), nwv = gridDim.x * 4;
        for (int it = gwv; it < (T / 64) * 4; it += nwv) {
            const int ck = it >> 2, hd = it & 3;
            const size_t row = (size_t)ck * 64 + lane;
            const float gi = gates[row * 8 + hd], gf = gates[row * 8 + 4 + hd];
            const float lf = fminf(gf, 0.f) - log1pf(expf(-fabsf(gf)));
            float bs = lf;
#pragma unroll
            for (int o = 1; o < 64; o <<= 1) { const float v = __shfl_up(bs, o); if (lane >= o) bs += v; }
            const float u = gi - bs; float um = u;
#pragma unroll
            for (int o = 1; o < 64; o <<= 1) { const float v = __shfl_up(um, o); if (lane >= o) um = fmaxf(um, v); }
            gscan[row * 4 + hd] = make_float4(bs, u, um, 0.f);
        }
    }
    {
        float* Tm = (float*)(p.ws + WS_S5M + (size_t)l * S5M_LAYER);
        float* Em = (float*)(p.ws + WS_S5M + (size_t)l * S5M_LAYER + S5M_E);
        float* Fm = (float*)(p.ws + WS_S5M + (size_t)l * S5M_LAYER + S5M_F);
        float* sp = (float*)lds + 512;
        float* scr = sp + 384;
        float* sci = scr + 1024; float* sbr = sci + 1024; float* sbi = sbr + 1024;
        for (int item = bid_(); item < 256; item += gridDim.x) {
            const int g = item >> 4, tau = item & 15, lg = l * 16 + g;
            float* Tg = Tm + (size_t)g * 256 * 256; float* Eg = Em + (size_t)g * 256 * 128; float* Fg = Fm + (size_t)g * 128 * 256;
            __syncthreads();
            {
                const float4 a0 = *(const float4*)(p.in[15] + (size_t)lg * 1024 + t * 4), a1 = *(const float4*)(p.in[16] + (size_t)lg * 1024 + t * 4);
                const float4 a2 = *(const float4*)(p.in[13] + (size_t)lg * 1024 + t * 4), a3 = *(const float4*)(p.in[14] + (size_t)lg * 1024 + t * 4);
                *(float4*)(scr + t * 4) = a0; *(float4*)(sci + t * 4) = a1; *(float4*)(sbr + t * 4) = a2; *(float4*)(sbi + t * 4) = a3;
            }
            if (t < 64) {
                const float lr = p.in[11][lg * 64 + t], li = p.in[12][lg * 64 + t], dt = expf(p.in[18][lg]);
                const float mag1 = expf(lr * dt), a1r = mag1 * cosf(li * dt), a1i = mag1 * sinf(li * dt);
                const float magt = expf(lr * dt * tau), atr = magt * cosf(li * dt * tau), ati = magt * sinf(li * dt * tau);
                const float zr = a1r - 1.0f, zi = a1i, dn = lr * lr + li * li;
                sp[t] = atr; sp[64 + t] = ati; sp[128 + t] = atr * a1r - ati * a1i; sp[192 + t] = atr * a1i + ati * a1r;
                sp[256 + t] = (zr * lr + zi * li) / dn; sp[320 + t] = (zi * lr - zr * li) / dn;
            }
            __syncthreads();
            {
                const int hh = t >> 4, hp = t & 15;
                float kv = 0.f;
#pragma unroll 8
                for (int pi = 0; pi < 64; ++pi) {
                    const float fr = sp[256 + pi], fi = sp[320 + pi], br = sbr[pi * 16 + hp], bi = sbi[pi * 16 + hp];
                    const float bbr = fr * br - fi * bi, bbi = fr * bi + fi * br;
                    const float cr = scr[hh * 64 + pi], ci = sci[hh * 64 + pi], ar = sp[pi], ai = sp[64 + pi];
                    kv += (cr * ar - ci * ai) * bbr - (cr * ai + ci * ar) * bbi;
                }
                if (tau == 0 && hh == hp) kv += p.in[17][lg * 16 + hh];
                for (int s_ = 0; s_ + tau < 16; ++s_) {
                    const int t_ = s_ + tau;
                    Tg[(size_t)(s_ * 16 + hp) * 256 + t_ * 16 + hh] = kv;
                    if (tau > 0) Tg[(size_t)(t_ * 16 + hp) * 256 + s_ * 16 + hh] = 0.f;
                }
            }
            for (int idx = t; idx < 1024; idx += 256) {
                const int pi = idx >> 4, x = idx & 15;
                {
                    const float fr = sp[256 + pi], fi = sp[320 + pi];
                    const float br = sbr[pi * 16 + x], bi = sbi[pi * 16 + x];
                    const float bbr = fr * br - fi * bi, bbi = fr * bi + fi * br, ar = sp[pi], ai = sp[64 + pi];
                    const size_t ro = (size_t)((15 - tau) * 16 + x) * 128;
                    Eg[ro + pi] = ar * bbr - ai * bbi; Eg[ro + 64 + pi] = ar * bbi + ai * bbr;
                }
                {
                    const float cr = scr[x * 64 + pi], ci = sci[x * 64 + pi];
                    const float ar = sp[128 + pi], ai = sp[192 + pi];
                    Fg[(size_t)pi * 256 + tau * 16 + x] = cr * ar - ci * ai; Fg[(size_t)(64 + pi) * 256 + tau * 16 + x] = -(cr * ai + ci * ar);
                }
            }
        }
    }
}

DI void mlstm_item_simple(const P& p, int l, int item, float* sm) {
    const int b = item >> 4, hd = (item >> 2) & 3, dq = item & 3;
    const int t = tid_();
    const bf16_t* projb = (const bf16_t*)(p.ws + WS_PROJ);
    const float* gates = (const float*)(p.ws + WS_GATES);
    float* hraw = (float*)(p.ws + WS_HRAW);
    const float* cw = p.in[5] + l * 4 * 512; const float* cb = p.in[6] + l * 512;
    float* Q = sm; float* K = Q + 64 * 65; float* Sm = K + 64 * 65; float* V = Sm + 64 * 65; float* C = V + 64 * 16; float* nv = C + 64 * 16;
    float* bc = nv + 64; float* Mt = bc + 64; float* uu = Mt + 64; float* den = uu + 64; float* misc = den + 64;
    __syncthreads();
    for (int i = t; i < 1024; i += 256) C[i] = 0.f;
    if (t < 64) nv[t] = 0.f;
    if (t == 0) misc[0] = 0.f;
    for (int c = 0; c < 32; ++c) {
        __syncthreads();
        const int row0 = b * SEQ + c * 64;
        for (int i = t; i < 8192; i += 256) {
            const int which = i >> 12, tt = (i >> 6) & 63, d = i & 63, ch = which * 256 + hd * 64 + d;
            float a = cb[ch];
#pragma unroll
            for (int j = 0; j < 4; ++j) { const int ts = c * 64 + tt + j - 3; if (ts >= 0) a += bf2f(projb[(size_t)(b * SEQ + ts) * PJ + ch]) * cw[j * 512 + ch]; }
            float y = a / (1.0f + expf(-a));
            if (which) K[tt * 65 + d] = y * 0.125f; else Q[tt * 65 + d] = y;
        }
        for (int i = t; i < 1024; i += 256) { const int tt = i >> 4, d = i & 15; V[i] = bf2f(projb[(size_t)(row0 + tt) * PJ + C_MV + hd * 64 + dq * 16 + d]); }
        if (t < 64) {
            const float ig = gates[(size_t)(row0 + t) * 8 + hd], fg = gates[(size_t)(row0 + t) * 8 + 4 + hd];
            const float lf = fminf(fg, 0.f) - log1pf(expf(-fabsf(fg)));
            float bs = lf;
#pragma unroll
            for (int o = 1; o < 64; o <<= 1) { float v = __shfl_up(bs, o); if (t >= o) bs += v; }
            const float u = ig - bs; float um = u;
#pragma unroll
            for (int o = 1; o < 64; o <<= 1) { float v = __shfl_up(um, o); if (t >= o) um = fmaxf(um, v); }
            bc[t] = bs; uu[t] = u; Mt[t] = fmaxf(misc[0], um);
        }
        __syncthreads();
        for (int i = t; i < 4096; i += 256) {
            const int tt = i >> 6, s = i & 63; float v = 0.f;
            if (s <= tt) { float dsum = 0.f; for (int d = 0; d < 64; ++d) dsum += Q[tt * 65 + d] * K[s * 65 + d]; v = dsum * expf(uu[s] - Mt[tt]); }
            Sm[tt * 65 + s] = v;
        }
        __syncthreads();
        if (t < 64) {
            const float inter = expf(misc[0] - Mt[t]);
            float qn = 0.f, rs = 0.f;
            for (int d = 0; d < 64; ++d) { qn += Q[t * 65 + d] * nv[d]; rs += Sm[t * 65 + d]; }
            den[t] = fmaxf(fabsf(inter * qn + rs), expf(-(bc[t] + Mt[t])));
        }
        __syncthreads();
        for (int i = t; i < 1024; i += 256) {
            const int tt = i >> 4, d = i & 15;
            const float inter = expf(misc[0] - Mt[tt]);
            float a = 0.f, bsum = 0.f;
            for (int k = 0; k < 64; ++k) { a += Q[tt * 65 + k] * C[k * 16 + d]; bsum += Sm[tt * 65 + k] * V[k * 16 + d]; }
            hraw[(size_t)(row0 + tt) * 256 + hd * 64 + dq * 16 + d] = (inter * a + bsum) / den[tt];
        }
        __syncthreads();
        const float Mlast = Mt[63], decay = expf(misc[0] - Mlast);
        for (int i = t; i < 1024; i += 256) {
            const int dk = i >> 4, d = i & 15; float a = 0.f;
            for (int s = 0; s < 64; ++s) a += expf(uu[s] - Mlast) * K[s * 65 + dk] * V[s * 16 + d];
            C[i] = decay * C[i] + a;
        }
        if (t < 64) { float a = 0.f; for (int s = 0; s < 64; ++s) a += expf(uu[s] - Mlast) * K[s * 65 + t]; nv[t] = decay * nv[t] + a; }
        __syncthreads();
        if (t == 0) misc[0] = bc[63] + Mlast;
    }
}

constexpr int ML_QP = 144, ML_TP = 192;
constexpr int ML_Q = 0, ML_K = 9216, ML_KW = 18432, ML_V = 30720, ML_C = 43008, ML_N = 55296, ML_U = 55808, ML_NP = 56064, ML_SS = 57088, ML_DEC = 57600;
DI bf16x8 scale8(u32x4 v, float w) {
    u32x4 o;
    o.x = pk2(bf2f(v.x & 0xffff) * w, bf2f(v.x >> 16) * w); o.y = pk2(bf2f(v.y & 0xffff) * w, bf2f(v.y >> 16) * w);
    o.z = pk2(bf2f(v.z & 0xffff) * w, bf2f(v.z >> 16) * w); o.w = pk2(bf2f(v.w & 0xffff) * w, bf2f(v.w >> 16) * w);
    return __builtin_bit_cast(bf16x8, o);
}
DI bf16x8 tr_frag(const LAS char* p, int hi_off) {
    s16x4 lo = tr_read(p), hi = tr_read(p + hi_off);
    return __builtin_shufflevector(lo, hi, 0, 1, 2, 3, 4, 5, 6, 7);
}
DI void mlstm_mscan(const float4* gscan, size_t rowb, int hd, int lane, float& m_in, float& decay) {
    const int ci = lane & 31;
    const float4 gl = gscan[(rowb + ci * 64 + 63) * 4 + hd];
    float A = gl.x, B = gl.z + gl.x;
#pragma unroll
    for (int o = 1; o < 32; o <<= 1) {
        const float Ap = __shfl_up(A, o), Bp = __shfl_up(B, o);
        if (ci >= o) { B = fmaxf(Bp + A, B); A = Ap + A; }
    }
    const float mafter = fmaxf(A, B);
    const float mprev = __shfl_up(mafter, 1);
    m_in = ci == 0 ? 0.f : mprev;
    decay = __expf(m_in - fmaxf(m_in, gl.z));
}
DI void mlstm_state_item(const P& p, int l, int item, char* lds_generic) {
    LAS char* lds = (LAS char*)lds_generic;
    const int bh = item >> 5, c = item & 31, b = bh >> 2, hd = bh & 3;
    const int t = tid_(), lane = t & 63, w = t >> 6, r = lane & 31, h = lane >> 5;
    const int i16 = lane & 15, q4 = i16 >> 2, pp = i16 & 3, blk = (lane >> 4) & 1;
    const int wd = w & 1, wt = w >> 1;
    const bf16_t* projb = (const bf16_t*)(p.ws + WS_PROJ);
    const bf16_t* mqkc = (const bf16_t*)(p.ws + WS_MQKC);
    const float4* gscan = (const float4*)(p.ws + WS_GSCAN);
    float* dC = (float*)(p.ws + WS_HRAW) + (size_t)item * 4096;
    float* dn = (float*)(p.ws + WS_ZBUF + 8 * MiB) + (size_t)item * 64;
    LAS float* npart = (LAS float*)(lds + ML_NP);
    const int srow = t >> 3, sc16 = t & 7;
    const size_t rowb = (size_t)b * SEQ, row0 = rowb + c * 64;
    const bf16_t* kp = mqkc + (row0 + srow) * 512 + 256 + hd * 64 + sc16 * 8;
    const u32x4 rk0 = *(const u32x4*)kp, rk1 = *(const u32x4*)(kp + 32 * 512);
    const bf16_t* vp = projb + (row0 + srow) * PJ + C_MV + hd * 64 + sc16 * 8;
    const u32x4 rv0 = *(const u32x4*)vp, rv1 = *(const u32x4*)(vp + (size_t)32 * PJ);
    const float4 gl0 = gscan[(row0 + srow) * 4 + hd], gl1 = gscan[(row0 + srow + 32) * 4 + hd], glast = gscan[(row0 + 63) * 4 + hd];
    float m_in, dec; mlstm_mscan(gscan, rowb, hd, lane, m_in, dec);
    const float m = __shfl(m_in, c);
    const float Mlast = fmaxf(m, glast.z);
    __syncthreads();
    {
        const float w0 = __expf(gl0.y - Mlast), w1 = __expf(gl1.y - Mlast);
        *(LAS u32x4*)(lds + ML_V + srow * ML_TP + sc16 * 16) = rv0; *(LAS u32x4*)(lds + ML_V + (srow + 32) * ML_TP + sc16 * 16) = rv1;
        *(LAS bf16x8*)(lds + ML_KW + srow * ML_TP + sc16 * 16) = scale8(rk0, w0); *(LAS bf16x8*)(lds + ML_KW + (srow + 32) * ML_TP + sc16 * 16) = scale8(rk1, w1);
    }
    __syncthreads();
    f32x16 cacc;
#pragma unroll
    for (int e = 0; e < 16; ++e) cacc[e] = 0.f;
#pragma unroll
    for (int k4 = 0; k4 < 4; ++k4) {
        const bf16x8 vf = tr_frag(lds + ML_V + (k4 * 16 + 4 * h + q4) * ML_TP + (wd * 32 + 16 * blk) * 2 + 8 * pp, 8 * ML_TP);
        const bf16x8 kwf = tr_frag(lds + ML_KW + (k4 * 16 + 4 * h + q4) * ML_TP + (wt * 32 + 16 * blk) * 2 + 8 * pp, 8 * ML_TP);
        cacc = __builtin_amdgcn_mfma_f32_32x32x16_bf16(vf, kwf, cacc, 0, 0, 0);
    }
    {
        const int dk = t & 63, qd = t >> 6; float a = 0.f;
#pragma unroll
        for (int s_ = 0; s_ < 16; ++s_) a += bf2f(*(const LAS bf16_t*)(lds + ML_KW + (qd * 16 + s_) * ML_TP + dk * 2));
        npart[qd * 64 + dk] = a;
    }
#pragma unroll
    for (int g = 0; g < 4; ++g) { float4 x = {cacc[4 * g], cacc[4 * g + 1], cacc[4 * g + 2], cacc[4 * g + 3]}; *(float4*)(dC + (wt * 32 + r) * 64 + wd * 32 + 8 * g + 4 * h) = x; }
    __syncthreads();
    if (t < 64) dn[t] = (npart[t] + npart[64 + t]) + (npart[128 + t] + npart[192 + t]);
}
DI void mlstm_out_item(const P& p, int l, int item, char* lds_generic) {
    LAS char* lds = (LAS char*)lds_generic;
    const int bh = item >> 5, c = item & 31, b = bh >> 2, hd = bh & 3;
    const int t = tid_(), lane = t & 63, w = t >> 6, r = lane & 31, h = lane >> 5;
    const int i16 = lane & 15, q4 = i16 >> 2, pp = i16 & 3, blk = (lane >> 4) & 1;
    const int wd = w & 1, wt = w >> 1;
    const bf16_t* projb = (const bf16_t*)(p.ws + WS_PROJ);
    const bf16_t* mqkc = (const bf16_t*)(p.ws + WS_MQKC);
    const float4* gscan = (const float4*)(p.ws + WS_GSCAN);
    const float* dCb = (const float*)(p.ws + WS_HRAW) + (size_t)bh * 32 * 4096;
    const float* dnb = (const float*)(p.ws + WS_ZBUF + 8 * MiB) + (size_t)bh * 32 * 64;
    bf16_t* mix = (bf16_t*)(p.ws + WS_MIX);
    const float* mg = p.in[7] + l * 256 + hd * 64;
    LAS float* nbuf = (LAS float*)(lds + ML_N); LAS float* ubuf2 = (LAS float*)(lds + ML_U); LAS float* ssbuf = (LAS float*)(lds + ML_SS); LAS float* decs = (LAS float*)(lds + ML_DEC);
    const int srow = t >> 3, sc16 = t & 7;
    const float LOG2E = 1.4426950408889634f;
    const size_t rowb = (size_t)b * SEQ, row0 = rowb + c * 64;
    const int tt = wt * 32 + r;
    const bf16_t* qp = mqkc + (row0 + srow) * 512 + hd * 64 + sc16 * 8;
    const u32x4 rq0 = *(const u32x4*)qp, rq1 = *(const u32x4*)(qp + 32 * 512), rk0 = *(const u32x4*)(qp + 256), rk1 = *(const u32x4*)(qp + 32 * 512 + 256);
    const bf16_t* vp = projb + (row0 + srow) * PJ + C_MV + hd * 64 + sc16 * 8;
    const u32x4 rv0 = *(const u32x4*)vp, rv1 = *(const u32x4*)(vp + (size_t)32 * PJ);
    const float4 gl0 = gscan[(row0 + srow) * 4 + hd], gl1 = gscan[(row0 + srow + 32) * 4 + hd], gtt = gscan[(row0 + tt) * 4 + hd];
    const bf16_t* opp = projb + (row0 + tt) * PJ + C_MO + hd * 64 + wd * 32 + 4 * h;
    const u32x2 opre[4] = {*(const u32x2*)(opp), *(const u32x2*)(opp + 8), *(const u32x2*)(opp + 16), *(const u32x2*)(opp + 24)};
    float4 mgr[4];
#pragma unroll
    for (int g = 0; g < 4; ++g) mgr[g] = *(const float4*)(mg + wd * 32 + 4 * h + 8 * g);
    float m_in, dec; mlstm_mscan(gscan, rowb, hd, lane, m_in, dec);
    const float m = __shfl(m_in, c);
    __syncthreads();
    if (t < 32) decs[t] = dec;
    __syncthreads();
    {
        float4 c0 = {0.f, 0.f, 0.f, 0.f}, c1 = c0, c2 = c0, c3 = c0; float nacc = 0.f;
        const float* src = dCb + (t >> 2) * 64 + (t & 3) * 16;
#pragma unroll 4
        for (int cc = 0; cc < c; ++cc) {
            const float d = decs[cc];
            const float4 x0 = *(const float4*)(src), x1 = *(const float4*)(src + 4), x2 = *(const float4*)(src + 8), x3 = *(const float4*)(src + 12);
            c0.x = c0.x * d + x0.x; c0.y = c0.y * d + x0.y; c0.z = c0.z * d + x0.z; c0.w = c0.w * d + x0.w;
            c1.x = c1.x * d + x1.x; c1.y = c1.y * d + x1.y; c1.z = c1.z * d + x1.z; c1.w = c1.w * d + x1.w;
            c2.x = c2.x * d + x2.x; c2.y = c2.y * d + x2.y; c2.z = c2.z * d + x2.z; c2.w = c2.w * d + x2.w;
            c3.x = c3.x * d + x3.x; c3.y = c3.y * d + x3.y; c3.z = c3.z * d + x3.z; c3.w = c3.w * d + x3.w;
            if (t < 64) nacc = nacc * d + dnb[cc * 64 + t];
            src += 4096;
        }
        u32x4 o0, o1;
        o0.x = pk2(c0.x, c0.y); o0.y = pk2(c0.z, c0.w); o0.z = pk2(c1.x, c1.y); o0.w = pk2(c1.z, c1.w);
        o1.x = pk2(c2.x, c2.y); o1.y = pk2(c2.z, c2.w); o1.z = pk2(c3.x, c3.y); o1.w = pk2(c3.z, c3.w);
        *(LAS u32x4*)(lds + ML_C + (t >> 2) * ML_TP + (t & 3) * 32) = o0; *(LAS u32x4*)(lds + ML_C + (t >> 2) * ML_TP + (t & 3) * 32 + 16) = o1;
        if (t < 64) nbuf[t] = nacc;
    }
    const float Mt_t = fmaxf(m, gtt.z), bs_t = gtt.x;
    {
        *(LAS u32x4*)(lds + ML_Q + srow * ML_QP + sc16 * 16) = rq0; *(LAS u32x4*)(lds + ML_Q + (srow + 32) * ML_QP + sc16 * 16) = rq1;
        *(LAS u32x4*)(lds + ML_K + srow * ML_QP + sc16 * 16) = rk0; *(LAS u32x4*)(lds + ML_K + (srow + 32) * ML_QP + sc16 * 16) = rk1;
        *(LAS u32x4*)(lds + ML_V + srow * ML_TP + sc16 * 16) = rv0; *(LAS u32x4*)(lds + ML_V + (srow + 32) * ML_TP + sc16 * 16) = rv1;
        if (sc16 == 0) { ubuf2[srow] = gl0.y * LOG2E; ubuf2[srow + 32] = gl1.y * LOG2E; }
    }
    __syncthreads();
    const float inter = __expf(m - Mt_t);
    bf16x8 qf[4];
#pragma unroll
    for (int ks = 0; ks < 4; ++ks) qf[ks] = *(const LAS bf16x8*)(lds + ML_Q + tt * ML_QP + (ks * 16 + 8 * h) * 2);
    f32x16 acca, accb;
#pragma unroll
    for (int e = 0; e < 16; ++e) { acca[e] = 0.f; accb[e] = 0.f; }
    float rs = 0.f;
    const float Mt2 = Mt_t * LOG2E;
#pragma unroll
    for (int st = 0; st < 2; ++st) {
        if (st <= wt) {
            f32x16 sa;
#pragma unroll
            for (int e = 0; e < 16; ++e) sa[e] = 0.f;
#pragma unroll
            for (int ks = 0; ks < 4; ++ks) {
                const bf16x8 kf = *(const LAS bf16x8*)(lds + ML_K + (st * 32 + r) * ML_QP + (ks * 16 + 8 * h) * 2);
                sa = __builtin_amdgcn_mfma_f32_32x32x16_bf16(kf, qf[ks], sa, 0, 0, 0);
            }
#pragma unroll
            for (int g = 0; g < 4; ++g) {
                const f32x4 u4 = *(const LAS f32x4*)(ubuf2 + st * 32 + 8 * g + 4 * h);
                const float uu[4] = {u4.x, u4.y, u4.z, u4.w};
#pragma unroll
                for (int i = 0; i < 4; ++i) {
                    const int sidx = st * 32 + 8 * g + 4 * h + i;
                    const float dv_ = (sidx <= tt) ? sa[4 * g + i] * __builtin_amdgcn_exp2f(uu[i] - Mt2) : 0.f;
                    sa[4 * g + i] = dv_; rs += dv_;
                }
            }
#pragma unroll
            for (int sk = 0; sk < 2; ++sk) {
                u32x4 pk; pk.x = pk2(sa[8 * sk], sa[8 * sk + 1]); pk.y = pk2(sa[8 * sk + 2], sa[8 * sk + 3]); pk.z = pk2(sa[8 * sk + 4], sa[8 * sk + 5]); pk.w = pk2(sa[8 * sk + 6], sa[8 * sk + 7]);
                const bf16x8 vf = tr_frag(lds + ML_V + ((st * 2 + sk) * 16 + 4 * h + q4) * ML_TP + (wd * 32 + 16 * blk) * 2 + 8 * pp, 8 * ML_TP);
                acca = __builtin_amdgcn_mfma_f32_32x32x16_bf16(vf, __builtin_bit_cast(bf16x8, pk), acca, 0, 0, 0);
            }
        }
    }
#pragma unroll
    for (int ks = 0; ks < 4; ++ks) {
        const bf16x8 cf = tr_frag(lds + ML_C + (ks * 16 + 8 * h + q4) * ML_TP + (wd * 32 + 16 * blk) * 2 + 8 * pp, 4 * ML_TP);
        accb = __builtin_amdgcn_mfma_f32_32x32x16_bf16(cf, qf[ks], accb, 0, 0, 0);
    }
    float qn = 0.f;
#pragma unroll
    for (int ks = 0; ks < 4; ++ks) {
        const f32x4 n0 = *(const LAS f32x4*)(nbuf + ks * 16 + 8 * h), n1 = *(const LAS f32x4*)(nbuf + ks * 16 + 8 * h + 4);
        qn += bf2f((bf16_t)qf[ks][0]) * n0.x + bf2f((bf16_t)qf[ks][1]) * n0.y + bf2f((bf16_t)qf[ks][2]) * n0.z + bf2f((bf16_t)qf[ks][3]) * n0.w
            + bf2f((bf16_t)qf[ks][4]) * n1.x + bf2f((bf16_t)qf[ks][5]) * n1.y + bf2f((bf16_t)qf[ks][6]) * n1.z + bf2f((bf16_t)qf[ks][7]) * n1.w;
    }
    qn = half_swap_sum(qn); rs = half_swap_sum(rs);
    const float hden = fmaxf(fabsf(inter * qn + rs), __expf(-(bs_t + Mt_t)));
    const float ihd = 1.0f / hden;
    float ss = 0.f;
#pragma unroll
    for (int e = 0; e < 16; ++e) { acca[e] = (acca[e] + inter * accb[e]) * ihd; ss += acca[e] * acca[e]; }
    ss = half_swap_sum(ss);
    if (h == 0) ssbuf[wd * 64 + tt] = ss;
    __syncthreads();
    {
        const float rstd = rsqrtf((ssbuf[tt] + ssbuf[64 + tt]) * (1.0f / 64.0f) + EPS);
        bf16_t* op = mix + (row0 + tt) * DM + hd * 64 + wd * 32 + 4 * h;
#pragma unroll
        for (int g = 0; g < 4; ++g) {
            const float4 g4 = mgr[g];
            const float o0 = bf2f(opre[g].x & 0xffff), o1 = bf2f(opre[g].x >> 16), o2 = bf2f(opre[g].y & 0xffff), o3 = bf2f(opre[g].y >> 16);
            u32x2 v;
            v.x = pk2(acca[4 * g] * rstd * g4.x * __builtin_amdgcn_rcpf(1.0f + __expf(-o0)), acca[4 * g + 1] * rstd * g4.y * __builtin_amdgcn_rcpf(1.0f + __expf(-o1)));
            v.y = pk2(acca[4 * g + 2] * rstd * g4.z * __builtin_amdgcn_rcpf(1.0f + __expf(-o2)), acca[4 * g + 3] * rstd * g4.w * __builtin_amdgcn_rcpf(1.0f + __expf(-o3)));
            *(u32x2*)(op + 8 * g) = v;
        }
    }
}

constexpr int KP = 144, VP = 192, ATT_K_BYTES = 64 * KP, ATT_BUF = 64 * KP + 64 * VP;
DI void moba_item(const P& p, int l, int item, char* lds_generic) {
    LAS char* lds = (LAS char*)lds_generic;
    const int b = item >> 7, hd = (item >> 4) & 7, qt = item & 15, qb = qt >> 1;
    const int t = tid_(), lane = t & 63, w = t >> 6, r = lane & 31, h = lane >> 5;
    const int i16 = lane & 15, q4 = i16 >> 2, pp = i16 & 3, blk = (lane >> 4) & 1;
    const bf16_t* projb = (const bf16_t*)(p.ws + WS_PROJ);
    bf16_t* mix = (bf16_t*)(p.ws + WS_MIX);
    const float* kmean = (const float*)(p.ws + WS_KMEAN);
    const size_t rowb = (size_t)b * SEQ;
    const int q0 = qt * 128, qpos = q0 + w * 32 + r;
    bf16x8 qf[4];
    {
        const bf16_t* qp = projb + (rowb + qpos) * PJ + C_AQ + hd * 64 + 8 * h;
#pragma unroll
        for (int ks = 0; ks < 4; ++ks) qf[ks] = *(const bf16x8*)(qp + ks * 16);
    }
    unsigned mask = 0;
    {
        float gate[8];
#pragma unroll
        for (int n = 0; n < 8; ++n) {
            float sacc = 0.f;
            if (n < qb) {
                const float* km = kmean + ((size_t)((b * 8 + n) * 8 + hd)) * 64 + 8 * h;
#pragma unroll
                for (int ks = 0; ks < 4; ++ks)
#pragma unroll
                    for (int j = 0; j < 8; ++j) sacc += bf2f((bf16_t)qf[ks][j]) * km[ks * 16 + j];
            }
            gate[n] = half_swap_sum(sacc);
        }
#pragma unroll
        for (int it = 0; it < 3; ++it) {
            int best = -1; float bv = -INFINITY;
#pragma unroll
            for (int n = 0; n < 8; ++n) if (n < qb && !((mask >> n) & 1u) && gate[n] > bv) { bv = gate[n]; best = n; }
            if (best >= 0) mask |= 1u << best;
        }
    }
    const int nown = ((q0 & 255) >> 6) + 2, ntiles = nown + qb * 4;
    f32x16 o0, o1;
#pragma unroll
    for (int e = 0; e < 16; ++e) { o0[e] = 0.f; o1[e] = 0.f; }
    float m = -INFINITY, lsum = 0.f;
    const int srow = t >> 3, sc16 = t & 7;
    struct KVStage { u32x4 k0, k1, v0, v1; };
    auto key0_of = [&](int it) { return it < nown ? qb * 256 + it * 64 : ((it - nown) >> 2) * 256 + ((it - nown) & 3) * 64; };
    auto gload = [&](KVStage& S, int it) {
        const int key0 = key0_of(it < ntiles ? it : ntiles - 1);
        const bf16_t* base = projb + (rowb + key0 + srow) * PJ + hd * 64 + sc16 * 8;
        S.k0 = *(const u32x4*)(base + C_AK); S.k1 = *(const u32x4*)(base + (size_t)32 * PJ + C_AK);
        S.v0 = *(const u32x4*)(base + C_AV); S.v1 = *(const u32x4*)(base + (size_t)32 * PJ + C_AV);
    };
    auto sstore = [&](const KVStage& S, int buf) {
        LAS char* sK = lds + buf * ATT_BUF; LAS char* sV = sK + ATT_K_BYTES;
        *(LAS u32x4*)(sK + srow * KP + sc16 * 16) = S.k0; *(LAS u32x4*)(sK + (srow + 32) * KP + sc16 * 16) = S.k1;
        *(LAS u32x4*)(sV + srow * VP + sc16 * 16) = S.v0; *(LAS u32x4*)(sV + (srow + 32) * VP + sc16 * 16) = S.v1;
    };
    KVStage KA, KB;
    __syncthreads();
    gload(KA, 0); gload(KB, 1); sstore(KA, 0); __syncthreads();
    auto step = [&](int it, KVStage& SL, const KVStage& SS) {
        gload(SL, it + 2);
        {
            const LAS char* sK = lds + (it & 1) * ATT_BUF; const LAS char* sV = sK + ATT_K_BYTES;
            const int key0 = key0_of(it), blockn = key0 >> 8;
            f32x16 s0, s1;
#pragma unroll
            for (int e = 0; e < 16; ++e) { s0[e] = 0.f; s1[e] = 0.f; }
#pragma unroll
            for (int ks = 0; ks < 4; ++ks) {
                const bf16x8 k0 = *(const LAS bf16x8*)(sK + r * KP + (ks * 16 + 8 * h) * 2);
                const bf16x8 k1 = *(const LAS bf16x8*)(sK + (32 + r) * KP + (ks * 16 + 8 * h) * 2);
                s0 = __builtin_amdgcn_mfma_f32_32x32x16_bf16(k0, qf[ks], s0, 0, 0, 0);
                s1 = __builtin_amdgcn_mfma_f32_32x32x16_bf16(k1, qf[ks], s1, 0, 0, 0);
            }
            const bool own = (blockn == qb);
            const bool active = own || ((mask >> blockn) & 1u);
            if (!active) {
#pragma unroll
                for (int e = 0; e < 16; ++e) { s0[e] = -INFINITY; s1[e] = -INFINITY; }
            } else if (own && key0 + 63 > q0 + w * 32) {
#pragma unroll
                for (int e = 0; e < 16; ++e) {
                    const int kk = key0 + (e & 3) + 8 * (e >> 2) + 4 * h;
                    if (kk > qpos) s0[e] = -INFINITY;
                    if (kk + 32 > qpos) s1[e] = -INFINITY;
                }
            }
            float mx = fmaxf(s0[0], s1[0]);
#pragma unroll
            for (int e = 1; e < 16; ++e) mx = fmaxf(mx, fmaxf(s0[e], s1[e]));
            mx = half_swap_max(mx);
            const float mn = fmaxf(m, mx);
            const float alpha = __builtin_amdgcn_exp2f(m - mn);
            m = mn;
            float ps = 0.f;
#pragma unroll
            for (int e = 0; e < 16; ++e) { s0[e] = __builtin_amdgcn_exp2f(s0[e] - mn); s1[e] = __builtin_amdgcn_exp2f(s1[e] - mn); ps += s0[e] + s1[e]; }
            lsum = lsum * alpha + ps;
#pragma unroll
            for (int e = 0; e < 16; ++e) { o0[e] *= alpha; o1[e] *= alpha; }
#pragma unroll
            for (int st = 0; st < 2; ++st)
#pragma unroll
                for (int sk = 0; sk < 2; ++sk) {
                    u32x4 pk;
                    if (st == 0) { pk.x = pk2(s0[8 * sk], s0[8 * sk + 1]); pk.y = pk2(s0[8 * sk + 2], s0[8 * sk + 3]); pk.z = pk2(s0[8 * sk + 4], s0[8 * sk + 5]); pk.w = pk2(s0[8 * sk + 6], s0[8 * sk + 7]); }
                    else         { pk.x = pk2(s1[8 * sk], s1[8 * sk + 1]); pk.y = pk2(s1[8 * sk + 2], s1[8 * sk + 3]); pk.z = pk2(s1[8 * sk + 4], s1[8 * sk + 5]); pk.w = pk2(s1[8 * sk + 6], s1[8 * sk + 7]); }
                    const bf16x8 pf = __builtin_bit_cast(bf16x8, pk);
                    const LAS char* vb = sV + (st * 32 + sk * 16 + 4 * h + q4) * VP + (16 * blk) * 2 + 8 * pp;
                    {
                        s16x4 lo = tr_read(vb), hi = tr_read(vb + 8 * VP);
                        const bf16x8 vf = __builtin_shufflevector(lo, hi, 0, 1, 2, 3, 4, 5, 6, 7);
                        o0 = __builtin_amdgcn_mfma_f32_32x32x16_bf16(vf, pf, o0, 0, 0, 0);
                    }
                    {
                        s16x4 lo = tr_read(vb + 64), hi = tr_read(vb + 64 + 8 * VP);
                        const bf16x8 vf = __builtin_shufflevector(lo, hi, 0, 1, 2, 3, 4, 5, 6, 7);
                        o1 = __builtin_amdgcn_mfma_f32_32x32x16_bf16(vf, pf, o1, 0, 0, 0);
                    }
                }
        }
        sstore(SS, (it + 1) & 1);
        __syncthreads();
    };
    for (int it = 0; it < ntiles; it += 2) { step(it, KA, KB); if (it + 1 < ntiles) step(it + 1, KB, KA); }
    const float il = 1.0f / half_swap_sum(lsum);
    float ss = 0.f;
#pragma unroll
    for (int e = 0; e < 16; ++e) { o0[e] *= il; o1[e] *= il; ss += o0[e] * o0[e] + o1[e] * o1[e]; }
    ss = half_swap_sum(ss);
    const float rstd = rsqrtf(ss * (1.0f / 64.0f) + EPS);
    const float* og = p.in[10] + (l * 8 + hd) * 64 + 4 * h;
    bf16_t* op = mix + (rowb + qpos) * DM + 256 + hd * 64 + 4 * h;
#pragma unroll
    for (int g = 0; g < 4; ++g) {
        const float4 g0 = *(const float4*)(og + 8 * g), g1 = *(const float4*)(og + 32 + 8 * g);
        u32x2 v0, v1;
        v0.x = pk2(o0[4 * g] * rstd * g0.x, o0[4 * g + 1] * rstd * g0.y); v0.y = pk2(o0[4 * g + 2] * rstd * g0.z, o0[4 * g + 3] * rstd * g0.w);
        v1.x = pk2(o1[4 * g] * rstd * g1.x, o1[4 * g + 1] * rstd * g1.y); v1.y = pk2(o1[4 * g + 2] * rstd * g1.z, o1[4 * g + 3] * rstd * g1.w);
        *(u32x2*)(op + 8 * g) = v0; *(u32x2*)(op + 32 + 8 * g) = v1;
    }
}

DI void s5_item_simple(const P& p, int l, int item, float* sm) {
    const int t = tid_(), lane = t & 63, w = t >> 6;
    const int bg = item * 4 + w, b = bg >> 4, g = bg & 15;
    const bf16_t* projb = (const bf16_t*)(p.ws + WS_PROJ);
    float* zbuf = (float*)(p.ws + WS_ZBUF);
    float* xr = sm + w * (2 * 16 * 65); float* xi = xr + 16 * 65;
    const int lg = l * 16 + g;
    const float lr = p.in[11][lg * 64 + lane], li = p.in[12][lg * 64 + lane];
    const float dt = expf(p.in[18][lg]);
    const float mag = expf(lr * dt);
    const float are = mag * cosf(li * dt), aim = mag * sinf(li * dt);
    const float zr = are - 1.0f, zi = aim, dn = lr * lr + li * li;
    const float fr = (zr * lr + zi * li) / dn, fi = (zi * lr - zr * li) / dn;
    float bbr[16], bbi[16];
#pragma unroll
    for (int hh = 0; hh < 16; ++hh) {
        const float br = p.in[13][((size_t)lg * 64 + lane) * 16 + hh], bi = p.in[14][((size_t)lg * 64 + lane) * 16 + hh];
        bbr[hh] = fr * br - fi * bi; bbi[hh] = fr * bi + fi * br;
    }
    const float* cre = p.in[15] + (size_t)lg * 16 * 64; const float* cim = p.in[16] + (size_t)lg * 16 * 64;
    const float* dd = p.in[17] + lg * 16;
    float sr = 0.f, si = 0.f;
    __syncthreads();
    for (int c = 0; c < SEQ / 16; ++c) {
        const size_t row0 = (size_t)b * SEQ + c * 16;
        for (int tt = 0; tt < 16; ++tt) {
            const bf16_t* up = projb + (row0 + tt) * PJ + C_SU + g * 16;
            uint4 u0 = *(const uint4*)up, u1 = *(const uint4*)(up + 8);
            float u[16] = {bf2f(u0.x & 0xffff), bf2f(u0.x >> 16), bf2f(u0.y & 0xffff), bf2f(u0.y >> 16), bf2f(u0.z & 0xffff), bf2f(u0.z >> 16), bf2f(u0.w & 0xffff), bf2f(u0.w >> 16),
                           bf2f(u1.x & 0xffff), bf2f(u1.x >> 16), bf2f(u1.y & 0xffff), bf2f(u1.y >> 16), bf2f(u1.z & 0xffff), bf2f(u1.z >> 16), bf2f(u1.w & 0xffff), bf2f(u1.w >> 16)};
            float br = 0.f, bi = 0.f;
#pragma unroll
            for (int hh = 0; hh < 16; ++hh) { br += bbr[hh] * u[hh]; bi += bbi[hh] * u[hh]; }
            const float nr = are * sr - aim * si + br, ni = are * si + aim * sr + bi;
            sr = nr; si = ni;
            xr[tt * 65 + lane] = sr; xi[tt * 65 + lane] = si;
        }
        __syncthreads();
        {
            const int tt = lane >> 2, hq = lane & 3;
            float y[4] = {0.f, 0.f, 0.f, 0.f};
            for (int pp = 0; pp < 64; ++pp) {
                const float a = xr[tt * 65 + pp], bq = xi[tt * 65 + pp];
#pragma unroll
                for (int j = 0; j < 4; ++j) y[j] += cre[(hq * 4 + j) * 64 + pp] * a - cim[(hq * 4 + j) * 64 + pp] * bq;
            }
#pragma unroll
            for (int j = 0; j < 4; ++j) {
                const int hh = hq * 4 + j;
                float v = y[j] + dd[hh] * bf2f(projb[(row0 + tt) * PJ + C_SU + g * 16 + hh]);
                const float inner = 0.7978845608028654f * (v + 0.044715f * v * v * v);
                const float th = 1.0f - 2.0f / (expf(2.0f * inner) + 1.0f);
                zbuf[(row0 + tt) * 256 + g * 16 + hh] = 0.5f * v * (1.0f + th);
            }
        }
        __syncthreads();
    }
}

DI void s5_item(const P& p, int l, int item, char* lds) {
    const int b = item >> 4, g = item & 15, lg = l * 16 + g;
    const int t = tid_();
    const bf16_t* projb = (const bf16_t*)(p.ws + WS_PROJ);
    bf16_t* zbuf = (bf16_t*)(p.ws + WS_ZBUF);
    const float* Tg = (const float*)(p.ws + WS_S5M + (size_t)l * S5M_LAYER) + (size_t)g * 256 * 256;
    const float* Eg = (const float*)(p.ws + WS_S5M + (size_t)l * S5M_LAYER + S5M_E) + (size_t)g * 256 * 128;
    const float* Fg = (const float*)(p.ws + WS_S5M + (size_t)l * S5M_LAYER + S5M_F) + (size_t)g * 128 * 256;
    float* eloc = (float*)(p.ws + WS_ELOC) + ((size_t)l * 128 + item) * 128 * 128;
    bf16_t* carr = (bf16_t*)(p.ws + WS_CARR) + ((size_t)l * 128 + item) * 128 * 128;
    const size_t rowb = (size_t)b * SEQ;
    const bf16_t* ua0 = projb + (rowb + (size_t)(t >> 2) * 16 + ((t & 3) >> 1)) * PJ + C_SU + g * 16 + (t & 1) * 8;
    const bf16_t* ua1 = ua0 + (size_t)64 * 16 * PJ;
    {
        GSeg g1{ua0, ua1, 2 * PJ, Eg + (size_t)(t >> 5) * 128 + (t & 31) * 4, 128, 8}; GSeg g2 = g1; g2.KT = 0;
        EpiF32 epi{eloc, 128};
        gemm_tile2(g1, g2, lds, epi);
    }
    __syncthreads();
    if (t < 64) {
        const float lr = p.in[11][lg * 64 + t], li = p.in[12][lg * 64 + t], dt = expf(p.in[18][lg]);
        const float mag = expf(lr * dt * 16.0f), ar = mag * cosf(li * dt * 16.0f), ai = mag * sinf(li * dt * 16.0f);
        float sr = 0.f, si = 0.f;
        for (int bt = 0; bt < 8; ++bt) {
            float er[16], ei[16];
#pragma unroll
            for (int i = 0; i < 16; ++i) { er[i] = eloc[(size_t)(bt * 16 + i) * 128 + t]; ei[i] = eloc[(size_t)(bt * 16 + i) * 128 + 64 + t]; }
#pragma unroll
            for (int i = 0; i < 16; ++i) {
                carr[(size_t)(bt * 16 + i) * 128 + t] = f2bf(sr); carr[(size_t)(bt * 16 + i) * 128 + 64 + t] = f2bf(si);
                const float nr = ar * sr - ai * si + er[i], ni = ar * si + ai * sr + ei[i];
                sr = nr; si = ni;
            }
        }
    }
    __syncthreads();
    const bf16_t* ca0 = carr + (size_t)(t >> 2) * 128 + (t & 3) * 8;
#pragma unroll 1
    for (int nt = 0; nt < 2; ++nt) {
        GSeg g1{ua0, ua1, 2 * PJ, Tg + (size_t)(t >> 5) * 256 + nt * 128 + (t & 31) * 4, 256, 4 * (nt + 1)};
        GSeg g2{ca0, ca0 + (size_t)64 * 128, BK, Fg + (size_t)(t >> 5) * 256 + nt * 128 + (t & 31) * 4, 256, 4};
        EpiS5Y epi{zbuf + rowb * 256 + g * 16, nt * 128};
        gemm_tile2(g1, g2, lds, epi);
    }
}

#ifndef PROBE_SUB
#define PROBE_SUB 0
#endif
DI void phase_mix(const P& p, int l, char* lds, unsigned long long& tsub) {
    for (int item = bid_(); item < 128 + 1024 + 1024; item += gridDim.x) {
        const unsigned long long ts0 = PROBE_SUB ? wall_clock64() : 0ull;
        const int kind = item >= 1152 ? 1 : (item < 128 ? 2 : 4);
        if (item >= 1152) mlstm_state_item(p, l, item - 1152, lds);
        else if (item < 128) s5_item(p, l, item, lds);
        else {
            const int i2 = item - 128;
            const int qo = i2 >> 6, bh = i2 & 63;
            moba_item(p, l, (bh << 4) | (15 - qo), lds);
        }
        if (PROBE_SUB & kind) tsub += wall_clock64() - ts0;
    }
}

DI void phase_glu(const P& p, int l, char* lds) {
    const int t = tid_();
    const bf16_t* zb = (const bf16_t*)(p.ws + WS_ZBUF);
    bf16_t* mix = (bf16_t*)(p.ws + WS_MIX);
    const float* gw = p.in[19] + (size_t)l * 256 * 256; const float* gb = p.in[20] + l * 256; const float* sg = p.in[21] + l * 256;
    for (int tile = bid_(); tile < 128 * 2; tile += gridDim.x) {
        const int mt = tile >> 1, nt = tile & 1;
        const bf16_t* a0 = zb + (size_t)(mt * 128 + (t >> 2)) * 256 + (t & 3) * 8;
        const float* b0 = gw + (size_t)(t >> 5) * 256 + nt * 128 + (t & 31) * 4;
        EpiGlu epi{zb + (size_t)mt * 128 * 256 + nt * 128, mix + (size_t)mt * 128 * DM + 768 + nt * 128, gb + nt * 128, sg + nt * 128};
        gemm_tile(a0, a0 + (size_t)64 * 256, b0, 256, 256 / BK, lds, epi);
    }
    for (int item = bid_(); item < 1024; item += gridDim.x) mlstm_out_item(p, l, ((item & 31) << 5) | (31 - (item >> 5)), lds);
}

DI void phase_outproj(const P& p, int l, char* lds) {
    const int t = tid_();
    const bf16_t* mix = (const bf16_t*)(p.ws + WS_MIX);
    float* xres = (float*)(p.ws + WS_XRES);
    const bf16_t* woutb = (const bf16_t*)(p.ws + WS_WOUTB) + (size_t)l * DM * DM;
    const float* xin = (l == 0) ? p.in[0] : xres;
    const int vx = bid_() & 7, vj = bid_() >> 3, nj = (gridDim.x - vx + 7) >> 3;
    for (int j = vj; j < 64; j += nj) {
        const int mt = vx * 16 + (j >> 2), nt = j & 3;
        const bf16_t* ar = mix + (size_t)(mt * 128 + (t >> 2)) * DM + (t & 3) * 8;
        GSeg4 g1{ar, ar + (size_t)64 * DM, 32, woutb + (size_t)(t >> 5) * DM + nt * 256 + (t & 31) * 8, DM, DM / 32}; GSeg4 g2 = g1; g2.KT = 0;
        const size_t o = (size_t)mt * 128 * DM + nt * 256;
        Epi4Resid epi{xres + o, xin + o, (size_t)DM};
        gemm4(g1, g2, lds, epi);
    }
}

DI void phase_norm2(const P& p, int l, char* lds) {
    const int t = tid_(), lane = t & 63, w = t >> 6;
    const float* xres = (const float*)(p.ws + WS_XRES);
    bf16_t* hbuf = (bf16_t*)(p.ws + WS_HBUF);
    const float* g2 = p.in[23] + l * DM;
    const float* wg = p.in[24] + (size_t)l * DM * 4; const float* bg = p.in[25] + l * 4;
    const float* we = p.in[26] + (size_t)l * DM * NE; const float* be = p.in[27] + l * NE;
    int4* rinfo = (int4*)(p.ws + WS_RINFO); int* hist = (int*)(p.ws + WS_HIST);
    int* lh = (int*)(lds + 65536 - 16 - 128);
    if (t < NE) lh[t] = 0;
    float* xs = (float*)lds;
    float* pe = xs + 8 * XS_P;
    for (int rb = bid_(); rb < T / 8; rb += gridDim.x) {
        __syncthreads();
#pragma unroll
        for (int rr = 0; rr < 2; ++rr) {
            const int lr = w * 2 + rr, row = rb * 8 + lr;
            float4 v[4];
#pragma unroll
            for (int i = 0; i < 4; ++i) v[i] = *(const float4*)(xres + (size_t)row * DM + i * 256 + lane * 4);
            float ss = 0.f;
#pragma unroll
            for (int i = 0; i < 4; ++i) ss += v[i].x * v[i].x + v[i].y * v[i].y + v[i].z * v[i].z + v[i].w * v[i].w;
            ss = wave_sum(ss);
            const float rstd = rsqrtf(ss * (1.0f / DM) + EPS);
#pragma unroll
            for (int i = 0; i < 4; ++i) {
                const int k0 = i * 256 + lane * 4;
                const float4 g = *(const float4*)(g2 + k0);
                float4 hv = {v[i].x * rstd * g.x, v[i].y * rstd * g.y, v[i].z * rstd * g.z, v[i].w * rstd * g.w};
                uint2 o; o.x = pk2(hv.x, hv.y); o.y = pk2(hv.z, hv.w);
                *(uint2*)(hbuf + (size_t)row * DM + k0) = o;
                *(float4*)(xs + lr * XS_P + k0) = hv;
            }
        }
        __syncthreads();
        {
            float* wb = pe + 1536;
            const float* wep = we + t * 4; const float* wgp = wg + (t & 127) * 4;
            float4 re0 = *(const float4*)(wep), re1 = *(const float4*)(wep + 1024), re2 = *(const float4*)(wep + 2048), re3 = *(const float4*)(wep + 3072);
            float4 rg = *(const float4*)(wgp);
            const int kq = lane >> 4, jc = lane & 15;
            f32x4 d0 = {0.f, 0.f, 0.f, 0.f}, d1 = d0, d2 = d0;
#pragma unroll 1
            for (int c = 0; c < 8; ++c) {
                {
                    const int e0 = t * 4;
#pragma unroll
                    for (int i = 0; i < 4; ++i) {
                        const int e = e0 + i * 1024, kk = e >> 5, jj = e & 31;
                        *(float4*)(wb + kk * 48 + jj) = (i == 0 ? re0 : i == 1 ? re1 : i == 2 ? re2 : re3);
                    }
                    if (t < 128) *(float4*)(wb + t * 48 + 32) = rg;
                }
                __syncthreads();
                if (c + 1 < 8) {
                    const float* q = wep + (size_t)(c + 1) * 4096;
                    re0 = *(const float4*)(q); re1 = *(const float4*)(q + 1024); re2 = *(const float4*)(q + 2048); re3 = *(const float4*)(q + 3072);
                    rg = *(const float4*)(wgp + (size_t)(c + 1) * 512);
                }
                const float* xa = xs + (lane & 7) * XS_P + c * 128 + w * 32 + kq;
                const float* wbp = wb + (w * 32 + kq) * 48 + jc;
#pragma unroll
                for (int ks = 0; ks < 8; ++ks) {
                    const float av = xa[ks * 4];
                    const float b0 = wbp[ks * 4 * 48], b1 = wbp[ks * 4 * 48 + 16], b2 = wbp[ks * 4 * 48 + 32];
                    d0 = __builtin_amdgcn_mfma_f32_16x16x4f32(av, b0, d0, 0, 0, 0);
                    d1 = __builtin_amdgcn_mfma_f32_16x16x4f32(av, b1, d1, 0, 0, 0);
                    d2 = __builtin_amdgcn_mfma_f32_16x16x4f32(av, b2, d2, 0, 0, 0);
                }
                __syncthreads();
            }
            if (lane < 32) {
#pragma unroll
                for (int rg_ = 0; rg_ < 4; ++rg_) {
                    const int row = 4 * kq + rg_;
                    pe[(w * 8 + row) * 48 + jc] = d0[rg_]; pe[(w * 8 + row) * 48 + 16 + jc] = d1[rg_]; pe[(w * 8 + row) * 48 + 32 + jc] = d2[rg_];
                }
            }
        }
        __syncthreads();
        if (t < 8) {
            const int row = rb * 8 + t;
            float gl[4];
#pragma unroll
            for (int j = 0; j < 4; ++j) {
                gl[j] = bg[j] + ((pe[(0 * 8 + t) * 48 + 32 + j] + pe[(1 * 8 + t) * 48 + 32 + j]) + (pe[(2 * 8 + t) * 48 + 32 + j] + pe[(3 * 8 + t) * 48 + 32 + j]));
            }
            int gs = 0; float gm = gl[0];
#pragma unroll
            for (int j = 1; j < 4; ++j) if (gl[j] > gm) { gm = gl[j]; gs = j; }
            float se = 0.f;
#pragma unroll
            for (int j = 0; j < 4; ++j) se += expf(gl[j] - gm);
            const float pgv = 1.0f / se;
            float ev[8];
#pragma unroll
            for (int j = 0; j < 8; ++j) { const int cj = gs * 8 + j; ev[j] = be[cj] + ((pe[(0 * 8 + t) * 48 + cj] + pe[(1 * 8 + t) * 48 + cj]) + (pe[(2 * 8 + t) * 48 + cj] + pe[(3 * 8 + t) * 48 + cj])); }
            int i1 = 0; float v1 = ev[0];
#pragma unroll
            for (int j = 1; j < 8; ++j) if (ev[j] > v1) { v1 = ev[j]; i1 = j; }
            int i2 = (i1 + 1) & 7; float v2 = -INFINITY;
#pragma unroll
            for (int j = 0; j < 8; ++j) if (j != i1 && ev[j] > v2) { v2 = ev[j]; i2 = j; }
            const float ex = expf(v2 - v1);
            const float w1 = pgv / (1.0f + ex), w2 = pgv * ex / (1.0f + ex);
            const int e1 = gs * 8 + i1, e2 = gs * 8 + i2;
            atomicAdd(&lh[e1], 1); atomicAdd(&lh[e2], 1);
            rinfo[row] = make_int4(e1, e2, __float_as_int(w1), __float_as_int(w2));
        }
    }
    __syncthreads();
    if (t < NE) hist[((size_t)l * 1024 + bid_()) * NE + t] = lh[t];
}

DI void phase_assign(const P& p, int l, char* lds) {
    const int t = tid_(), myb = bid_(), nb = gridDim.x;
    const int* hist = (const int*)(p.ws + WS_HIST) + (size_t)l * 1024 * NE;
    const int4* rinfo = (const int4*)(p.ws + WS_RINFO);
    int* cnt = (int*)(p.ws + WS_CTL) + l * NE;
    int* tokl = (int*)(p.ws + WS_TOKL); float* wl = (float*)(p.ws + WS_WL); int4* tinfo = (int4*)(p.ws + WS_TINFO);
    int* part = (int*)lds;
    int* pre = part + 512;
    int* le1 = pre + 32;
    int* le2 = le1 + 64;
    {
        const int e = t & 31, prt = t >> 5;
        int a = 0, tot = 0;
        for (int b = prt; b < nb; b += 8) { const int v = hist[(size_t)b * NE + e]; tot += v; if (b < myb) a += v; }
        part[prt * 32 + e] = a; part[256 + prt * 32 + e] = tot;
    }
    __syncthreads();
    if (t < 32) {
        int a = 0, tot = 0;
#pragma unroll
        for (int q = 0; q < 8; ++q) { a += part[q * 32 + t]; tot += part[256 + q * 32 + t]; }
        pre[t] = a;
        if (myb == 0) cnt[t] = tot;
    }
    const int nit = (T / 8 - myb + nb - 1) / nb;
    int4 ri = make_int4(0, 0, 0, 0); int row = -1;
    if (t < nit * 8 && t < 64) { row = (myb + (t >> 3) * nb) * 8 + (t & 7); ri = rinfo[row]; le1[t] = ri.x; le2[t] = ri.y; }
    __syncthreads();
    if (row >= 0) {
        int r1 = 0, r2 = 0;
        for (int j = 0; j < t; ++j) { const int a = le1[j], b2 = le2[j]; r1 += (a == ri.x) + (b2 == ri.x); r2 += (a == ri.y) + (b2 == ri.y); }
        const int s1 = pre[ri.x] + r1, s2 = pre[ri.y] + r2;
        tokl[ri.x * ECAP + s1] = row; wl[ri.x * ECAP + s1] = __int_as_float(ri.z);
        tokl[ri.y * ECAP + s2] = row; wl[ri.y * ECAP + s2] = __int_as_float(ri.w);
        tinfo[row] = make_int4(ri.x, s1, ri.y, s2);
    }
}

DI void phase_moe1(const P& p, int l, char* lds) {
    const int t = tid_();
    const bf16_t* hbuf = (const bf16_t*)(p.ws + WS_HBUF);
    bf16_t* hmoe = (bf16_t*)(p.ws + WS_HMOE);
    const int* cnt = (const int*)(p.ws + WS_CTL) + l * NE;
    const int* tokl = (const int*)(p.ws + WS_TOKL);
    int* stp = (int*)(lds + GEMM_LDS);
    moe_prefix(cnt, stp);
    const int vx = bid_() & 7, vj = bid_() >> 3, nj = (gridDim.x - vx + 7) >> 3;
    int tx[5]; tx[0] = 0;
#pragma unroll
    for (int i = 0; i < 4; ++i) tx[i + 1] = tx[i] + (stp[vx + 8 * i + 1] - stp[vx + 8 * i]) * 8;
    for (int tile = vj; tile < tx[4]; tile += nj) {
        const int ei = (tile >= tx[1]) + (tile >= tx[2]) + (tile >= tx[3]);
        const int e = vx + 8 * ei, tbase = ei == 0 ? 0 : (ei == 1 ? tx[1] : (ei == 2 ? tx[2] : tx[3]));
        const int te = stp[e + 1] - stp[e], local = tile - tbase, nt = local / te, mt = local % te;
        const int ne = cnt[e];
        const int i0 = mt * 128 + (t >> 2), i1 = i0 + 64;
        const int tok0 = tokl[e * ECAP + (i0 < ne ? i0 : 0)], tok1 = tokl[e * ECAP + (i1 < ne ? i1 : 0)];
        const bf16_t* a0 = hbuf + (size_t)tok0 * DM + (t & 3) * 8;
        const bf16_t* a1 = hbuf + (size_t)tok1 * DM + (t & 3) * 8;
        const int vcol = (t & 31) * 4, wn = vcol >> 6, tn = (vcol >> 5) & 1, rr = vcol & 31;
        const float* wsrc = (tn ? p.in[29] : p.in[28]) + ((size_t)l * NE + e) * DM * DE;
        const float* b0 = wsrc + (size_t)(t >> 5) * DE + nt * 64 + wn * 32 + rr;
        EpiGateUp epi{hmoe + (size_t)(stp[e] + mt) * 128 * DE + nt * 64};
        gemm_tile(a0, a1, b0, DE, DM / BK, lds, epi);
    }
}

DI void phase_moe2(const P& p, int l, char* lds) {
    const int t = tid_();
    const bf16_t* hmoe = (const bf16_t*)(p.ws + WS_HMOE);
    bf16_t* ymoe = (bf16_t*)(p.ws + WS_YMOE);
    const int* cnt = (const int*)(p.ws + WS_CTL) + l * NE;
    const float* wl = (const float*)(p.ws + WS_WL);
    int* stp = (int*)(lds + GEMM_LDS);
    moe_prefix(cnt, stp);
    const int vx = bid_() & 7, vj = bid_() >> 3, nj = (gridDim.x - vx + 7) >> 3;
    int tx[5]; tx[0] = 0;
#pragma unroll
    for (int i = 0; i < 4; ++i) tx[i + 1] = tx[i] + (stp[vx + 8 * i + 1] - stp[vx + 8 * i]) * 8;
    for (int tile = vj; tile < tx[4]; tile += nj) {
        const int ei = (tile >= tx[1]) + (tile >= tx[2]) + (tile >= tx[3]);
        const int e = vx + 8 * ei, tbase = ei == 0 ? 0 : (ei == 1 ? tx[1] : (ei == 2 ? tx[2] : tx[3]));
        const int te = stp[e + 1] - stp[e], local = tile - tbase, nt = local / te, mt = local % te;
        const int ne = cnt[e];
        const size_t r0 = (size_t)(stp[e] + mt) * 128;
        const bf16_t* a0 = hmoe + (r0 + (t >> 2)) * DE + (t & 3) * 8;
        const float* b0 = p.in[30] + ((size_t)l * NE + e) * DE * DM + (size_t)(t >> 5) * DM + nt * 128 + (t & 31) * 4;
        EpiDown epi{ymoe + r0 * DM + nt * 128, wl + e * ECAP + mt * 128, ne - mt * 128};
        gemm_tile(a0, a0 + (size_t)64 * DE, b0, DM, DE / BK, lds, epi);
    }
}

DI void phase_final(const P& p, char* lds) {
    const int lane = tid_() & 63;
    const int gw = bid_() * 4 + (tid_() >> 6), nw = gridDim.x * 4;
    const float* xres = (const float*)(p.ws + WS_XRES);
    const bf16_t* ymoe = (const bf16_t*)(p.ws + WS_YMOE);
    const int4* tinfo = (const int4*)(p.ws + WS_TINFO);
    int* stp = (int*)lds;
    moe_prefix((const int*)(p.ws + WS_CTL) + NE, stp);
    for (int row = gw; row < T; row += nw) {
        int4 ti = tinfo[row];
        const bf16_t* y0 = ymoe + (size_t)(stp[ti.x] * 128 + ti.y) * DM;
        const bf16_t* y1 = ymoe + (size_t)(stp[ti.z] * 128 + ti.w) * DM;
#pragma unroll
        for (int i = 0; i < 4; ++i) {
            float4 v = *(const float4*)(xres + (size_t)row * DM + i * 256 + lane * 4);
            uint2 a = *(const uint2*)(y0 + i * 256 + lane * 4), b = *(const uint2*)(y1 + i * 256 + lane * 4);
            v.x += bf2f(a.x & 0xffff) + bf2f(b.x & 0xffff); v.y += bf2f(a.x >> 16) + bf2f(b.x >> 16);
            v.z += bf2f(a.y & 0xffff) + bf2f(b.y & 0xffff); v.w += bf2f(a.y >> 16) + bf2f(b.y >> 16);
            *(float4*)(p.out + (size_t)row * DM + i * 256 + lane * 4) = v;
        }
    }
}

#define XB_TMO      128
#define XB_XCNT(j)  (256  + 64 * (j))
#define XB_XSUB(j)  (1280 + 64 * (j))
#define XB_XGEN(j)  (2304 + 64 * (j))
#define XB_TOP      3328
#define XB_TOPGEN   3392
#define XCD_BAR_WORDS 3456
#define XB_SPIN_CAP (1u << 18)

__device__ __forceinline__ unsigned xb_ld(unsigned* p)              { return __hip_atomic_load(p, __ATOMIC_RELAXED, __HIP_MEMORY_SCOPE_AGENT); }
__device__ __forceinline__ unsigned xb_add(unsigned* p, unsigned v) { return __hip_atomic_fetch_add(p, v, __ATOMIC_RELAXED, __HIP_MEMORY_SCOPE_AGENT); }
__device__ __forceinline__ unsigned xb_xcc_id() { return (unsigned)__builtin_amdgcn_s_getreg((3 << 11) | 20) & 0xFu; }
#define XB_SPIN(cond, bar) do { unsigned _sp = 0; while (cond) { __builtin_amdgcn_s_sleep(1); \
    if ((++_sp & 255u) == 0u) { if (xb_ld(&(bar)[XB_TMO])) break; if (_sp > XB_SPIN_CAP) { atomicAdd(&(bar)[XB_TMO], 1u); break; } } } } while (0)

struct XcdBarrier {
    unsigned* bar; unsigned x;
    volatile LAS unsigned* st;
};

__device__ __forceinline__ XcdBarrier xcd_barrier_post(unsigned* bar, volatile LAS unsigned* st) {
    XcdBarrier b; b.bar = bar; b.x = xb_xcc_id(); b.st = st;
    if (threadIdx.x == 0) (void)xb_add(&bar[XB_XCNT(b.x)], 1u);
    return b;
}
__device__ __forceinline__ void xcd_barrier_complete(unsigned* bar, unsigned x, unsigned& nloc, unsigned& nx) {
    const unsigned G = gridDim.x * gridDim.y * gridDim.z;
    unsigned sum, cnt, mine, sp = 0u;
    for (;;) {
        sum = 0u; cnt = 0u; mine = 0u;
#pragma unroll
        for (unsigned j = 0; j < 16; ++j) { const unsigned c = xb_ld(&bar[XB_XCNT(j)]); sum += c; cnt += (c > 0u) ? 1u : 0u; mine = (j == x) ? c : mine; }
        if (sum == G) break;
        __builtin_amdgcn_s_sleep(1);
        if ((++sp & 255u) == 0u) { if (xb_ld(&bar[XB_TMO])) break; if (sp > XB_SPIN_CAP) { atomicAdd(&bar[XB_TMO], 1u); break; } }
    }
    nloc = mine > 0u ? mine : 1u; nx = cnt > 0u ? cnt : 1u;
}

__device__ __forceinline__ void xcd_barrier(const XcdBarrier& b) {
    asm volatile("s_waitcnt vmcnt(0)" ::: "memory");
    __syncthreads();
    if (threadIdx.x == 0) {
        unsigned* bar = b.bar;
        __builtin_amdgcn_s_waitcnt(0);
        unsigned nloc = b.st[0], nx = b.st[1];
        if (nloc == 0u) { xcd_barrier_complete(bar, b.x, nloc, nx); b.st[0] = nloc; b.st[1] = nx; }
        const unsigned old = xb_add(&bar[XB_XSUB(b.x)], 1u);
        const unsigned gen = old / nloc;
        if (old + 1u == (gen + 1u) * nloc) {
            __builtin_amdgcn_fence(__ATOMIC_RELEASE, "agent");
            asm volatile("s_waitcnt vmcnt(0)" ::: "memory");
            const unsigned og = xb_add(&bar[XB_TOP], 1u);
            const unsigned tg = og / nx;
            if (og + 1u == (tg + 1u) * nx) xb_add(&bar[XB_TOPGEN], 1u);
            else XB_SPIN(xb_ld(&bar[XB_TOPGEN]) == tg, bar);
            __builtin_amdgcn_fence(__ATOMIC_ACQUIRE, "agent");
            xb_add(&bar[XB_XGEN(b.x)], 1u);
            asm volatile("s_waitcnt vmcnt(0)" ::: "memory");
        } else {
            XB_SPIN(xb_ld(&bar[XB_XGEN(b.x)]) == gen, bar);
            __builtin_amdgcn_fence(__ATOMIC_ACQUIRE, "agent");
            asm volatile("s_waitcnt vmcnt(0)" ::: "memory");
        }
    }
    __syncthreads();
}


#ifdef LAB
constexpr size_t WS_LAB = 440 * MiB;
DI void phase_lab(const P& p, char* lds) {
    const int t = tid_();
    const bf16_t* hbuf = (const bf16_t*)(p.ws + WS_HBUF);
    bf16_t* outb = (bf16_t*)(p.ws + WS_LAB);
    const float* win = p.in[2];
#if LAB == 40
    {
        const bf16_t* wb = (const bf16_t*)(p.ws + WS_HRAW);
        const int vx = bid_() & 7, vj = bid_() >> 3, nj = (gridDim.x - vx + 7) >> 3;
        for (int st = vx; st < 16; st += 8)
          for (int j = vj; j < 88; j += nj) {
            const int mt = st * 8 + j / 11, vt = j % 11;
            const int acol = vt < 4 ? vt * 256 : (vt < 10 ? 1032 + (vt - 4) * 256 : 2568);
            const bf16_t* ar = hbuf + (size_t)(mt * 128 + (t >> 2)) * DM + (t & 3) * 8;
            GSeg4 h1{ar, ar + (size_t)64 * DM, 32, wb + (size_t)(t >> 5) * DIN + acol + (t & 31) * 8, DIN, DM / 32}; GSeg4 h2 = h1; h2.KT = 0;
            Epi4Bf16 epi{outb + (size_t)mt * 128 * PJ + vt * 256, (size_t)PJ};
            gemm4(h1, h2, lds, epi);
          }
        return;
    }
#endif
    const int vx = bid_() & 7, vj = bid_() >> 3, nj = (gridDim.x - vx + 7) >> 3;
    for (int st = vx; st < 48; st += 8) {
      const int sm = st / 3, sn = st % 3, wdt = sn == 2 ? 7 : 8;
      for (int j = vj; j < 8 * wdt; j += nj) {
        const int mt = sm * 8 + j / wdt, vt = sn * 8 + j % wdt;
        const int acol = vt < 8 ? vt * 128 : (vt < 20 ? 1032 + (vt - 8) * 128 : (vt < 22 ? 2568 + (vt - 20) * 128 : 1024));
        const bf16_t* a0 = hbuf + (size_t)(mt * 128 + (t >> 2)) * DM + (t & 3) * 8;
        const float* b0 = win + (size_t)(t >> 5) * DIN + acol + (t & 31) * 4;
        EpiBf16 epi{outb + (size_t)mt * 128 * PJ + (vt % 22) * 128, (size_t)PJ};
#if LAB == 40
        (void)a0; (void)b0;
#elif LAB == 30
        const bf16_t* ar = hbuf + (size_t)(mt * 128 + (t >> 3)) * DM + (t & 7) * 8;
        GSeg3 h1{{ar, ar + (size_t)32 * DM, ar + (size_t)64 * DM, ar + (size_t)96 * DM}, 64, b0, DIN, DM / 32}; GSeg3 h2 = h1; h2.KT = 0;
        gemm3(h1, h2, lds, epi);
#elif LAB >= 20
        const bf16_t* wb = (const bf16_t*)(p.ws + WS_HRAW);
        const bf16_t* ar = hbuf + (size_t)(mt * 128 + (t >> 3)) * DM + (t & 7) * 8;
        GSeg2 h1{{ar, ar + (size_t)32 * DM, ar + (size_t)64 * DM, ar + (size_t)96 * DM}, 64, wb + (size_t)(t >> 4) * DIN + acol + (t & 15) * 8, DIN, DM / 32}; GSeg2 h2 = h1; h2.KT = 0;
        gemm2(h1, h2, lds, epi);
#else
        GSeg g1{a0, a0 + (size_t)64 * DM, BK, b0, DIN, DM / BK}; GSeg g2 = g1; g2.KT = 0;
        gemm_lab(g1, g2, lds, epi);
#endif
      }
    }
}
#endif
constexpr int LDS_BYTES = 65536;
constexpr int NPHASE = 9;

DI void run_phase(const P& p, int ph, int l, char* lds) {
    switch (ph) {
        case 0: phase_norm1(p, l, lds); break;
        case 1: phase_inproj(p, l, lds); break;
        case 2: phase_qkprep(p, l, lds); break;
        case 3: { unsigned long long dummy = 0; phase_mix(p, l, lds, dummy); } break;
        case 4: phase_glu(p, l, lds); break;
        case 5: phase_outproj(p, l, lds); break;
        case 6: phase_norm2(p, l, lds); break;
        case 7: phase_moe1(p, l, lds); break;
        case 8: phase_moe2(p, l, lds); break;
        default: phase_final(p, lds); break;
    }
}

#if MULTI
__global__ void __launch_bounds__(256) k_phase(P p, int ph, int l) {
    extern __shared__ __attribute__((aligned(16))) char lds[];
    run_phase(p, ph, l, lds);
}
#else
__global__ void __launch_bounds__(256, 2) k_mega(P p) {
    extern __shared__ __attribute__((aligned(16))) char lds[];
    cg::grid_group grid = cg::this_grid();
    volatile LAS unsigned* bst = (volatile LAS unsigned*)((LAS char*)lds + LDS_BYTES - 16);
    if (threadIdx.x < 4) bst[threadIdx.x] = 0u;
    __syncthreads();
    XcdBarrier gbar = xcd_barrier_post((unsigned*)(p.ws + WS_BAR), bst);
    if (p.ws == nullptr) grid.sync();
#define GSYNC() xcd_barrier(gbar)
#ifndef PROBE_MASK
#define PROBE_MASK 0
#endif
#ifndef PROBE_MULT
#define PROBE_MULT 4
#endif
#ifndef PROBE_BLK
#define PROBE_BLK 0
#endif
    unsigned long long tacc = 0, tprev = 0;
#define PH_BEGIN() do { if (PROBE_MASK) tprev = wall_clock64(); } while (0)
#define PH_END(ph) do { if (PROBE_MASK & (1 << (ph))) tacc += wall_clock64() - tprev; } while (0)
#pragma unroll
    for (int l = 0; l < 2; ++l) {
        PH_BEGIN(); phase_norm1(p, l, lds); GSYNC(); PH_END(0);
        PH_BEGIN(); phase_inproj(p, l, lds); GSYNC(); PH_END(1);
        PH_BEGIN(); phase_qkprep(p, l, lds); GSYNC(); PH_END(2);
        PH_BEGIN(); phase_mix(p, l, lds, tacc); GSYNC(); PH_END(3);
        PH_BEGIN(); phase_glu(p, l, lds); GSYNC(); PH_END(4);
        PH_BEGIN(); phase_outproj(p, l, lds); GSYNC(); PH_END(5);
        PH_BEGIN(); phase_norm2(p, l, lds); GSYNC(); phase_assign(p, l, lds); GSYNC(); PH_END(6);
        PH_BEGIN(); phase_moe1(p, l, lds); GSYNC(); PH_END(7);
        PH_BEGIN(); phase_moe2(p, l, lds); GSYNC(); PH_END(8);
    }
    PH_BEGIN(); phase_final(p, lds); PH_END(9);
#ifdef LAB
#if LAB >= 20
    {
        const float* src = p.in[2]; bf16_t* dst = (bf16_t*)(p.ws + WS_HRAW);
        const size_t n4 = (size_t)DM * DIN / 4, stride = (size_t)gridDim.x * 256;
        for (size_t i = (size_t)blockIdx.x * 256 + threadIdx.x; i < n4; i += stride) { const float4 v = ((const float4*)src)[i]; u32x2 o; o.x = pk2(v.x, v.y); o.y = pk2(v.z, v.w); ((u32x2*)dst)[i] = o; }
    }
#endif
    GSYNC(); phase_lab(p, lds);
#endif
#ifdef PROBE_SYNCS
    for (int i = 0; i < PROBE_SYNCS; ++i) GSYNC();
#endif
    if ((PROBE_MASK || PROBE_SUB) && blockIdx.x == PROBE_BLK) {
        const unsigned long long t0 = wall_clock64();
        while (wall_clock64() - t0 < (unsigned long long)PROBE_MULT * tacc) __builtin_amdgcn_s_sleep(8);
    }
}
#endif

extern "C" void kernel_launch(void* const* d_in, const int* in_sizes, int n_in, void* d_out, int out_size, void* d_ws, size_t ws_size, hipStream_t stream) {
    static int grid = 0;
    if (grid == 0) {
        if (n_in != 31 || out_size != T * DM || ws_size < WS_END) { fprintf(stderr, "kernel_launch: unexpected sizes n_in %d out %d ws %zu\n", n_in, out_size, ws_size); grid = -1; return; }
        int dev = 0, cus = 0, per_cu = 0;
        (void)hipGetDevice(&dev);
        (void)hipDeviceGetAttribute(&cus, hipDeviceAttributeMultiprocessorCount, dev);
#if MULTI
        (void)hipFuncSetAttribute((const void*)k_phase, hipFuncAttributeMaxDynamicSharedMemorySize, LDS_BYTES);
        (void)hipOccupancyMaxActiveBlocksPerMultiprocessor(&per_cu, (const void*)k_phase, 256, LDS_BYTES);
#else
        (void)hipFuncSetAttribute((const void*)k_mega, hipFuncAttributeMaxDynamicSharedMemorySize, LDS_BYTES);
        (void)hipOccupancyMaxActiveBlocksPerMultiprocessor(&per_cu, (const void*)k_mega, 256, LDS_BYTES);
#endif
        if (per_cu < 1) { fprintf(stderr, "kernel_launch: occupancy query gave %d\n", per_cu); per_cu = 1; }
        if (per_cu > 2) per_cu = 2;
        grid = cus * per_cu;
        fprintf(stderr, "kernel_launch: cus %d per_cu %d grid %d\n", cus, per_cu, grid);
    }
    if (grid < 0) return;
    (void)hipMemsetAsync((char*)d_ws + WS_CTL, 0, 65536, stream);
    P p{};
    for (int i = 0; i < 31; ++i) p.in[i] = (const float*)d_in[i];
    p.out = (float*)d_out; p.ws = (char*)d_ws;
#if MULTI
    for (int l = 0; l < 2; ++l)
        for (int ph = 0; ph < NPHASE; ++ph) hipLaunchKernelGGL(k_phase, dim3(grid), dim3(256), LDS_BYTES, stream, p, ph, l);
    hipLaunchKernelGGL(k_phase, dim3(grid), dim3(256), LDS_BYTES, stream, p, NPHASE, 0);
#else
    void* args[] = {&p};
    hipError_t e = hipLaunchCooperativeKernel((const void*)k_mega, dim3(grid), dim3(256), args, LDS_BYTES, stream);
    if (e != hipSuccess) fprintf(stderr, "cooperative launch failed: %s (grid %d)\n", hipGetErrorString(e), grid);
#endif
}
```

```cpp
#include <hip/hip_runtime.h>
#include <hip/hip_cooperative_groups.h>
#include <cstdio>
#include <cstdint>
namespace cg = cooperative_groups;

#ifndef MULTI
#define MULTI 0
#endif

#define DI __device__ __forceinline__
#define LAS __attribute__((address_space(3)))
typedef unsigned short bf16_t;
typedef short bf16x8 __attribute__((ext_vector_type(8)));
typedef short s16x4 __attribute__((ext_vector_type(4)));
typedef float f32x16 __attribute__((ext_vector_type(16)));
typedef unsigned u32x4 __attribute__((ext_vector_type(4)));
typedef float f32x4 __attribute__((ext_vector_type(4)));
typedef unsigned u32x2 __attribute__((ext_vector_type(2)));

constexpr int T = 16384, DM = 1024, SEQ = 2048, NBATCH = 8;
constexpr int DIN = 2824, PJ = 2816;
constexpr int NE = 32, DE = 512, ECAP = 16384;
constexpr float EPS = 1e-6f;
constexpr int C_MQ = 0, C_MK = 256, C_MV = 512, C_MO = 768, C_AQ = 1024, C_AK = 1536, C_AV = 2048, C_SU = 2560;

constexpr size_t MiB = 1u << 20;
constexpr size_t WS_CTL = 0;
constexpr size_t WS_BAR = 16384;
constexpr size_t WS_KMEAN = 512 * 1024;
constexpr size_t WS_XRES = 1 * MiB;
constexpr size_t WS_HBUF = 65 * MiB;
constexpr size_t WS_PROJ = 97 * MiB;
constexpr size_t WS_GATES = 185 * MiB;
constexpr size_t WS_MIX = 186 * MiB;
constexpr size_t WS_HRAW = 218 * MiB;
constexpr size_t WS_ZBUF = 234 * MiB;
constexpr size_t WS_TOKL = 250 * MiB;
constexpr size_t WS_WL = 252 * MiB;
constexpr size_t WS_TINFO = 254 * MiB;
constexpr size_t WS_HMOE = 256 * MiB;
constexpr size_t WS_YMOE = 292 * MiB;
constexpr size_t WS_MQKC = 364 * MiB;
constexpr size_t WS_S5M = 380 * MiB;
constexpr size_t S5M_LAYER = 8 * MiB, S5M_E = 4 * MiB, S5M_F = 6 * MiB;
constexpr size_t WS_ELOC = 396 * MiB;
constexpr size_t WS_CARR = 412 * MiB;
constexpr size_t WS_RINFO = 420 * MiB;
constexpr size_t WS_HIST = 421 * MiB;
constexpr size_t WS_GSCAN = 422 * MiB;
constexpr size_t WS_WINB = 424 * MiB;
constexpr size_t WS_WOUTB = 436 * MiB;
constexpr size_t WS_END = 440 * MiB;

struct P {
    const float* in[31];
    float* out;
    char* ws;
};

#ifndef PROBE_SUB
#define PROBE_SUB 0
#endif
DI int tid_() { int t = threadIdx.x; asm volatile("" : "+v"(t)); return t; }
DI int bid_() { int b = blockIdx.x; asm volatile("" : "+s"(b)); return b; }
DI float bf2f(bf16_t b) { return __uint_as_float(((unsigned)b) << 16); }
DI bf16_t f2bf(float f) { unsigned u = __float_as_uint(f); u += 0x7fffu + ((u >> 16) & 1u); return (bf16_t)(u >> 16); }
typedef float f32x2 __attribute__((ext_vector_type(2)));
typedef __bf16 bf16x2_t __attribute__((ext_vector_type(2)));
DI unsigned pk2(float lo, float hi) { f32x2 v = {lo, hi}; return __builtin_bit_cast(unsigned, __builtin_convertvector(v, bf16x2_t)); }
DI void lds_barrier() { asm volatile("s_waitcnt lgkmcnt(0)" ::: "memory"); __builtin_amdgcn_s_barrier(); asm volatile("" ::: "memory"); }
DI float wave_sum(float v) {
#pragma unroll
    for (int o = 32; o > 0; o >>= 1) v += __shfl_xor(v, o);
    return v;
}
DI float sigmoidf_(float x) { return 1.0f / (1.0f + expf(-x)); }
DI s16x4 tr_read(const LAS char* p) {
    typedef short v4i16_t __attribute__((ext_vector_type(4)));
    return __builtin_bit_cast(s16x4, __builtin_amdgcn_ds_read_tr16_b64_v4i16((LAS v4i16_t*)p));
}

DI float half_swap_max(float m) {
    auto rr = __builtin_amdgcn_permlane32_swap(__float_as_uint(m), __float_as_uint(m), false, false);
    return fmaxf(__uint_as_float(rr[0]), __uint_as_float(rr[1]));
}
DI float half_swap_sum(float m) {
    auto rr = __builtin_amdgcn_permlane32_swap(__float_as_uint(m), __float_as_uint(m), false, false);
    return __uint_as_float(rr[0]) + __uint_as_float(rr[1]);
}

constexpr int BK = 32, A_PITCH = 80, B_PITCH = 320, SA_BYTES = 128 * A_PITCH, SB_BYTES = BK * B_PITCH;
constexpr int GEMM_LDS = 2 * SA_BYTES + 2 * SB_BYTES;

struct GSeg { const bf16_t* a0; const bf16_t* a1; int akstep; const float* b0; size_t ldb; int KT; };
template <class Epi>
DI void gemm_tile2(const GSeg& g1, const GSeg& g2, char* lds_generic, const Epi& epi) {
    const int KT = g1.KT + g2.KT;
    LAS char* lds = (LAS char*)lds_generic;
    const int t = tid_(), lane = t & 63, w = t >> 6, wm = w >> 1, wn = w & 1;
    const int r = lane & 31, h = lane >> 5;
    const int i16 = lane & 15, q = i16 >> 2, pp = i16 & 3, blk = (lane >> 4) & 1;
    const int arow = t >> 2, akc = t & 3, bk = t >> 5, bn4 = t & 31;
    f32x16 acc[2][2];
#pragma unroll
    for (int i = 0; i < 2; ++i)
#pragma unroll
        for (int j = 0; j < 2; ++j)
#pragma unroll
            for (int e = 0; e < 16; ++e) acc[i][j][e] = 0.f;
    struct Stage { u32x4 a0, a1; float4 b0, b1, b2, b3; };
    const bf16_t* pa0 = g1.a0; const bf16_t* pa1 = g1.a1; const float* pb = g1.b0;
    size_t ldb = g1.ldb; int aks = g1.akstep, left = g1.KT, issued = 0;
    auto gload = [&](Stage& S) {
        S.a0 = *(const u32x4*)pa0; S.a1 = *(const u32x4*)pa1;
        S.b0 = *(const float4*)(pb); S.b1 = *(const float4*)(pb + 8 * ldb); S.b2 = *(const float4*)(pb + 16 * ldb); S.b3 = *(const float4*)(pb + 24 * ldb);
        if (++issued < KT) {
            if (--left == 0) { pa0 = g2.a0; pa1 = g2.a1; pb = g2.b0; ldb = g2.ldb; aks = g2.akstep; left = 1 << 30; }
            else { pa0 += aks; pa1 += aks; pb += BK * ldb; }
        }
    };
    auto sstore = [&](const Stage& S, int buf) {
        LAS char* sA = lds + buf * SA_BYTES; LAS char* sB = lds + 2 * SA_BYTES + buf * SB_BYTES;
        *(LAS u32x4*)(sA + arow * A_PITCH + akc * 16) = S.a0;
        *(LAS u32x4*)(sA + (arow + 64) * A_PITCH + akc * 16) = S.a1;
        u32x2 v;
        v.x = pk2(S.b0.x, S.b0.y); v.y = pk2(S.b0.z, S.b0.w); *(LAS u32x2*)(sB + (bk) * B_PITCH + bn4 * 8) = v;
        v.x = pk2(S.b1.x, S.b1.y); v.y = pk2(S.b1.z, S.b1.w); *(LAS u32x2*)(sB + (bk + 8) * B_PITCH + bn4 * 8) = v;
        v.x = pk2(S.b2.x, S.b2.y); v.y = pk2(S.b2.z, S.b2.w); *(LAS u32x2*)(sB + (bk + 16) * B_PITCH + bn4 * 8) = v;
        v.x = pk2(S.b3.x, S.b3.y); v.y = pk2(S.b3.z, S.b3.w); *(LAS u32x2*)(sB + (bk + 24) * B_PITCH + bn4 * 8) = v;
    };
    auto compute = [&](int buf) {
        const LAS char* sA = lds + buf * SA_BYTES; const LAS char* sB = lds + 2 * SA_BYTES + buf * SB_BYTES;
#pragma unroll
        for (int ks = 0; ks < 2; ++ks) {
            bf16x8 af[2], bfr[2];
#pragma unroll
            for (int tm = 0; tm < 2; ++tm) af[tm] = *(const LAS bf16x8*)(sA + (wm * 64 + tm * 32 + r) * A_PITCH + (ks * 16 + 8 * h) * 2);
#pragma unroll
            for (int tn = 0; tn < 2; ++tn) {
                const LAS char* pb = sB + (ks * 16 + 8 * h + q) * B_PITCH + (wn * 64 + tn * 32 + 16 * blk) * 2 + 8 * pp;
                s16x4 lo = tr_read(pb), hi = tr_read(pb + 4 * B_PITCH);
                bfr[tn] = __builtin_shufflevector(lo, hi, 0, 1, 2, 3, 4, 5, 6, 7);
            }
#pragma unroll
            for (int tm = 0; tm < 2; ++tm)
#pragma unroll
                for (int tn = 0; tn < 2; ++tn) acc[tm][tn] = __builtin_amdgcn_mfma_f32_32x32x16_bf16(bfr[tn], af[tm], acc[tm][tn], 0, 0, 0);
        }
    };
    Stage S0, S1;
    gload(S0); gload(S1);
    sstore(S0, 0); __syncthreads();
#define GSTEP(SL, SS) { gload(SL); compute(kt & 1); sstore(SS, (kt + 1) & 1); __syncthreads(); if (++kt >= KT) break; }
    for (int kt = 0;;) {
        GSTEP(S0, S1)
        GSTEP(S1, S0)
    }
#undef GSTEP
    epi(acc, wm, wn, r, h);
}
#ifdef LAB
template <class Epi>
DI void gemm_lab(const GSeg& g1, const GSeg& g2, char* lds_generic, const Epi& epi) {
    const int KT = g1.KT + g2.KT;
    LAS char* lds = (LAS char*)lds_generic;
    const int t = tid_(), lane = t & 63, w = t >> 6, wm = w >> 1, wn = w & 1;
    const int r = lane & 31, h = lane >> 5;
    const int i16 = lane & 15, q = i16 >> 2, pp = i16 & 3, blk = (lane >> 4) & 1;
    const int arow = t >> 2, akc = t & 3, bk = t >> 5, bn4 = t & 31;
    f32x16 acc[2][2];
#pragma unroll
    for (int i = 0; i < 2; ++i)
#pragma unroll
        for (int j = 0; j < 2; ++j)
#pragma unroll
            for (int e = 0; e < 16; ++e) acc[i][j][e] = 0.f;
    struct Stage { u32x4 a0, a1; float4 b0, b1, b2, b3; };
    const bf16_t* pa0 = g1.a0; const bf16_t* pa1 = g1.a1; const float* pb = g1.b0;
    size_t ldb = g1.ldb; int aks = g1.akstep, left = g1.KT, issued = 0;
    auto gload = [&](Stage& S) {
        if (LAB != 5 && LAB != 15) { S.a0 = *(const u32x4*)pa0; S.a1 = *(const u32x4*)pa1; }
        if (LAB != 6 && LAB != 16) { S.b0 = *(const float4*)(pb); S.b1 = *(const float4*)(pb + 8 * ldb); S.b2 = *(const float4*)(pb + 16 * ldb); S.b3 = *(const float4*)(pb + 24 * ldb); }
        if (++issued < KT) {
            if (--left == 0) { pa0 = g2.a0; pa1 = g2.a1; pb = g2.b0; ldb = g2.ldb; aks = g2.akstep; left = 1 << 30; }
            else { pa0 += aks; pa1 += aks; pb += BK * ldb; }
        }
    };
    auto sstore = [&](const Stage& S, int buf) {
        LAS char* sA = lds + buf * SA_BYTES; LAS char* sB = lds + 2 * SA_BYTES + buf * SB_BYTES;
        *(LAS u32x4*)(sA + arow * A_PITCH + akc * 16) = S.a0;
        *(LAS u32x4*)(sA + (arow + 64) * A_PITCH + akc * 16) = S.a1;
        u32x2 v;
        v.x = pk2(S.b0.x, S.b0.y); v.y = pk2(S.b0.z, S.b0.w); *(LAS u32x2*)(sB + (bk) * B_PITCH + bn4 * 8) = v;
        v.x = pk2(S.b1.x, S.b1.y); v.y = pk2(S.b1.z, S.b1.w); *(LAS u32x2*)(sB + (bk + 8) * B_PITCH + bn4 * 8) = v;
        v.x = pk2(S.b2.x, S.b2.y); v.y = pk2(S.b2.z, S.b2.w); *(LAS u32x2*)(sB + (bk + 16) * B_PITCH + bn4 * 8) = v;
        v.x = pk2(S.b3.x, S.b3.y); v.y = pk2(S.b3.z, S.b3.w); *(LAS u32x2*)(sB + (bk + 24) * B_PITCH + bn4 * 8) = v;
    };
    auto compute = [&](int buf) {
        const LAS char* sA = lds + buf * SA_BYTES; const LAS char* sB = lds + 2 * SA_BYTES + buf * SB_BYTES;
#pragma unroll
        for (int ks = 0; ks < 2; ++ks) {
            bf16x8 af[2], bfr[2];
#pragma unroll
            for (int tm = 0; tm < 2; ++tm) af[tm] = *(const LAS bf16x8*)(sA + (wm * 64 + tm * 32 + r) * A_PITCH + (ks * 16 + 8 * h) * 2);
#pragma unroll
            for (int tn = 0; tn < 2; ++tn) {
                const LAS char* pb = sB + (ks * 16 + 8 * h + q) * B_PITCH + (wn * 64 + tn * 32 + 16 * blk) * 2 + 8 * pp;
                s16x4 lo = tr_read(pb), hi = tr_read(pb + 4 * B_PITCH);
                bfr[tn] = __builtin_shufflevector(lo, hi, 0, 1, 2, 3, 4, 5, 6, 7);
            }
#pragma unroll
            for (int tm = 0; tm < 2; ++tm)
#pragma unroll
                for (int tn = 0; tn < 2; ++tn) acc[tm][tn] = __builtin_amdgcn_mfma_f32_32x32x16_bf16(bfr[tn], af[tm], acc[tm][tn], 0, 0, 0);
        }
    };
    Stage S0, S1;
    gload(S0); gload(S1);
    sstore(S0, 0); __syncthreads();
#define GSTEP(SL, SS) { if (LAB != 1 && LAB != 3) gload(SL); if (LAB != 4 && LAB != 5 && LAB != 6) compute(kt & 1); if (LAB != 2 && LAB != 3) sstore(SS, (kt + 1) & 1); __syncthreads(); if (++kt >= KT) break; }
    for (int kt = 0;;) {
        GSTEP(S0, S1)
        GSTEP(S1, S0)
    }
#undef GSTEP
    epi(acc, wm, wn, r, h);
}
#endif
template <class Epi>
DI void gemm_tile(const bf16_t* a0, const bf16_t* a1, const float* b0, size_t ldb, int KT, char* lds_generic, const Epi& epi) {
    GSeg g1{a0, a1, BK, b0, ldb, KT}; GSeg g2{a0, a1, BK, b0, ldb, 0};
    gemm_tile2(g1, g2, lds_generic, epi);
}
struct GSeg2 { const bf16_t* a[4]; int askip; const bf16_t* b0; size_t ldb; int KT; };
constexpr int A2_PITCH = 144, SA2_BYTES = 128 * A2_PITCH, G2_LDS = 2 * SA2_BYTES + 2 * SB_BYTES;
template <class Epi>
DI void gemm2(const GSeg2& g1, const GSeg2& g2, char* lds_generic, const Epi& epi) {
    const int KT = g1.KT + g2.KT;
    LAS char* lds = (LAS char*)lds_generic;
    const int t = tid_(), lane = t & 63, w = t >> 6, wm = w >> 1, wn = w & 1;
    const int r = lane & 31, h = lane >> 5;
    const int i16 = lane & 15, q = i16 >> 2, pp = i16 & 3, blk = (lane >> 4) & 1;
    const int arow = t >> 3, akc = t & 7, bk = t >> 4, bc = t & 15;
    f32x16 acc[2][2];
#pragma unroll
    for (int i = 0; i < 2; ++i)
#pragma unroll
        for (int j = 0; j < 2; ++j)
#pragma unroll
            for (int e = 0; e < 16; ++e) acc[i][j][e] = 0.f;
    struct AStage { u32x4 a0, a1, a2, a3; };
    struct BStage { u32x4 b0, b1; };
    const bf16_t* pa0 = g1.a[0]; const bf16_t* pa1 = g1.a[1]; const bf16_t* pa2 = g1.a[2]; const bf16_t* pa3 = g1.a[3];
    const bf16_t* pb = g1.b0; size_t ldb = g1.ldb; int askip = g1.askip, aleft = g1.KT >> 1, bleft = g1.KT, aiss = 0, biss = 0;
    auto aload = [&](AStage& S) {
        S.a0 = *(const u32x4*)pa0; S.a1 = *(const u32x4*)pa1; S.a2 = *(const u32x4*)pa2; S.a3 = *(const u32x4*)pa3;
        if (++aiss < (KT >> 1)) {
            if (--aleft == 0) { pa0 = g2.a[0]; pa1 = g2.a[1]; pa2 = g2.a[2]; pa3 = g2.a[3]; askip = g2.askip; aleft = 1 << 30; }
            else { pa0 += askip; pa1 += askip; pa2 += askip; pa3 += askip; }
        }
    };
    auto bload = [&](BStage& S) {
        S.b0 = *(const u32x4*)pb; S.b1 = *(const u32x4*)(pb + 16 * ldb);
        if (++biss < KT) {
            if (--bleft == 0) { pb = g2.b0; ldb = g2.ldb; bleft = 1 << 30; }
            else pb += 32 * ldb;
        }
    };
    auto astore = [&](const AStage& S, int buf) {
        LAS char* sA = lds + buf * SA2_BYTES + arow * A2_PITCH + akc * 16;
        *(LAS u32x4*)(sA) = S.a0; *(LAS u32x4*)(sA + 32 * A2_PITCH) = S.a1; *(LAS u32x4*)(sA + 64 * A2_PITCH) = S.a2; *(LAS u32x4*)(sA + 96 * A2_PITCH) = S.a3;
    };
    auto bstore = [&](const BStage& S, int buf) {
        LAS char* sB = lds + 2 * SA2_BYTES + buf * SB_BYTES + bk * B_PITCH + bc * 16;
        *(LAS u32x4*)(sB) = S.b0; *(LAS u32x4*)(sB + 16 * B_PITCH) = S.b1;
    };
    auto compute = [&](int abuf, int half, int bbuf) {
        const LAS char* sA = lds + abuf * SA2_BYTES + half * 64; const LAS char* sB = lds + 2 * SA2_BYTES + bbuf * SB_BYTES;
#pragma unroll
        for (int ks = 0; ks < 2; ++ks) {
            bf16x8 af[2], bfr[2];
#pragma unroll
            for (int tm = 0; tm < 2; ++tm) af[tm] = *(const LAS bf16x8*)(sA + (wm * 64 + tm * 32 + r) * A2_PITCH + (ks * 16 + 8 * h) * 2);
#pragma unroll
            for (int tn = 0; tn < 2; ++tn) {
                const LAS char* pbb = sB + (ks * 16 + 8 * h + q) * B_PITCH + (wn * 64 + tn * 32 + 16 * blk) * 2 + 8 * pp;
                s16x4 lo = tr_read(pbb), hi = tr_read(pbb + 4 * B_PITCH);
                bfr[tn] = __builtin_shufflevector(lo, hi, 0, 1, 2, 3, 4, 5, 6, 7);
            }
#pragma unroll
            for (int tm = 0; tm < 2; ++tm)
#pragma unroll
                for (int tn = 0; tn < 2; ++tn) acc[tm][tn] = __builtin_amdgcn_mfma_f32_32x32x16_bf16(bfr[tn], af[tm], acc[tm][tn], 0, 0, 0);
        }
    };
    AStage RA; BStage RB0, RB1;
    aload(RA); bload(RB0); bload(RB1);
    astore(RA, 0); bstore(RB0, 0); __syncthreads();
    for (int sl = 0;; ++sl) {
#ifndef LAB
#define LAB 0
#define LAB_UNDEF
#endif
        if (LAB != 22) { aload(RA); bload(RB0); }
        if (LAB != 21) compute(sl & 1, 0, 0);
        bstore(RB1, 1);
        __syncthreads();
        if (LAB != 22) bload(RB1);
        if (LAB != 21) compute(sl & 1, 1, 1);
#ifdef LAB_UNDEF
#undef LAB
#undef LAB_UNDEF
#endif
        astore(RA, (sl + 1) & 1); bstore(RB0, 0);
        __syncthreads();
        if (2 * sl + 2 >= KT) break;
    }
    epi(acc, wm, wn, r, h);
}
struct GSeg3 { const bf16_t* a[4]; int askip; const float* b0; size_t ldb; int KT; };
template <class Epi>
DI void gemm3(const GSeg3& g1, const GSeg3& g2, char* lds_generic, const Epi& epi) {
    const int KT = g1.KT + g2.KT;
    LAS char* lds = (LAS char*)lds_generic;
    const int t = tid_(), lane = t & 63, w = t >> 6, wm = w >> 1, wn = w & 1;
    const int r = lane & 31, h = lane >> 5;
    const int i16 = lane & 15, q = i16 >> 2, pp = i16 & 3, blk = (lane >> 4) & 1;
    const int arow = t >> 3, akc = t & 7, bk = t >> 5, bn4 = t & 31;
    f32x16 acc[2][2];
#pragma unroll
    for (int i = 0; i < 2; ++i)
#pragma unroll
        for (int j = 0; j < 2; ++j)
#pragma unroll
            for (int e = 0; e < 16; ++e) acc[i][j][e] = 0.f;
    struct AStage { u32x4 a0, a1, a2, a3; };
    struct BStage { float4 b0, b1, b2, b3; };
    const bf16_t* pa0 = g1.a[0]; const bf16_t* pa1 = g1.a[1]; const bf16_t* pa2 = g1.a[2]; const bf16_t* pa3 = g1.a[3];
    const float* pb = g1.b0; size_t ldb = g1.ldb; int askip = g1.askip, aleft = g1.KT >> 1, bleft = g1.KT, aiss = 0, biss = 0;
    auto aload = [&](AStage& S) {
        S.a0 = *(const u32x4*)pa0; S.a1 = *(const u32x4*)pa1; S.a2 = *(const u32x4*)pa2; S.a3 = *(const u32x4*)pa3;
        if (++aiss < (KT >> 1)) {
            if (--aleft == 0) { pa0 = g2.a[0]; pa1 = g2.a[1]; pa2 = g2.a[2]; pa3 = g2.a[3]; askip = g2.askip; aleft = 1 << 30; }
            else { pa0 += askip; pa1 += askip; pa2 += askip; pa3 += askip; }
        }
    };
    auto bload = [&](BStage& S) {
        S.b0 = *(const float4*)(pb); S.b1 = *(const float4*)(pb + 8 * ldb); S.b2 = *(const float4*)(pb + 16 * ldb); S.b3 = *(const float4*)(pb + 24 * ldb);
        if (++biss < KT) {
            if (--bleft == 0) { pb = g2.b0; ldb = g2.ldb; bleft = 1 << 30; }
            else pb += 32 * ldb;
        }
    };
    auto astore = [&](const AStage& S, int buf) {
        LAS char* sA = lds + buf * SA2_BYTES + arow * A2_PITCH + akc * 16;
        *(LAS u32x4*)(sA) = S.a0; *(LAS u32x4*)(sA + 32 * A2_PITCH) = S.a1; *(LAS u32x4*)(sA + 64 * A2_PITCH) = S.a2; *(LAS u32x4*)(sA + 96 * A2_PITCH) = S.a3;
    };
    auto bstore = [&](const BStage& S, int buf) {
        LAS char* sB = lds + 2 * SA2_BYTES + buf * SB_BYTES + bk * B_PITCH + bn4 * 8;
        u32x2 v;
        v.x = pk2(S.b0.x, S.b0.y); v.y = pk2(S.b0.z, S.b0.w); *(LAS u32x2*)(sB) = v;
        v.x = pk2(S.b1.x, S.b1.y); v.y = pk2(S.b1.z, S.b1.w); *(LAS u32x2*)(sB + 8 * B_PITCH) = v;
        v.x = pk2(S.b2.x, S.b2.y); v.y = pk2(S.b2.z, S.b2.w); *(LAS u32x2*)(sB + 16 * B_PITCH) = v;
        v.x = pk2(S.b3.x, S.b3.y); v.y = pk2(S.b3.z, S.b3.w); *(LAS u32x2*)(sB + 24 * B_PITCH) = v;
    };
    auto compute = [&](int abuf, int half, int bbuf) {
        const LAS char* sA = lds + abuf * SA2_BYTES + half * 64; const LAS char* sB = lds + 2 * SA2_BYTES + bbuf * SB_BYTES;
#pragma unroll
        for (int ks = 0; ks < 2; ++ks) {
            bf16x8 af[2], bfr[2];
#pragma unroll
            for (int tm = 0; tm < 2; ++tm) af[tm] = *(const LAS bf16x8*)(sA + (wm * 64 + tm * 32 + r) * A2_PITCH + (ks * 16 + 8 * h) * 2);
#pragma unroll
            for (int tn = 0; tn < 2; ++tn) {
                const LAS char* pbb = sB + (ks * 16 + 8 * h + q) * B_PITCH + (wn * 64 + tn * 32 + 16 * blk) * 2 + 8 * pp;
                s16x4 lo = tr_read(pbb), hi = tr_read(pbb + 4 * B_PITCH);
                bfr[tn] = __builtin_shufflevector(lo, hi, 0, 1, 2, 3, 4, 5, 6, 7);
            }
#pragma unroll
            for (int tm = 0; tm < 2; ++tm)
#pragma unroll
                for (int tn = 0; tn < 2; ++tn) acc[tm][tn] = __builtin_amdgcn_mfma_f32_32x32x16_bf16(bfr[tn], af[tm], acc[tm][tn], 0, 0, 0);
        }
    };
    AStage RA; BStage RB0, RB1;
    aload(RA); bload(RB0); bload(RB1);
    astore(RA, 0); bstore(RB0, 0); __syncthreads();
    for (int sl = 0;; ++sl) {
        aload(RA); bload(RB0);
        compute(sl & 1, 0, 0);
        bstore(RB1, 1);
        __syncthreads();
        bload(RB1);
        compute(sl & 1, 1, 1);
        astore(RA, (sl + 1) & 1); bstore(RB0, 0);
        __syncthreads();
        if (2 * sl + 2 >= KT) break;
    }
    epi(acc, wm, wn, r, h);
}
struct GSeg4 { const bf16_t* a0; const bf16_t* a1; int akstep; const bf16_t* b0; size_t ldb; int KT; };
constexpr int B4_PITCH = 576, SB4_BYTES = 32 * B4_PITCH, G4_LDS = 2 * SA_BYTES + 2 * SB4_BYTES;
template <class Epi>
DI void gemm4(const GSeg4& g1, const GSeg4& g2, char* lds_generic, const Epi& epi) {
    const int KT = g1.KT + g2.KT;
    LAS char* lds = (LAS char*)lds_generic;
    const int t = tid_(), lane = t & 63, w = t >> 6, wm = w >> 1, wn = w & 1;
    const int r = lane & 31, h = lane >> 5;
    const int i16 = lane & 15, q = i16 >> 2, pp = i16 & 3, blk = (lane >> 4) & 1;
    const int arow = t >> 2, akc = t & 3, bk = t >> 5, bc = t & 31;
    f32x16 acc[2][4];
#pragma unroll
    for (int i = 0; i < 2; ++i)
#pragma unroll
        for (int j = 0; j < 4; ++j)
#pragma unroll
            for (int e = 0; e < 16; ++e) acc[i][j][e] = 0.f;
    struct Stage { u32x4 a0, a1, b0, b1, b2, b3; };
    const bf16_t* pa0 = g1.a0; const bf16_t* pa1 = g1.a1; const bf16_t* pb = g1.b0;
    size_t ldb = g1.ldb; int aks = g1.akstep, left = g1.KT, issued = 0;
    auto gload = [&](Stage& S) {
        S.a0 = *(const u32x4*)pa0; S.a1 = *(const u32x4*)pa1;
        S.b0 = *(const u32x4*)(pb); S.b1 = *(const u32x4*)(pb + 8 * ldb); S.b2 = *(const u32x4*)(pb + 16 * ldb); S.b3 = *(const u32x4*)(pb + 24 * ldb);
        if (++issued < KT) {
            if (--left == 0) { pa0 = g2.a0; pa1 = g2.a1; pb = g2.b0; ldb = g2.ldb; aks = g2.akstep; left = 1 << 30; }
            else { pa0 += aks; pa1 += aks; pb += 32 * ldb; }
        }
    };
    auto sstore = [&](const Stage& S, int buf) {
        LAS char* sA = lds + buf * SA_BYTES; LAS char* sB = lds + 2 * SA_BYTES + buf * SB4_BYTES + bk * B4_PITCH + bc * 16;
        *(LAS u32x4*)(sA + arow * A_PITCH + akc * 16) = S.a0;
        *(LAS u32x4*)(sA + (arow + 64) * A_PITCH + akc * 16) = S.a1;
        *(LAS u32x4*)(sB) = S.b0; *(LAS u32x4*)(sB + 8 * B4_PITCH) = S.b1; *(LAS u32x4*)(sB + 16 * B4_PITCH) = S.b2; *(LAS u32x4*)(sB + 24 * B4_PITCH) = S.b3;
    };
    auto compute = [&](int buf) {
        const LAS char* sA = lds + buf * SA_BYTES; const LAS char* sB = lds + 2 * SA_BYTES + buf * SB4_BYTES;
#pragma unroll
        for (int ks = 0; ks < 2; ++ks) {
            bf16x8 af[2], bfr[4];
#pragma unroll
            for (int tm = 0; tm < 2; ++tm) af[tm] = *(const LAS bf16x8*)(sA + (wm * 64 + tm * 32 + r) * A_PITCH + (ks * 16 + 8 * h) * 2);
#pragma unroll
            for (int tn = 0; tn < 4; ++tn) {
                const LAS char* pbb = sB + (ks * 16 + 8 * h + q) * B4_PITCH + (wn * 128 + tn * 32 + 16 * blk) * 2 + 8 * pp;
                s16x4 lo = tr_read(pbb), hi = tr_read(pbb + 4 * B4_PITCH);
                bfr[tn] = __builtin_shufflevector(lo, hi, 0, 1, 2, 3, 4, 5, 6, 7);
            }
#pragma unroll
            for (int tm = 0; tm < 2; ++tm)
#pragma unroll
                for (int tn = 0; tn < 4; ++tn) acc[tm][tn] = __builtin_amdgcn_mfma_f32_32x32x16_bf16(bfr[tn], af[tm], acc[tm][tn], 0, 0, 0);
        }
    };
    Stage S0, S1;
    gload(S0); gload(S1);
    sstore(S0, 0); __syncthreads();
#define GSTEP(SL, SS) { gload(SL); compute(kt & 1); sstore(SS, (kt + 1) & 1); __syncthreads(); if (++kt >= KT) break; }
    for (int kt = 0;;) {
        GSTEP(S0, S1)
        GSTEP(S1, S0)
    }
#undef GSTEP
    epi(acc, wm, wn, r, h);
}
struct Epi4Bf16 {
    bf16_t* out; size_t ld;
    DI void operator()(const f32x16 (&acc)[2][4], int wm, int wn, int r, int h) const {
#pragma unroll
        for (int tm = 0; tm < 2; ++tm) {
            bf16_t* rp = out + (size_t)(wm * 64 + tm * 32 + r) * ld + wn * 128 + 4 * h;
#pragma unroll
            for (int tn = 0; tn < 4; ++tn)
#pragma unroll
                for (int g = 0; g < 4; ++g) {
                    u32x2 v; v.x = pk2(acc[tm][tn][4 * g], acc[tm][tn][4 * g + 1]); v.y = pk2(acc[tm][tn][4 * g + 2], acc[tm][tn][4 * g + 3]);
                    *(u32x2*)(rp + tn * 32 + 8 * g) = v;
                }
        }
    }
};
struct Epi4Resid {
    float* out; const float* res; size_t ld;
    DI void operator()(const f32x16 (&acc)[2][4], int wm, int wn, int r, int h) const {
#pragma unroll
        for (int tm = 0; tm < 2; ++tm) {
            const size_t o = (size_t)(wm * 64 + tm * 32 + r) * ld + wn * 128 + 4 * h;
#pragma unroll
            for (int hf = 0; hf < 2; ++hf) {
                float4 x[8];
#pragma unroll
                for (int i = 0; i < 8; ++i) x[i] = *(const float4*)(res + o + (hf * 2 + (i >> 2)) * 32 + 8 * (i & 3));
#pragma unroll
                for (int i = 0; i < 8; ++i) {
                    const int tn = hf * 2 + (i >> 2), g = i & 3;
                    x[i].x += acc[tm][tn][4 * g]; x[i].y += acc[tm][tn][4 * g + 1]; x[i].z += acc[tm][tn][4 * g + 2]; x[i].w += acc[tm][tn][4 * g + 3];
                }
#pragma unroll
                for (int i = 0; i < 8; ++i) *(float4*)(out + o + (hf * 2 + (i >> 2)) * 32 + 8 * (i & 3)) = x[i];
            }
        }
    }
};
struct Epi4Inproj {
    Epi4Bf16 eb; float* gout; const float* bi; const float* bf; bool isgate;
    DI void operator()(const f32x16 (&acc)[2][4], int wm, int wn, int r, int h) const {
        if (!isgate) { eb(acc, wm, wn, r, h); return; }
        if (wn == 0) {
#pragma unroll
            for (int tm = 0; tm < 2; ++tm) {
                const float* bb = h ? bf : bi;
                float4 x = {acc[tm][0][0] + bb[0], acc[tm][0][1] + bb[1], acc[tm][0][2] + bb[2], acc[tm][0][3] + bb[3]};
                *(float4*)(gout + (size_t)(wm * 64 + tm * 32 + r) * 8 + 4 * h) = x;
            }
        }
    }
};
struct EpiBf16 {
    bf16_t* out; size_t ld;
    DI void operator()(const f32x16 (&acc)[2][2], int wm, int wn, int r, int h) const {
#pragma unroll
        for (int tm = 0; tm < 2; ++tm) {
            bf16_t* rp = out + (size_t)(wm * 64 + tm * 32 + r) * ld + wn * 64 + 4 * h;
#pragma unroll
            for (int tn = 0; tn < 2; ++tn)
#pragma unroll
                for (int g = 0; g < 4; ++g) {
                    u32x2 v; v.x = pk2(acc[tm][tn][4 * g], acc[tm][tn][4 * g + 1]); v.y = pk2(acc[tm][tn][4 * g + 2], acc[tm][tn][4 * g + 3]);
                    *(u32x2*)(rp + tn * 32 + 8 * g) = v;
                }
        }
    }
};
struct EpiResid {
    float* out; const float* res; size_t ld;
    DI void operator()(const f32x16 (&acc)[2][2], int wm, int wn, int r, int h) const {
#pragma unroll
        for (int tm = 0; tm < 2; ++tm) {
            const size_t o = (size_t)(wm * 64 + tm * 32 + r) * ld + wn * 64 + 4 * h;
            float4 x[8];
#pragma unroll
            for (int i = 0; i < 8; ++i) x[i] = *(const float4*)(res + o + (i >> 2) * 32 + 8 * (i & 3));
#pragma unroll
            for (int i = 0; i < 8; ++i) {
                const int tn = i >> 2, g = i & 3;
                x[i].x += acc[tm][tn][4 * g]; x[i].y += acc[tm][tn][4 * g + 1]; x[i].z += acc[tm][tn][4 * g + 2]; x[i].w += acc[tm][tn][4 * g + 3];
            }
#pragma unroll
            for (int i = 0; i < 8; ++i) *(float4*)(out + o + (i >> 2) * 32 + 8 * (i & 3)) = x[i];
        }
    }
};
DI float silu_mul(float g, float u) { return g / (1.0f + __expf(-g)) * u; }
struct EpiGateUp {
    bf16_t* out;
    DI void operator()(const f32x16 (&acc)[2][2], int wm, int wn, int r, int h) const {
#pragma unroll
        for (int tm = 0; tm < 2; ++tm) {
            bf16_t* rp = out + (size_t)(wm * 64 + tm * 32 + r) * DE + wn * 32 + 4 * h;
#pragma unroll
            for (int g = 0; g < 4; ++g) {
                u32x2 v;
                v.x = pk2(silu_mul(acc[tm][0][4 * g], acc[tm][1][4 * g]), silu_mul(acc[tm][0][4 * g + 1], acc[tm][1][4 * g + 1]));
                v.y = pk2(silu_mul(acc[tm][0][4 * g + 2], acc[tm][1][4 * g + 2]), silu_mul(acc[tm][0][4 * g + 3], acc[tm][1][4 * g + 3]));
                *(u32x2*)(rp + 8 * g) = v;
            }
        }
    }
};
struct EpiDown {
    bf16_t* out; const float* roww; int nvalid;
    DI void operator()(const f32x16 (&acc)[2][2], int wm, int wn, int r, int h) const {
#pragma unroll
        for (int tm = 0; tm < 2; ++tm) {
            const int row = wm * 64 + tm * 32 + r;
            const float wv = row < nvalid ? roww[row] : 0.f;
            bf16_t* rp = out + (size_t)row * DM + wn * 64 + 4 * h;
#pragma unroll
            for (int tn = 0; tn < 2; ++tn)
#pragma unroll
                for (int g = 0; g < 4; ++g) {
                    u32x2 v; v.x = pk2(acc[tm][tn][4 * g] * wv, acc[tm][tn][4 * g + 1] * wv); v.y = pk2(acc[tm][tn][4 * g + 2] * wv, acc[tm][tn][4 * g + 3] * wv);
                    *(u32x2*)(rp + tn * 32 + 8 * g) = v;
                }
        }
    }
};

struct EpiGates {
    float* out; const float* bi; const float* bf;
    DI void operator()(const f32x16 (&acc)[2][2], int wm, int wn, int r, int h) const {
        if (wn == 0) {
#pragma unroll
            for (int tm = 0; tm < 2; ++tm) {
                const float* bb = h ? bf : bi;
                float4 x = {acc[tm][0][0] + bb[0], acc[tm][0][1] + bb[1], acc[tm][0][2] + bb[2], acc[tm][0][3] + bb[3]};
                *(float4*)(out + (size_t)(wm * 64 + tm * 32 + r) * 8 + 4 * h) = x;
            }
        }
    }
};
struct EpiInproj {
    EpiBf16 eb; EpiGates eg; bool isgate;
    DI void operator()(const f32x16 (&acc)[2][2], int wm, int wn, int r, int h) const { if (isgate) eg(acc, wm, wn, r, h); else eb(acc, wm, wn, r, h); }
};
struct EpiF32 {
    float* out; size_t ld;
    DI void operator()(const f32x16 (&acc)[2][2], int wm, int wn, int r, int h) const {
#pragma unroll
        for (int tm = 0; tm < 2; ++tm) {
            float* rp = out + (size_t)(wm * 64 + tm * 32 + r) * ld + wn * 64 + 4 * h;
#pragma unroll
            for (int tn = 0; tn < 2; ++tn)
#pragma unroll
                for (int g = 0; g < 4; ++g) { float4 x = {acc[tm][tn][4 * g], acc[tm][tn][4 * g + 1], acc[tm][tn][4 * g + 2], acc[tm][tn][4 * g + 3]}; *(float4*)(rp + tn * 32 + 8 * g) = x; }
        }
    }
};
DI float gelu_tanh(float v) {
    const float inner = 0.7978845608028654f * (v + 0.044715f * v * v * v);
    const float th = 1.0f - 2.0f / (__expf(2.0f * inner) + 1.0f);
    return 0.5f * v * (1.0f + th);
}
struct EpiS5Y {
    bf16_t* zrow0;
    int ncol0;
    DI void operator()(const f32x16 (&acc)[2][2], int wm, int wn, int r, int h) const {
#pragma unroll
        for (int tm = 0; tm < 2; ++tm) {
            const int chunk = wm * 64 + tm * 32 + r;
#pragma unroll
            for (int tn = 0; tn < 2; ++tn)
#pragma unroll
                for (int g = 0; g < 4; ++g) {
                    const int n0 = ncol0 + wn * 64 + tn * 32 + 8 * g + 4 * h;
                    u32x2 v; v.x = pk2(gelu_tanh(acc[tm][tn][4 * g]), gelu_tanh(acc[tm][tn][4 * g + 1])); v.y = pk2(gelu_tanh(acc[tm][tn][4 * g + 2]), gelu_tanh(acc[tm][tn][4 * g + 3]));
                    *(u32x2*)(zrow0 + (size_t)(chunk * 16 + (n0 >> 4)) * 256 + (n0 & 15)) = v;
                }
        }
    }
};
struct EpiGlu {
    const bf16_t* z; bf16_t* out; const float* gb; const float* sg;
    DI void operator()(const f32x16 (&acc)[2][2], int wm, int wn, int r, int h) const {
#pragma unroll
        for (int tm = 0; tm < 2; ++tm) {
            const int row = wm * 64 + tm * 32 + r;
#pragma unroll
            for (int tn = 0; tn < 2; ++tn) {
                const int c0 = wn * 64 + tn * 32 + 4 * h;
                float y[16];
#pragma unroll
                for (int g = 0; g < 4; ++g) {
                    const u32x2 zz = *(const u32x2*)(z + (size_t)row * 256 + c0 + 8 * g);
                    const float4 b4 = *(const float4*)(gb + c0 + 8 * g);
                    y[4 * g + 0] = bf2f(zz.x & 0xffff) / (1.0f + __expf(-(acc[tm][tn][4 * g + 0] + b4.x)));
                    y[4 * g + 1] = bf2f(zz.x >> 16) / (1.0f + __expf(-(acc[tm][tn][4 * g + 1] + b4.y)));
                    y[4 * g + 2] = bf2f(zz.y & 0xffff) / (1.0f + __expf(-(acc[tm][tn][4 * g + 2] + b4.z)));
                    y[4 * g + 3] = bf2f(zz.y >> 16) / (1.0f + __expf(-(acc[tm][tn][4 * g + 3] + b4.w)));
                }
#pragma unroll
                for (int q = 0; q < 2; ++q) {
                    float ss = 0.f;
#pragma unroll
                    for (int e = 0; e < 8; ++e) ss += y[8 * q + e] * y[8 * q + e];
                    ss = half_swap_sum(ss);
                    const float rstd = rsqrtf(ss * (1.0f / 16.0f) + EPS);
#pragma unroll
                    for (int g = 2 * q; g < 2 * q + 2; ++g) {
                        const float4 s4 = *(const float4*)(sg + c0 + 8 * g);
                        u32x2 v; v.x = pk2(y[4 * g] * rstd * s4.x, y[4 * g + 1] * rstd * s4.y); v.y = pk2(y[4 * g + 2] * rstd * s4.z, y[4 * g + 3] * rstd * s4.w);
                        *(u32x2*)(out + (size_t)row * DM + c0 + 8 * g) = v;
                    }
                }
            }
        }
    }
};

DI void moe_prefix(const int* cnt, int* stp  ) {
    __syncthreads();
    if (tid_() == 0) { int a = 0; for (int e = 0; e < NE; ++e) { stp[e] = a; a += (cnt[e] + 127) >> 7; } stp[NE] = a; }
    __syncthreads();
}

constexpr int XS_P = 1028;
template <int NC>
DI void rows_matvec(const float* xs, const float* W, int ldw, float* part  ) {
    constexpr int O = 8 * NC, PARTS = 256 / O, KLEN = 1024 / PARTS;
    const int t = tid_(), o = t % O, prt = t / O, r = o / NC, j = o % NC;
    const float* xr = xs + r * XS_P + prt * KLEN;
    const float* wp = W + (size_t)(prt * KLEN) * ldw + j;
    float a0 = 0.f, a1 = 0.f, a2 = 0.f, a3 = 0.f;
#pragma unroll 4
    for (int k = 0; k < KLEN; k += 4) {
        const float4 x = *(const float4*)(xr + k);
        a0 += x.x * wp[(size_t)k * ldw]; a1 += x.y * wp[(size_t)(k + 1) * ldw]; a2 += x.z * wp[(size_t)(k + 2) * ldw]; a3 += x.w * wp[(size_t)(k + 3) * ldw];
    }
    part[t] = (a0 + a1) + (a2 + a3);
}

DI void phase_norm1(const P& p, int l, char* lds) {
    const int t = tid_(), lane = t & 63, w = t >> 6;
    float* xres = (float*)(p.ws + WS_XRES);
    bf16_t* hbuf = (bf16_t*)(p.ws + WS_HBUF);
    float* gates = (float*)(p.ws + WS_GATES);
    const float* g1 = p.in[1] + l * DM;
    const float* win = p.in[2] + (size_t)l * DM * DIN;
    float* xs = (float*)lds;
    float* part = xs + 8 * XS_P;
    int* stp = (int*)(part + 256);
    const bf16_t* ymoe = (const bf16_t*)(p.ws + WS_YMOE);
    const int4* tinfo = (const int4*)(p.ws + WS_TINFO);
    if (l > 0) moe_prefix((const int*)(p.ws + WS_CTL) + (l - 1) * NE, stp);
    if (l == 0) {
        const size_t stride = (size_t)gridDim.x * 256, i0 = (size_t)bid_() * 256 + t;
        const float4* s1 = (const float4*)p.in[2]; u32x2* d1 = (u32x2*)(p.ws + WS_WINB);
        for (size_t i = i0; i < (size_t)2 * DM * DIN / 4; i += stride) { const float4 v = s1[i]; u32x2 o; o.x = pk2(v.x, v.y); o.y = pk2(v.z, v.w); d1[i] = o; }
        const float4* s2 = (const float4*)p.in[22]; u32x2* d2 = (u32x2*)(p.ws + WS_WOUTB);
        for (size_t i = i0; i < (size_t)2 * DM * DM / 4; i += stride) { const float4 v = s2[i]; u32x2 o; o.x = pk2(v.x, v.y); o.y = pk2(v.z, v.w); d2[i] = o; }
    }
    for (int rb = bid_(); rb < T / 8; rb += gridDim.x) {
        __syncthreads();
#pragma unroll
        for (int rr = 0; rr < 2; ++rr) {
            const int lr = w * 2 + rr, row = rb * 8 + lr;
            float4 v[4];
            const float* xsrc = (l == 0) ? p.in[0] + (size_t)row * DM : xres + (size_t)row * DM;
#pragma unroll
            for (int i = 0; i < 4; ++i) v[i] = *(const float4*)(xsrc + i * 256 + lane * 4);
            if (l > 0) {
                int4 ti = tinfo[row];
                const bf16_t* y0 = ymoe + (size_t)(stp[ti.x] * 128 + ti.y) * DM;
                const bf16_t* y1 = ymoe + (size_t)(stp[ti.z] * 128 + ti.w) * DM;
#pragma unroll
                for (int i = 0; i < 4; ++i) {
                    uint2 a = *(const uint2*)(y0 + i * 256 + lane * 4), b2 = *(const uint2*)(y1 + i * 256 + lane * 4);
                    v[i].x += bf2f(a.x & 0xffff) + bf2f(b2.x & 0xffff); v[i].y += bf2f(a.x >> 16) + bf2f(b2.x >> 16);
                    v[i].z += bf2f(a.y & 0xffff) + bf2f(b2.y & 0xffff); v[i].w += bf2f(a.y >> 16) + bf2f(b2.y >> 16);
                    *(float4*)(xres + (size_t)row * DM + i * 256 + lane * 4) = v[i];
                }
            }
            float ss = 0.f;
#pragma unroll
            for (int i = 0; i < 4; ++i) ss += v[i].x * v[i].x + v[i].y * v[i].y + v[i].z * v[i].z + v[i].w * v[i].w;
            ss = wave_sum(ss);
            const float rstd = rsqrtf(ss * (1.0f / DM) + EPS);
#pragma unroll
            for (int i = 0; i < 4; ++i) {
                const int k0 = i * 256 + lane * 4;
                const float4 g = *(const float4*)(g1 + k0);
                float4 hv = {v[i].x * rstd * g.x, v[i].y * rstd * g.y, v[i].z * rstd * g.z, v[i].w * rstd * g.w};
                uint2 o; o.x = pk2(hv.x, hv.y); o.y = pk2(hv.z, hv.w);
                *(uint2*)(hbuf + (size_t)row * DM + k0) = o;
            }
        }
    }
}

DI void phase_inproj(const P& p, int l, char* lds) {
    const int t = tid_();
    const bf16_t* hbuf = (const bf16_t*)(p.ws + WS_HBUF);
    bf16_t* projb = (bf16_t*)(p.ws + WS_PROJ);
    const bf16_t* winb = (const bf16_t*)(p.ws + WS_WINB) + (size_t)l * DM * DIN;
    float* gates = (float*)(p.ws + WS_GATES);
    const int vx = bid_() & 7, vj = bid_() >> 3, nj = (gridDim.x - vx + 7) >> 3;
    for (int st = vx; st < 16; st += 8)
      for (int j = vj; j < 96; j += nj) {
        const int mt = st * 8 + j / 12, vt = j % 12;
        const int acol = vt < 4 ? vt * 256 : (vt < 10 ? 1032 + (vt - 4) * 256 : (vt == 10 ? 2568 : 1024));
        const bf16_t* ar = hbuf + (size_t)(mt * 128 + (t >> 2)) * DM + (t & 3) * 8;
        GSeg4 g1{ar, ar + (size_t)64 * DM, 32, winb + (size_t)(t >> 5) * DIN + acol + (t & 31) * 8, DIN, DM / 32}; GSeg4 g2 = g1; g2.KT = 0;
        Epi4Inproj epi{Epi4Bf16{projb + (size_t)mt * 128 * PJ + (vt % 11) * 256, (size_t)PJ}, gates + (size_t)mt * 128 * 8, p.in[3] + l * 4, p.in[4] + l * 4, vt == 11};
        gemm4(g1, g2, lds, epi);
      }
}

__constant__ float ROPE_INV_REV[8] = {0.15915494309189535f, 0.03086376340470123f, 0.005985185712713705f, 0.001160663641240061f,
                                      0.00022507907903927653f, 4.364795279280289e-05f, 8.464330808241401e-06f, 1.6414262627950345e-06f};
DI void load64(const bf16_t* ptr, float (&x)[64]) {
#pragma unroll
    for (int c = 0; c < 8; ++c) {
        u32x4 u = *(const u32x4*)(ptr + c * 8);
        x[c * 8 + 0] = bf2f(u.x & 0xffff); x[c * 8 + 1] = bf2f(u.x >> 16); x[c * 8 + 2] = bf2f(u.y & 0xffff); x[c * 8 + 3] = bf2f(u.y >> 16);
        x[c * 8 + 4] = bf2f(u.z & 0xffff); x[c * 8 + 5] = bf2f(u.z >> 16); x[c * 8 + 6] = bf2f(u.w & 0xffff); x[c * 8 + 7] = bf2f(u.w >> 16);
    }
}
DI void store64(bf16_t* ptr, const float (&x)[64], float sc) {
#pragma unroll
    for (int c = 0; c < 8; ++c) {
        u32x4 u;
        u.x = pk2(x[c * 8 + 0] * sc, x[c * 8 + 1] * sc); u.y = pk2(x[c * 8 + 2] * sc, x[c * 8 + 3] * sc);
        u.z = pk2(x[c * 8 + 4] * sc, x[c * 8 + 5] * sc); u.w = pk2(x[c * 8 + 6] * sc, x[c * 8 + 7] * sc);
        *(u32x4*)(ptr + c * 8) = u;
    }
}
DI void norm_rope64(float (&x)[64], const float* g, int pos) {
    float ss = 0.f;
#pragma unroll
    for (int d = 0; d < 64; ++d) ss += x[d] * x[d];
    const float rstd = rsqrtf(ss * (1.0f / 64.0f) + EPS);
#pragma unroll
    for (int d = 0; d < 64; ++d) x[d] = x[d] * rstd * g[d];
#pragma unroll
    for (int d = 0; d < 8; ++d) {
        constexpr double RINV[8] = {0.15915494309189535, 0.03086376340470123, 0.005985185712713705, 0.001160663641240061,
                                    0.00022507907903927653, 4.364795279280289e-05, 8.464330808241401e-06, 1.6414262627950345e-06};
        double rr = (double)pos * RINV[d];
        rr -= floor(rr);
        const float sn = __builtin_amdgcn_sinf((float)rr), cs = __builtin_amdgcn_cosf((float)rr);
        const float x1 = x[d], x2 = x[d + 8];
        x[d] = x1 * cs - x2 * sn; x[d + 8] = x2 * cs + x1 * sn;
    }
}
DI void phase_qkprep(const P& p, int l, char* lds, unsigned long long& tsub) {
    unsigned long long tq0 = PROBE_SUB ? wall_clock64() : 0ull;
#define QSUB(bit) do { if (PROBE_SUB) { const unsigned long long tn_ = wall_clock64(); if (PROBE_SUB & (bit)) tsub += tn_ - tq0; tq0 = tn_; } } while (0)
    bf16_t* projb = (bf16_t*)(p.ws + WS_PROJ);
    float* kmean = (float*)(p.ws + WS_KMEAN);
    float* red = (float*)lds;
    const int t = tid_(), lane = t & 63, w = t >> 6;
    for (int item = bid_(); item < 512; item += gridDim.x) {
        const int b = item >> 6, n = (item >> 3) & 7, hd = item & 7;
        const int s8 = t & 7, tg = t >> 3;
        float ks[8];
#pragma unroll
        for (int j = 0; j < 8; ++j) ks[j] = 0.f;
        float gq[8], gk[8];
        {
            const float4 a0 = *(const float4*)(p.in[8] + l * 64 + s8 * 8), a1 = *(const float4*)(p.in[8] + l * 64 + s8 * 8 + 4);
            const float4 c0 = *(const float4*)(p.in[9] + l * 64 + s8 * 8), c1 = *(const float4*)(p.in[9] + l * 64 + s8 * 8 + 4);
            gq[0] = a0.x; gq[1] = a0.y; gq[2] = a0.z; gq[3] = a0.w; gq[4] = a1.x; gq[5] = a1.y; gq[6] = a1.z; gq[7] = a1.w;
            gk[0] = c0.x; gk[1] = c0.y; gk[2] = c0.z; gk[3] = c0.w; gk[4] = c1.x; gk[5] = c1.y; gk[6] = c1.z; gk[7] = c1.w;
        }
#pragma unroll 2
        for (int itk = 0; itk < 8; ++itk) {
            const int pos = n * 256 + itk * 32 + tg;
            bf16_t* rowp = projb + ((size_t)b * SEQ + pos) * PJ + hd * 64 + s8 * 8;
            const u32x4 uq = *(const u32x4*)(rowp + C_AQ), uk = *(const u32x4*)(rowp + C_AK);
            float sn[8], cs[8];
#pragma unroll
            for (int d = 0; d < 8; ++d) {
                constexpr double RINV[8] = {0.15915494309189535, 0.03086376340470123, 0.005985185712713705, 0.001160663641240061,
                                            0.00022507907903927653, 4.364795279280289e-05, 8.464330808241401e-06, 1.6414262627950345e-06};
                double rr = (double)pos * RINV[d];
                rr -= floor(rr);
                sn[d] = __builtin_amdgcn_sinf((float)rr); cs[d] = __builtin_amdgcn_cosf((float)rr);
            }
#pragma unroll
            for (int which = 0; which < 2; ++which) {
                const u32x4 u = which ? uk : uq;
                float x[8] = {bf2f(u.x & 0xffff), bf2f(u.x >> 16), bf2f(u.y & 0xffff), bf2f(u.y >> 16), bf2f(u.z & 0xffff), bf2f(u.z >> 16), bf2f(u.w & 0xffff), bf2f(u.w >> 16)};
                float ss = 0.f;
#pragma unroll
                for (int j = 0; j < 8; ++j) ss += x[j] * x[j];
                ss += __shfl_xor(ss, 1); ss += __shfl_xor(ss, 2); ss += __shfl_xor(ss, 4);
                const float rstd = rsqrtf(ss * (1.0f / 64.0f) + EPS);
#pragma unroll
                for (int j = 0; j < 8; ++j) x[j] = x[j] * rstd * (which ? gk[j] : gq[j]);
#pragma unroll
                for (int j = 0; j < 8; ++j) {
                    const float other = __shfl_xor(x[j], 1);
                    if (s8 == 0) x[j] = x[j] * cs[j] - other * sn[j];
                    else if (s8 == 1) x[j] = x[j] * cs[j] + other * sn[j];
                }
                const float sc = which ? 1.0f : 0.125f * 1.4426950408889634f;
                u32x4 o; o.x = pk2(x[0] * sc, x[1] * sc); o.y = pk2(x[2] * sc, x[3] * sc); o.z = pk2(x[4] * sc, x[5] * sc); o.w = pk2(x[6] * sc, x[7] * sc);
                *(u32x4*)(rowp + (which ? C_AK : C_AQ)) = o;
                if (which) {
#pragma unroll
                    for (int j = 0; j < 8; ++j) ks[j] += x[j];
                }
            }
        }
#pragma unroll
        for (int j = 0; j < 8; ++j) { ks[j] += __shfl_xor(ks[j], 8); ks[j] += __shfl_xor(ks[j], 16); ks[j] += __shfl_xor(ks[j], 32); }
        __syncthreads();
        if (lane < 8) {
#pragma unroll
            for (int j = 0; j < 8; ++j) red[w * 64 + lane * 8 + j] = ks[j];
        }
        __syncthreads();
        if (t < 64) kmean[(size_t)item * 64 + t] = (red[t] + red[64 + t] + red[128 + t] + red[192 + t]) * (1.0f / 256.0f);
    }
    QSUB(8);
    {
        bf16_t* mqkc = (bf16_t*)(p.ws + WS_MQKC);
        const float* cw = p.in[5] + l * 4 * 512; const float* cb = p.in[6] + l * 512;
        const int nthreads = gridDim.x * 256;
        for (int idx = bid_() * 256 + t; idx < T * 64; idx += nthreads) {
            const int token = idx >> 6, ch = (idx & 63) * 8, pos = token & (SEQ - 1);
            float a[8];
            { const float4 b0 = *(const float4*)(cb + ch), b1 = *(const float4*)(cb + ch + 4); a[0] = b0.x; a[1] = b0.y; a[2] = b0.z; a[3] = b0.w; a[4] = b1.x; a[5] = b1.y; a[6] = b1.z; a[7] = b1.w; }
#pragma unroll
            for (int j = 0; j < 4; ++j) {
                if (pos + j - 3 >= 0) {
                    const u32x4 u = *(const u32x4*)(projb + (size_t)(token + j - 3) * PJ + ch);
                    const float4 w0 = *(const float4*)(cw + j * 512 + ch), w1 = *(const float4*)(cw + j * 512 + ch + 4);
                    a[0] += bf2f(u.x & 0xffff) * w0.x; a[1] += bf2f(u.x >> 16) * w0.y; a[2] += bf2f(u.y & 0xffff) * w0.z; a[3] += bf2f(u.y >> 16) * w0.w;
                    a[4] += bf2f(u.z & 0xffff) * w1.x; a[5] += bf2f(u.z >> 16) * w1.y; a[6] += bf2f(u.w & 0xffff) * w1.z; a[7] += bf2f(u.w >> 16) * w1.w;
                }
            }
            const float sc = ch >= 256 ? 0.125f : 1.0f;
#pragma unroll
            for (int e = 0; e < 8; ++e) a[e] = a[e] / (1.0f + __expf(-a[e])) * sc;
            u32x4 o; o.x = pk2(a[0], a[1]); o.y = pk2(a[2], a[3]); o.z = pk2(a[4], a[5]); o.w = pk2(a[6], a[7]);
            *(u32x4*)(mqkc + (size_t)token * 512 + ch) = o;
        }
    }
    QSUB(16);
    {
        const float* gates = (const float*)(p.ws + WS_GATES);
        float4* gscan = (float4*)(p.ws + WS_GSCAN);
        const int lane = t & 63, gwv = bid_() * 4 + (t >> 6), nwv = gridDim.x * 4;
        for (int it = gwv; it < (T / 64) * 4; it += nwv) {
            const int ck = it >> 2, hd = it & 3;
            const size_t row = (size_t)ck * 64 + lane;
            const float gi = gates[row * 8 + hd], gf = gates[row * 8 + 4 + hd];
            const float lf = fminf(gf, 0.f) - log1pf(expf(-fabsf(gf)));
            float bs = lf;
#pragma unroll
            for (int o = 1; o < 64; o <<= 1) { const float v = __shfl_up(bs, o); if (lane >= o) bs += v; }
            const float u = gi - bs; float um = u;
#pragma unroll
            for (int o = 1; o < 64; o <<= 1) { const float v = __shfl_up(um, o); if (lane >= o) um = fmaxf(um, v); }
            gscan[row * 4 + hd] = make_float4(bs, u, um, 0.f);
        }
    }
    QSUB(32);
    {
        float* Tm = (float*)(p.ws + WS_S5M + (size_t)l * S5M_LAYER);
        float* Em = (float*)(p.ws + WS_S5M + (size_t)l * S5M_LAYER + S5M_E);
        float* Fm = (float*)(p.ws + WS_S5M + (size_t)l * S5M_LAYER + S5M_F);
        float* sp = (float*)lds + 512;
        float* scr = sp + 384;
        float* sci = scr + 1024; float* sbr = sci + 1024; float* sbi = sbr + 1024;
        for (int item = bid_(); item < 512; item += gridDim.x) {
            const int g = item >> 5, tau = (item >> 1) & 15, part = item & 1, lg = l * 16 + g;
            float* Tg = Tm + (size_t)g * 256 * 256; float* Eg = Em + (size_t)g * 256 * 128; float* Fg = Fm + (size_t)g * 128 * 256;
            __syncthreads();
            {
                const float4 a0 = *(const float4*)(p.in[15] + (size_t)lg * 1024 + t * 4), a1 = *(const float4*)(p.in[16] + (size_t)lg * 1024 + t * 4);
                const float4 a2 = *(const float4*)(p.in[13] + (size_t)lg * 1024 + t * 4), a3 = *(const float4*)(p.in[14] + (size_t)lg * 1024 + t * 4);
                *(float4*)(scr + t * 4) = a0; *(float4*)(sci + t * 4) = a1; *(float4*)(sbr + t * 4) = a2; *(float4*)(sbi + t * 4) = a3;
            }
            if (t < 64) {
                const float lr = p.in[11][lg * 64 + t], li = p.in[12][lg * 64 + t], dt = expf(p.in[18][lg]);
                const float mag1 = expf(lr * dt), a1r = mag1 * cosf(li * dt), a1i = mag1 * sinf(li * dt);
                const float magt = expf(lr * dt * tau), atr = magt * cosf(li * dt * tau), ati = magt * sinf(li * dt * tau);
                const float zr = a1r - 1.0f, zi = a1i, dn = lr * lr + li * li;
                sp[t] = atr; sp[64 + t] = ati; sp[128 + t] = atr * a1r - ati * a1i; sp[192 + t] = atr * a1i + ati * a1r;
                sp[256 + t] = (zr * lr + zi * li) / dn; sp[320 + t] = (zi * lr - zr * li) / dn;
            }
            __syncthreads();
            if (part == 0) {
                const int hh = t >> 4, hp = t & 15;
                float kv = 0.f;
#pragma unroll 8
                for (int pi = 0; pi < 64; ++pi) {
                    const float fr = sp[256 + pi], fi = sp[320 + pi], br = sbr[pi * 16 + hp], bi = sbi[pi * 16 + hp];
                    const float bbr = fr * br - fi * bi, bbi = fr * bi + fi * br;
                    const float cr = scr[hh * 64 + pi], ci = sci[hh * 64 + pi], ar = sp[pi], ai = sp[64 + pi];
                    kv += (cr * ar - ci * ai) * bbr - (cr * ai + ci * ar) * bbi;
                }
                if (tau == 0 && hh == hp) kv += p.in[17][lg * 16 + hh];
                for (int s_ = 0; s_ + tau < 16; ++s_) {
                    const int t_ = s_ + tau;
                    Tg[(size_t)(s_ * 16 + hp) * 256 + t_ * 16 + hh] = kv;
                    if (tau > 0) Tg[(size_t)(t_ * 16 + hp) * 256 + s_ * 16 + hh] = 0.f;
                }
            }
            if (part == 1)
            for (int idx = t; idx < 1024; idx += 256) {
                const int pi = idx >> 4, x = idx & 15;
                {
                    const float fr = sp[256 + pi], fi = sp[320 + pi];
                    const float br = sbr[pi * 16 + x], bi = sbi[pi * 16 + x];
                    const float bbr = fr * br - fi * bi, bbi = fr * bi + fi * br, ar = sp[pi], ai = sp[64 + pi];
                    const size_t ro = (size_t)((15 - tau) * 16 + x) * 128;
                    Eg[ro + pi] = ar * bbr - ai * bbi; Eg[ro + 64 + pi] = ar * bbi + ai * bbr;
                }
                {
                    const float cr = scr[x * 64 + pi], ci = sci[x * 64 + pi];
                    const float ar = sp[128 + pi], ai = sp[192 + pi];
                    Fg[(size_t)pi * 256 + tau * 16 + x] = cr * ar - ci * ai; Fg[(size_t)(64 + pi) * 256 + tau * 16 + x] = -(cr * ai + ci * ar);
                }
            }
        }
    }
    QSUB(64);
#undef QSUB
}

DI void mlstm_item_simple(const P& p, int l, int item, float* sm) {
    const int b = item >> 4, hd = (item >> 2) & 3, dq = item & 3;
    const int t = tid_();
    const bf16_t* projb = (const bf16_t*)(p.ws + WS_PROJ);
    const float* gates = (const float*)(p.ws + WS_GATES);
    float* hraw = (float*)(p.ws + WS_HRAW);
    const float* cw = p.in[5] + l * 4 * 512; const float* cb = p.in[6] + l * 512;
    float* Q = sm; float* K = Q + 64 * 65; float* Sm = K + 64 * 65; float* V = Sm + 64 * 65; float* C = V + 64 * 16; float* nv = C + 64 * 16;
    float* bc = nv + 64; float* Mt = bc + 64; float* uu = Mt + 64; float* den = uu + 64; float* misc = den + 64;
    __syncthreads();
    for (int i = t; i < 1024; i += 256) C[i] = 0.f;
    if (t < 64) nv[t] = 0.f;
    if (t == 0) misc[0] = 0.f;
    for (int c = 0; c < 32; ++c) {
        __syncthreads();
        const int row0 = b * SEQ + c * 64;
        for (int i = t; i < 8192; i += 256) {
            const int which = i >> 12, tt = (i >> 6) & 63, d = i & 63, ch = which * 256 + hd * 64 + d;
            float a = cb[ch];
#pragma unroll
            for (int j = 0; j < 4; ++j) { const int ts = c * 64 + tt + j - 3; if (ts >= 0) a += bf2f(projb[(size_t)(b * SEQ + ts) * PJ + ch]) * cw[j * 512 + ch]; }
            float y = a / (1.0f + expf(-a));
            if (which) K[tt * 65 + d] = y * 0.125f; else Q[tt * 65 + d] = y;
        }
        for (int i = t; i < 1024; i += 256) { const int tt = i >> 4, d = i & 15; V[i] = bf2f(projb[(size_t)(row0 + tt) * PJ + C_MV + hd * 64 + dq * 16 + d]); }
        if (t < 64) {
            const float ig = gates[(size_t)(row0 + t) * 8 + hd], fg = gates[(size_t)(row0 + t) * 8 + 4 + hd];
            const float lf = fminf(fg, 0.f) - log1pf(expf(-fabsf(fg)));
            float bs = lf;
#pragma unroll
            for (int o = 1; o < 64; o <<= 1) { float v = __shfl_up(bs, o); if (t >= o) bs += v; }
            const float u = ig - bs; float um = u;
#pragma unroll
            for (int o = 1; o < 64; o <<= 1) { float v = __shfl_up(um, o); if (t >= o) um = fmaxf(um, v); }
            bc[t] = bs; uu[t] = u; Mt[t] = fmaxf(misc[0], um);
        }
        __syncthreads();
        for (int i = t; i < 4096; i += 256) {
            const int tt = i >> 6, s = i & 63; float v = 0.f;
            if (s <= tt) { float dsum = 0.f; for (int d = 0; d < 64; ++d) dsum += Q[tt * 65 + d] * K[s * 65 + d]; v = dsum * expf(uu[s] - Mt[tt]); }
            Sm[tt * 65 + s] = v;
        }
        __syncthreads();
        if (t < 64) {
            const float inter = expf(misc[0] - Mt[t]);
            float qn = 0.f, rs = 0.f;
            for (int d = 0; d < 64; ++d) { qn += Q[t * 65 + d] * nv[d]; rs += Sm[t * 65 + d]; }
            den[t] = fmaxf(fabsf(inter * qn + rs), expf(-(bc[t] + Mt[t])));
        }
        __syncthreads();
        for (int i = t; i < 1024; i += 256) {
            const int tt = i >> 4, d = i & 15;
            const float inter = expf(misc[0] - Mt[tt]);
            float a = 0.f, bsum = 0.f;
            for (int k = 0; k < 64; ++k) { a += Q[tt * 65 + k] * C[k * 16 + d]; bsum += Sm[tt * 65 + k] * V[k * 16 + d]; }
            hraw[(size_t)(row0 + tt) * 256 + hd * 64 + dq * 16 + d] = (inter * a + bsum) / den[tt];
        }
        __syncthreads();
        const float Mlast = Mt[63], decay = expf(misc[0] - Mlast);
        for (int i = t; i < 1024; i += 256) {
            const int dk = i >> 4, d = i & 15; float a = 0.f;
            for (int s = 0; s < 64; ++s) a += expf(uu[s] - Mlast) * K[s * 65 + dk] * V[s * 16 + d];
            C[i] = decay * C[i] + a;
        }
        if (t < 64) { float a = 0.f; for (int s = 0; s < 64; ++s) a += expf(uu[s] - Mlast) * K[s * 65 + t]; nv[t] = decay * nv[t] + a; }
        __syncthreads();
        if (t == 0) misc[0] = bc[63] + Mlast;
    }
}

constexpr int ML_QP = 144, ML_TP = 192;
constexpr int ML_Q = 0, ML_K = 9216, ML_KW = 18432, ML_V = 30720, ML_C = 43008, ML_N = 55296, ML_U = 55808, ML_NP = 56064, ML_SS = 57088, ML_DEC = 57600;
DI bf16x8 scale8(u32x4 v, float w) {
    u32x4 o;
    o.x = pk2(bf2f(v.x & 0xffff) * w, bf2f(v.x >> 16) * w); o.y = pk2(bf2f(v.y & 0xffff) * w, bf2f(v.y >> 16) * w);
    o.z = pk2(bf2f(v.z & 0xffff) * w, bf2f(v.z >> 16) * w); o.w = pk2(bf2f(v.w & 0xffff) * w, bf2f(v.w >> 16) * w);
    return __builtin_bit_cast(bf16x8, o);
}
DI bf16x8 tr_frag(const LAS char* p, int hi_off) {
    s16x4 lo = tr_read(p), hi = tr_read(p + hi_off);
    return __builtin_shufflevector(lo, hi, 0, 1, 2, 3, 4, 5, 6, 7);
}
DI void mlstm_mscan(const float4* gscan, size_t rowb, int hd, int lane, float& m_in, float& decay) {
    const int ci = lane & 31;
    const float4 gl = gscan[(rowb + ci * 64 + 63) * 4 + hd];
    float A = gl.x, B = gl.z + gl.x;
#pragma unroll
    for (int o = 1; o < 32; o <<= 1) {
        const float Ap = __shfl_up(A, o), Bp = __shfl_up(B, o);
        if (ci >= o) { B = fmaxf(Bp + A, B); A = Ap + A; }
    }
    const float mafter = fmaxf(A, B);
    const float mprev = __shfl_up(mafter, 1);
    m_in = ci == 0 ? 0.f : mprev;
    decay = __expf(m_in - fmaxf(m_in, gl.z));
}
DI void mlstm_state_item(const P& p, int l, int item, char* lds_generic) {
    LAS char* lds = (LAS char*)lds_generic;
    const int bh = item >> 5, c = item & 31, b = bh >> 2, hd = bh & 3;
    const int t = tid_(), lane = t & 63, w = t >> 6, r = lane & 31, h = lane >> 5;
    const int i16 = lane & 15, q4 = i16 >> 2, pp = i16 & 3, blk = (lane >> 4) & 1;
    const int wd = w & 1, wt = w >> 1;
    const bf16_t* projb = (const bf16_t*)(p.ws + WS_PROJ);
    const bf16_t* mqkc = (const bf16_t*)(p.ws + WS_MQKC);
    const float4* gscan = (const float4*)(p.ws + WS_GSCAN);
    float* dC = (float*)(p.ws + WS_HRAW) + (size_t)item * 4096;
    float* dn = (float*)(p.ws + WS_ZBUF + 8 * MiB) + (size_t)item * 64;
    LAS float* npart = (LAS float*)(lds + ML_NP);
    const int srow = t >> 3, sc16 = t & 7;
    const size_t rowb = (size_t)b * SEQ, row0 = rowb + c * 64;
    const bf16_t* kp = mqkc + (row0 + srow) * 512 + 256 + hd * 64 + sc16 * 8;
    const u32x4 rk0 = *(const u32x4*)kp, rk1 = *(const u32x4*)(kp + 32 * 512);
    const bf16_t* vp = projb + (row0 + srow) * PJ + C_MV + hd * 64 + sc16 * 8;
    const u32x4 rv0 = *(const u32x4*)vp, rv1 = *(const u32x4*)(vp + (size_t)32 * PJ);
    const float4 gl0 = gscan[(row0 + srow) * 4 + hd], gl1 = gscan[(row0 + srow + 32) * 4 + hd], glast = gscan[(row0 + 63) * 4 + hd];
    float m_in, dec; mlstm_mscan(gscan, rowb, hd, lane, m_in, dec);
    const float m = __shfl(m_in, c);
    const float Mlast = fmaxf(m, glast.z);
    __syncthreads();
    {
        const float w0 = __expf(gl0.y - Mlast), w1 = __expf(gl1.y - Mlast);
        *(LAS u32x4*)(lds + ML_V + srow * ML_TP + sc16 * 16) = rv0; *(LAS u32x4*)(lds + ML_V + (srow + 32) * ML_TP + sc16 * 16) = rv1;
        *(LAS bf16x8*)(lds + ML_KW + srow * ML_TP + sc16 * 16) = scale8(rk0, w0); *(LAS bf16x8*)(lds + ML_KW + (srow + 32) * ML_TP + sc16 * 16) = scale8(rk1, w1);
    }
    __syncthreads();
    f32x16 cacc;
#pragma unroll
    for (int e = 0; e < 16; ++e) cacc[e] = 0.f;
#pragma unroll
    for (int k4 = 0; k4 < 4; ++k4) {
        const bf16x8 vf = tr_frag(lds + ML_V + (k4 * 16 + 4 * h + q4) * ML_TP + (wd * 32 + 16 * blk) * 2 + 8 * pp, 8 * ML_TP);
        const bf16x8 kwf = tr_frag(lds + ML_KW + (k4 * 16 + 4 * h + q4) * ML_TP + (wt * 32 + 16 * blk) * 2 + 8 * pp, 8 * ML_TP);
        cacc = __builtin_amdgcn_mfma_f32_32x32x16_bf16(vf, kwf, cacc, 0, 0, 0);
    }
    {
        const int dk = t & 63, qd = t >> 6; float a = 0.f;
#pragma unroll
        for (int s_ = 0; s_ < 16; ++s_) a += bf2f(*(const LAS bf16_t*)(lds + ML_KW + (qd * 16 + s_) * ML_TP + dk * 2));
        npart[qd * 64 + dk] = a;
    }
#pragma unroll
    for (int g = 0; g < 4; ++g) { float4 x = {cacc[4 * g], cacc[4 * g + 1], cacc[4 * g + 2], cacc[4 * g + 3]}; *(float4*)(dC + (wt * 32 + r) * 64 + wd * 32 + 8 * g + 4 * h) = x; }
    __syncthreads();
    if (t < 64) dn[t] = (npart[t] + npart[64 + t]) + (npart[128 + t] + npart[192 + t]);
}
DI void mlstm_out_item(const P& p, int l, int item, char* lds_generic) {
    LAS char* lds = (LAS char*)lds_generic;
    const int bh = item >> 5, c = item & 31, b = bh >> 2, hd = bh & 3;
    const int t = tid_(), lane = t & 63, w = t >> 6, r = lane & 31, h = lane >> 5;
    const int i16 = lane & 15, q4 = i16 >> 2, pp = i16 & 3, blk = (lane >> 4) & 1;
    const int wd = w & 1, wt = w >> 1;
    const bf16_t* projb = (const bf16_t*)(p.ws + WS_PROJ);
    const bf16_t* mqkc = (const bf16_t*)(p.ws + WS_MQKC);
    const float4* gscan = (const float4*)(p.ws + WS_GSCAN);
    const float* dCb = (const float*)(p.ws + WS_HRAW) + (size_t)bh * 32 * 4096;
    const float* dnb = (const float*)(p.ws + WS_ZBUF + 8 * MiB) + (size_t)bh * 32 * 64;
    bf16_t* mix = (bf16_t*)(p.ws + WS_MIX);
    const float* mg = p.in[7] + l * 256 + hd * 64;
    LAS float* nbuf = (LAS float*)(lds + ML_N); LAS float* ubuf2 = (LAS float*)(lds + ML_U); LAS float* ssbuf = (LAS float*)(lds + ML_SS); LAS float* decs = (LAS float*)(lds + ML_DEC);
    const int srow = t >> 3, sc16 = t & 7;
    const float LOG2E = 1.4426950408889634f;
    const size_t rowb = (size_t)b * SEQ, row0 = rowb + c * 64;
    const int tt = wt * 32 + r;
    const bf16_t* qp = mqkc + (row0 + srow) * 512 + hd * 64 + sc16 * 8;
    const u32x4 rq0 = *(const u32x4*)qp, rq1 = *(const u32x4*)(qp + 32 * 512), rk0 = *(const u32x4*)(qp + 256), rk1 = *(const u32x4*)(qp + 32 * 512 + 256);
    const bf16_t* vp = projb + (row0 + srow) * PJ + C_MV + hd * 64 + sc16 * 8;
    const u32x4 rv0 = *(const u32x4*)vp, rv1 = *(const u32x4*)(vp + (size_t)32 * PJ);
    const float4 gl0 = gscan[(row0 + srow) * 4 + hd], gl1 = gscan[(row0 + srow + 32) * 4 + hd], gtt = gscan[(row0 + tt) * 4 + hd];
    const bf16_t* opp = projb + (row0 + tt) * PJ + C_MO + hd * 64 + wd * 32 + 4 * h;
    const u32x2 opre[4] = {*(const u32x2*)(opp), *(const u32x2*)(opp + 8), *(const u32x2*)(opp + 16), *(const u32x2*)(opp + 24)};
    float4 mgr[4];
#pragma unroll
    for (int g = 0; g < 4; ++g) mgr[g] = *(const float4*)(mg + wd * 32 + 4 * h + 8 * g);
    float m_in, dec; mlstm_mscan(gscan, rowb, hd, lane, m_in, dec);
    const float m = __shfl(m_in, c);
    __syncthreads();
    if (t < 32) decs[t] = dec;
    __syncthreads();
    {
        float4 c0 = {0.f, 0.f, 0.f, 0.f}, c1 = c0, c2 = c0, c3 = c0; float nacc = 0.f;
        const float* src = dCb + (t >> 2) * 64 + (t & 3) * 16;
#pragma unroll 4
        for (int cc = 0; cc < c; ++cc) {
            const float d = decs[cc];
            const float4 x0 = *(const float4*)(src), x1 = *(const float4*)(src + 4), x2 = *(const float4*)(src + 8), x3 = *(const float4*)(src + 12);
            c0.x = c0.x * d + x0.x; c0.y = c0.y * d + x0.y; c0.z = c0.z * d + x0.z; c0.w = c0.w * d + x0.w;
            c1.x = c1.x * d + x1.x; c1.y = c1.y * d + x1.y; c1.z = c1.z * d + x1.z; c1.w = c1.w * d + x1.w;
            c2.x = c2.x * d + x2.x; c2.y = c2.y * d + x2.y; c2.z = c2.z * d + x2.z; c2.w = c2.w * d + x2.w;
            c3.x = c3.x * d + x3.x; c3.y = c3.y * d + x3.y; c3.z = c3.z * d + x3.z; c3.w = c3.w * d + x3.w;
            if (t < 64) nacc = nacc * d + dnb[cc * 64 + t];
            src += 4096;
        }
        u32x4 o0, o1;
        o0.x = pk2(c0.x, c0.y); o0.y = pk2(c0.z, c0.w); o0.z = pk2(c1.x, c1.y); o0.w = pk2(c1.z, c1.w);
        o1.x = pk2(c2.x, c2.y); o1.y = pk2(c2.z, c2.w); o1.z = pk2(c3.x, c3.y); o1.w = pk2(c3.z, c3.w);
        *(LAS u32x4*)(lds + ML_C + (t >> 2) * ML_TP + (t & 3) * 32) = o0; *(LAS u32x4*)(lds + ML_C + (t >> 2) * ML_TP + (t & 3) * 32 + 16) = o1;
        if (t < 64) nbuf[t] = nacc;
    }
    const float Mt_t = fmaxf(m, gtt.z), bs_t = gtt.x;
    {
        *(LAS u32x4*)(lds + ML_Q + srow * ML_QP + sc16 * 16) = rq0; *(LAS u32x4*)(lds + ML_Q + (srow + 32) * ML_QP + sc16 * 16) = rq1;
        *(LAS u32x4*)(lds + ML_K + srow * ML_QP + sc16 * 16) = rk0; *(LAS u32x4*)(lds + ML_K + (srow + 32) * ML_QP + sc16 * 16) = rk1;
        *(LAS u32x4*)(lds + ML_V + srow * ML_TP + sc16 * 16) = rv0; *(LAS u32x4*)(lds + ML_V + (srow + 32) * ML_TP + sc16 * 16) = rv1;
        if (sc16 == 0) { ubuf2[srow] = gl0.y * LOG2E; ubuf2[srow + 32] = gl1.y * LOG2E; }
    }
    __syncthreads();
    const float inter = __expf(m - Mt_t);
    bf16x8 qf[4];
#pragma unroll
    for (int ks = 0; ks < 4; ++ks) qf[ks] = *(const LAS bf16x8*)(lds + ML_Q + tt * ML_QP + (ks * 16 + 8 * h) * 2);
    f32x16 acca, accb;
#pragma unroll
    for (int e = 0; e < 16; ++e) { acca[e] = 0.f; accb[e] = 0.f; }
    float rs = 0.f;
    const float Mt2 = Mt_t * LOG2E;
#pragma unroll
    for (int st = 0; st < 2; ++st) {
        if (st <= wt) {
            f32x16 sa;
#pragma unroll
            for (int e = 0; e < 16; ++e) sa[e] = 0.f;
#pragma unroll
            for (int ks = 0; ks < 4; ++ks) {
                const bf16x8 kf = *(const LAS bf16x8*)(lds + ML_K + (st * 32 + r) * ML_QP + (ks * 16 + 8 * h) * 2);
                sa = __builtin_amdgcn_mfma_f32_32x32x16_bf16(kf, qf[ks], sa, 0, 0, 0);
            }
#pragma unroll
            for (int g = 0; g < 4; ++g) {
                const f32x4 u4 = *(const LAS f32x4*)(ubuf2 + st * 32 + 8 * g + 4 * h);
                const float uu[4] = {u4.x, u4.y, u4.z, u4.w};
#pragma unroll
                for (int i = 0; i < 4; ++i) {
                    const int sidx = st * 32 + 8 * g + 4 * h + i;
                    const float dv_ = (sidx <= tt) ? sa[4 * g + i] * __builtin_amdgcn_exp2f(uu[i] - Mt2) : 0.f;
                    sa[4 * g + i] = dv_; rs += dv_;
                }
            }
#pragma unroll
            for (int sk = 0; sk < 2; ++sk) {
                u32x4 pk; pk.x = pk2(sa[8 * sk], sa[8 * sk + 1]); pk.y = pk2(sa[8 * sk + 2], sa[8 * sk + 3]); pk.z = pk2(sa[8 * sk + 4], sa[8 * sk + 5]); pk.w = pk2(sa[8 * sk + 6], sa[8 * sk + 7]);
                const bf16x8 vf = tr_frag(lds + ML_V + ((st * 2 + sk) * 16 + 4 * h + q4) * ML_TP + (wd * 32 + 16 * blk) * 2 + 8 * pp, 8 * ML_TP);
                acca = __builtin_amdgcn_mfma_f32_32x32x16_bf16(vf, __builtin_bit_cast(bf16x8, pk), acca, 0, 0, 0);
            }
        }
    }
#pragma unroll
    for (int ks = 0; ks < 4; ++ks) {
        const bf16x8 cf = tr_frag(lds + ML_C + (ks * 16 + 8 * h + q4) * ML_TP + (wd * 32 + 16 * blk) * 2 + 8 * pp, 4 * ML_TP);
        accb = __builtin_amdgcn_mfma_f32_32x32x16_bf16(cf, qf[ks], accb, 0, 0, 0);
    }
    float qn = 0.f;
#pragma unroll
    for (int ks = 0; ks < 4; ++ks) {
        const f32x4 n0 = *(const LAS f32x4*)(nbuf + ks * 16 + 8 * h), n1 = *(const LAS f32x4*)(nbuf + ks * 16 + 8 * h + 4);
        qn += bf2f((bf16_t)qf[ks][0]) * n0.x + bf2f((bf16_t)qf[ks][1]) * n0.y + bf2f((bf16_t)qf[ks][2]) * n0.z + bf2f((bf16_t)qf[ks][3]) * n0.w
            + bf2f((bf16_t)qf[ks][4]) * n1.x + bf2f((bf16_t)qf[ks][5]) * n1.y + bf2f((bf16_t)qf[ks][6]) * n1.z + bf2f((bf16_t)qf[ks][7]) * n1.w;
    }
    qn = half_swap_sum(qn); rs = half_swap_sum(rs);
    const float hden = fmaxf(fabsf(inter * qn + rs), __expf(-(bs_t + Mt_t)));
    const float ihd = 1.0f / hden;
    float ss = 0.f;
#pragma unroll
    for (int e = 0; e < 16; ++e) { acca[e] = (acca[e] + inter * accb[e]) * ihd; ss += acca[e] * acca[e]; }
    ss = half_swap_sum(ss);
    if (h == 0) ssbuf[wd * 64 + tt] = ss;
    __syncthreads();
    {
        const float rstd = rsqrtf((ssbuf[tt] + ssbuf[64 + tt]) * (1.0f / 64.0f) + EPS);
        bf16_t* op = mix + (row0 + tt) * DM + hd * 64 + wd * 32 + 4 * h;
#pragma unroll
        for (int g = 0; g < 4; ++g) {
            const float4 g4 = mgr[g];
            const float o0 = bf2f(opre[g].x & 0xffff), o1 = bf2f(opre[g].x >> 16), o2 = bf2f(opre[g].y & 0xffff), o3 = bf2f(opre[g].y >> 16);
            u32x2 v;
            v.x = pk2(acca[4 * g] * rstd * g4.x * __builtin_amdgcn_rcpf(1.0f + __expf(-o0)), acca[4 * g + 1] * rstd * g4.y * __builtin_amdgcn_rcpf(1.0f + __expf(-o1)));
            v.y = pk2(acca[4 * g + 2] * rstd * g4.z * __builtin_amdgcn_rcpf(1.0f + __expf(-o2)), acca[4 * g + 3] * rstd * g4.w * __builtin_amdgcn_rcpf(1.0f + __expf(-o3)));
            *(u32x2*)(op + 8 * g) = v;
        }
    }
}

constexpr int KP = 144, VP = 192, ATT_K_BYTES = 64 * KP, ATT_BUF = 64 * KP + 64 * VP;
DI void moba_item(const P& p, int l, int item, char* lds_generic) {
    LAS char* lds = (LAS char*)lds_generic;
    const int b = item >> 7, hd = (item >> 4) & 7, qt = item & 15, qb = qt >> 1;
    const int t = tid_(), lane = t & 63, w = t >> 6, r = lane & 31, h = lane >> 5;
    const int i16 = lane & 15, q4 = i16 >> 2, pp = i16 & 3, blk = (lane >> 4) & 1;
    const bf16_t* projb = (const bf16_t*)(p.ws + WS_PROJ);
    bf16_t* mix = (bf16_t*)(p.ws + WS_MIX);
    const float* kmean = (const float*)(p.ws + WS_KMEAN);
    const size_t rowb = (size_t)b * SEQ;
    const int q0 = qt * 128, qpos = q0 + w * 32 + r;
    bf16x8 qf[4];
    {
        const bf16_t* qp = projb + (rowb + qpos) * PJ + C_AQ + hd * 64 + 8 * h;
#pragma unroll
        for (int ks = 0; ks < 4; ++ks) qf[ks] = *(const bf16x8*)(qp + ks * 16);
    }
    unsigned mask = 0;
    {
        float gate[8];
#pragma unroll
        for (int n = 0; n < 8; ++n) {
            float sacc = 0.f;
            if (n < qb) {
                const float* km = kmean + ((size_t)((b * 8 + n) * 8 + hd)) * 64 + 8 * h;
#pragma unroll
                for (int ks = 0; ks < 4; ++ks)
#pragma unroll
                    for (int j = 0; j < 8; ++j) sacc += bf2f((bf16_t)qf[ks][j]) * km[ks * 16 + j];
            }
            gate[n] = half_swap_sum(sacc);
        }
#pragma unroll
        for (int it = 0; it < 3; ++it) {
            int best = -1; float bv = -INFINITY;
#pragma unroll
            for (int n = 0; n < 8; ++n) if (n < qb && !((mask >> n) & 1u) && gate[n] > bv) { bv = gate[n]; best = n; }
            if (best >= 0) mask |= 1u << best;
        }
    }
    const int nown = ((q0 & 255) >> 6) + 2, ntiles = nown + qb * 4;
    f32x16 o0, o1;
#pragma unroll
    for (int e = 0; e < 16; ++e) { o0[e] = 0.f; o1[e] = 0.f; }
    float m = -INFINITY, lsum = 0.f;
    const int srow = t >> 3, sc16 = t & 7;
    struct KVStage { u32x4 k0, k1, v0, v1; };
    auto key0_of = [&](int it) { return it < nown ? qb * 256 + it * 64 : ((it - nown) >> 2) * 256 + ((it - nown) & 3) * 64; };
    auto gload = [&](KVStage& S, int it) {
        const int key0 = key0_of(it < ntiles ? it : ntiles - 1);
        const bf16_t* base = projb + (rowb + key0 + srow) * PJ + hd * 64 + sc16 * 8;
        S.k0 = *(const u32x4*)(base + C_AK); S.k1 = *(const u32x4*)(base + (size_t)32 * PJ + C_AK);
        S.v0 = *(const u32x4*)(base + C_AV); S.v1 = *(const u32x4*)(base + (size_t)32 * PJ + C_AV);
    };
    auto sstore = [&](const KVStage& S, int buf) {
        LAS char* sK = lds + buf * ATT_BUF; LAS char* sV = sK + ATT_K_BYTES;
        *(LAS u32x4*)(sK + srow * KP + sc16 * 16) = S.k0; *(LAS u32x4*)(sK + (srow + 32) * KP + sc16 * 16) = S.k1;
        *(LAS u32x4*)(sV + srow * VP + sc16 * 16) = S.v0; *(LAS u32x4*)(sV + (srow + 32) * VP + sc16 * 16) = S.v1;
    };
    KVStage KA, KB;
    __syncthreads();
    gload(KA, 0); gload(KB, 1); sstore(KA, 0); __syncthreads();
    auto step = [&](int it, KVStage& SL, const KVStage& SS) {
        gload(SL, it + 2);
        {
            const LAS char* sK = lds + (it & 1) * ATT_BUF; const LAS char* sV = sK + ATT_K_BYTES;
            const int key0 = key0_of(it), blockn = key0 >> 8;
            f32x16 s0, s1;
            const float minit = (it == 0) ? 0.f : -m;
#pragma unroll
            for (int e = 0; e < 16; ++e) { s0[e] = minit; s1[e] = minit; }
#pragma unroll
            for (int ks = 0; ks < 4; ++ks) {
                const bf16x8 k0 = *(const LAS bf16x8*)(sK + r * KP + (ks * 16 + 8 * h) * 2);
                const bf16x8 k1 = *(const LAS bf16x8*)(sK + (32 + r) * KP + (ks * 16 + 8 * h) * 2);
                s0 = __builtin_amdgcn_mfma_f32_32x32x16_bf16(k0, qf[ks], s0, 0, 0, 0);
                s1 = __builtin_amdgcn_mfma_f32_32x32x16_bf16(k1, qf[ks], s1, 0, 0, 0);
            }
            const bool own = (blockn == qb);
            const bool active = own || ((mask >> blockn) & 1u);
            if (!active) {
#pragma unroll
                for (int e = 0; e < 16; ++e) { s0[e] = -INFINITY; s1[e] = -INFINITY; }
            } else if (own && key0 + 63 > q0 + w * 32) {
#pragma unroll
                for (int e = 0; e < 16; ++e) {
                    const int kk = key0 + (e & 3) + 8 * (e >> 2) + 4 * h;
                    if (kk > qpos) s0[e] = -INFINITY;
                    if (kk + 32 > qpos) s1[e] = -INFINITY;
                }
            }
            float mx = fmaxf(fmaxf(s0[0], s1[0]), fmaxf(s0[1], s1[1]));
#pragma unroll
            for (int e = 2; e < 16; e += 2) mx = fmaxf(fmaxf(mx, fmaxf(s0[e], s1[e])), fmaxf(s0[e + 1], s1[e + 1]));
            mx = half_swap_max(mx);
            if (it == 0 || __builtin_amdgcn_ballot_w64(mx > 16.0f) != 0ull) {
                const float d = (it == 0) ? mx : fmaxf(mx, 0.f);
                const float alpha = __builtin_amdgcn_exp2f(-d);
                m = (it == 0) ? d : m + d;
                lsum *= alpha;
#pragma unroll
                for (int e = 0; e < 16; ++e) { s0[e] -= d; s1[e] -= d; o0[e] *= alpha; o1[e] *= alpha; }
            }
            float ps = 0.f;
#pragma unroll
            for (int e = 0; e < 16; ++e) { s0[e] = __builtin_amdgcn_exp2f(s0[e]); s1[e] = __builtin_amdgcn_exp2f(s1[e]); ps += s0[e] + s1[e]; }
            lsum += ps;
#pragma unroll
            for (int st = 0; st < 2; ++st)
#pragma unroll
                for (int sk = 0; sk < 2; ++sk) {
                    u32x4 pk;
                    if (st == 0) { pk.x = pk2(s0[8 * sk], s0[8 * sk + 1]); pk.y = pk2(s0[8 * sk + 2], s0[8 * sk + 3]); pk.z = pk2(s0[8 * sk + 4], s0[8 * sk + 5]); pk.w = pk2(s0[8 * sk + 6], s0[8 * sk + 7]); }
                    else         { pk.x = pk2(s1[8 * sk], s1[8 * sk + 1]); pk.y = pk2(s1[8 * sk + 2], s1[8 * sk + 3]); pk.z = pk2(s1[8 * sk + 4], s1[8 * sk + 5]); pk.w = pk2(s1[8 * sk + 6], s1[8 * sk + 7]); }
                    const bf16x8 pf = __builtin_bit_cast(bf16x8, pk);
                    const LAS char* vb = sV + (st * 32 + sk * 16 + 4 * h + q4) * VP + (16 * blk) * 2 + 8 * pp;
                    {
                        s16x4 lo = tr_read(vb), hi = tr_read(vb + 8 * VP);
                        const bf16x8 vf = __builtin_shufflevector(lo, hi, 0, 1, 2, 3, 4, 5, 6, 7);
                        o0 = __builtin_amdgcn_mfma_f32_32x32x16_bf16(vf, pf, o0, 0, 0, 0);
                    }
                    {
                        s16x4 lo = tr_read(vb + 64), hi = tr_read(vb + 64 + 8 * VP);
                        const bf16x8 vf = __builtin_shufflevector(lo, hi, 0, 1, 2, 3, 4, 5, 6, 7);
                        o1 = __builtin_amdgcn_mfma_f32_32x32x16_bf16(vf, pf, o1, 0, 0, 0);
                    }
                }
        }
        sstore(SS, (it + 1) & 1);
        __syncthreads();
    };
    for (int it = 0; it < ntiles; it += 2) { step(it, KA, KB); if (it + 1 < ntiles) step(it + 1, KB, KA); }
    const float il = 1.0f / half_swap_sum(lsum);
    float ss = 0.f;
#pragma unroll
    for (int e = 0; e < 16; ++e) { o0[e] *= il; o1[e] *= il; ss += o0[e] * o0[e] + o1[e] * o1[e]; }
    ss = half_swap_sum(ss);
    const float rstd = rsqrtf(ss * (1.0f / 64.0f) + EPS);
    const float* og = p.in[10] + (l * 8 + hd) * 64 + 4 * h;
    bf16_t* op = mix + (rowb + qpos) * DM + 256 + hd * 64 + 4 * h;
#pragma unroll
    for (int g = 0; g < 4; ++g) {
        const float4 g0 = *(const float4*)(og + 8 * g), g1 = *(const float4*)(og + 32 + 8 * g);
        u32x2 v0, v1;
        v0.x = pk2(o0[4 * g] * rstd * g0.x, o0[4 * g + 1] * rstd * g0.y); v0.y = pk2(o0[4 * g + 2] * rstd * g0.z, o0[4 * g + 3] * rstd * g0.w);
        v1.x = pk2(o1[4 * g] * rstd * g1.x, o1[4 * g + 1] * rstd * g1.y); v1.y = pk2(o1[4 * g + 2] * rstd * g1.z, o1[4 * g + 3] * rstd * g1.w);
        *(u32x2*)(op + 8 * g) = v0; *(u32x2*)(op + 32 + 8 * g) = v1;
    }
}

DI void s5_item_simple(const P& p, int l, int item, float* sm) {
    const int t = tid_(), lane = t & 63, w = t >> 6;
    const int bg = item * 4 + w, b = bg >> 4, g = bg & 15;
    const bf16_t* projb = (const bf16_t*)(p.ws + WS_PROJ);
    float* zbuf = (float*)(p.ws + WS_ZBUF);
    float* xr = sm + w * (2 * 16 * 65); float* xi = xr + 16 * 65;
    const int lg = l * 16 + g;
    const float lr = p.in[11][lg * 64 + lane], li = p.in[12][lg * 64 + lane];
    const float dt = expf(p.in[18][lg]);
    const float mag = expf(lr * dt);
    const float are = mag * cosf(li * dt), aim = mag * sinf(li * dt);
    const float zr = are - 1.0f, zi = aim, dn = lr * lr + li * li;
    const float fr = (zr * lr + zi * li) / dn, fi = (zi * lr - zr * li) / dn;
    float bbr[16], bbi[16];
#pragma unroll
    for (int hh = 0; hh < 16; ++hh) {
        const float br = p.in[13][((size_t)lg * 64 + lane) * 16 + hh], bi = p.in[14][((size_t)lg * 64 + lane) * 16 + hh];
        bbr[hh] = fr * br - fi * bi; bbi[hh] = fr * bi + fi * br;
    }
    const float* cre = p.in[15] + (size_t)lg * 16 * 64; const float* cim = p.in[16] + (size_t)lg * 16 * 64;
    const float* dd = p.in[17] + lg * 16;
    float sr = 0.f, si = 0.f;
    __syncthreads();
    for (int c = 0; c < SEQ / 16; ++c) {
        const size_t row0 = (size_t)b * SEQ + c * 16;
        for (int tt = 0; tt < 16; ++tt) {
            const bf16_t* up = projb + (row0 + tt) * PJ + C_SU + g * 16;
            uint4 u0 = *(const uint4*)up, u1 = *(const uint4*)(up + 8);
            float u[16] = {bf2f(u0.x & 0xffff), bf2f(u0.x >> 16), bf2f(u0.y & 0xffff), bf2f(u0.y >> 16), bf2f(u0.z & 0xffff), bf2f(u0.z >> 16), bf2f(u0.w & 0xffff), bf2f(u0.w >> 16),
                           bf2f(u1.x & 0xffff), bf2f(u1.x >> 16), bf2f(u1.y & 0xffff), bf2f(u1.y >> 16), bf2f(u1.z & 0xffff), bf2f(u1.z >> 16), bf2f(u1.w & 0xffff), bf2f(u1.w >> 16)};
            float br = 0.f, bi = 0.f;
#pragma unroll
            for (int hh = 0; hh < 16; ++hh) { br += bbr[hh] * u[hh]; bi += bbi[hh] * u[hh]; }
            const float nr = are * sr - aim * si + br, ni = are * si + aim * sr + bi;
            sr = nr; si = ni;
            xr[tt * 65 + lane] = sr; xi[tt * 65 + lane] = si;
        }
        __syncthreads();
        {
            const int tt = lane >> 2, hq = lane & 3;
            float y[4] = {0.f, 0.f, 0.f, 0.f};
            for (int pp = 0; pp < 64; ++pp) {
                const float a = xr[tt * 65 + pp], bq = xi[tt * 65 + pp];
#pragma unroll
                for (int j = 0; j < 4; ++j) y[j] += cre[(hq * 4 + j) * 64 + pp] * a - cim[(hq * 4 + j) * 64 + pp] * bq;
            }
#pragma unroll
            for (int j = 0; j < 4; ++j) {
                const int hh = hq * 4 + j;
                float v = y[j] + dd[hh] * bf2f(projb[(row0 + tt) * PJ + C_SU + g * 16 + hh]);
                const float inner = 0.7978845608028654f * (v + 0.044715f * v * v * v);
                const float th = 1.0f - 2.0f / (expf(2.0f * inner) + 1.0f);
                zbuf[(row0 + tt) * 256 + g * 16 + hh] = 0.5f * v * (1.0f + th);
            }
        }
        __syncthreads();
    }
}

DI void s5_item(const P& p, int l, int item, char* lds) {
    const int b = item >> 4, g = item & 15, lg = l * 16 + g;
    const int t = tid_();
    const bf16_t* projb = (const bf16_t*)(p.ws + WS_PROJ);
    bf16_t* zbuf = (bf16_t*)(p.ws + WS_ZBUF);
    const float* Tg = (const float*)(p.ws + WS_S5M + (size_t)l * S5M_LAYER) + (size_t)g * 256 * 256;
    const float* Eg = (const float*)(p.ws + WS_S5M + (size_t)l * S5M_LAYER + S5M_E) + (size_t)g * 256 * 128;
    const float* Fg = (const float*)(p.ws + WS_S5M + (size_t)l * S5M_LAYER + S5M_F) + (size_t)g * 128 * 256;
    float* eloc = (float*)(p.ws + WS_ELOC) + ((size_t)l * 128 + item) * 128 * 128;
    bf16_t* carr = (bf16_t*)(p.ws + WS_CARR) + ((size_t)l * 128 + item) * 128 * 128;
    const size_t rowb = (size_t)b * SEQ;
    const bf16_t* ua0 = projb + (rowb + (size_t)(t >> 2) * 16 + ((t & 3) >> 1)) * PJ + C_SU + g * 16 + (t & 1) * 8;
    const bf16_t* ua1 = ua0 + (size_t)64 * 16 * PJ;
    {
        GSeg g1{ua0, ua1, 2 * PJ, Eg + (size_t)(t >> 5) * 128 + (t & 31) * 4, 128, 8}; GSeg g2 = g1; g2.KT = 0;
        EpiF32 epi{eloc, 128};
        gemm_tile2(g1, g2, lds, epi);
    }
    __syncthreads();
    if (t < 64) {
        const float lr = p.in[11][lg * 64 + t], li = p.in[12][lg * 64 + t], dt = expf(p.in[18][lg]);
        const float mag = expf(lr * dt * 16.0f), ar = mag * cosf(li * dt * 16.0f), ai = mag * sinf(li * dt * 16.0f);
        float sr = 0.f, si = 0.f;
        for (int bt = 0; bt < 8; ++bt) {
            float er[16], ei[16];
#pragma unroll
            for (int i = 0; i < 16; ++i) { er[i] = eloc[(size_t)(bt * 16 + i) * 128 + t]; ei[i] = eloc[(size_t)(bt * 16 + i) * 128 + 64 + t]; }
#pragma unroll
            for (int i = 0; i < 16; ++i) {
                carr[(size_t)(bt * 16 + i) * 128 + t] = f2bf(sr); carr[(size_t)(bt * 16 + i) * 128 + 64 + t] = f2bf(si);
                const float nr = ar * sr - ai * si + er[i], ni = ar * si + ai * sr + ei[i];
                sr = nr; si = ni;
            }
        }
    }
    __syncthreads();
    const bf16_t* ca0 = carr + (size_t)(t >> 2) * 128 + (t & 3) * 8;
#pragma unroll 1
    for (int nt = 0; nt < 2; ++nt) {
        GSeg g1{ua0, ua1, 2 * PJ, Tg + (size_t)(t >> 5) * 256 + nt * 128 + (t & 31) * 4, 256, 4 * (nt + 1)};
        GSeg g2{ca0, ca0 + (size_t)64 * 128, BK, Fg + (size_t)(t >> 5) * 256 + nt * 128 + (t & 31) * 4, 256, 4};
        EpiS5Y epi{zbuf + rowb * 256 + g * 16, nt * 128};
        gemm_tile2(g1, g2, lds, epi);
    }
}

DI void phase_mix(const P& p, int l, char* lds, unsigned long long& tsub) {
    for (int item = bid_(); item < 128 + 1024 + 1024; item += gridDim.x) {
        const unsigned long long ts0 = PROBE_SUB ? wall_clock64() : 0ull;
        const int kind = item >= 1152 ? 1 : (item < 128 ? 2 : 4);
        if (item >= 1152) mlstm_state_item(p, l, item - 1152, lds);
        else if (item < 128) s5_item(p, l, item, lds);
        else {
            const int i2 = item - 128;
            const int qo = i2 >> 6, bh = i2 & 63;
            moba_item(p, l, (bh << 4) | (15 - qo), lds);
        }
        if (PROBE_SUB & kind) tsub += wall_clock64() - ts0;
    }
}

DI void phase_glu(const P& p, int l, char* lds) {
    const int t = tid_();
    const bf16_t* zb = (const bf16_t*)(p.ws + WS_ZBUF);
    bf16_t* mix = (bf16_t*)(p.ws + WS_MIX);
    const float* gw = p.in[19] + (size_t)l * 256 * 256; const float* gb = p.in[20] + l * 256; const float* sg = p.in[21] + l * 256;
    for (int tile = bid_(); tile < 128 * 2; tile += gridDim.x) {
        const int mt = tile >> 1, nt = tile & 1;
        const bf16_t* a0 = zb + (size_t)(mt * 128 + (t >> 2)) * 256 + (t & 3) * 8;
        const float* b0 = gw + (size_t)(t >> 5) * 256 + nt * 128 + (t & 31) * 4;
        EpiGlu epi{zb + (size_t)mt * 128 * 256 + nt * 128, mix + (size_t)mt * 128 * DM + 768 + nt * 128, gb + nt * 128, sg + nt * 128};
        gemm_tile(a0, a0 + (size_t)64 * 256, b0, 256, 256 / BK, lds, epi);
    }
    for (int item = bid_(); item < 1024; item += gridDim.x) mlstm_out_item(p, l, ((item & 31) << 5) | (31 - (item >> 5)), lds);
}

DI void phase_outproj(const P& p, int l, char* lds) {
    const int t = tid_();
    const bf16_t* mix = (const bf16_t*)(p.ws + WS_MIX);
    float* xres = (float*)(p.ws + WS_XRES);
    const bf16_t* woutb = (const bf16_t*)(p.ws + WS_WOUTB) + (size_t)l * DM * DM;
    const float* xin = (l == 0) ? p.in[0] : xres;
    const int vx = bid_() & 7, vj = bid_() >> 3, nj = (gridDim.x - vx + 7) >> 3;
    for (int j = vj; j < 64; j += nj) {
        const int mt = vx * 16 + (j >> 2), nt = j & 3;
        const bf16_t* ar = mix + (size_t)(mt * 128 + (t >> 2)) * DM + (t & 3) * 8;
        GSeg4 g1{ar, ar + (size_t)64 * DM, 32, woutb + (size_t)(t >> 5) * DM + nt * 256 + (t & 31) * 8, DM, DM / 32}; GSeg4 g2 = g1; g2.KT = 0;
        const size_t o = (size_t)mt * 128 * DM + nt * 256;
        Epi4Resid epi{xres + o, xin + o, (size_t)DM};
        gemm4(g1, g2, lds, epi);
    }
}

DI void phase_norm2(const P& p, int l, char* lds) {
    const int t = tid_(), lane = t & 63, w = t >> 6;
    const float* xres = (const float*)(p.ws + WS_XRES);
    bf16_t* hbuf = (bf16_t*)(p.ws + WS_HBUF);
    const float* g2 = p.in[23] + l * DM;
    const float* wg = p.in[24] + (size_t)l * DM * 4; const float* bg = p.in[25] + l * 4;
    const float* we = p.in[26] + (size_t)l * DM * NE; const float* be = p.in[27] + l * NE;
    int4* rinfo = (int4*)(p.ws + WS_RINFO); int* hist = (int*)(p.ws + WS_HIST);
    int* lh = (int*)(lds + 65536 - 16 - 128);
    if (t < NE) lh[t] = 0;
    float* xs = (float*)lds;
    float* pe = xs + 8 * XS_P;
    for (int rb = bid_(); rb < T / 8; rb += gridDim.x) {
        __syncthreads();
#pragma unroll
        for (int rr = 0; rr < 2; ++rr) {
            const int lr = w * 2 + rr, row = rb * 8 + lr;
            float4 v[4];
#pragma unroll
            for (int i = 0; i < 4; ++i) v[i] = *(const float4*)(xres + (size_t)row * DM + i * 256 + lane * 4);
            float ss = 0.f;
#pragma unroll
            for (int i = 0; i < 4; ++i) ss += v[i].x * v[i].x + v[i].y * v[i].y + v[i].z * v[i].z + v[i].w * v[i].w;
            ss = wave_sum(ss);
            const float rstd = rsqrtf(ss * (1.0f / DM) + EPS);
#pragma unroll
            for (int i = 0; i < 4; ++i) {
                const int k0 = i * 256 + lane * 4;
                const float4 g = *(const float4*)(g2 + k0);
                float4 hv = {v[i].x * rstd * g.x, v[i].y * rstd * g.y, v[i].z * rstd * g.z, v[i].w * rstd * g.w};
                uint2 o; o.x = pk2(hv.x, hv.y); o.y = pk2(hv.z, hv.w);
                *(uint2*)(hbuf + (size_t)row * DM + k0) = o;
                *(float4*)(xs + lr * XS_P + k0) = hv;
            }
        }
        __syncthreads();
        {
            float* wb = pe + 1536;
            const float* wep = we + t * 4; const float* wgp = wg + (t & 127) * 4;
            float4 re0 = *(const float4*)(wep), re1 = *(const float4*)(wep + 1024), re2 = *(const float4*)(wep + 2048), re3 = *(const float4*)(wep + 3072);
            float4 rg = *(const float4*)(wgp);
            const int kq = lane >> 4, jc = lane & 15;
            f32x4 d0 = {0.f, 0.f, 0.f, 0.f}, d1 = d0, d2 = d0;
#pragma unroll 1
            for (int c = 0; c < 8; ++c) {
                {
                    const int e0 = t * 4;
#pragma unroll
                    for (int i = 0; i < 4; ++i) {
                        const int e = e0 + i * 1024, kk = e >> 5, jj = e & 31;
                        *(float4*)(wb + kk * 48 + jj) = (i == 0 ? re0 : i == 1 ? re1 : i == 2 ? re2 : re3);
                    }
                    if (t < 128) *(float4*)(wb + t * 48 + 32) = rg;
                }
                __syncthreads();
                if (c + 1 < 8) {
                    const float* q = wep + (size_t)(c + 1) * 4096;
                    re0 = *(const float4*)(q); re1 = *(const float4*)(q + 1024); re2 = *(const float4*)(q + 2048); re3 = *(const float4*)(q + 3072);
                    rg = *(const float4*)(wgp + (size_t)(c + 1) * 512);
                }
                const float* xa = xs + (lane & 7) * XS_P + c * 128 + w * 32 + kq;
                const float* wbp = wb + (w * 32 + kq) * 48 + jc;
#pragma unroll
                for (int ks = 0; ks < 8; ++ks) {
                    const float av = xa[ks * 4];
                    const float b0 = wbp[ks * 4 * 48], b1 = wbp[ks * 4 * 48 + 16], b2 = wbp[ks * 4 * 48 + 32];
                    d0 = __builtin_amdgcn_mfma_f32_16x16x4f32(av, b0, d0, 0, 0, 0);
                    d1 = __builtin_amdgcn_mfma_f32_16x16x4f32(av, b1, d1, 0, 0, 0);
                    d2 = __builtin_amdgcn_mfma_f32_16x16x4f32(av, b2, d2, 0, 0, 0);
                }
                __syncthreads();
            }
            if (lane < 32) {
#pragma unroll
                for (int rg_ = 0; rg_ < 4; ++rg_) {
                    const int row = 4 * kq + rg_;
                    pe[(w * 8 + row) * 48 + jc] = d0[rg_]; pe[(w * 8 + row) * 48 + 16 + jc] = d1[rg_]; pe[(w * 8 + row) * 48 + 32 + jc] = d2[rg_];
                }
            }
        }
        __syncthreads();
        if (t < 8) {
            const int row = rb * 8 + t;
            float gl[4];
#pragma unroll
            for (int j = 0; j < 4; ++j) {
                gl[j] = bg[j] + ((pe[(0 * 8 + t) * 48 + 32 + j] + pe[(1 * 8 + t) * 48 + 32 + j]) + (pe[(2 * 8 + t) * 48 + 32 + j] + pe[(3 * 8 + t) * 48 + 32 + j]));
            }
            int gs = 0; float gm = gl[0];
#pragma unroll
            for (int j = 1; j < 4; ++j) if (gl[j] > gm) { gm = gl[j]; gs = j; }
            float se = 0.f;
#pragma unroll
            for (int j = 0; j < 4; ++j) se += expf(gl[j] - gm);
            const float pgv = 1.0f / se;
            float ev[8];
#pragma unroll
            for (int j = 0; j < 8; ++j) { const int cj = gs * 8 + j; ev[j] = be[cj] + ((pe[(0 * 8 + t) * 48 + cj] + pe[(1 * 8 + t) * 48 + cj]) + (pe[(2 * 8 + t) * 48 + cj] + pe[(3 * 8 + t) * 48 + cj])); }
            int i1 = 0; float v1 = ev[0];
#pragma unroll
            for (int j = 1; j < 8; ++j) if (ev[j] > v1) { v1 = ev[j]; i1 = j; }
            int i2 = (i1 + 1) & 7; float v2 = -INFINITY;
#pragma unroll
            for (int j = 0; j < 8; ++j) if (j != i1 && ev[j] > v2) { v2 = ev[j]; i2 = j; }
            const float ex = expf(v2 - v1);
            const float w1 = pgv / (1.0f + ex), w2 = pgv * ex / (1.0f + ex);
            const int e1 = gs * 8 + i1, e2 = gs * 8 + i2;
            atomicAdd(&lh[e1], 1); atomicAdd(&lh[e2], 1);
            rinfo[row] = make_int4(e1, e2, __float_as_int(w1), __float_as_int(w2));
        }
    }
    __syncthreads();
    if (t < NE) hist[((size_t)l * 1024 + bid_()) * NE + t] = lh[t];
}

DI void phase_assign(const P& p, int l, char* lds) {
    const int t = tid_(), myb = bid_(), nb = gridDim.x;
    const int* hist = (const int*)(p.ws + WS_HIST) + (size_t)l * 1024 * NE;
    const int4* rinfo = (const int4*)(p.ws + WS_RINFO);
    int* cnt = (int*)(p.ws + WS_CTL) + l * NE;
    int* tokl = (int*)(p.ws + WS_TOKL); float* wl = (float*)(p.ws + WS_WL); int4* tinfo = (int4*)(p.ws + WS_TINFO);
    int* part = (int*)lds;
    int* pre = part + 512;
    int* le1 = pre + 32;
    int* le2 = le1 + 64;
    {
        const int e = t & 31, prt = t >> 5;
        int a = 0, tot = 0;
        for (int b = prt; b < nb; b += 8) { const int v = hist[(size_t)b * NE + e]; tot += v; if (b < myb) a += v; }
        part[prt * 32 + e] = a; part[256 + prt * 32 + e] = tot;
    }
    __syncthreads();
    if (t < 32) {
        int a = 0, tot = 0;
#pragma unroll
        for (int q = 0; q < 8; ++q) { a += part[q * 32 + t]; tot += part[256 + q * 32 + t]; }
        pre[t] = a;
        if (myb == 0) cnt[t] = tot;
    }
    const int nit = (T / 8 - myb + nb - 1) / nb;
    int4 ri = make_int4(0, 0, 0, 0); int row = -1;
    if (t < nit * 8 && t < 64) { row = (myb + (t >> 3) * nb) * 8 + (t & 7); ri = rinfo[row]; le1[t] = ri.x; le2[t] = ri.y; }
    __syncthreads();
    if (row >= 0) {
        int r1 = 0, r2 = 0;
        for (int j = 0; j < t; ++j) { const int a = le1[j], b2 = le2[j]; r1 += (a == ri.x) + (b2 == ri.x); r2 += (a == ri.y) + (b2 == ri.y); }
        const int s1 = pre[ri.x] + r1, s2 = pre[ri.y] + r2;
        tokl[ri.x * ECAP + s1] = row; wl[ri.x * ECAP + s1] = __int_as_float(ri.z);
        tokl[ri.y * ECAP + s2] = row; wl[ri.y * ECAP + s2] = __int_as_float(ri.w);
        tinfo[row] = make_int4(ri.x, s1, ri.y, s2);
    }
}

DI void phase_moe1(const P& p, int l, char* lds) {
    const int t = tid_();
    const bf16_t* hbuf = (const bf16_t*)(p.ws + WS_HBUF);
    bf16_t* hmoe = (bf16_t*)(p.ws + WS_HMOE);
    const int* cnt = (const int*)(p.ws + WS_CTL) + l * NE;
    const int* tokl = (const int*)(p.ws + WS_TOKL);
    int* stp = (int*)(lds + GEMM_LDS);
    moe_prefix(cnt, stp);
    const int vx = bid_() & 7, vj = bid_() >> 3, nj = (gridDim.x - vx + 7) >> 3;
    int tx[5]; tx[0] = 0;
#pragma unroll
    for (int i = 0; i < 4; ++i) tx[i + 1] = tx[i] + (stp[vx + 8 * i + 1] - stp[vx + 8 * i]) * 8;
    for (int tile = vj; tile < tx[4]; tile += nj) {
        const int ei = (tile >= tx[1]) + (tile >= tx[2]) + (tile >= tx[3]);
        const int e = vx + 8 * ei, tbase = ei == 0 ? 0 : (ei == 1 ? tx[1] : (ei == 2 ? tx[2] : tx[3]));
        const int te = stp[e + 1] - stp[e], local = tile - tbase, nt = local / te, mt = local % te;
        const int ne = cnt[e];
        const int i0 = mt * 128 + (t >> 2), i1 = i0 + 64;
        const int tok0 = tokl[e * ECAP + (i0 < ne ? i0 : 0)], tok1 = tokl[e * ECAP + (i1 < ne ? i1 : 0)];
        const bf16_t* a0 = hbuf + (size_t)tok0 * DM + (t & 3) * 8;
        const bf16_t* a1 = hbuf + (size_t)tok1 * DM + (t & 3) * 8;
        const int vcol = (t & 31) * 4, wn = vcol >> 6, tn = (vcol >> 5) & 1, rr = vcol & 31;
        const float* wsrc = (tn ? p.in[29] : p.in[28]) + ((size_t)l * NE + e) * DM * DE;
        const float* b0 = wsrc + (size_t)(t >> 5) * DE + nt * 64 + wn * 32 + rr;
        EpiGateUp epi{hmoe + (size_t)(stp[e] + mt) * 128 * DE + nt * 64};
        gemm_tile(a0, a1, b0, DE, DM / BK, lds, epi);
    }
}

DI void phase_moe2(const P& p, int l, char* lds) {
    const int t = tid_();
    const bf16_t* hmoe = (const bf16_t*)(p.ws + WS_HMOE);
    bf16_t* ymoe = (bf16_t*)(p.ws + WS_YMOE);
    const int* cnt = (const int*)(p.ws + WS_CTL) + l * NE;
    const float* wl = (const float*)(p.ws + WS_WL);
    int* stp = (int*)(lds + GEMM_LDS);
    moe_prefix(cnt, stp);
    const int vx = bid_() & 7, vj = bid_() >> 3, nj = (gridDim.x - vx + 7) >> 3;
    int tx[5]; tx[0] = 0;
#pragma unroll
    for (int i = 0; i < 4; ++i) tx[i + 1] = tx[i] + (stp[vx + 8 * i + 1] - stp[vx + 8 * i]) * 8;
    for (int tile = vj; tile < tx[4]; tile += nj) {
        const int ei = (tile >= tx[1]) + (tile >= tx[2]) + (tile >= tx[3]);
        const int e = vx + 8 * ei, tbase = ei == 0 ? 0 : (ei == 1 ? tx[1] : (ei == 2 ? tx[2] : tx[3]));
        const int te = stp[e + 1] - stp[e], local = tile - tbase, nt = local / te, mt = local % te;
        const int ne = cnt[e];
        const size_t r0 = (size_t)(stp[e] + mt) * 128;
        const bf16_t* a0 = hmoe + (r0 + (t >> 2)) * DE + (t & 3) * 8;
        const float* b0 = p.in[30] + ((size_t)l * NE + e) * DE * DM + (size_t)(t >> 5) * DM + nt * 128 + (t & 31) * 4;
        EpiDown epi{ymoe + r0 * DM + nt * 128, wl + e * ECAP + mt * 128, ne - mt * 128};
        gemm_tile(a0, a0 + (size_t)64 * DE, b0, DM, DE / BK, lds, epi);
    }
}

DI void phase_final(const P& p, char* lds) {
    const int lane = tid_() & 63;
    const int gw = bid_() * 4 + (tid_() >> 6), nw = gridDim.x * 4;
    const float* xres = (const float*)(p.ws + WS_XRES);
    const bf16_t* ymoe = (const bf16_t*)(p.ws + WS_YMOE);
    const int4* tinfo = (const int4*)(p.ws + WS_TINFO);
    int* stp = (int*)lds;
    moe_prefix((const int*)(p.ws + WS_CTL) + NE, stp);
    for (int row = gw; row < T; row += nw) {
        int4 ti = tinfo[row];
        const bf16_t* y0 = ymoe + (size_t)(stp[ti.x] * 128 + ti.y) * DM;
        const bf16_t* y1 = ymoe + (size_t)(stp[ti.z] * 128 + ti.w) * DM;
#pragma unroll
        for (int i = 0; i < 4; ++i) {
            float4 v = *(const float4*)(xres + (size_t)row * DM + i * 256 + lane * 4);
            uint2 a = *(const uint2*)(y0 + i * 256 + lane * 4), b = *(const uint2*)(y1 + i * 256 + lane * 4);
            v.x += bf2f(a.x & 0xffff) + bf2f(b.x & 0xffff); v.y += bf2f(a.x >> 16) + bf2f(b.x >> 16);
            v.z += bf2f(a.y & 0xffff) + bf2f(b.y & 0xffff); v.w += bf2f(a.y >> 16) + bf2f(b.y >> 16);
            *(float4*)(p.out + (size_t)row * DM + i * 256 + lane * 4) = v;
        }
    }
}

#define XB_TMO      128
#define XB_XCNT(j)  (256  + 64 * (j))
#define XB_XSUB(j)  (1280 + 64 * (j))
#define XB_XGEN(j)  (2304 + 64 * (j))
#define XB_TOP      3328
#define XB_TOPGEN   3392
#define XCD_BAR_WORDS 3456
#define XB_SPIN_CAP (1u << 18)

__device__ __forceinline__ unsigned xb_ld(unsigned* p)              { return __hip_atomic_load(p, __ATOMIC_RELAXED, __HIP_MEMORY_SCOPE_AGENT); }
__device__ __forceinline__ unsigned xb_add(unsigned* p, unsigned v) { return __hip_atomic_fetch_add(p, v, __ATOMIC_RELAXED, __HIP_MEMORY_SCOPE_AGENT); }
__device__ __forceinline__ unsigned xb_xcc_id() { return (unsigned)__builtin_amdgcn_s_getreg((3 << 11) | 20) & 0xFu; }
#define XB_SPIN(cond, bar) do { unsigned _sp = 0; while (cond) { __builtin_amdgcn_s_sleep(1); \
    if ((++_sp & 255u) == 0u) { if (xb_ld(&(bar)[XB_TMO])) break; if (_sp > XB_SPIN_CAP) { atomicAdd(&(bar)[XB_TMO], 1u); break; } } } } while (0)

struct XcdBarrier {
    unsigned* bar; unsigned x;
    volatile LAS unsigned* st;
};

__device__ __forceinline__ XcdBarrier xcd_barrier_post(unsigned* bar, volatile LAS unsigned* st) {
    XcdBarrier b; b.bar = bar; b.x = xb_xcc_id(); b.st = st;
    if (threadIdx.x == 0) (void)xb_add(&bar[XB_XCNT(b.x)], 1u);
    return b;
}
__device__ __forceinline__ void xcd_barrier_complete(unsigned* bar, unsigned x, unsigned& nloc, unsigned& nx) {
    const unsigned G = gridDim.x * gridDim.y * gridDim.z;
    unsigned sum, cnt, mine, sp = 0u;
    for (;;) {
        sum = 0u; cnt = 0u; mine = 0u;
#pragma unroll
        for (unsigned j = 0; j < 16; ++j) { const unsigned c = xb_ld(&bar[XB_XCNT(j)]); sum += c; cnt += (c > 0u) ? 1u : 0u; mine = (j == x) ? c : mine; }
        if (sum == G) break;
        __builtin_amdgcn_s_sleep(1);
        if ((++sp & 255u) == 0u) { if (xb_ld(&bar[XB_TMO])) break; if (sp > XB_SPIN_CAP) { atomicAdd(&bar[XB_TMO], 1u); break; } }
    }
    nloc = mine > 0u ? mine : 1u; nx = cnt > 0u ? cnt : 1u;
}

__device__ __forceinline__ void xcd_barrier(const XcdBarrier& b) {
    asm volatile("s_waitcnt vmcnt(0)" ::: "memory");
    __syncthreads();
    if (threadIdx.x == 0) {
        unsigned* bar = b.bar;
        __builtin_amdgcn_s_waitcnt(0);
        unsigned nloc = b.st[0], nx = b.st[1];
        if (nloc == 0u) { xcd_barrier_complete(bar, b.x, nloc, nx); b.st[0] = nloc; b.st[1] = nx; }
        const unsigned old = xb_add(&bar[XB_XSUB(b.x)], 1u);
        const unsigned gen = old / nloc;
        if (old + 1u == (gen + 1u) * nloc) {
            __builtin_amdgcn_fence(__ATOMIC_RELEASE, "agent");
            asm volatile("s_waitcnt vmcnt(0)" ::: "memory");
            const unsigned og = xb_add(&bar[XB_TOP], 1u);
            const unsigned tg = og / nx;
            if (og + 1u == (tg + 1u) * nx) xb_add(&bar[XB_TOPGEN], 1u);
            else XB_SPIN(xb_ld(&bar[XB_TOPGEN]) == tg, bar);
            __builtin_amdgcn_fence(__ATOMIC_ACQUIRE, "agent");
            xb_add(&bar[XB_XGEN(b.x)], 1u);
            asm volatile("s_waitcnt vmcnt(0)" ::: "memory");
        } else {
            XB_SPIN(xb_ld(&bar[XB_XGEN(b.x)]) == gen, bar);
            __builtin_amdgcn_fence(__ATOMIC_ACQUIRE, "agent");
            asm volatile("s_waitcnt vmcnt(0)" ::: "memory");
        }
    }
    __syncthreads();
}


#ifdef LAB
constexpr size_t WS_LAB = 440 * MiB;
DI void phase_lab(const P& p, char* lds) {
    const int t = tid_();
    const bf16_t* hbuf = (const bf16_t*)(p.ws + WS_HBUF);
    bf16_t* outb = (bf16_t*)(p.ws + WS_LAB);
    const float* win = p.in[2];
#if LAB == 40
    {
        const bf16_t* wb = (const bf16_t*)(p.ws + WS_HRAW);
        const int vx = bid_() & 7, vj = bid_() >> 3, nj = (gridDim.x - vx + 7) >> 3;
        for (int st = vx; st < 16; st += 8)
          for (int j = vj; j < 88; j += nj) {
            const int mt = st * 8 + j / 11, vt = j % 11;
            const int acol = vt < 4 ? vt * 256 : (vt < 10 ? 1032 + (vt - 4) * 256 : 2568);
            const bf16_t* ar = hbuf + (size_t)(mt * 128 + (t >> 2)) * DM + (t & 3) * 8;
            GSeg4 h1{ar, ar + (size_t)64 * DM, 32, wb + (size_t)(t >> 5) * DIN + acol + (t & 31) * 8, DIN, DM / 32}; GSeg4 h2 = h1; h2.KT = 0;
            Epi4Bf16 epi{outb + (size_t)mt * 128 * PJ + vt * 256, (size_t)PJ};
            gemm4(h1, h2, lds, epi);
          }
        return;
    }
#endif
    const int vx = bid_() & 7, vj = bid_() >> 3, nj = (gridDim.x - vx + 7) >> 3;
    for (int st = vx; st < 48; st += 8) {
      const int sm = st / 3, sn = st % 3, wdt = sn == 2 ? 7 : 8;
      for (int j = vj; j < 8 * wdt; j += nj) {
        const int mt = sm * 8 + j / wdt, vt = sn * 8 + j % wdt;
        const int acol = vt < 8 ? vt * 128 : (vt < 20 ? 1032 + (vt - 8) * 128 : (vt < 22 ? 2568 + (vt - 20) * 128 : 1024));
        const bf16_t* a0 = hbuf + (size_t)(mt * 128 + (t >> 2)) * DM + (t & 3) * 8;
        const float* b0 = win + (size_t)(t >> 5) * DIN + acol + (t & 31) * 4;
        EpiBf16 epi{outb + (size_t)mt * 128 * PJ + (vt % 22) * 128, (size_t)PJ};
#if LAB == 40
        (void)a0; (void)b0;
#elif LAB == 30
        const bf16_t* ar = hbuf + (size_t)(mt * 128 + (t >> 3)) * DM + (t & 7) * 8;
        GSeg3 h1{{ar, ar + (size_t)32 * DM, ar + (size_t)64 * DM, ar + (size_t)96 * DM}, 64, b0, DIN, DM / 32}; GSeg3 h2 = h1; h2.KT = 0;
        gemm3(h1, h2, lds, epi);
#elif LAB >= 20
        const bf16_t* wb = (const bf16_t*)(p.ws + WS_HRAW);
        const bf16_t* ar = hbuf + (size_t)(mt * 128 + (t >> 3)) * DM + (t & 7) * 8;
        GSeg2 h1{{ar, ar + (size_t)32 * DM, ar + (size_t)64 * DM, ar + (size_t)96 * DM}, 64, wb + (size_t)(t >> 4) * DIN + acol + (t & 15) * 8, DIN, DM / 32}; GSeg2 h2 = h1; h2.KT = 0;
        gemm2(h1, h2, lds, epi);
#else
        GSeg g1{a0, a0 + (size_t)64 * DM, BK, b0, DIN, DM / BK}; GSeg g2 = g1; g2.KT = 0;
        gemm_lab(g1, g2, lds, epi);
#endif
      }
    }
}
#endif
constexpr int LDS_BYTES = 65536;
constexpr int NPHASE = 9;

DI void run_phase(const P& p, int ph, int l, char* lds) {
    switch (ph) {
        case 0: phase_norm1(p, l, lds); break;
        case 1: phase_inproj(p, l, lds); break;
        case 2: { unsigned long long dummy = 0; phase_qkprep(p, l, lds, dummy); } break;
        case 3: { unsigned long long dummy = 0; phase_mix(p, l, lds, dummy); } break;
        case 4: phase_glu(p, l, lds); break;
        case 5: phase_outproj(p, l, lds); break;
        case 6: phase_norm2(p, l, lds); break;
        case 7: phase_moe1(p, l, lds); break;
        case 8: phase_moe2(p, l, lds); break;
        default: phase_final(p, lds); break;
    }
}

#if MULTI
__global__ void __launch_bounds__(256) k_phase(P p, int ph, int l) {
    extern __shared__ __attribute__((aligned(16))) char lds[];
    run_phase(p, ph, l, lds);
}
#else
__global__ void __launch_bounds__(256, 2) k_mega(P p) {
    extern __shared__ __attribute__((aligned(16))) char lds[];
    cg::grid_group grid = cg::this_grid();
    volatile LAS unsigned* bst = (volatile LAS unsigned*)((LAS char*)lds + LDS_BYTES - 16);
    if (threadIdx.x < 4) bst[threadIdx.x] = 0u;
    __syncthreads();
    XcdBarrier gbar = xcd_barrier_post((unsigned*)(p.ws + WS_BAR), bst);
    if (p.ws == nullptr) grid.sync();
#define GSYNC() xcd_barrier(gbar)
#ifndef PROBE_MASK
#define PROBE_MASK 0
#endif
#ifndef PROBE_MULT
#define PROBE_MULT 4
#endif
#ifndef PROBE_BLK
#define PROBE_BLK 0
#endif
    unsigned long long tacc = 0, tprev = 0;
#define PH_BEGIN() do { if (PROBE_MASK) tprev = wall_clock64(); } while (0)
#define PH_END(ph) do { if (PROBE_MASK & (1 << (ph))) tacc += wall_clock64() - tprev; } while (0)
#pragma unroll
    for (int l = 0; l < 2; ++l) {
        PH_BEGIN(); phase_norm1(p, l, lds); GSYNC(); PH_END(0);
        PH_BEGIN(); phase_inproj(p, l, lds); GSYNC(); PH_END(1);
        PH_BEGIN(); phase_qkprep(p, l, lds, tacc); GSYNC(); PH_END(2);
        PH_BEGIN(); phase_mix(p, l, lds, tacc); GSYNC(); PH_END(3);
        PH_BEGIN(); phase_glu(p, l, lds); GSYNC(); PH_END(4);
        PH_BEGIN(); phase_outproj(p, l, lds); GSYNC(); PH_END(5);
        PH_BEGIN(); phase_norm2(p, l, lds); GSYNC(); phase_assign(p, l, lds); GSYNC(); PH_END(6);
        PH_BEGIN(); phase_moe1(p, l, lds); GSYNC(); PH_END(7);
        PH_BEGIN(); phase_moe2(p, l, lds); GSYNC(); PH_END(8);
    }
    PH_BEGIN(); phase_final(p, lds); PH_END(9);
#ifdef LAB
#if LAB >= 20
    {
        const float* src = p.in[2]; bf16_t* dst = (bf16_t*)(p.ws + WS_HRAW);
        const size_t n4 = (size_t)DM * DIN / 4, stride = (size_t)gridDim.x * 256;
        for (size_t i = (size_t)blockIdx.x * 256 + threadIdx.x; i < n4; i += stride) { const float4 v = ((const float4*)src)[i]; u32x2 o; o.x = pk2(v.x, v.y); o.y = pk2(v.z, v.w); ((u32x2*)dst)[i] = o; }
    }
#endif
    GSYNC(); phase_lab(p, lds);
#endif
#ifdef PROBE_SYNCS
    for (int i = 0; i < PROBE_SYNCS; ++i) GSYNC();
#endif
    if ((PROBE_MASK || PROBE_SUB) && blockIdx.x == PROBE_BLK) {
        const unsigned long long t0 = wall_clock64();
        while (wall_clock64() - t0 < (unsigned long long)PROBE_MULT * tacc) __builtin_amdgcn_s_sleep(8);
    }
}
#endif

extern "C" void kernel_launch(void* const* d_in, const int* in_sizes, int n_in, void* d_out, int out_size, void* d_ws, size_t ws_size, hipStream_t stream) {
    static int grid = 0;
    if (grid == 0) {
        if (n_in != 31 || out_size != T * DM || ws_size < WS_END) { fprintf(stderr, "kernel_launch: unexpected sizes n_in %d out %d ws %zu\n", n_in, out_size, ws_size); grid = -1; return; }
        int dev = 0, cus = 0, per_cu = 0;
        (void)hipGetDevice(&dev);
        (void)hipDeviceGetAttribute(&cus, hipDeviceAttributeMultiprocessorCount, dev);
#if MULTI
        (void)hipFuncSetAttribute((const void*)k_phase, hipFuncAttributeMaxDynamicSharedMemorySize, LDS_BYTES);
        (void)hipOccupancyMaxActiveBlocksPerMultiprocessor(&per_cu, (const void*)k_phase, 256, LDS_BYTES);
#else
        (void)hipFuncSetAttribute((const void*)k_mega, hipFuncAttributeMaxDynamicSharedMemorySize, LDS_BYTES);
        (void)hipOccupancyMaxActiveBlocksPerMultiprocessor(&per_cu, (const void*)k_mega, 256, LDS_BYTES);
#endif
        if (per_cu < 1) { fprintf(stderr, "kernel_launch: occupancy query gave %d\n", per_cu); per_cu = 1; }
        if (per_cu > 2) per_cu = 2;
        grid = cus * per_cu;
        fprintf(stderr, "kernel_launch: cus %d per_cu %d grid %d\n", cus, per_cu, grid);
    }
    if (grid < 0) return;
    (void)hipMemsetAsync((char*)d_ws + WS_CTL, 0, 65536, stream);
    P p{};
    for (int i = 0; i < 31; ++i) p.in[i] = (const float*)d_in[i];
    p.out = (float*)d_out; p.ws = (char*)d_ws;
#if MULTI
    for (int l = 0; l < 2; ++l)
        for (int ph = 0; ph < NPHASE; ++ph) hipLaunchKernelGGL(k_phase, dim3(grid), dim3(256), LDS_BYTES, stream, p, ph, l);
    hipLaunchKernelGGL(k_phase, dim3(grid), dim3(256), LDS_BYTES, stream, p, NPHASE, 0);
#else
    void* args[] = {&p};
    hipError_t e = hipLaunchCooperativeKernel((const void*)k_mega, dim3(grid), dim3(256), args, LDS_BYTES, stream);
    if (e != hipSuccess) fprintf(stderr, "cooperative launch failed: %s (grid %d)\n", hipGetErrorString(e), grid);
#endif
}
```

```cpp
#include <hip/hip_runtime.h>
#include <hip/hip_cooperative_groups.h>
#include <cstdio>
#include <cstdint>
namespace cg = cooperative_groups;

#ifndef MULTI
#define MULTI 0
#endif

#define DI __device__ __forceinline__
#define LAS __attribute__((address_space(3)))
typedef unsigned short bf16_t;
typedef short bf16x8 __attribute__((ext_vector_type(8)));
typedef short s16x4 __attribute__((ext_vector_type(4)));
typedef float f32x16 __attribute__((ext_vector_type(16)));
typedef unsigned u32x4 __attribute__((ext_vector_type(4)));
typedef float f32x4 __attribute__((ext_vector_type(4)));
typedef unsigned u32x2 __attribute__((ext_vector_type(2)));

constexpr int T = 16384, DM = 1024, SEQ = 2048, NBATCH = 8;
constexpr int DIN = 2824, PJ = 2816;
constexpr int NE = 32, DE = 512, ECAP = 16384;
constexpr float EPS = 1e-6f;
constexpr int C_MQ = 0, C_MK = 256, C_MV = 512, C_MO = 768, C_AQ = 1024, C_AK = 1536, C_AV = 2048, C_SU = 2560;

constexpr size_t MiB = 1u << 20;
constexpr size_t WS_CTL = 0;
constexpr size_t WS_BAR = 16384;
constexpr size_t WS_KMEAN = 512 * 1024;
constexpr size_t WS_XRES = 1 * MiB;
constexpr size_t WS_HBUF = 65 * MiB;
constexpr size_t WS_PROJ = 97 * MiB;
constexpr size_t WS_GATES = 185 * MiB;
constexpr size_t WS_MIX = 186 * MiB;
constexpr size_t WS_HRAW = 218 * MiB;
constexpr size_t WS_ZBUF = 234 * MiB;
constexpr size_t WS_TOKL = 250 * MiB;
constexpr size_t WS_WL = 252 * MiB;
constexpr size_t WS_TINFO = 254 * MiB;
constexpr size_t WS_HMOE = 256 * MiB;
constexpr size_t WS_YMOE = 292 * MiB;
constexpr size_t WS_MQKC = 364 * MiB;
constexpr size_t WS_S5M = 380 * MiB;
constexpr size_t S5M_LAYER = 8 * MiB, S5M_E = 4 * MiB, S5M_F = 6 * MiB;
constexpr size_t WS_ELOC = 396 * MiB;
constexpr size_t WS_CARR = 412 * MiB;
constexpr size_t WS_RINFO = 420 * MiB;
constexpr size_t WS_HIST = 421 * MiB;
constexpr size_t WS_GSCAN = 422 * MiB;
constexpr size_t WS_WINB = 424 * MiB;
constexpr size_t WS_WOUTB = 436 * MiB;
constexpr size_t WS_END = 440 * MiB;

struct P {
    const float* in[31];
    float* out;
    char* ws;
};

#ifndef PROBE_SUB
#define PROBE_SUB 0
#endif
DI int tid_() { int t = threadIdx.x; asm volatile("" : "+v"(t)); return t; }
DI int bid_() { int b = blockIdx.x; asm volatile("" : "+s"(b)); return b; }
DI float bf2f(bf16_t b) { return __uint_as_float(((unsigned)b) << 16); }
DI bf16_t f2bf(float f) { unsigned u = __float_as_uint(f); u += 0x7fffu + ((u >> 16) & 1u); return (bf16_t)(u >> 16); }
typedef float f32x2 __attribute__((ext_vector_type(2)));
typedef __bf16 bf16x2_t __attribute__((ext_vector_type(2)));
DI unsigned pk2(float lo, float hi) { f32x2 v = {lo, hi}; return __builtin_bit_cast(unsigned, __builtin_convertvector(v, bf16x2_t)); }
DI void lds_barrier() { asm volatile("s_waitcnt lgkmcnt(0)" ::: "memory"); __builtin_amdgcn_s_barrier(); asm volatile("" ::: "memory"); }
DI float wave_sum(float v) {
#pragma unroll
    for (int o = 32; o > 0; o >>= 1) v += __shfl_xor(v, o);
    return v;
}
DI float sigmoidf_(float x) { return 1.0f / (1.0f + expf(-x)); }
DI s16x4 tr_read(const LAS char* p) {
    typedef short v4i16_t __attribute__((ext_vector_type(4)));
    return __builtin_bit_cast(s16x4, __builtin_amdgcn_ds_read_tr16_b64_v4i16((LAS v4i16_t*)p));
}

DI float half_swap_max(float m) {
    auto rr = __builtin_amdgcn_permlane32_swap(__float_as_uint(m), __float_as_uint(m), false, false);
    return fmaxf(__uint_as_float(rr[0]), __uint_as_float(rr[1]));
}
DI float half_swap_sum(float m) {
    auto rr = __builtin_amdgcn_permlane32_swap(__float_as_uint(m), __float_as_uint(m), false, false);
    return __uint_as_float(rr[0]) + __uint_as_float(rr[1]);
}

constexpr int BK = 32, A_PITCH = 80, B_PITCH = 320, SA_BYTES = 128 * A_PITCH, SB_BYTES = BK * B_PITCH;
constexpr int GEMM_LDS = 2 * SA_BYTES + 2 * SB_BYTES;

struct GSeg { const bf16_t* a0; const bf16_t* a1; int akstep; const float* b0; size_t ldb; int KT; };
template <class Epi>
DI void gemm_tile2(const GSeg& g1, const GSeg& g2, char* lds_generic, const Epi& epi) {
    const int KT = g1.KT + g2.KT;
    LAS char* lds = (LAS char*)lds_generic;
    const int t = tid_(), lane = t & 63, w = t >> 6, wm = w >> 1, wn = w & 1;
    const int r = lane & 31, h = lane >> 5;
    const int i16 = lane & 15, q = i16 >> 2, pp = i16 & 3, blk = (lane >> 4) & 1;
    const int arow = t >> 2, akc = t & 3, bk = t >> 5, bn4 = t & 31;
    f32x16 acc[2][2];
#pragma unroll
    for (int i = 0; i < 2; ++i)
#pragma unroll
        for (int j = 0; j < 2; ++j)
#pragma unroll
            for (int e = 0; e < 16; ++e) acc[i][j][e] = 0.f;
    struct Stage { u32x4 a0, a1; float4 b0, b1, b2, b3; };
    const bf16_t* pa0 = g1.a0; const bf16_t* pa1 = g1.a1; const float* pb = g1.b0;
    size_t ldb = g1.ldb; int aks = g1.akstep, left = g1.KT, issued = 0;
    auto gload = [&](Stage& S) {
        S.a0 = *(const u32x4*)pa0; S.a1 = *(const u32x4*)pa1;
        S.b0 = *(const float4*)(pb); S.b1 = *(const float4*)(pb + 8 * ldb); S.b2 = *(const float4*)(pb + 16 * ldb); S.b3 = *(const float4*)(pb + 24 * ldb);
        if (++issued < KT) {
            if (--left == 0) { pa0 = g2.a0; pa1 = g2.a1; pb = g2.b0; ldb = g2.ldb; aks = g2.akstep; left = 1 << 30; }
            else { pa0 += aks; pa1 += aks; pb += BK * ldb; }
        }
    };
    auto sstore = [&](const Stage& S, int buf) {
        LAS char* sA = lds + buf * SA_BYTES; LAS char* sB = lds + 2 * SA_BYTES + buf * SB_BYTES;
        *(LAS u32x4*)(sA + arow * A_PITCH + akc * 16) = S.a0;
        *(LAS u32x4*)(sA + (arow + 64) * A_PITCH + akc * 16) = S.a1;
        u32x2 v;
        v.x = pk2(S.b0.x, S.b0.y); v.y = pk2(S.b0.z, S.b0.w); *(LAS u32x2*)(sB + (bk) * B_PITCH + bn4 * 8) = v;
        v.x = pk2(S.b1.x, S.b1.y); v.y = pk2(S.b1.z, S.b1.w); *(LAS u32x2*)(sB + (bk + 8) * B_PITCH + bn4 * 8) = v;
        v.x = pk2(S.b2.x, S.b2.y); v.y = pk2(S.b2.z, S.b2.w); *(LAS u32x2*)(sB + (bk + 16) * B_PITCH + bn4 * 8) = v;
        v.x = pk2(S.b3.x, S.b3.y); v.y = pk2(S.b3.z, S.b3.w); *(LAS u32x2*)(sB + (bk + 24) * B_PITCH + bn4 * 8) = v;
    };
    auto compute = [&](int buf) {
        const LAS char* sA = lds + buf * SA_BYTES; const LAS char* sB = lds + 2 * SA_BYTES + buf * SB_BYTES;
#pragma unroll
        for (int ks = 0; ks < 2; ++ks) {
            bf16x8 af[2], bfr[2];
#pragma unroll
            for (int tm = 0; tm < 2; ++tm) af[tm] = *(const LAS bf16x8*)(sA + (wm * 64 + tm * 32 + r) * A_PITCH + (ks * 16 + 8 * h) * 2);
#pragma unroll
            for (int tn = 0; tn < 2; ++tn) {
                const LAS char* pb = sB + (ks * 16 + 8 * h + q) * B_PITCH + (wn * 64 + tn * 32 + 16 * blk) * 2 + 8 * pp;
                s16x4 lo = tr_read(pb), hi = tr_read(pb + 4 * B_PITCH);
                bfr[tn] = __builtin_shufflevector(lo, hi, 0, 1, 2, 3, 4, 5, 6, 7);
            }
#pragma unroll
            for (int tm = 0; tm < 2; ++tm)
#pragma unroll
                for (int tn = 0; tn < 2; ++tn) acc[tm][tn] = __builtin_amdgcn_mfma_f32_32x32x16_bf16(bfr[tn], af[tm], acc[tm][tn], 0, 0, 0);
        }
    };
    Stage S0, S1;
    gload(S0); gload(S1);
    sstore(S0, 0); __syncthreads();
#define GSTEP(SL, SS) { gload(SL); compute(kt & 1); sstore(SS, (kt + 1) & 1); __syncthreads(); if (++kt >= KT) break; }
    for (int kt = 0;;) {
        GSTEP(S0, S1)
        GSTEP(S1, S0)
    }
#undef GSTEP
    epi(acc, wm, wn, r, h);
}
#ifdef LAB
template <class Epi>
DI void gemm_lab(const GSeg& g1, const GSeg& g2, char* lds_generic, const Epi& epi) {
    const int KT = g1.KT + g2.KT;
    LAS char* lds = (LAS char*)lds_generic;
    const int t = tid_(), lane = t & 63, w = t >> 6, wm = w >> 1, wn = w & 1;
    const int r = lane & 31, h = lane >> 5;
    const int i16 = lane & 15, q = i16 >> 2, pp = i16 & 3, blk = (lane >> 4) & 1;
    const int arow = t >> 2, akc = t & 3, bk = t >> 5, bn4 = t & 31;
    f32x16 acc[2][2];
#pragma unroll
    for (int i = 0; i < 2; ++i)
#pragma unroll
        for (int j = 0; j < 2; ++j)
#pragma unroll
            for (int e = 0; e < 16; ++e) acc[i][j][e] = 0.f;
    struct Stage { u32x4 a0, a1; float4 b0, b1, b2, b3; };
    const bf16_t* pa0 = g1.a0; const bf16_t* pa1 = g1.a1; const float* pb = g1.b0;
    size_t ldb = g1.ldb; int aks = g1.akstep, left = g1.KT, issued = 0;
    auto gload = [&](Stage& S) {
        if (LAB != 5 && LAB != 15) { S.a0 = *(const u32x4*)pa0; S.a1 = *(const u32x4*)pa1; }
        if (LAB != 6 && LAB != 16) { S.b0 = *(const float4*)(pb); S.b1 = *(const float4*)(pb + 8 * ldb); S.b2 = *(const float4*)(pb + 16 * ldb); S.b3 = *(const float4*)(pb + 24 * ldb); }
        if (++issued < KT) {
            if (--left == 0) { pa0 = g2.a0; pa1 = g2.a1; pb = g2.b0; ldb = g2.ldb; aks = g2.akstep; left = 1 << 30; }
            else { pa0 += aks; pa1 += aks; pb += BK * ldb; }
        }
    };
    auto sstore = [&](const Stage& S, int buf) {
        LAS char* sA = lds + buf * SA_BYTES; LAS char* sB = lds + 2 * SA_BYTES + buf * SB_BYTES;
        *(LAS u32x4*)(sA + arow * A_PITCH + akc * 16) = S.a0;
        *(LAS u32x4*)(sA + (arow + 64) * A_PITCH + akc * 16) = S.a1;
        u32x2 v;
        v.x = pk2(S.b0.x, S.b0.y); v.y = pk2(S.b0.z, S.b0.w); *(LAS u32x2*)(sB + (bk) * B_PITCH + bn4 * 8) = v;
        v.x = pk2(S.b1.x, S.b1.y); v.y = pk2(S.b1.z, S.b1.w); *(LAS u32x2*)(sB + (bk + 8) * B_PITCH + bn4 * 8) = v;
        v.x = pk2(S.b2.x, S.b2.y); v.y = pk2(S.b2.z, S.b2.w); *(LAS u32x2*)(sB + (bk + 16) * B_PITCH + bn4 * 8) = v;
        v.x = pk2(S.b3.x, S.b3.y); v.y = pk2(S.b3.z, S.b3.w); *(LAS u32x2*)(sB + (bk + 24) * B_PITCH + bn4 * 8) = v;
    };
    auto compute = [&](int buf) {
        const LAS char* sA = lds + buf * SA_BYTES; const LAS char* sB = lds + 2 * SA_BYTES + buf * SB_BYTES;
#pragma unroll
        for (int ks = 0; ks < 2; ++ks) {
            bf16x8 af[2], bfr[2];
#pragma unroll
            for (int tm = 0; tm < 2; ++tm) af[tm] = *(const LAS bf16x8*)(sA + (wm * 64 + tm * 32 + r) * A_PITCH + (ks * 16 + 8 * h) * 2);
#pragma unroll
            for (int tn = 0; tn < 2; ++tn) {
                const LAS char* pb = sB + (ks * 16 + 8 * h + q) * B_PITCH + (wn * 64 + tn * 32 + 16 * blk) * 2 + 8 * pp;
                s16x4 lo = tr_read(pb), hi = tr_read(pb + 4 * B_PITCH);
                bfr[tn] = __builtin_shufflevector(lo, hi, 0, 1, 2, 3, 4, 5, 6, 7);
            }
#pragma unroll
            for (int tm = 0; tm < 2; ++tm)
#pragma unroll
                for (int tn = 0; tn < 2; ++tn) acc[tm][tn] = __builtin_amdgcn_mfma_f32_32x32x16_bf16(bfr[tn], af[tm], acc[tm][tn], 0, 0, 0);
        }
    };
    Stage S0, S1;
    gload(S0); gload(S1);
    sstore(S0, 0); __syncthreads();
#define GSTEP(SL, SS) { if (LAB != 1 && LAB != 3) gload(SL); if (LAB != 4 && LAB != 5 && LAB != 6) compute(kt & 1); if (LAB != 2 && LAB != 3) sstore(SS, (kt + 1) & 1); __syncthreads(); if (++kt >= KT) break; }
    for (int kt = 0;;) {
        GSTEP(S0, S1)
        GSTEP(S1, S0)
    }
#undef GSTEP
    epi(acc, wm, wn, r, h);
}
#endif
template <class Epi>
DI void gemm_tile(const bf16_t* a0, const bf16_t* a1, const float* b0, size_t ldb, int KT, char* lds_generic, const Epi& epi) {
    GSeg g1{a0, a1, BK, b0, ldb, KT}; GSeg g2{a0, a1, BK, b0, ldb, 0};
    gemm_tile2(g1, g2, lds_generic, epi);
}
struct GSeg2 { const bf16_t* a[4]; int askip; const bf16_t* b0; size_t ldb; int KT; };
constexpr int A2_PITCH = 144, SA2_BYTES = 128 * A2_PITCH, G2_LDS = 2 * SA2_BYTES + 2 * SB_BYTES;
template <class Epi>
DI void gemm2(const GSeg2& g1, const GSeg2& g2, char* lds_generic, const Epi& epi) {
    const int KT = g1.KT + g2.KT;
    LAS char* lds = (LAS char*)lds_generic;
    const int t = tid_(), lane = t & 63, w = t >> 6, wm = w >> 1, wn = w & 1;
    const int r = lane & 31, h = lane >> 5;
    const int i16 = lane & 15, q = i16 >> 2, pp = i16 & 3, blk = (lane >> 4) & 1;
    const int arow = t >> 3, akc = t & 7, bk = t >> 4, bc = t & 15;
    f32x16 acc[2][2];
#pragma unroll
    for (int i = 0; i < 2; ++i)
#pragma unroll
        for (int j = 0; j < 2; ++j)
#pragma unroll
            for (int e = 0; e < 16; ++e) acc[i][j][e] = 0.f;
    struct AStage { u32x4 a0, a1, a2, a3; };
    struct BStage { u32x4 b0, b1; };
    const bf16_t* pa0 = g1.a[0]; const bf16_t* pa1 = g1.a[1]; const bf16_t* pa2 = g1.a[2]; const bf16_t* pa3 = g1.a[3];
    const bf16_t* pb = g1.b0; size_t ldb = g1.ldb; int askip = g1.askip, aleft = g1.KT >> 1, bleft = g1.KT, aiss = 0, biss = 0;
    auto aload = [&](AStage& S) {
        S.a0 = *(const u32x4*)pa0; S.a1 = *(const u32x4*)pa1; S.a2 = *(const u32x4*)pa2; S.a3 = *(const u32x4*)pa3;
        if (++aiss < (KT >> 1)) {
            if (--aleft == 0) { pa0 = g2.a[0]; pa1 = g2.a[1]; pa2 = g2.a[2]; pa3 = g2.a[3]; askip = g2.askip; aleft = 1 << 30; }
            else { pa0 += askip; pa1 += askip; pa2 += askip; pa3 += askip; }
        }
    };
    auto bload = [&](BStage& S) {
        S.b0 = *(const u32x4*)pb; S.b1 = *(const u32x4*)(pb + 16 * ldb);
        if (++biss < KT) {
            if (--bleft == 0) { pb = g2.b0; ldb = g2.ldb; bleft = 1 << 30; }
            else pb += 32 * ldb;
        }
    };
    auto astore = [&](const AStage& S, int buf) {
        LAS char* sA = lds + buf * SA2_BYTES + arow * A2_PITCH + akc * 16;
        *(LAS u32x4*)(sA) = S.a0; *(LAS u32x4*)(sA + 32 * A2_PITCH) = S.a1; *(LAS u32x4*)(sA + 64 * A2_PITCH) = S.a2; *(LAS u32x4*)(sA + 96 * A2_PITCH) = S.a3;
    };
    auto bstore = [&](const BStage& S, int buf) {
        LAS char* sB = lds + 2 * SA2_BYTES + buf * SB_BYTES + bk * B_PITCH + bc * 16;
        *(LAS u32x4*)(sB) = S.b0; *(LAS u32x4*)(sB + 16 * B_PITCH) = S.b1;
    };
    auto compute = [&](int abuf, int half, int bbuf) {
        const LAS char* sA = lds + abuf * SA2_BYTES + half * 64; const LAS char* sB = lds + 2 * SA2_BYTES + bbuf * SB_BYTES;
#pragma unroll
        for (int ks = 0; ks < 2; ++ks) {
            bf16x8 af[2], bfr[2];
#pragma unroll
            for (int tm = 0; tm < 2; ++tm) af[tm] = *(const LAS bf16x8*)(sA + (wm * 64 + tm * 32 + r) * A2_PITCH + (ks * 16 + 8 * h) * 2);
#pragma unroll
            for (int tn = 0; tn < 2; ++tn) {
                const LAS char* pbb = sB + (ks * 16 + 8 * h + q) * B_PITCH + (wn * 64 + tn * 32 + 16 * blk) * 2 + 8 * pp;
                s16x4 lo = tr_read(pbb), hi = tr_read(pbb + 4 * B_PITCH);
                bfr[tn] = __builtin_shufflevector(lo, hi, 0, 1, 2, 3, 4, 5, 6, 7);
            }
#pragma unroll
            for (int tm = 0; tm < 2; ++tm)
#pragma unroll
                for (int tn = 0; tn < 2; ++tn) acc[tm][tn] = __builtin_amdgcn_mfma_f32_32x32x16_bf16(bfr[tn], af[tm], acc[tm][tn], 0, 0, 0);
        }
    };
    AStage RA; BStage RB0, RB1;
    aload(RA); bload(RB0); bload(RB1);
    astore(RA, 0); bstore(RB0, 0); __syncthreads();
    for (int sl = 0;; ++sl) {
#ifndef LAB
#define LAB 0
#define LAB_UNDEF
#endif
        if (LAB != 22) { aload(RA); bload(RB0); }
        if (LAB != 21) compute(sl & 1, 0, 0);
        bstore(RB1, 1);
        __syncthreads();
        if (LAB != 22) bload(RB1);
        if (LAB != 21) compute(sl & 1, 1, 1);
#ifdef LAB_UNDEF
#undef LAB
#undef LAB_UNDEF
#endif
        astore(RA, (sl + 1) & 1); bstore(RB0, 0);
        __syncthreads();
        if (2 * sl + 2 >= KT) break;
    }
    epi(acc, wm, wn, r, h);
}
struct GSeg3 { const bf16_t* a[4]; int askip; const float* b0; size_t ldb; int KT; };
template <class Epi>
DI void gemm3(const GSeg3& g1, const GSeg3& g2, char* lds_generic, const Epi& epi) {
    const int KT = g1.KT + g2.KT;
    LAS char* lds = (LAS char*)lds_generic;
    const int t = tid_(), lane = t & 63, w = t >> 6, wm = w >> 1, wn = w & 1;
    const int r = lane & 31, h = lane >> 5;
    const int i16 = lane & 15, q = i16 >> 2, pp = i16 & 3, blk = (lane >> 4) & 1;
    const int arow = t >> 3, akc = t & 7, bk = t >> 5, bn4 = t & 31;
    f32x16 acc[2][2];
#pragma unroll
    for (int i = 0; i < 2; ++i)
#pragma unroll
        for (int j = 0; j < 2; ++j)
#pragma unroll
            for (int e = 0; e < 16; ++e) acc[i][j][e] = 0.f;
    struct AStage { u32x4 a0, a1, a2, a3; };
    struct BStage { float4 b0, b1, b2, b3; };
    const bf16_t* pa0 = g1.a[0]; const bf16_t* pa1 = g1.a[1]; const bf16_t* pa2 = g1.a[2]; const bf16_t* pa3 = g1.a[3];
    const float* pb = g1.b0; size_t ldb = g1.ldb; int askip = g1.askip, aleft = g1.KT >> 1, bleft = g1.KT, aiss = 0, biss = 0;
    auto aload = [&](AStage& S) {
        S.a0 = *(const u32x4*)pa0; S.a1 = *(const u32x4*)pa1; S.a2 = *(const u32x4*)pa2; S.a3 = *(const u32x4*)pa3;
        if (++aiss < (KT >> 1)) {
            if (--aleft == 0) { pa0 = g2.a[0]; pa1 = g2.a[1]; pa2 = g2.a[2]; pa3 = g2.a[3]; askip = g2.askip; aleft = 1 << 30; }
            else { pa0 += askip; pa1 += askip; pa2 += askip; pa3 += askip; }
        }
    };
    auto bload = [&](BStage& S) {
        S.b0 = *(const float4*)(pb); S.b1 = *(const float4*)(pb + 8 * ldb); S.b2 = *(const float4*)(pb + 16 * ldb); S.b3 = *(const float4*)(pb + 24 * ldb);
        if (++biss < KT) {
            if (--bleft == 0) { pb = g2.b0; ldb = g2.ldb; bleft = 1 << 30; }
            else pb += 32 * ldb;
        }
    };
    auto astore = [&](const AStage& S, int buf) {
        LAS char* sA = lds + buf * SA2_BYTES + arow * A2_PITCH + akc * 16;
        *(LAS u32x4*)(sA) = S.a0; *(LAS u32x4*)(sA + 32 * A2_PITCH) = S.a1; *(LAS u32x4*)(sA + 64 * A2_PITCH) = S.a2; *(LAS u32x4*)(sA + 96 * A2_PITCH) = S.a3;
    };
    auto bstore = [&](const BStage& S, int buf) {
        LAS char* sB = lds + 2 * SA2_BYTES + buf * SB_BYTES + bk * B_PITCH + bn4 * 8;
        u32x2 v;
        v.x = pk2(S.b0.x, S.b0.y); v.y = pk2(S.b0.z, S.b0.w); *(LAS u32x2*)(sB) = v;
        v.x = pk2(S.b1.x, S.b1.y); v.y = pk2(S.b1.z, S.b1.w); *(LAS u32x2*)(sB + 8 * B_PITCH) = v;
        v.x = pk2(S.b2.x, S.b2.y); v.y = pk2(S.b2.z, S.b2.w); *(LAS u32x2*)(sB + 16 * B_PITCH) = v;
        v.x = pk2(S.b3.x, S.b3.y); v.y = pk2(S.b3.z, S.b3.w); *(LAS u32x2*)(sB + 24 * B_PITCH) = v;
    };
    auto compute = [&](int abuf, int half, int bbuf) {
        const LAS char* sA = lds + abuf * SA2_BYTES + half * 64; const LAS char* sB = lds + 2 * SA2_BYTES + bbuf * SB_BYTES;
#pragma unroll
        for (int ks = 0; ks < 2; ++ks) {
            bf16x8 af[2], bfr[2];
#pragma unroll
            for (int tm = 0; tm < 2; ++tm) af[tm] = *(const LAS bf16x8*)(sA + (wm * 64 + tm * 32 + r) * A2_PITCH + (ks * 16 + 8 * h) * 2);
#pragma unroll
            for (int tn = 0; tn < 2; ++tn) {
                const LAS char* pbb = sB + (ks * 16 + 8 * h + q) * B_PITCH + (wn * 64 + tn * 32 + 16 * blk) * 2 + 8 * pp;
                s16x4 lo = tr_read(pbb), hi = tr_read(pbb + 4 * B_PITCH);
                bfr[tn] = __builtin_shufflevector(lo, hi, 0, 1, 2, 3, 4, 5, 6, 7);
            }
#pragma unroll
            for (int tm = 0; tm < 2; ++tm)
#pragma unroll
                for (int tn = 0; tn < 2; ++tn) acc[tm][tn] = __builtin_amdgcn_mfma_f32_32x32x16_bf16(bfr[tn], af[tm], acc[tm][tn], 0, 0, 0);
        }
    };
    AStage RA; BStage RB0, RB1;
    aload(RA); bload(RB0); bload(RB1);
    astore(RA, 0); bstore(RB0, 0); __syncthreads();
    for (int sl = 0;; ++sl) {
        aload(RA); bload(RB0);
        compute(sl & 1, 0, 0);
        bstore(RB1, 1);
        __syncthreads();
        bload(RB1);
        compute(sl & 1, 1, 1);
        astore(RA, (sl + 1) & 1); bstore(RB0, 0);
        __syncthreads();
        if (2 * sl + 2 >= KT) break;
    }
    epi(acc, wm, wn, r, h);
}
struct GSeg4 { const bf16_t* a0; const bf16_t* a1; int akstep; const bf16_t* b0; size_t ldb; int KT; };
constexpr int B4_PITCH = 576, SB4_BYTES = 32 * B4_PITCH, G4_LDS = 2 * SA_BYTES + 2 * SB4_BYTES;
template <class Epi>
DI void gemm4(const GSeg4& g1, const GSeg4& g2, char* lds_generic, const Epi& epi) {
    const int KT = g1.KT + g2.KT;
    LAS char* lds = (LAS char*)lds_generic;
    const int t = tid_(), lane = t & 63, w = t >> 6, wm = w >> 1, wn = w & 1;
    const int r = lane & 31, h = lane >> 5;
    const int i16 = lane & 15, q = i16 >> 2, pp = i16 & 3, blk = (lane >> 4) & 1;
    const int arow = t >> 2, akc = t & 3, bk = t >> 5, bc = t & 31;
    f32x16 acc[2][4];
#pragma unroll
    for (int i = 0; i < 2; ++i)
#pragma unroll
        for (int j = 0; j < 4; ++j)
#pragma unroll
            for (int e = 0; e < 16; ++e) acc[i][j][e] = 0.f;
    struct Stage { u32x4 a0, a1, b0, b1, b2, b3; };
    const bf16_t* pa0 = g1.a0; const bf16_t* pa1 = g1.a1; const bf16_t* pb = g1.b0;
    size_t ldb = g1.ldb; int aks = g1.akstep, left = g1.KT, issued = 0;
    auto gload = [&](Stage& S) {
        S.a0 = *(const u32x4*)pa0; S.a1 = *(const u32x4*)pa1;
        S.b0 = *(const u32x4*)(pb); S.b1 = *(const u32x4*)(pb + 8 * ldb); S.b2 = *(const u32x4*)(pb + 16 * ldb); S.b3 = *(const u32x4*)(pb + 24 * ldb);
        if (++issued < KT) {
            if (--left == 0) { pa0 = g2.a0; pa1 = g2.a1; pb = g2.b0; ldb = g2.ldb; aks = g2.akstep; left = 1 << 30; }
            else { pa0 += aks; pa1 += aks; pb += 32 * ldb; }
        }
    };
    auto sstore = [&](const Stage& S, int buf) {
        LAS char* sA = lds + buf * SA_BYTES; LAS char* sB = lds + 2 * SA_BYTES + buf * SB4_BYTES + bk * B4_PITCH + bc * 16;
        *(LAS u32x4*)(sA + arow * A_PITCH + akc * 16) = S.a0;
        *(LAS u32x4*)(sA + (arow + 64) * A_PITCH + akc * 16) = S.a1;
        *(LAS u32x4*)(sB) = S.b0; *(LAS u32x4*)(sB + 8 * B4_PITCH) = S.b1; *(LAS u32x4*)(sB + 16 * B4_PITCH) = S.b2; *(LAS u32x4*)(sB + 24 * B4_PITCH) = S.b3;
    };
    auto compute = [&](int buf) {
        const LAS char* sA = lds + buf * SA_BYTES; const LAS char* sB = lds + 2 * SA_BYTES + buf * SB4_BYTES;
#pragma unroll
        for (int ks = 0; ks < 2; ++ks) {
            bf16x8 af[2], bfr[4];
#pragma unroll
            for (int tm = 0; tm < 2; ++tm) af[tm] = *(const LAS bf16x8*)(sA + (wm * 64 + tm * 32 + r) * A_PITCH + (ks * 16 + 8 * h) * 2);
#pragma unroll
            for (int tn = 0; tn < 4; ++tn) {
                const LAS char* pbb = sB + (ks * 16 + 8 * h + q) * B4_PITCH + (wn * 128 + tn * 32 + 16 * blk) * 2 + 8 * pp;
                s16x4 lo = tr_read(pbb), hi = tr_read(pbb + 4 * B4_PITCH);
                bfr[tn] = __builtin_shufflevector(lo, hi, 0, 1, 2, 3, 4, 5, 6, 7);
            }
#pragma unroll
            for (int tm = 0; tm < 2; ++tm)
#pragma unroll
                for (int tn = 0; tn < 4; ++tn) acc[tm][tn] = __builtin_amdgcn_mfma_f32_32x32x16_bf16(bfr[tn], af[tm], acc[tm][tn], 0, 0, 0);
        }
    };
    Stage S0, S1;
    gload(S0); gload(S1);
    sstore(S0, 0); __syncthreads();
#define GSTEP(SL, SS) { gload(SL); compute(kt & 1); sstore(SS, (kt + 1) & 1); __syncthreads(); if (++kt >= KT) break; }
    for (int kt = 0;;) {
        GSTEP(S0, S1)
        GSTEP(S1, S0)
    }
#undef GSTEP
    epi(acc, wm, wn, r, h);
}
struct Epi4Bf16 {
    bf16_t* out; size_t ld;
    DI void operator()(const f32x16 (&acc)[2][4], int wm, int wn, int r, int h) const {
#pragma unroll
        for (int tm = 0; tm < 2; ++tm) {
            bf16_t* rp = out + (size_t)(wm * 64 + tm * 32 + r) * ld + wn * 128 + 4 * h;
#pragma unroll
            for (int tn = 0; tn < 4; ++tn)
#pragma unroll
                for (int g = 0; g < 4; ++g) {
                    u32x2 v; v.x = pk2(acc[tm][tn][4 * g], acc[tm][tn][4 * g + 1]); v.y = pk2(acc[tm][tn][4 * g + 2], acc[tm][tn][4 * g + 3]);
                    *(u32x2*)(rp + tn * 32 + 8 * g) = v;
                }
        }
    }
};
struct Epi4Resid {
    float* out; const float* res; size_t ld;
    DI void operator()(const f32x16 (&acc)[2][4], int wm, int wn, int r, int h) const {
#pragma unroll
        for (int tm = 0; tm < 2; ++tm) {
            const size_t o = (size_t)(wm * 64 + tm * 32 + r) * ld + wn * 128 + 4 * h;
#pragma unroll
            for (int hf = 0; hf < 2; ++hf) {
                float4 x[8];
#pragma unroll
                for (int i = 0; i < 8; ++i) x[i] = *(const float4*)(res + o + (hf * 2 + (i >> 2)) * 32 + 8 * (i & 3));
#pragma unroll
                for (int i = 0; i < 8; ++i) {
                    const int tn = hf * 2 + (i >> 2), g = i & 3;
                    x[i].x += acc[tm][tn][4 * g]; x[i].y += acc[tm][tn][4 * g + 1]; x[i].z += acc[tm][tn][4 * g + 2]; x[i].w += acc[tm][tn][4 * g + 3];
                }
#pragma unroll
                for (int i = 0; i < 8; ++i) *(float4*)(out + o + (hf * 2 + (i >> 2)) * 32 + 8 * (i & 3)) = x[i];
            }
        }
    }
};
struct Epi4Inproj {
    Epi4Bf16 eb; float* gout; const float* bi; const float* bf; bool isgate;
    DI void operator()(const f32x16 (&acc)[2][4], int wm, int wn, int r, int h) const {
        if (!isgate) { eb(acc, wm, wn, r, h); return; }
        if (wn == 0) {
#pragma unroll
            for (int tm = 0; tm < 2; ++tm) {
                const float* bb = h ? bf : bi;
                float4 x = {acc[tm][0][0] + bb[0], acc[tm][0][1] + bb[1], acc[tm][0][2] + bb[2], acc[tm][0][3] + bb[3]};
                *(float4*)(gout + (size_t)(wm * 64 + tm * 32 + r) * 8 + 4 * h) = x;
            }
        }
    }
};
struct EpiBf16 {
    bf16_t* out; size_t ld;
    DI void operator()(const f32x16 (&acc)[2][2], int wm, int wn, int r, int h) const {
#pragma unroll
        for (int tm = 0; tm < 2; ++tm) {
            bf16_t* rp = out + (size_t)(wm * 64 + tm * 32 + r) * ld + wn * 64 + 4 * h;
#pragma unroll
            for (int tn = 0; tn < 2; ++tn)
#pragma unroll
                for (int g = 0; g < 4; ++g) {
                    u32x2 v; v.x = pk2(acc[tm][tn][4 * g], acc[tm][tn][4 * g + 1]); v.y = pk2(acc[tm][tn][4 * g + 2], acc[tm][tn][4 * g + 3]);
                    *(u32x2*)(rp + tn * 32 + 8 * g) = v;
                }
        }
    }
};
struct EpiResid {
    float* out; const float* res; size_t ld;
    DI void operator()(const f32x16 (&acc)[2][2], int wm, int wn, int r, int h) const {
#pragma unroll
        for (int tm = 0; tm < 2; ++tm) {
            const size_t o = (size_t)(wm * 64 + tm * 32 + r) * ld + wn * 64 + 4 * h;
            float4 x[8];
#pragma unroll
            for (int i = 0; i < 8; ++i) x[i] = *(const float4*)(res + o + (i >> 2) * 32 + 8 * (i & 3));
#pragma unroll
            for (int i = 0; i < 8; ++i) {
                const int tn = i >> 2, g = i & 3;
                x[i].x += acc[tm][tn][4 * g]; x[i].y += acc[tm][tn][4 * g + 1]; x[i].z += acc[tm][tn][4 * g + 2]; x[i].w += acc[tm][tn][4 * g + 3];
            }
#pragma unroll
            for (int i = 0; i < 8; ++i) *(float4*)(out + o + (i >> 2) * 32 + 8 * (i & 3)) = x[i];
        }
    }
};
DI float silu_mul(float g, float u) { return g / (1.0f + __expf(-g)) * u; }
struct EpiGateUp {
    bf16_t* out;
    DI void operator()(const f32x16 (&acc)[2][2], int wm, int wn, int r, int h) const {
#pragma unroll
        for (int tm = 0; tm < 2; ++tm) {
            bf16_t* rp = out + (size_t)(wm * 64 + tm * 32 + r) * DE + wn * 32 + 4 * h;
#pragma unroll
            for (int g = 0; g < 4; ++g) {
                u32x2 v;
                v.x = pk2(silu_mul(acc[tm][0][4 * g], acc[tm][1][4 * g]), silu_mul(acc[tm][0][4 * g + 1], acc[tm][1][4 * g + 1]));
                v.y = pk2(silu_mul(acc[tm][0][4 * g + 2], acc[tm][1][4 * g + 2]), silu_mul(acc[tm][0][4 * g + 3], acc[tm][1][4 * g + 3]));
                *(u32x2*)(rp + 8 * g) = v;
            }
        }
    }
};
struct EpiDown {
    bf16_t* out; const float* roww; int nvalid;
    DI void operator()(const f32x16 (&acc)[2][2], int wm, int wn, int r, int h) const {
#pragma unroll
        for (int tm = 0; tm < 2; ++tm) {
            const int row = wm * 64 + tm * 32 + r;
            const float wv = row < nvalid ? roww[row] : 0.f;
            bf16_t* rp = out + (size_t)row * DM + wn * 64 + 4 * h;
#pragma unroll
            for (int tn = 0; tn < 2; ++tn)
#pragma unroll
                for (int g = 0; g < 4; ++g) {
                    u32x2 v; v.x = pk2(acc[tm][tn][4 * g] * wv, acc[tm][tn][4 * g + 1] * wv); v.y = pk2(acc[tm][tn][4 * g + 2] * wv, acc[tm][tn][4 * g + 3] * wv);
                    *(u32x2*)(rp + tn * 32 + 8 * g) = v;
                }
        }
    }
};

struct EpiGates {
    float* out; const float* bi; const float* bf;
    DI void operator()(const f32x16 (&acc)[2][2], int wm, int wn, int r, int h) const {
        if (wn == 0) {
#pragma unroll
            for (int tm = 0; tm < 2; ++tm) {
                const float* bb = h ? bf : bi;
                float4 x = {acc[tm][0][0] + bb[0], acc[tm][0][1] + bb[1], acc[tm][0][2] + bb[2], acc[tm][0][3] + bb[3]};
                *(float4*)(out + (size_t)(wm * 64 + tm * 32 + r) * 8 + 4 * h) = x;
            }
        }
    }
};
struct EpiInproj {
    EpiBf16 eb; EpiGates eg; bool isgate;
    DI void operator()(const f32x16 (&acc)[2][2], int wm, int wn, int r, int h) const { if (isgate) eg(acc, wm, wn, r, h); else eb(acc, wm, wn, r, h); }
};
struct EpiF32 {
    float* out; size_t ld;
    DI void operator()(const f32x16 (&acc)[2][2], int wm, int wn, int r, int h) const {
#pragma unroll
        for (int tm = 0; tm < 2; ++tm) {
            float* rp = out + (size_t)(wm * 64 + tm * 32 + r) * ld + wn * 64 + 4 * h;
#pragma unroll
            for (int tn = 0; tn < 2; ++tn)
#pragma unroll
                for (int g = 0; g < 4; ++g) { float4 x = {acc[tm][tn][4 * g], acc[tm][tn][4 * g + 1], acc[tm][tn][4 * g + 2], acc[tm][tn][4 * g + 3]}; *(float4*)(rp + tn * 32 + 8 * g) = x; }
        }
    }
};
DI float gelu_tanh(float v) {
    const float inner = 0.7978845608028654f * (v + 0.044715f * v * v * v);
    const float th = 1.0f - 2.0f / (__expf(2.0f * inner) + 1.0f);
    return 0.5f * v * (1.0f + th);
}
struct EpiS5Y {
    bf16_t* zrow0;
    int ncol0;
    DI void operator()(const f32x16 (&acc)[2][2], int wm, int wn, int r, int h) const {
#pragma unroll
        for (int tm = 0; tm < 2; ++tm) {
            const int chunk = wm * 64 + tm * 32 + r;
#pragma unroll
            for (int tn = 0; tn < 2; ++tn)
#pragma unroll
                for (int g = 0; g < 4; ++g) {
                    const int n0 = ncol0 + wn * 64 + tn * 32 + 8 * g + 4 * h;
                    u32x2 v; v.x = pk2(gelu_tanh(acc[tm][tn][4 * g]), gelu_tanh(acc[tm][tn][4 * g + 1])); v.y = pk2(gelu_tanh(acc[tm][tn][4 * g + 2]), gelu_tanh(acc[tm][tn][4 * g + 3]));
                    *(u32x2*)(zrow0 + (size_t)(chunk * 16 + (n0 >> 4)) * 256 + (n0 & 15)) = v;
                }
        }
    }
};
struct EpiGlu {
    const bf16_t* z; bf16_t* out; const float* gb; const float* sg;
    DI void operator()(const f32x16 (&acc)[2][2], int wm, int wn, int r, int h) const {
#pragma unroll
        for (int tm = 0; tm < 2; ++tm) {
            const int row = wm * 64 + tm * 32 + r;
#pragma unroll
            for (int tn = 0; tn < 2; ++tn) {
                const int c0 = wn * 64 + tn * 32 + 4 * h;
                float y[16];
#pragma unroll
                for (int g = 0; g < 4; ++g) {
                    const u32x2 zz = *(const u32x2*)(z + (size_t)row * 256 + c0 + 8 * g);
                    const float4 b4 = *(const float4*)(gb + c0 + 8 * g);
                    y[4 * g + 0] = bf2f(zz.x & 0xffff) / (1.0f + __expf(-(acc[tm][tn][4 * g + 0] + b4.x)));
                    y[4 * g + 1] = bf2f(zz.x >> 16) / (1.0f + __expf(-(acc[tm][tn][4 * g + 1] + b4.y)));
                    y[4 * g + 2] = bf2f(zz.y & 0xffff) / (1.0f + __expf(-(acc[tm][tn][4 * g + 2] + b4.z)));
                    y[4 * g + 3] = bf2f(zz.y >> 16) / (1.0f + __expf(-(acc[tm][tn][4 * g + 3] + b4.w)));
                }
#pragma unroll
                for (int q = 0; q < 2; ++q) {
                    float ss = 0.f;
#pragma unroll
                    for (int e = 0; e < 8; ++e) ss += y[8 * q + e] * y[8 * q + e];
                    ss = half_swap_sum(ss);
                    const float rstd = rsqrtf(ss * (1.0f / 16.0f) + EPS);
#pragma unroll
                    for (int g = 2 * q; g < 2 * q + 2; ++g) {
                        const float4 s4 = *(const float4*)(sg + c0 + 8 * g);
                        u32x2 v; v.x = pk2(y[4 * g] * rstd * s4.x, y[4 * g + 1] * rstd * s4.y); v.y = pk2(y[4 * g + 2] * rstd * s4.z, y[4 * g + 3] * rstd * s4.w);
                        *(u32x2*)(out + (size_t)row * DM + c0 + 8 * g) = v;
                    }
                }
            }
        }
    }
};

DI void moe_prefix(const int* cnt, int* stp  ) {
    __syncthreads();
    if (tid_() == 0) { int a = 0; for (int e = 0; e < NE; ++e) { stp[e] = a; a += (cnt[e] + 127) >> 7; } stp[NE] = a; }
    __syncthreads();
}

constexpr int XS_P = 1028;
template <int NC>
DI void rows_matvec(const float* xs, const float* W, int ldw, float* part  ) {
    constexpr int O = 8 * NC, PARTS = 256 / O, KLEN = 1024 / PARTS;
    const int t = tid_(), o = t % O, prt = t / O, r = o / NC, j = o % NC;
    const float* xr = xs + r * XS_P + prt * KLEN;
    const float* wp = W + (size_t)(prt * KLEN) * ldw + j;
    float a0 = 0.f, a1 = 0.f, a2 = 0.f, a3 = 0.f;
#pragma unroll 4
    for (int k = 0; k < KLEN; k += 4) {
        const float4 x = *(const float4*)(xr + k);
        a0 += x.x * wp[(size_t)k * ldw]; a1 += x.y * wp[(size_t)(k + 1) * ldw]; a2 += x.z * wp[(size_t)(k + 2) * ldw]; a3 += x.w * wp[(size_t)(k + 3) * ldw];
    }
    part[t] = (a0 + a1) + (a2 + a3);
}

DI void phase_norm1(const P& p, int l, char* lds) {
    const int t = tid_(), lane = t & 63, w = t >> 6;
    float* xres = (float*)(p.ws + WS_XRES);
    bf16_t* hbuf = (bf16_t*)(p.ws + WS_HBUF);
    float* gates = (float*)(p.ws + WS_GATES);
    const float* g1 = p.in[1] + l * DM;
    const float* win = p.in[2] + (size_t)l * DM * DIN;
    float* xs = (float*)lds;
    float* part = xs + 8 * XS_P;
    int* stp = (int*)(part + 256);
    const bf16_t* ymoe = (const bf16_t*)(p.ws + WS_YMOE);
    const int4* tinfo = (const int4*)(p.ws + WS_TINFO);
    if (l > 0) moe_prefix((const int*)(p.ws + WS_CTL) + (l - 1) * NE, stp);
    if (l == 0) {
        const size_t stride = (size_t)gridDim.x * 256, i0 = (size_t)bid_() * 256 + t;
        const float4* s1 = (const float4*)p.in[2]; u32x2* d1 = (u32x2*)(p.ws + WS_WINB);
        for (size_t i = i0; i < (size_t)2 * DM * DIN / 4; i += stride) { const float4 v = s1[i]; u32x2 o; o.x = pk2(v.x, v.y); o.y = pk2(v.z, v.w); d1[i] = o; }
        const float4* s2 = (const float4*)p.in[22]; u32x2* d2 = (u32x2*)(p.ws + WS_WOUTB);
        for (size_t i = i0; i < (size_t)2 * DM * DM / 4; i += stride) { const float4 v = s2[i]; u32x2 o; o.x = pk2(v.x, v.y); o.y = pk2(v.z, v.w); d2[i] = o; }
    }
    for (int rb = bid_(); rb < T / 8; rb += gridDim.x) {
        __syncthreads();
#pragma unroll
        for (int rr = 0; rr < 2; ++rr) {
            const int lr = w * 2 + rr, row = rb * 8 + lr;
            float4 v[4];
            const float* xsrc = (l == 0) ? p.in[0] + (size_t)row * DM : xres + (size_t)row * DM;
#pragma unroll
            for (int i = 0; i < 4; ++i) v[i] = *(const float4*)(xsrc + i * 256 + lane * 4);
            if (l > 0) {
                int4 ti = tinfo[row];
                const bf16_t* y0 = ymoe + (size_t)(stp[ti.x] * 128 + ti.y) * DM;
                const bf16_t* y1 = ymoe + (size_t)(stp[ti.z] * 128 + ti.w) * DM;
#pragma unroll
                for (int i = 0; i < 4; ++i) {
                    uint2 a = *(const uint2*)(y0 + i * 256 + lane * 4), b2 = *(const uint2*)(y1 + i * 256 + lane * 4);
                    v[i].x += bf2f(a.x & 0xffff) + bf2f(b2.x & 0xffff); v[i].y += bf2f(a.x >> 16) + bf2f(b2.x >> 16);
                    v[i].z += bf2f(a.y & 0xffff) + bf2f(b2.y & 0xffff); v[i].w += bf2f(a.y >> 16) + bf2f(b2.y >> 16);
                    *(float4*)(xres + (size_t)row * DM + i * 256 + lane * 4) = v[i];
                }
            }
            float ss = 0.f;
#pragma unroll
            for (int i = 0; i < 4; ++i) ss += v[i].x * v[i].x + v[i].y * v[i].y + v[i].z * v[i].z + v[i].w * v[i].w;
            ss = wave_sum(ss);
            const float rstd = rsqrtf(ss * (1.0f / DM) + EPS);
#pragma unroll
            for (int i = 0; i < 4; ++i) {
                const int k0 = i * 256 + lane * 4;
                const float4 g = *(const float4*)(g1 + k0);
                float4 hv = {v[i].x * rstd * g.x, v[i].y * rstd * g.y, v[i].z * rstd * g.z, v[i].w * rstd * g.w};
                uint2 o; o.x = pk2(hv.x, hv.y); o.y = pk2(hv.z, hv.w);
                *(uint2*)(hbuf + (size_t)row * DM + k0) = o;
            }
        }
    }
}

DI void phase_inproj(const P& p, int l, char* lds) {
    const int t = tid_();
    const bf16_t* hbuf = (const bf16_t*)(p.ws + WS_HBUF);
    bf16_t* projb = (bf16_t*)(p.ws + WS_PROJ);
    const bf16_t* winb = (const bf16_t*)(p.ws + WS_WINB) + (size_t)l * DM * DIN;
    float* gates = (float*)(p.ws + WS_GATES);
    const int vx = bid_() & 7, vj = bid_() >> 3, nj = (gridDim.x - vx + 7) >> 3;
    for (int st = vx; st < 16; st += 8)
      for (int j = vj; j < 96; j += nj) {
        const int mt = st * 8 + j / 12, vt = j % 12;
        const int acol = vt < 4 ? vt * 256 : (vt < 10 ? 1032 + (vt - 4) * 256 : (vt == 10 ? 2568 : 1024));
        const bf16_t* ar = hbuf + (size_t)(mt * 128 + (t >> 2)) * DM + (t & 3) * 8;
        GSeg4 g1{ar, ar + (size_t)64 * DM, 32, winb + (size_t)(t >> 5) * DIN + acol + (t & 31) * 8, DIN, DM / 32}; GSeg4 g2 = g1; g2.KT = 0;
        Epi4Inproj epi{Epi4Bf16{projb + (size_t)mt * 128 * PJ + (vt % 11) * 256, (size_t)PJ}, gates + (size_t)mt * 128 * 8, p.in[3] + l * 4, p.in[4] + l * 4, vt == 11};
        gemm4(g1, g2, lds, epi);
      }
}

__constant__ float ROPE_INV_REV[8] = {0.15915494309189535f, 0.03086376340470123f, 0.005985185712713705f, 0.001160663641240061f,
                                      0.00022507907903927653f, 4.364795279280289e-05f, 8.464330808241401e-06f, 1.6414262627950345e-06f};
DI void load64(const bf16_t* ptr, float (&x)[64]) {
#pragma unroll
    for (int c = 0; c < 8; ++c) {
        u32x4 u = *(const u32x4*)(ptr + c * 8);
        x[c * 8 + 0] = bf2f(u.x & 0xffff); x[c * 8 + 1] = bf2f(u.x >> 16); x[c * 8 + 2] = bf2f(u.y & 0xffff); x[c * 8 + 3] = bf2f(u.y >> 16);
        x[c * 8 + 4] = bf2f(u.z & 0xffff); x[c * 8 + 5] = bf2f(u.z >> 16); x[c * 8 + 6] = bf2f(u.w & 0xffff); x[c * 8 + 7] = bf2f(u.w >> 16);
    }
}
DI void store64(bf16_t* ptr, const float (&x)[64], float sc) {
#pragma unroll
    for (int c = 0; c < 8; ++c) {
        u32x4 u;
        u.x = pk2(x[c * 8 + 0] * sc, x[c * 8 + 1] * sc); u.y = pk2(x[c * 8 + 2] * sc, x[c * 8 + 3] * sc);
        u.z = pk2(x[c * 8 + 4] * sc, x[c * 8 + 5] * sc); u.w = pk2(x[c * 8 + 6] * sc, x[c * 8 + 7] * sc);
        *(u32x4*)(ptr + c * 8) = u;
    }
}
DI void norm_rope64(float (&x)[64], const float* g, int pos) {
    float ss = 0.f;
#pragma unroll
    for (int d = 0; d < 64; ++d) ss += x[d] * x[d];
    const float rstd = rsqrtf(ss * (1.0f / 64.0f) + EPS);
#pragma unroll
    for (int d = 0; d < 64; ++d) x[d] = x[d] * rstd * g[d];
#pragma unroll
    for (int d = 0; d < 8; ++d) {
        constexpr double RINV[8] = {0.15915494309189535, 0.03086376340470123, 0.005985185712713705, 0.001160663641240061,
                                    0.00022507907903927653, 4.364795279280289e-05, 8.464330808241401e-06, 1.6414262627950345e-06};
        double rr = (double)pos * RINV[d];
        rr -= floor(rr);
        const float sn = __builtin_amdgcn_sinf((float)rr), cs = __builtin_amdgcn_cosf((float)rr);
        const float x1 = x[d], x2 = x[d + 8];
        x[d] = x1 * cs - x2 * sn; x[d + 8] = x2 * cs + x1 * sn;
    }
}
DI void phase_qkprep(const P& p, int l, char* lds, unsigned long long& tsub) {
    unsigned long long tq0 = PROBE_SUB ? wall_clock64() : 0ull;
#define QSUB(bit) do { if (PROBE_SUB) { const unsigned long long tn_ = wall_clock64(); if (PROBE_SUB & (bit)) tsub += tn_ - tq0; tq0 = tn_; } } while (0)
    bf16_t* projb = (bf16_t*)(p.ws + WS_PROJ);
    float* kmean = (float*)(p.ws + WS_KMEAN);
    float* red = (float*)lds;
    const int t = tid_(), lane = t & 63, w = t >> 6;
    for (int item = bid_(); item < 512; item += gridDim.x) {
        const int b = item >> 6, n = (item >> 3) & 7, hd = item & 7;
        const int s8 = t & 7, tg = t >> 3;
        float ks[8];
#pragma unroll
        for (int j = 0; j < 8; ++j) ks[j] = 0.f;
        float gq[8], gk[8];
        {
            const float4 a0 = *(const float4*)(p.in[8] + l * 64 + s8 * 8), a1 = *(const float4*)(p.in[8] + l * 64 + s8 * 8 + 4);
            const float4 c0 = *(const float4*)(p.in[9] + l * 64 + s8 * 8), c1 = *(const float4*)(p.in[9] + l * 64 + s8 * 8 + 4);
            gq[0] = a0.x; gq[1] = a0.y; gq[2] = a0.z; gq[3] = a0.w; gq[4] = a1.x; gq[5] = a1.y; gq[6] = a1.z; gq[7] = a1.w;
            gk[0] = c0.x; gk[1] = c0.y; gk[2] = c0.z; gk[3] = c0.w; gk[4] = c1.x; gk[5] = c1.y; gk[6] = c1.z; gk[7] = c1.w;
        }
#pragma unroll 2
        for (int itk = 0; itk < 8; ++itk) {
            const int pos = n * 256 + itk * 32 + tg;
            bf16_t* rowp = projb + ((size_t)b * SEQ + pos) * PJ + hd * 64 + s8 * 8;
            const u32x4 uq = *(const u32x4*)(rowp + C_AQ), uk = *(const u32x4*)(rowp + C_AK);
            float sn[8], cs[8];
#pragma unroll
            for (int d = 0; d < 8; ++d) {
                constexpr double RINV[8] = {0.15915494309189535, 0.03086376340470123, 0.005985185712713705, 0.001160663641240061,
                                            0.00022507907903927653, 4.364795279280289e-05, 8.464330808241401e-06, 1.6414262627950345e-06};
                double rr = (double)pos * RINV[d];
                rr -= floor(rr);
                sn[d] = __builtin_amdgcn_sinf((float)rr); cs[d] = __builtin_amdgcn_cosf((float)rr);
            }
#pragma unroll
            for (int which = 0; which < 2; ++which) {
                const u32x4 u = which ? uk : uq;
                float x[8] = {bf2f(u.x & 0xffff), bf2f(u.x >> 16), bf2f(u.y & 0xffff), bf2f(u.y >> 16), bf2f(u.z & 0xffff), bf2f(u.z >> 16), bf2f(u.w & 0xffff), bf2f(u.w >> 16)};
                float ss = 0.f;
#pragma unroll
                for (int j = 0; j < 8; ++j) ss += x[j] * x[j];
                ss += __shfl_xor(ss, 1); ss += __shfl_xor(ss, 2); ss += __shfl_xor(ss, 4);
                const float rstd = rsqrtf(ss * (1.0f / 64.0f) + EPS);
#pragma unroll
                for (int j = 0; j < 8; ++j) x[j] = x[j] * rstd * (which ? gk[j] : gq[j]);
#pragma unroll
                for (int j = 0; j < 8; ++j) {
                    const float other = __shfl_xor(x[j], 1);
                    if (s8 == 0) x[j] = x[j] * cs[j] - other * sn[j];
                    else if (s8 == 1) x[j] = x[j] * cs[j] + other * sn[j];
                }
                const float sc = which ? 1.0f : 0.125f * 1.4426950408889634f;
                u32x4 o; o.x = pk2(x[0] * sc, x[1] * sc); o.y = pk2(x[2] * sc, x[3] * sc); o.z = pk2(x[4] * sc, x[5] * sc); o.w = pk2(x[6] * sc, x[7] * sc);
                *(u32x4*)(rowp + (which ? C_AK : C_AQ)) = o;
                if (which) {
#pragma unroll
                    for (int j = 0; j < 8; ++j) ks[j] += x[j];
                }
            }
        }
#pragma unroll
        for (int j = 0; j < 8; ++j) { ks[j] += __shfl_xor(ks[j], 8); ks[j] += __shfl_xor(ks[j], 16); ks[j] += __shfl_xor(ks[j], 32); }
        __syncthreads();
        if (lane < 8) {
#pragma unroll
            for (int j = 0; j < 8; ++j) red[w * 64 + lane * 8 + j] = ks[j];
        }
        __syncthreads();
        if (t < 64) kmean[(size_t)item * 64 + t] = (red[t] + red[64 + t] + red[128 + t] + red[192 + t]) * (1.0f / 256.0f);
    }
    QSUB(8);
    {
        bf16_t* mqkc = (bf16_t*)(p.ws + WS_MQKC);
        const float* cw = p.in[5] + l * 4 * 512; const float* cb = p.in[6] + l * 512;
        const int nthreads = gridDim.x * 256;
        for (int idx = bid_() * 256 + t; idx < T * 64; idx += nthreads) {
            const int token = idx >> 6, ch = (idx & 63) * 8, pos = token & (SEQ - 1);
            float a[8];
            { const float4 b0 = *(const float4*)(cb + ch), b1 = *(const float4*)(cb + ch + 4); a[0] = b0.x; a[1] = b0.y; a[2] = b0.z; a[3] = b0.w; a[4] = b1.x; a[5] = b1.y; a[6] = b1.z; a[7] = b1.w; }
#pragma unroll
            for (int j = 0; j < 4; ++j) {
                if (pos + j - 3 >= 0) {
                    const u32x4 u = *(const u32x4*)(projb + (size_t)(token + j - 3) * PJ + ch);
                    const float4 w0 = *(const float4*)(cw + j * 512 + ch), w1 = *(const float4*)(cw + j * 512 + ch + 4);
                    a[0] += bf2f(u.x & 0xffff) * w0.x; a[1] += bf2f(u.x >> 16) * w0.y; a[2] += bf2f(u.y & 0xffff) * w0.z; a[3] += bf2f(u.y >> 16) * w0.w;
                    a[4] += bf2f(u.z & 0xffff) * w1.x; a[5] += bf2f(u.z >> 16) * w1.y; a[6] += bf2f(u.w & 0xffff) * w1.z; a[7] += bf2f(u.w >> 16) * w1.w;
                }
            }
            const float sc = ch >= 256 ? 0.125f : 1.0f;
#pragma unroll
            for (int e = 0; e < 8; ++e) a[e] = a[e] / (1.0f + __expf(-a[e])) * sc;
            u32x4 o; o.x = pk2(a[0], a[1]); o.y = pk2(a[2], a[3]); o.z = pk2(a[4], a[5]); o.w = pk2(a[6], a[7]);
            *(u32x4*)(mqkc + (size_t)token * 512 + ch) = o;
        }
    }
    QSUB(16);
    {
        const float* gates = (const float*)(p.ws + WS_GATES);
        float4* gscan = (float4*)(p.ws + WS_GSCAN);
        const int lane = t & 63, gwv = bid_() * 4 + (t >> 6), nwv = gridDim.x * 4;
        for (int it = gwv; it < (T / 64) * 4; it += nwv) {
            const int ck = it >> 2, hd = it & 3;
            const size_t row = (size_t)ck * 64 + lane;
            const float gi = gates[row * 8 + hd], gf = gates[row * 8 + 4 + hd];
            const float lf = fminf(gf, 0.f) - log1pf(expf(-fabsf(gf)));
            float bs = lf;
#pragma unroll
            for (int o = 1; o < 64; o <<= 1) { const float v = __shfl_up(bs, o); if (lane >= o) bs += v; }
            const float u = gi - bs; float um = u;
#pragma unroll
            for (int o = 1; o < 64; o <<= 1) { const float v = __shfl_up(um, o); if (lane >= o) um = fmaxf(um, v); }
            gscan[row * 4 + hd] = make_float4(bs, u, um, 0.f);
        }
    }
    QSUB(32);
    {
        float* Tm = (float*)(p.ws + WS_S5M + (size_t)l * S5M_LAYER);
        float* Em = (float*)(p.ws + WS_S5M + (size_t)l * S5M_LAYER + S5M_E);
        float* Fm = (float*)(p.ws + WS_S5M + (size_t)l * S5M_LAYER + S5M_F);
        float* sp = (float*)lds + 512;
        float* scr = sp + 384;
        float* sci = scr + 1024; float* sbr = sci + 1024; float* sbi = sbr + 1024;
        for (int item = bid_(); item < 512; item += gridDim.x) {
            const int g = item >> 5, tau = (item >> 1) & 15, part = item & 1, lg = l * 16 + g;
            float* Tg = Tm + (size_t)g * 256 * 256; float* Eg = Em + (size_t)g * 256 * 128; float* Fg = Fm + (size_t)g * 128 * 256;
            __syncthreads();
            {
                const float4 a0 = *(const float4*)(p.in[15] + (size_t)lg * 1024 + t * 4), a1 = *(const float4*)(p.in[16] + (size_t)lg * 1024 + t * 4);
                const float4 a2 = *(const float4*)(p.in[13] + (size_t)lg * 1024 + t * 4), a3 = *(const float4*)(p.in[14] + (size_t)lg * 1024 + t * 4);
                *(float4*)(scr + t * 4) = a0; *(float4*)(sci + t * 4) = a1; *(float4*)(sbr + t * 4) = a2; *(float4*)(sbi + t * 4) = a3;
            }
            if (t < 64) {
                const float lr = p.in[11][lg * 64 + t], li = p.in[12][lg * 64 + t], dt = expf(p.in[18][lg]);
                const float mag1 = expf(lr * dt), a1r = mag1 * cosf(li * dt), a1i = mag1 * sinf(li * dt);
                const float magt = expf(lr * dt * tau), atr = magt * cosf(li * dt * tau), ati = magt * sinf(li * dt * tau);
                const float zr = a1r - 1.0f, zi = a1i, dn = lr * lr + li * li;
                sp[t] = atr; sp[64 + t] = ati; sp[128 + t] = atr * a1r - ati * a1i; sp[192 + t] = atr * a1i + ati * a1r;
                sp[256 + t] = (zr * lr + zi * li) / dn; sp[320 + t] = (zi * lr - zr * li) / dn;
            }
            __syncthreads();
            if (part == 0) {
                const int hh = t >> 4, hp = t & 15;
                float kv = 0.f;
#pragma unroll 8
                for (int pi = 0; pi < 64; ++pi) {
                    const float fr = sp[256 + pi], fi = sp[320 + pi], br = sbr[pi * 16 + hp], bi = sbi[pi * 16 + hp];
                    const float bbr = fr * br - fi * bi, bbi = fr * bi + fi * br;
                    const float cr = scr[hh * 64 + pi], ci = sci[hh * 64 + pi], ar = sp[pi], ai = sp[64 + pi];
                    kv += (cr * ar - ci * ai) * bbr - (cr * ai + ci * ar) * bbi;
                }
                if (tau == 0 && hh == hp) kv += p.in[17][lg * 16 + hh];
                for (int s_ = 0; s_ + tau < 16; ++s_) {
                    const int t_ = s_ + tau;
                    Tg[(size_t)(s_ * 16 + hp) * 256 + t_ * 16 + hh] = kv;
                    if (tau > 0) Tg[(size_t)(t_ * 16 + hp) * 256 + s_ * 16 + hh] = 0.f;
                }
            }
            if (part == 1)
            for (int idx = t; idx < 1024; idx += 256) {
                const int pi = idx >> 4, x = idx & 15;
                {
                    const float fr = sp[256 + pi], fi = sp[320 + pi];
                    const float br = sbr[pi * 16 + x], bi = sbi[pi * 16 + x];
                    const float bbr = fr * br - fi * bi, bbi = fr * bi + fi * br, ar = sp[pi], ai = sp[64 + pi];
                    const size_t ro = (size_t)((15 - tau) * 16 + x) * 128;
                    Eg[ro + pi] = ar * bbr - ai * bbi; Eg[ro + 64 + pi] = ar * bbi + ai * bbr;
                }
                {
                    const float cr = scr[x * 64 + pi], ci = sci[x * 64 + pi];
                    const float ar = sp[128 + pi], ai = sp[192 + pi];
                    Fg[(size_t)pi * 256 + tau * 16 + x] = cr * ar - ci * ai; Fg[(size_t)(64 + pi) * 256 + tau * 16 + x] = -(cr * ai + ci * ar);
                }
            }
        }
    }
    QSUB(64);
#undef QSUB
}

DI void mlstm_item_simple(const P& p, int l, int item, float* sm) {
    const int b = item >> 4, hd = (item >> 2) & 3, dq = item & 3;
    const int t = tid_();
    const bf16_t* projb = (const bf16_t*)(p.ws + WS_PROJ);
    const float* gates = (const float*)(p.ws + WS_GATES);
    float* hraw = (float*)(p.ws + WS_HRAW);
    const float* cw = p.in[5] + l * 4 * 512; const float* cb = p.in[6] + l * 512;
    float* Q = sm; float* K = Q + 64 * 65; float* Sm = K + 64 * 65; float* V = Sm + 64 * 65; float* C = V + 64 * 16; float* nv = C + 64 * 16;
    float* bc = nv + 64; float* Mt = bc + 64; float* uu = Mt + 64; float* den = uu + 64; float* misc = den + 64;
    __syncthreads();
    for (int i = t; i < 1024; i += 256) C[i] = 0.f;
    if (t < 64) nv[t] = 0.f;
    if (t == 0) misc[0] = 0.f;
    for (int c = 0; c < 32; ++c) {
        __syncthreads();
        const int row0 = b * SEQ + c * 64;
        for (int i = t; i < 8192; i += 256) {
            const int which = i >> 12, tt = (i >> 6) & 63, d = i & 63, ch = which * 256 + hd * 64 + d;
            float a = cb[ch];
#pragma unroll
            for (int j = 0; j < 4; ++j) { const int ts = c * 64 + tt + j - 3; if (ts >= 0) a += bf2f(projb[(size_t)(b * SEQ + ts) * PJ + ch]) * cw[j * 512 + ch]; }
            float y = a / (1.0f + expf(-a));
            if (which) K[tt * 65 + d] = y * 0.125f; else Q[tt * 65 + d] = y;
        }
        for (int i = t; i < 1024; i += 256) { const int tt = i >> 4, d = i & 15; V[i] = bf2f(projb[(size_t)(row0 + tt) * PJ + C_MV + hd * 64 + dq * 16 + d]); }
        if (t < 64) {
            const float ig = gates[(size_t)(row0 + t) * 8 + hd], fg = gates[(size_t)(row0 + t) * 8 + 4 + hd];
            const float lf = fminf(fg, 0.f) - log1pf(expf(-fabsf(fg)));
            float bs = lf;
#pragma unroll
            for (int o = 1; o < 64; o <<= 1) { float v = __shfl_up(bs, o); if (t >= o) bs += v; }
            const float u = ig - bs; float um = u;
#pragma unroll
            for (int o = 1; o < 64; o <<= 1) { float v = __shfl_up(um, o); if (t >= o) um = fmaxf(um, v); }
            bc[t] = bs; uu[t] = u; Mt[t] = fmaxf(misc[0], um);
        }
        __syncthreads();
        for (int i = t; i < 4096; i += 256) {
            const int tt = i >> 6, s = i & 63; float v = 0.f;
            if (s <= tt) { float dsum = 0.f; for (int d = 0; d < 64; ++d) dsum += Q[tt * 65 + d] * K[s * 65 + d]; v = dsum * expf(uu[s] - Mt[tt]); }
            Sm[tt * 65 + s] = v;
        }
        __syncthreads();
        if (t < 64) {
            const float inter = expf(misc[0] - Mt[t]);
            float qn = 0.f, rs = 0.f;
            for (int d = 0; d < 64; ++d) { qn += Q[t * 65 + d] * nv[d]; rs += Sm[t * 65 + d]; }
            den[t] = fmaxf(fabsf(inter * qn + rs), expf(-(bc[t] + Mt[t])));
        }
        __syncthreads();
        for (int i = t; i < 1024; i += 256) {
            const int tt = i >> 4, d = i & 15;
            const float inter = expf(misc[0] - Mt[tt]);
            float a = 0.f, bsum = 0.f;
            for (int k = 0; k < 64; ++k) { a += Q[tt * 65 + k] * C[k * 16 + d]; bsum += Sm[tt * 65 + k] * V[k * 16 + d]; }
            hraw[(size_t)(row0 + tt) * 256 + hd * 64 + dq * 16 + d] = (inter * a + bsum) / den[tt];
        }
        __syncthreads();
        const float Mlast = Mt[63], decay = expf(misc[0] - Mlast);
        for (int i = t; i < 1024; i += 256) {
            const int dk = i >> 4, d = i & 15; float a = 0.f;
            for (int s = 0; s < 64; ++s) a += expf(uu[s] - Mlast) * K[s * 65 + dk] * V[s * 16 + d];
            C[i] = decay * C[i] + a;
        }
        if (t < 64) { float a = 0.f; for (int s = 0; s < 64; ++s) a += expf(uu[s] - Mlast) * K[s * 65 + t]; nv[t] = decay * nv[t] + a; }
        __syncthreads();
        if (t == 0) misc[0] = bc[63] + Mlast;
    }
}

constexpr int ML_QP = 144, ML_TP = 192;
constexpr int ML_Q = 0, ML_K = 9216, ML_KW = 18432, ML_V = 30720, ML_C = 43008, ML_N = 55296, ML_U = 55808, ML_NP = 56064, ML_SS = 57088, ML_DEC = 57600;
DI bf16x8 scale8(u32x4 v, float w) {
    u32x4 o;
    o.x = pk2(bf2f(v.x & 0xffff) * w, bf2f(v.x >> 16) * w); o.y = pk2(bf2f(v.y & 0xffff) * w, bf2f(v.y >> 16) * w);
    o.z = pk2(bf2f(v.z & 0xffff) * w, bf2f(v.z >> 16) * w); o.w = pk2(bf2f(v.w & 0xffff) * w, bf2f(v.w >> 16) * w);
    return __builtin_bit_cast(bf16x8, o);
}
DI bf16x8 tr_frag(const LAS char* p, int hi_off) {
    s16x4 lo = tr_read(p), hi = tr_read(p + hi_off);
    return __builtin_shufflevector(lo, hi, 0, 1, 2, 3, 4, 5, 6, 7);
}
DI void mlstm_mscan(const float4* gscan, size_t rowb, int hd, int lane, float& m_in, float& decay) {
    const int ci = lane & 31;
    const float4 gl = gscan[(rowb + ci * 64 + 63) * 4 + hd];
    float A = gl.x, B = gl.z + gl.x;
#pragma unroll
    for (int o = 1; o < 32; o <<= 1) {
        const float Ap = __shfl_up(A, o), Bp = __shfl_up(B, o);
        if (ci >= o) { B = fmaxf(Bp + A, B); A = Ap + A; }
    }
    const float mafter = fmaxf(A, B);
    const float mprev = __shfl_up(mafter, 1);
    m_in = ci == 0 ? 0.f : mprev;
    decay = __expf(m_in - fmaxf(m_in, gl.z));
}
DI void mlstm_state_item(const P& p, int l, int item, char* lds_generic) {
    LAS char* lds = (LAS char*)lds_generic;
    const int bh = item >> 5, c = item & 31, b = bh >> 2, hd = bh & 3;
    const int t = tid_(), lane = t & 63, w = t >> 6, r = lane & 31, h = lane >> 5;
    const int i16 = lane & 15, q4 = i16 >> 2, pp = i16 & 3, blk = (lane >> 4) & 1;
    const int wd = w & 1, wt = w >> 1;
    const bf16_t* projb = (const bf16_t*)(p.ws + WS_PROJ);
    const bf16_t* mqkc = (const bf16_t*)(p.ws + WS_MQKC);
    const float4* gscan = (const float4*)(p.ws + WS_GSCAN);
    float* dC = (float*)(p.ws + WS_HRAW) + (size_t)item * 4096;
    float* dn = (float*)(p.ws + WS_ZBUF + 8 * MiB) + (size_t)item * 64;
    LAS float* npart = (LAS float*)(lds + ML_NP);
    const int srow = t >> 3, sc16 = t & 7;
    const size_t rowb = (size_t)b * SEQ, row0 = rowb + c * 64;
    const bf16_t* kp = mqkc + (row0 + srow) * 512 + 256 + hd * 64 + sc16 * 8;
    const u32x4 rk0 = *(const u32x4*)kp, rk1 = *(const u32x4*)(kp + 32 * 512);
    const bf16_t* vp = projb + (row0 + srow) * PJ + C_MV + hd * 64 + sc16 * 8;
    const u32x4 rv0 = *(const u32x4*)vp, rv1 = *(const u32x4*)(vp + (size_t)32 * PJ);
    const float4 gl0 = gscan[(row0 + srow) * 4 + hd], gl1 = gscan[(row0 + srow + 32) * 4 + hd], glast = gscan[(row0 + 63) * 4 + hd];
    float m_in, dec; mlstm_mscan(gscan, rowb, hd, lane, m_in, dec);
    const float m = __shfl(m_in, c);
    const float Mlast = fmaxf(m, glast.z);
    __syncthreads();
    {
        const float w0 = __expf(gl0.y - Mlast), w1 = __expf(gl1.y - Mlast);
        *(LAS u32x4*)(lds + ML_V + srow * ML_TP + sc16 * 16) = rv0; *(LAS u32x4*)(lds + ML_V + (srow + 32) * ML_TP + sc16 * 16) = rv1;
        *(LAS bf16x8*)(lds + ML_KW + srow * ML_TP + sc16 * 16) = scale8(rk0, w0); *(LAS bf16x8*)(lds + ML_KW + (srow + 32) * ML_TP + sc16 * 16) = scale8(rk1, w1);
    }
    __syncthreads();
    f32x16 cacc;
#pragma unroll
    for (int e = 0; e < 16; ++e) cacc[e] = 0.f;
#pragma unroll
    for (int k4 = 0; k4 < 4; ++k4) {
        const bf16x8 vf = tr_frag(lds + ML_V + (k4 * 16 + 4 * h + q4) * ML_TP + (wd * 32 + 16 * blk) * 2 + 8 * pp, 8 * ML_TP);
        const bf16x8 kwf = tr_frag(lds + ML_KW + (k4 * 16 + 4 * h + q4) * ML_TP + (wt * 32 + 16 * blk) * 2 + 8 * pp, 8 * ML_TP);
        cacc = __builtin_amdgcn_mfma_f32_32x32x16_bf16(vf, kwf, cacc, 0, 0, 0);
    }
    {
        const int dk = t & 63, qd = t >> 6; float a = 0.f;
#pragma unroll
        for (int s_ = 0; s_ < 16; ++s_) a += bf2f(*(const LAS bf16_t*)(lds + ML_KW + (qd * 16 + s_) * ML_TP + dk * 2));
        npart[qd * 64 + dk] = a;
    }
#pragma unroll
    for (int g = 0; g < 4; ++g) { float4 x = {cacc[4 * g], cacc[4 * g + 1], cacc[4 * g + 2], cacc[4 * g + 3]}; *(float4*)(dC + (wt * 32 + r) * 64 + wd * 32 + 8 * g + 4 * h) = x; }
    __syncthreads();
    if (t < 64) dn[t] = (npart[t] + npart[64 + t]) + (npart[128 + t] + npart[192 + t]);
}
DI void mlstm_out_item(const P& p, int l, int item, char* lds_generic) {
    LAS char* lds = (LAS char*)lds_generic;
    const int bh = item >> 5, c = item & 31, b = bh >> 2, hd = bh & 3;
    const int t = tid_(), lane = t & 63, w = t >> 6, r = lane & 31, h = lane >> 5;
    const int i16 = lane & 15, q4 = i16 >> 2, pp = i16 & 3, blk = (lane >> 4) & 1;
    const int wd = w & 1, wt = w >> 1;
    const bf16_t* projb = (const bf16_t*)(p.ws + WS_PROJ);
    const bf16_t* mqkc = (const bf16_t*)(p.ws + WS_MQKC);
    const float4* gscan = (const float4*)(p.ws + WS_GSCAN);
    const float* dCb = (const float*)(p.ws + WS_HRAW) + (size_t)bh * 32 * 4096;
    const float* dnb = (const float*)(p.ws + WS_ZBUF + 8 * MiB) + (size_t)bh * 32 * 64;
    bf16_t* mix = (bf16_t*)(p.ws + WS_MIX);
    const float* mg = p.in[7] + l * 256 + hd * 64;
    LAS float* nbuf = (LAS float*)(lds + ML_N); LAS float* ubuf2 = (LAS float*)(lds + ML_U); LAS float* ssbuf = (LAS float*)(lds + ML_SS); LAS float* decs = (LAS float*)(lds + ML_DEC);
    const int srow = t >> 3, sc16 = t & 7;
    const float LOG2E = 1.4426950408889634f;
    const size_t rowb = (size_t)b * SEQ, row0 = rowb + c * 64;
    const int tt = wt * 32 + r;
    const bf16_t* qp = mqkc + (row0 + srow) * 512 + hd * 64 + sc16 * 8;
    const u32x4 rq0 = *(const u32x4*)qp, rq1 = *(const u32x4*)(qp + 32 * 512), rk0 = *(const u32x4*)(qp + 256), rk1 = *(const u32x4*)(qp + 32 * 512 + 256);
    const bf16_t* vp = projb + (row0 + srow) * PJ + C_MV + hd * 64 + sc16 * 8;
    const u32x4 rv0 = *(const u32x4*)vp, rv1 = *(const u32x4*)(vp + (size_t)32 * PJ);
    const float4 gl0 = gscan[(row0 + srow) * 4 + hd], gl1 = gscan[(row0 + srow + 32) * 4 + hd], gtt = gscan[(row0 + tt) * 4 + hd];
    const bf16_t* opp = projb + (row0 + tt) * PJ + C_MO + hd * 64 + wd * 32 + 4 * h;
    const u32x2 opre[4] = {*(const u32x2*)(opp), *(const u32x2*)(opp + 8), *(const u32x2*)(opp + 16), *(const u32x2*)(opp + 24)};
    float4 mgr[4];
#pragma unroll
    for (int g = 0; g < 4; ++g) mgr[g] = *(const float4*)(mg + wd * 32 + 4 * h + 8 * g);
    float m_in, dec; mlstm_mscan(gscan, rowb, hd, lane, m_in, dec);
    const float m = __shfl(m_in, c);
    __syncthreads();
    if (t < 32) decs[t] = dec;
    __syncthreads();
    {
        float4 c0 = {0.f, 0.f, 0.f, 0.f}, c1 = c0, c2 = c0, c3 = c0; float nacc = 0.f;
        const float* src = dCb + (t >> 2) * 64 + (t & 3) * 16;
#pragma unroll 4
        for (int cc = 0; cc < c; ++cc) {
            const float d = decs[cc];
            const float4 x0 = *(const float4*)(src), x1 = *(const float4*)(src + 4), x2 = *(const float4*)(src + 8), x3 = *(const float4*)(src + 12);
            c0.x = c0.x * d + x0.x; c0.y = c0.y * d + x0.y; c0.z = c0.z * d + x0.z; c0.w = c0.w * d + x0.w;
            c1.x = c1.x * d + x1.x; c1.y = c1.y * d + x1.y; c1.z = c1.z * d + x1.z; c1.w = c1.w * d + x1.w;
            c2.x = c2.x * d + x2.x; c2.y = c2.y * d + x2.y; c2.z = c2.z * d + x2.z; c2.w = c2.w * d + x2.w;
            c3.x = c3.x * d + x3.x; c3.y = c3.y * d + x3.y; c3.z = c3.z * d + x3.z; c3.w = c3.w * d + x3.w;
            if (t < 64) nacc = nacc * d + dnb[cc * 64 + t];
            src += 4096;
        }
        u32x4 o0, o1;
        o0.x = pk2(c0.x, c0.y); o0.y = pk2(c0.z, c0.w); o0.z = pk2(c1.x, c1.y); o0.w = pk2(c1.z, c1.w);
        o1.x = pk2(c2.x, c2.y); o1.y = pk2(c2.z, c2.w); o1.z = pk2(c3.x, c3.y); o1.w = pk2(c3.z, c3.w);
        *(LAS u32x4*)(lds + ML_C + (t >> 2) * ML_TP + (t & 3) * 32) = o0; *(LAS u32x4*)(lds + ML_C + (t >> 2) * ML_TP + (t & 3) * 32 + 16) = o1;
        if (t < 64) nbuf[t] = nacc;
    }
    const float Mt_t = fmaxf(m, gtt.z), bs_t = gtt.x;
    {
        *(LAS u32x4*)(lds + ML_Q + srow * ML_QP + sc16 * 16) = rq0; *(LAS u32x4*)(lds + ML_Q + (srow + 32) * ML_QP + sc16 * 16) = rq1;
        *(LAS u32x4*)(lds + ML_K + srow * ML_QP + sc16 * 16) = rk0; *(LAS u32x4*)(lds + ML_K + (srow + 32) * ML_QP + sc16 * 16) = rk1;
        *(LAS u32x4*)(lds + ML_V + srow * ML_TP + sc16 * 16) = rv0; *(LAS u32x4*)(lds + ML_V + (srow + 32) * ML_TP + sc16 * 16) = rv1;
        if (sc16 == 0) { ubuf2[srow] = gl0.y * LOG2E; ubuf2[srow + 32] = gl1.y * LOG2E; }
    }
    __syncthreads();
    const float inter = __expf(m - Mt_t);
    bf16x8 qf[4];
#pragma unroll
    for (int ks = 0; ks < 4; ++ks) qf[ks] = *(const LAS bf16x8*)(lds + ML_Q + tt * ML_QP + (ks * 16 + 8 * h) * 2);
    f32x16 acca, accb;
#pragma unroll
    for (int e = 0; e < 16; ++e) { acca[e] = 0.f; accb[e] = 0.f; }
    float rs = 0.f;
    const float Mt2 = Mt_t * LOG2E;
#pragma unroll
    for (int st = 0; st < 2; ++st) {
        if (st <= wt) {
            f32x16 sa;
#pragma unroll
            for (int e = 0; e < 16; ++e) sa[e] = 0.f;
#pragma unroll
            for (int ks = 0; ks < 4; ++ks) {
                const bf16x8 kf = *(const LAS bf16x8*)(lds + ML_K + (st * 32 + r) * ML_QP + (ks * 16 + 8 * h) * 2);
                sa = __builtin_amdgcn_mfma_f32_32x32x16_bf16(kf, qf[ks], sa, 0, 0, 0);
            }
#pragma unroll
            for (int g = 0; g < 4; ++g) {
                const f32x4 u4 = *(const LAS f32x4*)(ubuf2 + st * 32 + 8 * g + 4 * h);
                const float uu[4] = {u4.x, u4.y, u4.z, u4.w};
#pragma unroll
                for (int i = 0; i < 4; ++i) {
                    const int sidx = st * 32 + 8 * g + 4 * h + i;
                    const float dv_ = (sidx <= tt) ? sa[4 * g + i] * __builtin_amdgcn_exp2f(uu[i] - Mt2) : 0.f;
                    sa[4 * g + i] = dv_; rs += dv_;
                }
            }
#pragma unroll
            for (int sk = 0; sk < 2; ++sk) {
                u32x4 pk; pk.x = pk2(sa[8 * sk], sa[8 * sk + 1]); pk.y = pk2(sa[8 * sk + 2], sa[8 * sk + 3]); pk.z = pk2(sa[8 * sk + 4], sa[8 * sk + 5]); pk.w = pk2(sa[8 * sk + 6], sa[8 * sk + 7]);
                const bf16x8 vf = tr_frag(lds + ML_V + ((st * 2 + sk) * 16 + 4 * h + q4) * ML_TP + (wd * 32 + 16 * blk) * 2 + 8 * pp, 8 * ML_TP);
                acca = __builtin_amdgcn_mfma_f32_32x32x16_bf16(vf, __builtin_bit_cast(bf16x8, pk), acca, 0, 0, 0);
            }
        }
    }
#pragma unroll
    for (int ks = 0; ks < 4; ++ks) {
        const bf16x8 cf = tr_frag(lds + ML_C + (ks * 16 + 8 * h + q4) * ML_TP + (wd * 32 + 16 * blk) * 2 + 8 * pp, 4 * ML_TP);
        accb = __builtin_amdgcn_mfma_f32_32x32x16_bf16(cf, qf[ks], accb, 0, 0, 0);
    }
    float qn = 0.f;
#pragma unroll
    for (int ks = 0; ks < 4; ++ks) {
        const f32x4 n0 = *(const LAS f32x4*)(nbuf + ks * 16 + 8 * h), n1 = *(const LAS f32x4*)(nbuf + ks * 16 + 8 * h + 4);
        qn += bf2f((bf16_t)qf[ks][0]) * n0.x + bf2f((bf16_t)qf[ks][1]) * n0.y + bf2f((bf16_t)qf[ks][2]) * n0.z + bf2f((bf16_t)qf[ks][3]) * n0.w
            + bf2f((bf16_t)qf[ks][4]) * n1.x + bf2f((bf16_t)qf[ks][5]) * n1.y + bf2f((bf16_t)qf[ks][6]) * n1.z + bf2f((bf16_t)qf[ks][7]) * n1.w;
    }
    qn = half_swap_sum(qn); rs = half_swap_sum(rs);
    const float hden = fmaxf(fabsf(inter * qn + rs), __expf(-(bs_t + Mt_t)));
    const float ihd = 1.0f / hden;
    float ss = 0.f;
#pragma unroll
    for (int e = 0; e < 16; ++e) { acca[e] = (acca[e] + inter * accb[e]) * ihd; ss += acca[e] * acca[e]; }
    ss = half_swap_sum(ss);
    if (h == 0) ssbuf[wd * 64 + tt] = ss;
    __syncthreads();
    {
        const float rstd = rsqrtf((ssbuf[tt] + ssbuf[64 + tt]) * (1.0f / 64.0f) + EPS);
        bf16_t* op = mix + (row0 + tt) * DM + hd * 64 + wd * 32 + 4 * h;
#pragma unroll
        for (int g = 0; g < 4; ++g) {
            const float4 g4 = mgr[g];
            const float o0 = bf2f(opre[g].x & 0xffff), o1 = bf2f(opre[g].x >> 16), o2 = bf2f(opre[g].y & 0xffff), o3 = bf2f(opre[g].y >> 16);
            u32x2 v;
            v.x = pk2(acca[4 * g] * rstd * g4.x * __builtin_amdgcn_rcpf(1.0f + __expf(-o0)), acca[4 * g + 1] * rstd * g4.y * __builtin_amdgcn_rcpf(1.0f + __expf(-o1)));
            v.y = pk2(acca[4 * g + 2] * rstd * g4.z * __builtin_amdgcn_rcpf(1.0f + __expf(-o2)), acca[4 * g + 3] * rstd * g4.w * __builtin_amdgcn_rcpf(1.0f + __expf(-o3)));
            *(u32x2*)(op + 8 * g) = v;
        }
    }
}

constexpr int KP = 144, VP = 192, ATT_K_BYTES = 64 * KP, ATT_BUF = 64 * KP + 64 * VP;
DI void moba_item(const P& p, int l, int item, char* lds_generic) {
    LAS char* lds = (LAS char*)lds_generic;
    const int b = item >> 7, hd = (item >> 4) & 7, qt = item & 15, qb = qt >> 1;
    const int t = tid_(), lane = t & 63, w = t >> 6, r = lane & 31, h = lane >> 5;
    const int i16 = lane & 15, q4 = i16 >> 2, pp = i16 & 3, blk = (lane >> 4) & 1;
    const bf16_t* projb = (const bf16_t*)(p.ws + WS_PROJ);
    bf16_t* mix = (bf16_t*)(p.ws + WS_MIX);
    const float* kmean = (const float*)(p.ws + WS_KMEAN);
    const size_t rowb = (size_t)b * SEQ;
    const int q0 = qt * 128, qpos = q0 + w * 32 + r;
    bf16x8 qf[4];
    {
        const bf16_t* qp = projb + (rowb + qpos) * PJ + C_AQ + hd * 64 + 8 * h;
#pragma unroll
        for (int ks = 0; ks < 4; ++ks) qf[ks] = *(const bf16x8*)(qp + ks * 16);
    }
    unsigned mask = 0;
    {
        float gate[8];
#pragma unroll
        for (int n = 0; n < 8; ++n) {
            float sacc = 0.f;
            if (n < qb) {
                const float* km = kmean + ((size_t)((b * 8 + n) * 8 + hd)) * 64 + 8 * h;
#pragma unroll
                for (int ks = 0; ks < 4; ++ks)
#pragma unroll
                    for (int j = 0; j < 8; ++j) sacc += bf2f((bf16_t)qf[ks][j]) * km[ks * 16 + j];
            }
            gate[n] = half_swap_sum(sacc);
        }
#pragma unroll
        for (int it = 0; it < 3; ++it) {
            int best = -1; float bv = -INFINITY;
#pragma unroll
            for (int n = 0; n < 8; ++n) if (n < qb && !((mask >> n) & 1u) && gate[n] > bv) { bv = gate[n]; best = n; }
            if (best >= 0) mask |= 1u << best;
        }
    }
    const int nown = ((q0 & 255) >> 6) + 2, ntiles = nown + qb * 4;
    f32x16 o0, o1;
#pragma unroll
    for (int e = 0; e < 16; ++e) { o0[e] = 0.f; o1[e] = 0.f; }
    float m = -INFINITY, lsum = 0.f;
    const int srow = t >> 3, sc16 = t & 7;
    struct KVStage { u32x4 k0, k1, v0, v1; };
    auto key0_of = [&](int it) { return it < nown ? qb * 256 + it * 64 : ((it - nown) >> 2) * 256 + ((it - nown) & 3) * 64; };
    auto gload = [&](KVStage& S, int it) {
        const int key0 = key0_of(it < ntiles ? it : ntiles - 1);
        const bf16_t* base = projb + (rowb + key0 + srow) * PJ + hd * 64 + sc16 * 8;
        S.k0 = *(const u32x4*)(base + C_AK); S.k1 = *(const u32x4*)(base + (size_t)32 * PJ + C_AK);
        S.v0 = *(const u32x4*)(base + C_AV); S.v1 = *(const u32x4*)(base + (size_t)32 * PJ + C_AV);
    };
    auto sstore = [&](const KVStage& S, int buf) {
        LAS char* sK = lds + buf * ATT_BUF; LAS char* sV = sK + ATT_K_BYTES;
        *(LAS u32x4*)(sK + srow * KP + sc16 * 16) = S.k0; *(LAS u32x4*)(sK + (srow + 32) * KP + sc16 * 16) = S.k1;
        *(LAS u32x4*)(sV + srow * VP + sc16 * 16) = S.v0; *(LAS u32x4*)(sV + (srow + 32) * VP + sc16 * 16) = S.v1;
    };
    KVStage KA, KB;
    __syncthreads();
    gload(KA, 0); gload(KB, 1); sstore(KA, 0); __syncthreads();
    auto step = [&](int it, KVStage& SL, const KVStage& SS) {
        gload(SL, it + 2);
        {
            const LAS char* sK = lds + (it & 1) * ATT_BUF; const LAS char* sV = sK + ATT_K_BYTES;
            const int key0 = key0_of(it), blockn = key0 >> 8;
            f32x16 s0, s1;
            const float minit = (it == 0) ? 0.f : -m;
#pragma unroll
            for (int e = 0; e < 16; ++e) { s0[e] = minit; s1[e] = minit; }
#pragma unroll
            for (int ks = 0; ks < 4; ++ks) {
                const bf16x8 k0 = *(const LAS bf16x8*)(sK + r * KP + (ks * 16 + 8 * h) * 2);
                const bf16x8 k1 = *(const LAS bf16x8*)(sK + (32 + r) * KP + (ks * 16 + 8 * h) * 2);
                s0 = __builtin_amdgcn_mfma_f32_32x32x16_bf16(k0, qf[ks], s0, 0, 0, 0);
                s1 = __builtin_amdgcn_mfma_f32_32x32x16_bf16(k1, qf[ks], s1, 0, 0, 0);
            }
            const bool own = (blockn == qb);
            const bool active = own || ((mask >> blockn) & 1u);
            if (!active) {
#pragma unroll
                for (int e = 0; e < 16; ++e) { s0[e] = -INFINITY; s1[e] = -INFINITY; }
            } else if (own && key0 + 63 > q0 + w * 32) {
#pragma unroll
                for (int e = 0; e < 16; ++e) {
                    const int kk = key0 + (e & 3) + 8 * (e >> 2) + 4 * h;
                    if (kk > qpos) s0[e] = -INFINITY;
                    if (kk + 32 > qpos) s1[e] = -INFINITY;
                }
            }
            float mx = fmaxf(fmaxf(s0[0], s1[0]), fmaxf(s0[1], s1[1]));
#pragma unroll
            for (int e = 2; e < 16; e += 2) mx = fmaxf(fmaxf(mx, fmaxf(s0[e], s1[e])), fmaxf(s0[e + 1], s1[e + 1]));
            mx = half_swap_max(mx);
            if (it == 0 || __builtin_amdgcn_ballot_w64(mx > 16.0f) != 0ull) {
                const float d = (it == 0) ? mx : fmaxf(mx, 0.f);
                const float alpha = __builtin_amdgcn_exp2f(-d);
                m = (it == 0) ? d : m + d;
                lsum *= alpha;
#pragma unroll
                for (int e = 0; e < 16; ++e) { s0[e] -= d; s1[e] -= d; o0[e] *= alpha; o1[e] *= alpha; }
            }
            float ps = 0.f;
#pragma unroll
            for (int e = 0; e < 16; ++e) { s0[e] = __builtin_amdgcn_exp2f(s0[e]); s1[e] = __builtin_amdgcn_exp2f(s1[e]); ps += s0[e] + s1[e]; }
            lsum += ps;
#pragma unroll
            for (int st = 0; st < 2; ++st)
#pragma unroll
                for (int sk = 0; sk < 2; ++sk) {
                    u32x4 pk;
                    if (st == 0) { pk.x = pk2(s0[8 * sk], s0[8 * sk + 1]); pk.y = pk2(s0[8 * sk + 2], s0[8 * sk + 3]); pk.z = pk2(s0[8 * sk + 4], s0[8 * sk + 5]); pk.w = pk2(s0[8 * sk + 6], s0[8 * sk + 7]); }
                    else         { pk.x = pk2(s1[8 * sk], s1[8 * sk + 1]); pk.y = pk2(s1[8 * sk + 2], s1[8 * sk + 3]); pk.z = pk2(s1[8 * sk + 4], s1[8 * sk + 5]); pk.w = pk2(s1[8 * sk + 6], s1[8 * sk + 7]); }
                    const bf16x8 pf = __builtin_bit_cast(bf16x8, pk);
                    const LAS char* vb = sV + (st * 32 + sk * 16 + 4 * h + q4) * VP + (16 * blk) * 2 + 8 * pp;
                    {
                        s16x4 lo = tr_read(vb), hi = tr_read(vb + 8 * VP);
                        const bf16x8 vf = __builtin_shufflevector(lo, hi, 0, 1, 2, 3, 4, 5, 6, 7);
                        o0 = __builtin_amdgcn_mfma_f32_32x32x16_bf16(vf, pf, o0, 0, 0, 0);
                    }
                    {
                        s16x4 lo = tr_read(vb + 64), hi = tr_read(vb + 64 + 8 * VP);
                        const bf16x8 vf = __builtin_shufflevector(lo, hi, 0, 1, 2, 3, 4, 5, 6, 7);
                        o1 = __builtin_amdgcn_mfma_f32_32x32x16_bf16(vf, pf, o1, 0, 0, 0);
                    }
                }
        }
        sstore(SS, (it + 1) & 1);
        __syncthreads();
    };
    for (int it = 0; it < ntiles; it += 2) { step(it, KA, KB); if (it + 1 < ntiles) step(it + 1, KB, KA); }
    const float il = 1.0f / half_swap_sum(lsum);
    float ss = 0.f;
#pragma unroll
    for (int e = 0; e < 16; ++e) { o0[e] *= il; o1[e] *= il; ss += o0[e] * o0[e] + o1[e] * o1[e]; }
    ss = half_swap_sum(ss);
    const float rstd = rsqrtf(ss * (1.0f / 64.0f) + EPS);
    const float* og = p.in[10] + (l * 8 + hd) * 64 + 4 * h;
    bf16_t* op = mix + (rowb + qpos) * DM + 256 + hd * 64 + 4 * h;
#pragma unroll
    for (int g = 0; g < 4; ++g) {
        const float4 g0 = *(const float4*)(og + 8 * g), g1 = *(const float4*)(og + 32 + 8 * g);
        u32x2 v0, v1;
        v0.x = pk2(o0[4 * g] * rstd * g0.x, o0[4 * g + 1] * rstd * g0.y); v0.y = pk2(o0[4 * g + 2] * rstd * g0.z, o0[4 * g + 3] * rstd * g0.w);
        v1.x = pk2(o1[4 * g] * rstd * g1.x, o1[4 * g + 1] * rstd * g1.y); v1.y = pk2(o1[4 * g + 2] * rstd * g1.z, o1[4 * g + 3] * rstd * g1.w);
        *(u32x2*)(op + 8 * g) = v0; *(u32x2*)(op + 32 + 8 * g) = v1;
    }
}

DI void s5_item_simple(const P& p, int l, int item, float* sm) {
    const int t = tid_(), lane = t & 63, w = t >> 6;
    const int bg = item * 4 + w, b = bg >> 4, g = bg & 15;
    const bf16_t* projb = (const bf16_t*)(p.ws + WS_PROJ);
    float* zbuf = (float*)(p.ws + WS_ZBUF);
    float* xr = sm + w * (2 * 16 * 65); float* xi = xr + 16 * 65;
    const int lg = l * 16 + g;
    const float lr = p.in[11][lg * 64 + lane], li = p.in[12][lg * 64 + lane];
    const float dt = expf(p.in[18][lg]);
    const float mag = expf(lr * dt);
    const float are = mag * cosf(li * dt), aim = mag * sinf(li * dt);
    const float zr = are - 1.0f, zi = aim, dn = lr * lr + li * li;
    const float fr = (zr * lr + zi * li) / dn, fi = (zi * lr - zr * li) / dn;
    float bbr[16], bbi[16];
#pragma unroll
    for (int hh = 0; hh < 16; ++hh) {
        const float br = p.in[13][((size_t)lg * 64 + lane) * 16 + hh], bi = p.in[14][((size_t)lg * 64 + lane) * 16 + hh];
        bbr[hh] = fr * br - fi * bi; bbi[hh] = fr * bi + fi * br;
    }
    const float* cre = p.in[15] + (size_t)lg * 16 * 64; const float* cim = p.in[16] + (size_t)lg * 16 * 64;
    const float* dd = p.in[17] + lg * 16;
    float sr = 0.f, si = 0.f;
    __syncthreads();
    for (int c = 0; c < SEQ / 16; ++c) {
        const size_t row0 = (size_t)b * SEQ + c * 16;
        for (int tt = 0; tt < 16; ++tt) {
            const bf16_t* up = projb + (row0 + tt) * PJ + C_SU + g * 16;
            uint4 u0 = *(const uint4*)up, u1 = *(const uint4*)(up + 8);
            float u[16] = {bf2f(u0.x & 0xffff), bf2f(u0.x >> 16), bf2f(u0.y & 0xffff), bf2f(u0.y >> 16), bf2f(u0.z & 0xffff), bf2f(u0.z >> 16), bf2f(u0.w & 0xffff), bf2f(u0.w >> 16),
                           bf2f(u1.x & 0xffff), bf2f(u1.x >> 16), bf2f(u1.y & 0xffff), bf2f(u1.y >> 16), bf2f(u1.z & 0xffff), bf2f(u1.z >> 16), bf2f(u1.w & 0xffff), bf2f(u1.w >> 16)};
            float br = 0.f, bi = 0.f;
#pragma unroll
            for (int hh = 0; hh < 16; ++hh) { br += bbr[hh] * u[hh]; bi += bbi[hh] * u[hh]; }
            const float nr = are * sr - aim * si + br, ni = are * si + aim * sr + bi;
            sr = nr; si = ni;
            xr[tt * 65 + lane] = sr; xi[tt * 65 + lane] = si;
        }
        __syncthreads();
        {
            const int tt = lane >> 2, hq = lane & 3;
            float y[4] = {0.f, 0.f, 0.f, 0.f};
            for (int pp = 0; pp < 64; ++pp) {
                const float a = xr[tt * 65 + pp], bq = xi[tt * 65 + pp];
#pragma unroll
                for (int j = 0; j < 4; ++j) y[j] += cre[(hq * 4 + j) * 64 + pp] * a - cim[(hq * 4 + j) * 64 + pp] * bq;
            }
#pragma unroll
            for (int j = 0; j < 4; ++j) {
                const int hh = hq * 4 + j;
                float v = y[j] + dd[hh] * bf2f(projb[(row0 + tt) * PJ + C_SU + g * 16 + hh]);
                const float inner = 0.7978845608028654f * (v + 0.044715f * v * v * v);
                const float th = 1.0f - 2.0f / (expf(2.0f * inner) + 1.0f);
                zbuf[(row0 + tt) * 256 + g * 16 + hh] = 0.5f * v * (1.0f + th);
            }
        }
        __syncthreads();
    }
}

DI void s5_item(const P& p, int l, int item, char* lds) {
    const int b = item >> 4, g = item & 15, lg = l * 16 + g;
    const int t = tid_();
    const bf16_t* projb = (const bf16_t*)(p.ws + WS_PROJ);
    bf16_t* zbuf = (bf16_t*)(p.ws + WS_ZBUF);
    const float* Tg = (const float*)(p.ws + WS_S5M + (size_t)l * S5M_LAYER) + (size_t)g * 256 * 256;
    const float* Eg = (const float*)(p.ws + WS_S5M + (size_t)l * S5M_LAYER + S5M_E) + (size_t)g * 256 * 128;
    const float* Fg = (const float*)(p.ws + WS_S5M + (size_t)l * S5M_LAYER + S5M_F) + (size_t)g * 128 * 256;
    float* eloc = (float*)(p.ws + WS_ELOC) + ((size_t)l * 128 + item) * 128 * 128;
    bf16_t* carr = (bf16_t*)(p.ws + WS_CARR) + ((size_t)l * 128 + item) * 128 * 128;
    const size_t rowb = (size_t)b * SEQ;
    const bf16_t* ua0 = projb + (rowb + (size_t)(t >> 2) * 16 + ((t & 3) >> 1)) * PJ + C_SU + g * 16 + (t & 1) * 8;
    const bf16_t* ua1 = ua0 + (size_t)64 * 16 * PJ;
    {
        GSeg g1{ua0, ua1, 2 * PJ, Eg + (size_t)(t >> 5) * 128 + (t & 31) * 4, 128, 8}; GSeg g2 = g1; g2.KT = 0;
        EpiF32 epi{eloc, 128};
        gemm_tile2(g1, g2, lds, epi);
    }
    __syncthreads();
    if (t < 64) {
        const float lr = p.in[11][lg * 64 + t], li = p.in[12][lg * 64 + t], dt = expf(p.in[18][lg]);
        const float mag = expf(lr * dt * 16.0f), ar = mag * cosf(li * dt * 16.0f), ai = mag * sinf(li * dt * 16.0f);
        float sr = 0.f, si = 0.f;
        for (int bt = 0; bt < 8; ++bt) {
            float er[16], ei[16];
#pragma unroll
            for (int i = 0; i < 16; ++i) { er[i] = eloc[(size_t)(bt * 16 + i) * 128 + t]; ei[i] = eloc[(size_t)(bt * 16 + i) * 128 + 64 + t]; }
#pragma unroll
            for (int i = 0; i < 16; ++i) {
                carr[(size_t)(bt * 16 + i) * 128 + t] = f2bf(sr); carr[(size_t)(bt * 16 + i) * 128 + 64 + t] = f2bf(si);
                const float nr = ar * sr - ai * si + er[i], ni = ar * si + ai * sr + ei[i];
                sr = nr; si = ni;
            }
        }
    }
    __syncthreads();
    const bf16_t* ca0 = carr + (size_t)(t >> 2) * 128 + (t & 3) * 8;
#pragma unroll 1
    for (int nt = 0; nt < 2; ++nt) {
        GSeg g1{ua0, ua1, 2 * PJ, Tg + (size_t)(t >> 5) * 256 + nt * 128 + (t & 31) * 4, 256, 4 * (nt + 1)};
        GSeg g2{ca0, ca0 + (size_t)64 * 128, BK, Fg + (size_t)(t >> 5) * 256 + nt * 128 + (t & 31) * 4, 256, 4};
        EpiS5Y epi{zbuf + rowb * 256 + g * 16, nt * 128};
        gemm_tile2(g1, g2, lds, epi);
    }
}

DI void phase_mix(const P& p, int l, char* lds, unsigned long long& tsub) {
    for (int item = bid_(); item < 128 + 1024 + 1024; item += gridDim.x) {
        const unsigned long long ts0 = PROBE_SUB ? wall_clock64() : 0ull;
        const int kind = item >= 1152 ? 1 : (item < 128 ? 2 : 4);
        if (item >= 1152) mlstm_state_item(p, l, item - 1152, lds);
        else if (item < 128) s5_item(p, l, item, lds);
        else {
            const int i2 = item - 128;
            const int qo = i2 >> 6, bh = i2 & 63;
            moba_item(p, l, (bh << 4) | (15 - qo), lds);
        }
        if (PROBE_SUB & kind) tsub += wall_clock64() - ts0;
    }
}

DI void phase_glu(const P& p, int l, char* lds) {
    const int t = tid_();
    const bf16_t* zb = (const bf16_t*)(p.ws + WS_ZBUF);
    bf16_t* mix = (bf16_t*)(p.ws + WS_MIX);
    const float* gw = p.in[19] + (size_t)l * 256 * 256; const float* gb = p.in[20] + l * 256; const float* sg = p.in[21] + l * 256;
    for (int tile = bid_(); tile < 128 * 2; tile += gridDim.x) {
        const int mt = tile >> 1, nt = tile & 1;
        const bf16_t* a0 = zb + (size_t)(mt * 128 + (t >> 2)) * 256 + (t & 3) * 8;
        const float* b0 = gw + (size_t)(t >> 5) * 256 + nt * 128 + (t & 31) * 4;
        EpiGlu epi{zb + (size_t)mt * 128 * 256 + nt * 128, mix + (size_t)mt * 128 * DM + 768 + nt * 128, gb + nt * 128, sg + nt * 128};
        gemm_tile(a0, a0 + (size_t)64 * 256, b0, 256, 256 / BK, lds, epi);
    }
    for (int item = bid_(); item < 1024; item += gridDim.x) mlstm_out_item(p, l, ((item & 31) << 5) | (31 - (item >> 5)), lds);
}

DI void phase_outproj(const P& p, int l, char* lds) {
    const int t = tid_();
    const bf16_t* mix = (const bf16_t*)(p.ws + WS_MIX);
    float* xres = (float*)(p.ws + WS_XRES);
    const bf16_t* woutb = (const bf16_t*)(p.ws + WS_WOUTB) + (size_t)l * DM * DM;
    const float* xin = (l == 0) ? p.in[0] : xres;
    const int vx = bid_() & 7, vj = bid_() >> 3, nj = (gridDim.x - vx + 7) >> 3;
    for (int j = vj; j < 64; j += nj) {
        const int mt = vx * 16 + (j >> 2), nt = j & 3;
        const bf16_t* ar = mix + (size_t)(mt * 128 + (t >> 2)) * DM + (t & 3) * 8;
        GSeg4 g1{ar, ar + (size_t)64 * DM, 32, woutb + (size_t)(t >> 5) * DM + nt * 256 + (t & 31) * 8, DM, DM / 32}; GSeg4 g2 = g1; g2.KT = 0;
        const size_t o = (size_t)mt * 128 * DM + nt * 256;
        Epi4Resid epi{xres + o, xin + o, (size_t)DM};
        gemm4(g1, g2, lds, epi);
    }
}

DI void phase_norm2(const P& p, int l, char* lds) {
    const int t = tid_(), lane = t & 63, w = t >> 6, nb = gridDim.x, myb = bid_();
    const float* xres = (const float*)(p.ws + WS_XRES);
    bf16_t* hbuf = (bf16_t*)(p.ws + WS_HBUF);
    const float* g2 = p.in[23] + l * DM;
    const float* wg = p.in[24] + (size_t)l * DM * 4; const float* bg = p.in[25] + l * 4;
    const float* we = p.in[26] + (size_t)l * DM * NE; const float* be = p.in[27] + l * NE;
    int4* rinfo = (int4*)(p.ws + WS_RINFO); int* hist = (int*)(p.ws + WS_HIST);
    int* lh = (int*)(lds + 65536 - 16 - 128);
    constexpr int XP = 132;
    float* xs = (float*)lds;
    float* wb = xs + 32 * XP;
    float* rstd_s = wb + 128 * 48;
    const int nit = (T / 8 - myb + nb - 1) / nb;
    auto grow = [&](int lr) { return (size_t)((myb + (lr >> 3) * nb) * 8 + (lr & 7)); };
    __syncthreads();
    if (t < NE) lh[t] = 0;
    if (w < nit) {
        float4 cur[4], nxt[4];
#pragma unroll
        for (int i = 0; i < 4; ++i) cur[i] = *(const float4*)(xres + grow(w * 8) * DM + i * 256 + lane * 4);
#pragma unroll
        for (int j = 0; j < 8; ++j) {
            const size_t row = grow(w * 8 + j);
            if (j < 7) {
#pragma unroll
                for (int i = 0; i < 4; ++i) nxt[i] = *(const float4*)(xres + grow(w * 8 + j + 1) * DM + i * 256 + lane * 4);
            }
            float ss = 0.f;
#pragma unroll
            for (int i = 0; i < 4; ++i) ss += cur[i].x * cur[i].x + cur[i].y * cur[i].y + cur[i].z * cur[i].z + cur[i].w * cur[i].w;
            ss = wave_sum(ss);
            const float rstd = rsqrtf(ss * (1.0f / DM) + EPS);
            if (lane == 0) rstd_s[w * 8 + j] = rstd;
#pragma unroll
            for (int i = 0; i < 4; ++i) {
                const int k0 = i * 256 + lane * 4;
                const float4 g = *(const float4*)(g2 + k0);
                uint2 o; o.x = pk2(cur[i].x * rstd * g.x, cur[i].y * rstd * g.y); o.y = pk2(cur[i].z * rstd * g.z, cur[i].w * rstd * g.w);
                *(uint2*)(hbuf + row * DM + k0) = o;
                cur[i] = nxt[i];
            }
        }
    }
    __syncthreads();
    const int kq = lane >> 4, jc = lane & 15, xr0 = t >> 5, xk4 = (t & 31) * 4;
    f32x4 d[2][3];
#pragma unroll
    for (int a_ = 0; a_ < 2; ++a_)
#pragma unroll
        for (int c_ = 0; c_ < 3; ++c_) d[a_][c_] = (f32x4){0.f, 0.f, 0.f, 0.f};
    const float* wep = we + t * 4; const float* wgp = wg + (t & 127) * 4;
    const float* xp0 = xres + grow(xr0 < nit * 8 ? xr0 : 0) * DM + xk4;
    const float* xp1 = xres + grow(xr0 + 8 < nit * 8 ? xr0 + 8 : 0) * DM + xk4;
    const float* xp2 = xres + grow(xr0 + 16 < nit * 8 ? xr0 + 16 : 0) * DM + xk4;
    const float* xp3 = xres + grow(xr0 + 24 < nit * 8 ? xr0 + 24 : 0) * DM + xk4;
    const float rs0 = rstd_s[xr0], rs1 = rstd_s[xr0 + 8], rs2 = rstd_s[xr0 + 16], rs3 = rstd_s[xr0 + 24];
    float4 re0 = *(const float4*)(wep), re1 = *(const float4*)(wep + 1024), re2 = *(const float4*)(wep + 2048), re3 = *(const float4*)(wep + 3072);
    float4 rg = *(const float4*)(wgp);
    float4 x0 = *(const float4*)xp0, x1 = *(const float4*)xp1, x2 = *(const float4*)xp2, x3 = *(const float4*)xp3, gg = *(const float4*)(g2 + xk4);
#pragma unroll 1
    for (int c = 0; c < 8; ++c) {
        {
            const int e0 = t * 4;
#pragma unroll
            for (int i = 0; i < 4; ++i) {
                const int e = e0 + i * 1024, kk = e >> 5, jj = e & 31;
                *(float4*)(wb + kk * 48 + jj) = (i == 0 ? re0 : i == 1 ? re1 : i == 2 ? re2 : re3);
            }
            if (t < 128) *(float4*)(wb + t * 48 + 32) = rg;
            float4 y;
            y.x = x0.x * rs0 * gg.x; y.y = x0.y * rs0 * gg.y; y.z = x0.z * rs0 * gg.z; y.w = x0.w * rs0 * gg.w; *(float4*)(xs + xr0 * XP + xk4) = y;
            y.x = x1.x * rs1 * gg.x; y.y = x1.y * rs1 * gg.y; y.z = x1.z * rs1 * gg.z; y.w = x1.w * rs1 * gg.w; *(float4*)(xs + (xr0 + 8) * XP + xk4) = y;
            y.x = x2.x * rs2 * gg.x; y.y = x2.y * rs2 * gg.y; y.z = x2.z * rs2 * gg.z; y.w = x2.w * rs2 * gg.w; *(float4*)(xs + (xr0 + 16) * XP + xk4) = y;
            y.x = x3.x * rs3 * gg.x; y.y = x3.y * rs3 * gg.y; y.z = x3.z * rs3 * gg.z; y.w = x3.w * rs3 * gg.w; *(float4*)(xs + (xr0 + 24) * XP + xk4) = y;
        }
        lds_barrier();
        {
            const int cn = c + 1 < 8 ? c + 1 : 7;
            const float* q = wep + (size_t)cn * 4096;
            re0 = *(const float4*)(q); re1 = *(const float4*)(q + 1024); re2 = *(const float4*)(q + 2048); re3 = *(const float4*)(q + 3072);
            rg = *(const float4*)(wgp + (size_t)cn * 512);
            x0 = *(const float4*)(xp0 + cn * 128); x1 = *(const float4*)(xp1 + cn * 128); x2 = *(const float4*)(xp2 + cn * 128); x3 = *(const float4*)(xp3 + cn * 128);
            gg = *(const float4*)(g2 + cn * 128 + xk4);
        }
        const float* xa = xs + (lane & 15) * XP + w * 32 + kq;
        const float* wbp = wb + (w * 32 + kq) * 48 + jc;
#pragma unroll
        for (int ks = 0; ks < 8; ++ks) {
            const float a0 = xa[ks * 4], a1 = xa[16 * XP + ks * 4];
            const float b0 = wbp[ks * 4 * 48], b1 = wbp[ks * 4 * 48 + 16], b2 = wbp[ks * 4 * 48 + 32];
            d[0][0] = __builtin_amdgcn_mfma_f32_16x16x4f32(a0, b0, d[0][0], 0, 0, 0);
            d[0][1] = __builtin_amdgcn_mfma_f32_16x16x4f32(a0, b1, d[0][1], 0, 0, 0);
            d[0][2] = __builtin_amdgcn_mfma_f32_16x16x4f32(a0, b2, d[0][2], 0, 0, 0);
            d[1][0] = __builtin_amdgcn_mfma_f32_16x16x4f32(a1, b0, d[1][0], 0, 0, 0);
            d[1][1] = __builtin_amdgcn_mfma_f32_16x16x4f32(a1, b1, d[1][1], 0, 0, 0);
            d[1][2] = __builtin_amdgcn_mfma_f32_16x16x4f32(a1, b2, d[1][2], 0, 0, 0);
        }
        lds_barrier();
    }
    float* pe = wb;
#pragma unroll
    for (int rt = 0; rt < 2; ++rt)
#pragma unroll
        for (int rg_ = 0; rg_ < 4; ++rg_) {
            const int row = rt * 16 + 4 * kq + rg_;
            pe[(w * 32 + row) * 48 + jc] = d[rt][0][rg_]; pe[(w * 32 + row) * 48 + 16 + jc] = d[rt][1][rg_]; pe[(w * 32 + row) * 48 + 32 + jc] = d[rt][2][rg_];
        }
    lds_barrier();
    if (t < nit * 8) {
        const size_t row = grow(t);
        float gl[4];
#pragma unroll
        for (int j = 0; j < 4; ++j) gl[j] = bg[j] + ((pe[(0 * 32 + t) * 48 + 32 + j] + pe[(1 * 32 + t) * 48 + 32 + j]) + (pe[(2 * 32 + t) * 48 + 32 + j] + pe[(3 * 32 + t) * 48 + 32 + j]));
        int gs = 0; float gm = gl[0];
#pragma unroll
        for (int j = 1; j < 4; ++j) if (gl[j] > gm) { gm = gl[j]; gs = j; }
        float se = 0.f;
#pragma unroll
        for (int j = 0; j < 4; ++j) se += expf(gl[j] - gm);
        const float pgv = 1.0f / se;
        float ev[8];
#pragma unroll
        for (int j = 0; j < 8; ++j) { const int cj = gs * 8 + j; ev[j] = be[cj] + ((pe[(0 * 32 + t) * 48 + cj] + pe[(1 * 32 + t) * 48 + cj]) + (pe[(2 * 32 + t) * 48 + cj] + pe[(3 * 32 + t) * 48 + cj])); }
        int i1 = 0; float v1 = ev[0];
#pragma unroll
        for (int j = 1; j < 8; ++j) if (ev[j] > v1) { v1 = ev[j]; i1 = j; }
        int i2 = (i1 + 1) & 7; float v2 = -INFINITY;
#pragma unroll
        for (int j = 0; j < 8; ++j) if (j != i1 && ev[j] > v2) { v2 = ev[j]; i2 = j; }
        const float ex = expf(v2 - v1);
        const float w1 = pgv / (1.0f + ex), w2 = pgv * ex / (1.0f + ex);
        const int e1 = gs * 8 + i1, e2 = gs * 8 + i2;
        atomicAdd(&lh[e1], 1); atomicAdd(&lh[e2], 1);
        rinfo[row] = make_int4(e1, e2, __float_as_int(w1), __float_as_int(w2));
    }
    __syncthreads();
    if (t < NE) hist[((size_t)l * 1024 + myb) * NE + t] = lh[t];
}

DI void phase_assign(const P& p, int l, char* lds) {
    const int t = tid_(), myb = bid_(), nb = gridDim.x;
    const int* hist = (const int*)(p.ws + WS_HIST) + (size_t)l * 1024 * NE;
    const int4* rinfo = (const int4*)(p.ws + WS_RINFO);
    int* cnt = (int*)(p.ws + WS_CTL) + l * NE;
    int* tokl = (int*)(p.ws + WS_TOKL); float* wl = (float*)(p.ws + WS_WL); int4* tinfo = (int4*)(p.ws + WS_TINFO);
    int* part = (int*)lds;
    int* pre = part + 512;
    int* le1 = pre + 32;
    int* le2 = le1 + 64;
    {
        const int e4 = t & 7;
        int tot[4] = {0, 0, 0, 0}, pr[4] = {0, 0, 0, 0};
        const int4* h4 = (const int4*)hist;
        for (int base = 0; base < nb * 8; base += 256 * 16) {
            int4 v[16];
#pragma unroll
            for (int i = 0; i < 16; ++i) { const int idx = base + t + 256 * i; v[i] = idx < nb * 8 ? h4[idx] : make_int4(0, 0, 0, 0); }
#pragma unroll
            for (int i = 0; i < 16; ++i) {
                const int bb = (base + t + 256 * i) >> 3; const int m = bb < myb ? 1 : 0;
                tot[0] += v[i].x; tot[1] += v[i].y; tot[2] += v[i].z; tot[3] += v[i].w;
                pr[0] += m * v[i].x; pr[1] += m * v[i].y; pr[2] += m * v[i].z; pr[3] += m * v[i].w;
            }
        }
#pragma unroll
        for (int j = 0; j < 4; ++j) {
#pragma unroll
            for (int o = 8; o < 64; o <<= 1) { tot[j] += __shfl_xor(tot[j], o); pr[j] += __shfl_xor(pr[j], o); }
        }
        const int wv = t >> 6;
        if ((t & 63) < 8) {
#pragma unroll
            for (int j = 0; j < 4; ++j) { part[wv * 32 + e4 * 4 + j] = pr[j]; part[256 + wv * 32 + e4 * 4 + j] = tot[j]; }
        }
    }
    __syncthreads();
    if (t < 32) {
        int a = 0, tot = 0;
#pragma unroll
        for (int q = 0; q < 4; ++q) { a += part[q * 32 + t]; tot += part[256 + q * 32 + t]; }
        pre[t] = a;
        if (myb == 0) cnt[t] = tot;
    }
    const int nit = (T / 8 - myb + nb - 1) / nb;
    int4 ri = make_int4(0, 0, 0, 0); int row = -1;
    if (t < nit * 8 && t < 64) { row = (myb + (t >> 3) * nb) * 8 + (t & 7); ri = rinfo[row]; le1[t] = ri.x; le2[t] = ri.y; }
    __syncthreads();
    if (row >= 0) {
        int r1 = 0, r2 = 0;
        for (int j = 0; j < t; ++j) { const int a = le1[j], b2 = le2[j]; r1 += (a == ri.x) + (b2 == ri.x); r2 += (a == ri.y) + (b2 == ri.y); }
        const int s1 = pre[ri.x] + r1, s2 = pre[ri.y] + r2;
        tokl[ri.x * ECAP + s1] = row; wl[ri.x * ECAP + s1] = __int_as_float(ri.z);
        tokl[ri.y * ECAP + s2] = row; wl[ri.y * ECAP + s2] = __int_as_float(ri.w);
        tinfo[row] = make_int4(ri.x, s1, ri.y, s2);
    }
}

DI void phase_moe1(const P& p, int l, char* lds) {
    const int t = tid_();
    const bf16_t* hbuf = (const bf16_t*)(p.ws + WS_HBUF);
    bf16_t* hmoe = (bf16_t*)(p.ws + WS_HMOE);
    const int* cnt = (const int*)(p.ws + WS_CTL) + l * NE;
    const int* tokl = (const int*)(p.ws + WS_TOKL);
    int* stp = (int*)(lds + GEMM_LDS);
    moe_prefix(cnt, stp);
    const int vx = bid_() & 7, vj = bid_() >> 3, nj = (gridDim.x - vx + 7) >> 3;
    int tx[5]; tx[0] = 0;
#pragma unroll
    for (int i = 0; i < 4; ++i) tx[i + 1] = tx[i] + (stp[vx + 8 * i + 1] - stp[vx + 8 * i]) * 8;
    for (int tile = vj; tile < tx[4]; tile += nj) {
        const int ei = (tile >= tx[1]) + (tile >= tx[2]) + (tile >= tx[3]);
        const int e = vx + 8 * ei, tbase = ei == 0 ? 0 : (ei == 1 ? tx[1] : (ei == 2 ? tx[2] : tx[3]));
        const int te = stp[e + 1] - stp[e], local = tile - tbase, nt = local / te, mt = local % te;
        const int ne = cnt[e];
        const int i0 = mt * 128 + (t >> 2), i1 = i0 + 64;
        const int tok0 = tokl[e * ECAP + (i0 < ne ? i0 : 0)], tok1 = tokl[e * ECAP + (i1 < ne ? i1 : 0)];
        const bf16_t* a0 = hbuf + (size_t)tok0 * DM + (t & 3) * 8;
        const bf16_t* a1 = hbuf + (size_t)tok1 * DM + (t & 3) * 8;
        const int vcol = (t & 31) * 4, wn = vcol >> 6, tn = (vcol >> 5) & 1, rr = vcol & 31;
        const float* wsrc = (tn ? p.in[29] : p.in[28]) + ((size_t)l * NE + e) * DM * DE;
        const float* b0 = wsrc + (size_t)(t >> 5) * DE + nt * 64 + wn * 32 + rr;
        EpiGateUp epi{hmoe + (size_t)(stp[e] + mt) * 128 * DE + nt * 64};
        gemm_tile(a0, a1, b0, DE, DM / BK, lds, epi);
    }
}

DI void phase_moe2(const P& p, int l, char* lds) {
    const int t = tid_();
    const bf16_t* hmoe = (const bf16_t*)(p.ws + WS_HMOE);
    bf16_t* ymoe = (bf16_t*)(p.ws + WS_YMOE);
    const int* cnt = (const int*)(p.ws + WS_CTL) + l * NE;
    const float* wl = (const float*)(p.ws + WS_WL);
    int* stp = (int*)(lds + GEMM_LDS);
    moe_prefix(cnt, stp);
    const int vx = bid_() & 7, vj = bid_() >> 3, nj = (gridDim.x - vx + 7) >> 3;
    int tx[5]; tx[0] = 0;
#pragma unroll
    for (int i = 0; i < 4; ++i) tx[i + 1] = tx[i] + (stp[vx + 8 * i + 1] - stp[vx + 8 * i]) * 8;
    for (int tile = vj; tile < tx[4]; tile += nj) {
        const int ei = (tile >= tx[1]) + (tile >= tx[2]) + (tile >= tx[3]);
        const int e = vx + 8 * ei, tbase = ei == 0 ? 0 : (ei == 1 ? tx[1] : (ei == 2 ? tx[2] : tx[3]));
        const int te = stp[e + 1] - stp[e], local = tile - tbase, nt = local / te, mt = local % te;
        const int ne = cnt[e];
        const size_t r0 = (size_t)(stp[e] + mt) * 128;
        const bf16_t* a0 = hmoe + (r0 + (t >> 2)) * DE + (t & 3) * 8;
        const float* b0 = p.in[30] + ((size_t)l * NE + e) * DE * DM + (size_t)(t >> 5) * DM + nt * 128 + (t & 31) * 4;
        EpiDown epi{ymoe + r0 * DM + nt * 128, wl + e * ECAP + mt * 128, ne - mt * 128};
        gemm_tile(a0, a0 + (size_t)64 * DE, b0, DM, DE / BK, lds, epi);
    }
}

DI void phase_final(const P& p, char* lds) {
    const int lane = tid_() & 63;
    const int gw = bid_() * 4 + (tid_() >> 6), nw = gridDim.x * 4;
    const float* xres = (const float*)(p.ws + WS_XRES);
    const bf16_t* ymoe = (const bf16_t*)(p.ws + WS_YMOE);
    const int4* tinfo = (const int4*)(p.ws + WS_TINFO);
    int* stp = (int*)lds;
    moe_prefix((const int*)(p.ws + WS_CTL) + NE, stp);
    for (int row = gw; row < T; row += nw) {
        int4 ti = tinfo[row];
        const bf16_t* y0 = ymoe + (size_t)(stp[ti.x] * 128 + ti.y) * DM;
        const bf16_t* y1 = ymoe + (size_t)(stp[ti.z] * 128 + ti.w) * DM;
#pragma unroll
        for (int i = 0; i < 4; ++i) {
            float4 v = *(const float4*)(xres + (size_t)row * DM + i * 256 + lane * 4);
            uint2 a = *(const uint2*)(y0 + i * 256 + lane * 4), b = *(const uint2*)(y1 + i * 256 + lane * 4);
            v.x += bf2f(a.x & 0xffff) + bf2f(b.x & 0xffff); v.y += bf2f(a.x >> 16) + bf2f(b.x >> 16);
            v.z += bf2f(a.y & 0xffff) + bf2f(b.y & 0xffff); v.w += bf2f(a.y >> 16) + bf2f(b.y >> 16);
            *(float4*)(p.out + (size_t)row * DM + i * 256 + lane * 4) = v;
        }
    }
}

#define XB_TMO      128
#define XB_XCNT(j)  (256  + 64 * (j))
#define XB_XSUB(j)  (1280 + 64 * (j))
#define XB_XGEN(j)  (2304 + 64 * (j))
#define XB_TOP      3328
#define XB_TOPGEN   3392
#define XCD_BAR_WORDS 3456
#define XB_SPIN_CAP (1u << 18)

__device__ __forceinline__ unsigned xb_ld(unsigned* p)              { return __hip_atomic_load(p, __ATOMIC_RELAXED, __HIP_MEMORY_SCOPE_AGENT); }
__device__ __forceinline__ unsigned xb_add(unsigned* p, unsigned v) { return __hip_atomic_fetch_add(p, v, __ATOMIC_RELAXED, __HIP_MEMORY_SCOPE_AGENT); }
__device__ __forceinline__ unsigned xb_xcc_id() { return (unsigned)__builtin_amdgcn_s_getreg((3 << 11) | 20) & 0xFu; }
#define XB_SPIN(cond, bar) do { unsigned _sp = 0; while (cond) { __builtin_amdgcn_s_sleep(1); \
    if ((++_sp & 255u) == 0u) { if (xb_ld(&(bar)[XB_TMO])) break; if (_sp > XB_SPIN_CAP) { atomicAdd(&(bar)[XB_TMO], 1u); break; } } } } while (0)

struct XcdBarrier {
    unsigned* bar; unsigned x;
    volatile LAS unsigned* st;
};

__device__ __forceinline__ XcdBarrier xcd_barrier_post(unsigned* bar, volatile LAS unsigned* st) {
    XcdBarrier b; b.bar = bar; b.x = xb_xcc_id(); b.st = st;
    if (threadIdx.x == 0) (void)xb_add(&bar[XB_XCNT(b.x)], 1u);
    return b;
}
__device__ __forceinline__ void xcd_barrier_complete(unsigned* bar, unsigned x, unsigned& nloc, unsigned& nx) {
    const unsigned G = gridDim.x * gridDim.y * gridDim.z;
    unsigned sum, cnt, mine, sp = 0u;
    for (;;) {
        sum = 0u; cnt = 0u; mine = 0u;
#pragma unroll
        for (unsigned j = 0; j < 16; ++j) { const unsigned c = xb_ld(&bar[XB_XCNT(j)]); sum += c; cnt += (c > 0u) ? 1u : 0u; mine = (j == x) ? c : mine; }
        if (sum == G) break;
        __builtin_amdgcn_s_sleep(1);
        if ((++sp & 255u) == 0u) { if (xb_ld(&bar[XB_TMO])) break; if (sp > XB_SPIN_CAP) { atomicAdd(&bar[XB_TMO], 1u); break; } }
    }
    nloc = mine > 0u ? mine : 1u; nx = cnt > 0u ? cnt : 1u;
}

__device__ __forceinline__ void xcd_barrier(const XcdBarrier& b) {
    asm volatile("s_waitcnt vmcnt(0)" ::: "memory");
    __syncthreads();
    if (threadIdx.x == 0) {
        unsigned* bar = b.bar;
        __builtin_amdgcn_s_waitcnt(0);
        unsigned nloc = b.st[0], nx = b.st[1];
        if (nloc == 0u) { xcd_barrier_complete(bar, b.x, nloc, nx); b.st[0] = nloc; b.st[1] = nx; }
        const unsigned old = xb_add(&bar[XB_XSUB(b.x)], 1u);
        const unsigned gen = old / nloc;
        if (old + 1u == (gen + 1u) * nloc) {
            __builtin_amdgcn_fence(__ATOMIC_RELEASE, "agent");
            asm volatile("s_waitcnt vmcnt(0)" ::: "memory");
            const unsigned og = xb_add(&bar[XB_TOP], 1u);
            const unsigned tg = og / nx;
            if (og + 1u == (tg + 1u) * nx) xb_add(&bar[XB_TOPGEN], 1u);
            else XB_SPIN(xb_ld(&bar[XB_TOPGEN]) == tg, bar);
            __builtin_amdgcn_fence(__ATOMIC_ACQUIRE, "agent");
            xb_add(&bar[XB_XGEN(b.x)], 1u);
            asm volatile("s_waitcnt vmcnt(0)" ::: "memory");
        } else {
            XB_SPIN(xb_ld(&bar[XB_XGEN(b.x)]) == gen, bar);
            __builtin_amdgcn_fence(__ATOMIC_ACQUIRE, "agent");
            asm volatile("s_waitcnt vmcnt(0)" ::: "memory");
        }
    }
    __syncthreads();
}


#ifdef LAB
constexpr size_t WS_LAB = 440 * MiB;
DI void phase_lab(const P& p, char* lds) {
    const int t = tid_();
    const bf16_t* hbuf = (const bf16_t*)(p.ws + WS_HBUF);
    bf16_t* outb = (bf16_t*)(p.ws + WS_LAB);
    const float* win = p.in[2];
#if LAB == 40
    {
        const bf16_t* wb = (const bf16_t*)(p.ws + WS_HRAW);
        const int vx = bid_() & 7, vj = bid_() >> 3, nj = (gridDim.x - vx + 7) >> 3;
        for (int st = vx; st < 16; st += 8)
          for (int j = vj; j < 88; j += nj) {
            const int mt = st * 8 + j / 11, vt = j % 11;
            const int acol = vt < 4 ? vt * 256 : (vt < 10 ? 1032 + (vt - 4) * 256 : 2568);
            const bf16_t* ar = hbuf + (size_t)(mt * 128 + (t >> 2)) * DM + (t & 3) * 8;
            GSeg4 h1{ar, ar + (size_t)64 * DM, 32, wb + (size_t)(t >> 5) * DIN + acol + (t & 31) * 8, DIN, DM / 32}; GSeg4 h2 = h1; h2.KT = 0;
            Epi4Bf16 epi{outb + (size_t)mt * 128 * PJ + vt * 256, (size_t)PJ};
            gemm4(h1, h2, lds, epi);
          }
        return;
    }
#endif
    const int vx = bid_() & 7, vj = bid_() >> 3, nj = (gridDim.x - vx + 7) >> 3;
    for (int st = vx; st < 48; st += 8) {
      const int sm = st / 3, sn = st % 3, wdt = sn == 2 ? 7 : 8;
      for (int j = vj; j < 8 * wdt; j += nj) {
        const int mt = sm * 8 + j / wdt, vt = sn * 8 + j % wdt;
        const int acol = vt < 8 ? vt * 128 : (vt < 20 ? 1032 + (vt - 8) * 128 : (vt < 22 ? 2568 + (vt - 20) * 128 : 1024));
        const bf16_t* a0 = hbuf + (size_t)(mt * 128 + (t >> 2)) * DM + (t & 3) * 8;
        const float* b0 = win + (size_t)(t >> 5) * DIN + acol + (t & 31) * 4;
        EpiBf16 epi{outb + (size_t)mt * 128 * PJ + (vt % 22) * 128, (size_t)PJ};
#if LAB == 40
        (void)a0; (void)b0;
#elif LAB == 30
        const bf16_t* ar = hbuf + (size_t)(mt * 128 + (t >> 3)) * DM + (t & 7) * 8;
        GSeg3 h1{{ar, ar + (size_t)32 * DM, ar + (size_t)64 * DM, ar + (size_t)96 * DM}, 64, b0, DIN, DM / 32}; GSeg3 h2 = h1; h2.KT = 0;
        gemm3(h1, h2, lds, epi);
#elif LAB >= 20
        const bf16_t* wb = (const bf16_t*)(p.ws + WS_HRAW);
        const bf16_t* ar = hbuf + (size_t)(mt * 128 + (t >> 3)) * DM + (t & 7) * 8;
        GSeg2 h1{{ar, ar + (size_t)32 * DM, ar + (size_t)64 * DM, ar + (size_t)96 * DM}, 64, wb + (size_t)(t >> 4) * DIN + acol + (t & 15) * 8, DIN, DM / 32}; GSeg2 h2 = h1; h2.KT = 0;
        gemm2(h1, h2, lds, epi);
#else
        GSeg g1{a0, a0 + (size_t)64 * DM, BK, b0, DIN, DM / BK}; GSeg g2 = g1; g2.KT = 0;
        gemm_lab(g1, g2, lds, epi);
#endif
      }
    }
}
#endif
constexpr int LDS_BYTES = 65536;
constexpr int NPHASE = 9;

DI void run_phase(const P& p, int ph, int l, char* lds) {
    switch (ph) {
        case 0: phase_norm1(p, l, lds); break;
        case 1: phase_inproj(p, l, lds); break;
        case 2: { unsigned long long dummy = 0; phase_qkprep(p, l, lds, dummy); } break;
        case 3: { unsigned long long dummy = 0; phase_mix(p, l, lds, dummy); } break;
        case 4: phase_glu(p, l, lds); break;
        case 5: phase_outproj(p, l, lds); break;
        case 6: phase_norm2(p, l, lds); break;
        case 7: phase_moe1(p, l, lds); break;
        case 8: phase_moe2(p, l, lds); break;
        default: phase_final(p, lds); break;
    }
}

#if MULTI
__global__ void __launch_bounds__(256) k_phase(P p, int ph, int l) {
    extern __shared__ __attribute__((aligned(16))) char lds[];
    run_phase(p, ph, l, lds);
}
#else
__global__ void __launch_bounds__(256, 2) k_mega(P p) {
    extern __shared__ __attribute__((aligned(16))) char lds[];
    cg::grid_group grid = cg::this_grid();
    volatile LAS unsigned* bst = (volatile LAS unsigned*)((LAS char*)lds + LDS_BYTES - 16);
    if (threadIdx.x < 4) bst[threadIdx.x] = 0u;
    __syncthreads();
    XcdBarrier gbar = xcd_barrier_post((unsigned*)(p.ws + WS_BAR), bst);
    if (p.ws == nullptr) grid.sync();
#define GSYNC() xcd_barrier(gbar)
#ifndef PROBE_MASK
#define PROBE_MASK 0
#endif
#ifndef PROBE_MULT
#define PROBE_MULT 4
#endif
#ifndef PROBE_BLK
#define PROBE_BLK 0
#endif
    unsigned long long tacc = 0, tprev = 0;
#define PH_BEGIN() do { if (PROBE_MASK) tprev = wall_clock64(); } while (0)
#define PH_END(ph) do { if (PROBE_MASK & (1 << (ph))) tacc += wall_clock64() - tprev; } while (0)
#pragma unroll
    for (int l = 0; l < 2; ++l) {
        PH_BEGIN(); phase_norm1(p, l, lds); GSYNC(); PH_END(0);
        PH_BEGIN(); phase_inproj(p, l, lds); GSYNC(); PH_END(1);
        PH_BEGIN(); phase_qkprep(p, l, lds, tacc); GSYNC(); PH_END(2);
        PH_BEGIN(); phase_mix(p, l, lds, tacc); GSYNC(); PH_END(3);
        PH_BEGIN(); phase_glu(p, l, lds); GSYNC(); PH_END(4);
        PH_BEGIN(); phase_outproj(p, l, lds); GSYNC(); PH_END(5);
        PH_BEGIN(); phase_norm2(p, l, lds); GSYNC(); phase_assign(p, l, lds); GSYNC(); PH_END(6);
        PH_BEGIN(); phase_moe1(p, l, lds); GSYNC(); PH_END(7);
        PH_BEGIN(); phase_moe2(p, l, lds); GSYNC(); PH_END(8);
    }
    PH_BEGIN(); phase_final(p, lds); PH_END(9);
#ifdef LAB
#if LAB >= 20
    {
        const float* src = p.in[2]; bf16_t* dst = (bf16_t*)(p.ws + WS_HRAW);
        const size_t n4 = (size_t)DM * DIN / 4, stride = (size_t)gridDim.x * 256;
        for (size_t i = (size_t)blockIdx.x * 256 + threadIdx.x; i < n4; i += stride) { const float4 v = ((const float4*)src)[i]; u32x2 o; o.x = pk2(v.x, v.y); o.y = pk2(v.z, v.w); ((u32x2*)dst)[i] = o; }
    }
#endif
    GSYNC(); phase_lab(p, lds);
#endif
#ifdef PROBE_SYNCS
    for (int i = 0; i < PROBE_SYNCS; ++i) GSYNC();
#endif
    if ((PROBE_MASK || PROBE_SUB) && blockIdx.x == PROBE_BLK) {
        const unsigned long long t0 = wall_clock64();
        while (wall_clock64() - t0 < (unsigned long long)PROBE_MULT * tacc) __builtin_amdgcn_s_sleep(8);
    }
}
#endif

extern "C" void kernel_launch(void* const* d_in, const int* in_sizes, int n_in, void* d_out, int out_size, void* d_ws, size_t ws_size, hipStream_t stream) {
    static int grid = 0;
    if (grid == 0) {
        if (n_in != 31 || out_size != T * DM || ws_size < WS_END) { fprintf(stderr, "kernel_launch: unexpected sizes n_in %d out %d ws %zu\n", n_in, out_size, ws_size); grid = -1; return; }
        int dev = 0, cus = 0, per_cu = 0;
        (void)hipGetDevice(&dev);
        (void)hipDeviceGetAttribute(&cus, hipDeviceAttributeMultiprocessorCount, dev);
#if MULTI
        (void)hipFuncSetAttribute((const void*)k_phase, hipFuncAttributeMaxDynamicSharedMemorySize, LDS_BYTES);
        (void)hipOccupancyMaxActiveBlocksPerMultiprocessor(&per_cu, (const void*)k_phase, 256, LDS_BYTES);
#else
        (void)hipFuncSetAttribute((const void*)k_mega, hipFuncAttributeMaxDynamicSharedMemorySize, LDS_BYTES);
        (void)hipOccupancyMaxActiveBlocksPerMultiprocessor(&per_cu, (const void*)k_mega, 256, LDS_BYTES);
#endif
        if (per_cu < 1) { fprintf(stderr, "kernel_launch: occupancy query gave %d\n", per_cu); per_cu = 1; }
        if (per_cu > 2) per_cu = 2;
        grid = cus * per_cu;
        fprintf(stderr, "kernel_launch: cus %d per_cu %d grid %d\n", cus, per_cu, grid);
    }
    if (grid < 0) return;
    (void)hipMemsetAsync((char*)d_ws + WS_CTL, 0, 65536, stream);
    P p{};
    for (int i = 0; i < 31; ++i) p.in[i] = (const float*)d_in[i];
    p.out = (float*)d_out; p.ws = (char*)d_ws;
#if MULTI
    for (int l = 0; l < 2; ++l)
        for (int ph = 0; ph < NPHASE; ++ph) hipLaunchKernelGGL(k_phase, dim3(grid), dim3(256), LDS_BYTES, stream, p, ph, l);
    hipLaunchKernelGGL(k_phase, dim3(grid), dim3(256), LDS_BYTES, stream, p, NPHASE, 0);
#else
    void* args[] = {&p};
    hipError_t e = hipLaunchCooperativeKernel((const void*)k_mega, dim3(grid), dim3(256), args, LDS_BYTES, stream);
    if (e != hipSuccess) fprintf(stderr, "cooperative launch failed: %s (grid %d)\n", hipGetErrorString(e), grid);
#endif
}
```

```cpp
#include <hip/hip_runtime.h>
#include <hip/hip_cooperative_groups.h>
#include <cstdio>
#include <cstdint>
namespace cg = cooperative_groups;


#define DI __device__ __forceinline__
#define LAS __attribute__((address_space(3)))
typedef unsigned short bf16_t;
typedef short bf16x8 __attribute__((ext_vector_type(8)));
typedef short s16x4 __attribute__((ext_vector_type(4)));
typedef float f32x16 __attribute__((ext_vector_type(16)));
typedef unsigned u32x4 __attribute__((ext_vector_type(4)));
typedef float f32x4 __attribute__((ext_vector_type(4)));
typedef unsigned u32x2 __attribute__((ext_vector_type(2)));

constexpr int T = 16384, DM = 1024, SEQ = 2048, NBATCH = 8;
constexpr int DIN = 2824, PJ = 2816;
constexpr int NE = 32, DE = 512, ECAP = 16384;
constexpr float EPS = 1e-6f;
constexpr int C_MQ = 0, C_MK = 256, C_MV = 512, C_MO = 768, C_AQ = 1024, C_AK = 1536, C_AV = 2048, C_SU = 2560;

constexpr size_t MiB = 1u << 20;
constexpr size_t WS_CTL = 0;
constexpr size_t WS_BAR = 16384;
constexpr size_t WS_KMEAN = 512 * 1024;
constexpr size_t WS_XRES = 1 * MiB;
constexpr size_t WS_HBUF = 65 * MiB;
constexpr size_t WS_PROJ = 97 * MiB;
constexpr size_t WS_GATES = 185 * MiB;
constexpr size_t WS_MIX = 186 * MiB;
constexpr size_t WS_HRAW = 218 * MiB;
constexpr size_t WS_ZBUF = 234 * MiB;
constexpr size_t WS_TOKL = 250 * MiB;
constexpr size_t WS_WL = 252 * MiB;
constexpr size_t WS_TINFO = 254 * MiB;
constexpr size_t WS_HMOE = 256 * MiB;
constexpr size_t WS_YMOE = 294 * MiB;
constexpr size_t WS_MQKC = 370 * MiB;
constexpr size_t WS_S5M = 386 * MiB;
constexpr size_t S5M_LAYER = 8 * MiB, S5M_E = 4 * MiB, S5M_F = 6 * MiB;
constexpr size_t WS_ELOC = 402 * MiB;
constexpr size_t WS_CARR = 418 * MiB;
constexpr size_t WS_RINFO = 426 * MiB;
constexpr size_t WS_HIST = 427 * MiB;
constexpr size_t WS_GSCAN = 428 * MiB;
constexpr size_t WS_WINB = 430 * MiB;
constexpr size_t WS_WOUTB = 442 * MiB;
constexpr size_t WS_EXPD = 33 * MiB;
constexpr size_t WS_EXPG = 446 * MiB;
constexpr size_t WS_EXPU = 478 * MiB;
constexpr size_t WS_END = 510 * MiB;

struct P {
    const float* in[31];
    float* out;
    char* ws;
};

#ifndef PROBE_SUB
#define PROBE_SUB 0
#endif
DI int tid_() { int t = threadIdx.x; asm volatile("" : "+v"(t)); return t; }
DI int bid_() { int b = blockIdx.x; asm volatile("" : "+s"(b)); return b; }
DI float bf2f(bf16_t b) { return __uint_as_float(((unsigned)b) << 16); }
DI bf16_t f2bf(float f) { unsigned u = __float_as_uint(f); u += 0x7fffu + ((u >> 16) & 1u); return (bf16_t)(u >> 16); }
typedef float f32x2 __attribute__((ext_vector_type(2)));
typedef __bf16 bf16x2_t __attribute__((ext_vector_type(2)));
DI unsigned pk2(float lo, float hi) { f32x2 v = {lo, hi}; return __builtin_bit_cast(unsigned, __builtin_convertvector(v, bf16x2_t)); }
DI void lds_barrier() { asm volatile("s_waitcnt lgkmcnt(0)" ::: "memory"); __builtin_amdgcn_s_barrier(); asm volatile("" ::: "memory"); }
DI float4 bf4_to_f4(u32x2 u) { float4 v = {bf2f(u.x & 0xffff), bf2f(u.x >> 16), bf2f(u.y & 0xffff), bf2f(u.y >> 16)}; return v; }
DI u32x2 f4_to_bf4(float4 v) { u32x2 o; o.x = pk2(v.x, v.y); o.y = pk2(v.z, v.w); return o; }
DI float wave_sum(float v) {
#pragma unroll
    for (int o = 32; o > 0; o >>= 1) v += __shfl_xor(v, o);
    return v;
}
DI float sigmoidf_(float x) { return 1.0f / (1.0f + expf(-x)); }
DI s16x4 tr_read(const LAS char* p) {
    typedef short v4i16_t __attribute__((ext_vector_type(4)));
    return __builtin_bit_cast(s16x4, __builtin_amdgcn_ds_read_tr16_b64_v4i16((LAS v4i16_t*)p));
}

DI float half_swap_max(float m) {
    auto rr = __builtin_amdgcn_permlane32_swap(__float_as_uint(m), __float_as_uint(m), false, false);
    return fmaxf(__uint_as_float(rr[0]), __uint_as_float(rr[1]));
}
DI float half_swap_sum(float m) {
    auto rr = __builtin_amdgcn_permlane32_swap(__float_as_uint(m), __float_as_uint(m), false, false);
    return __uint_as_float(rr[0]) + __uint_as_float(rr[1]);
}

constexpr int BK = 32, A_PITCH = 80, B_PITCH = 320, SA_BYTES = 128 * A_PITCH, SB_BYTES = BK * B_PITCH;
constexpr int GEMM_LDS = 2 * SA_BYTES + 2 * SB_BYTES;

struct GSeg { const bf16_t* a0; const bf16_t* a1; int akstep; const float* b0; size_t ldb; int KT; };
template <class Epi>
DI void gemm_tile2(const GSeg& g1, const GSeg& g2, char* lds_generic, const Epi& epi) {
    const int KT = g1.KT + g2.KT;
    LAS char* lds = (LAS char*)lds_generic;
    const int t = tid_(), lane = t & 63, w = t >> 6, wm = w >> 1, wn = w & 1;
    const int r = lane & 31, h = lane >> 5;
    const int i16 = lane & 15, q = i16 >> 2, pp = i16 & 3, blk = (lane >> 4) & 1;
    const int arow = t >> 2, akc = t & 3, bk = t >> 5, bn4 = t & 31;
    f32x16 acc[2][2];
#pragma unroll
    for (int i = 0; i < 2; ++i)
#pragma unroll
        for (int j = 0; j < 2; ++j)
#pragma unroll
            for (int e = 0; e < 16; ++e) acc[i][j][e] = 0.f;
    struct Stage { u32x4 a0, a1; float4 b0, b1, b2, b3; };
    const bf16_t* pa0 = g1.a0; const bf16_t* pa1 = g1.a1; const float* pb = g1.b0;
    size_t ldb = g1.ldb; int aks = g1.akstep, left = g1.KT, issued = 0;
    auto gload = [&](Stage& S) {
        S.a0 = *(const u32x4*)pa0; S.a1 = *(const u32x4*)pa1;
        S.b0 = *(const float4*)(pb); S.b1 = *(const float4*)(pb + 8 * ldb); S.b2 = *(const float4*)(pb + 16 * ldb); S.b3 = *(const float4*)(pb + 24 * ldb);
        if (++issued < KT) {
            if (--left == 0) { pa0 = g2.a0; pa1 = g2.a1; pb = g2.b0; ldb = g2.ldb; aks = g2.akstep; left = 1 << 30; }
            else { pa0 += aks; pa1 += aks; pb += BK * ldb; }
        }
    };
    auto sstore = [&](const Stage& S, int buf) {
        LAS char* sA = lds + buf * SA_BYTES; LAS char* sB = lds + 2 * SA_BYTES + buf * SB_BYTES;
        *(LAS u32x4*)(sA + arow * A_PITCH + akc * 16) = S.a0;
        *(LAS u32x4*)(sA + (arow + 64) * A_PITCH + akc * 16) = S.a1;
        u32x2 v;
        v.x = pk2(S.b0.x, S.b0.y); v.y = pk2(S.b0.z, S.b0.w); *(LAS u32x2*)(sB + (bk) * B_PITCH + bn4 * 8) = v;
        v.x = pk2(S.b1.x, S.b1.y); v.y = pk2(S.b1.z, S.b1.w); *(LAS u32x2*)(sB + (bk + 8) * B_PITCH + bn4 * 8) = v;
        v.x = pk2(S.b2.x, S.b2.y); v.y = pk2(S.b2.z, S.b2.w); *(LAS u32x2*)(sB + (bk + 16) * B_PITCH + bn4 * 8) = v;
        v.x = pk2(S.b3.x, S.b3.y); v.y = pk2(S.b3.z, S.b3.w); *(LAS u32x2*)(sB + (bk + 24) * B_PITCH + bn4 * 8) = v;
    };
    auto compute = [&](int buf) {
        const LAS char* sA = lds + buf * SA_BYTES; const LAS char* sB = lds + 2 * SA_BYTES + buf * SB_BYTES;
#pragma unroll
        for (int ks = 0; ks < 2; ++ks) {
            bf16x8 af[2], bfr[2];
#pragma unroll
            for (int tm = 0; tm < 2; ++tm) af[tm] = *(const LAS bf16x8*)(sA + (wm * 64 + tm * 32 + r) * A_PITCH + (ks * 16 + 8 * h) * 2);
#pragma unroll
            for (int tn = 0; tn < 2; ++tn) {
                const LAS char* pb = sB + (ks * 16 + 8 * h + q) * B_PITCH + (wn * 64 + tn * 32 + 16 * blk) * 2 + 8 * pp;
                s16x4 lo = tr_read(pb), hi = tr_read(pb + 4 * B_PITCH);
                bfr[tn] = __builtin_shufflevector(lo, hi, 0, 1, 2, 3, 4, 5, 6, 7);
            }
#pragma unroll
            for (int tm = 0; tm < 2; ++tm)
#pragma unroll
                for (int tn = 0; tn < 2; ++tn) acc[tm][tn] = __builtin_amdgcn_mfma_f32_32x32x16_bf16(bfr[tn], af[tm], acc[tm][tn], 0, 0, 0);
        }
    };
    Stage S0, S1;
    gload(S0); gload(S1);
    sstore(S0, 0); __syncthreads();
#define GSTEP(SL, SS) { gload(SL); compute(kt & 1); sstore(SS, (kt + 1) & 1); __syncthreads(); if (++kt >= KT) break; }
    for (int kt = 0;;) {
        GSTEP(S0, S1)
        GSTEP(S1, S0)
    }
#undef GSTEP
    epi(acc, wm, wn, r, h);
}
template <class Epi>
DI void gemm_tile(const bf16_t* a0, const bf16_t* a1, const float* b0, size_t ldb, int KT, char* lds_generic, const Epi& epi) {
    GSeg g1{a0, a1, BK, b0, ldb, KT}; GSeg g2{a0, a1, BK, b0, ldb, 0};
    gemm_tile2(g1, g2, lds_generic, epi);
}
struct GSeg4 { const bf16_t* a0; const bf16_t* a1; int akstep; const bf16_t* b0; size_t ldb; int KT; };
constexpr int B4_PITCH = 576, SB4_BYTES = 32 * B4_PITCH, G4_LDS = 2 * SA_BYTES + 2 * SB4_BYTES;
template <class Epi>
DI void gemm4(const GSeg4& g1, const GSeg4& g2, char* lds_generic, const Epi& epi) {
    const int KT = g1.KT + g2.KT;
    LAS char* lds = (LAS char*)lds_generic;
    const int t = tid_(), lane = t & 63, w = t >> 6, wm = w >> 1, wn = w & 1;
    const int r = lane & 31, h = lane >> 5;
    const int i16 = lane & 15, q = i16 >> 2, pp = i16 & 3, blk = (lane >> 4) & 1;
    const int arow = t >> 2, akc = t & 3, bk = t >> 5, bc = t & 31;
    f32x16 acc[2][4];
#pragma unroll
    for (int i = 0; i < 2; ++i)
#pragma unroll
        for (int j = 0; j < 4; ++j)
#pragma unroll
            for (int e = 0; e < 16; ++e) acc[i][j][e] = 0.f;
    struct Stage { u32x4 a0, a1, b0, b1, b2, b3; };
    const bf16_t* pa0 = g1.a0; const bf16_t* pa1 = g1.a1; const bf16_t* pb = g1.b0;
    size_t ldb = g1.ldb; int aks = g1.akstep, left = g1.KT, issued = 0;
    auto gload = [&](Stage& S) {
        S.a0 = *(const u32x4*)pa0; S.a1 = *(const u32x4*)pa1;
        S.b0 = *(const u32x4*)(pb); S.b1 = *(const u32x4*)(pb + 8 * ldb); S.b2 = *(const u32x4*)(pb + 16 * ldb); S.b3 = *(const u32x4*)(pb + 24 * ldb);
        if (++issued < KT) {
            if (--left == 0) { pa0 = g2.a0; pa1 = g2.a1; pb = g2.b0; ldb = g2.ldb; aks = g2.akstep; left = 1 << 30; }
            else { pa0 += aks; pa1 += aks; pb += 32 * ldb; }
        }
    };
    auto sstore = [&](const Stage& S, int buf) {
        LAS char* sA = lds + buf * SA_BYTES; LAS char* sB = lds + 2 * SA_BYTES + buf * SB4_BYTES + bk * B4_PITCH + bc * 16;
        *(LAS u32x4*)(sA + arow * A_PITCH + akc * 16) = S.a0;
        *(LAS u32x4*)(sA + (arow + 64) * A_PITCH + akc * 16) = S.a1;
        *(LAS u32x4*)(sB) = S.b0; *(LAS u32x4*)(sB + 8 * B4_PITCH) = S.b1; *(LAS u32x4*)(sB + 16 * B4_PITCH) = S.b2; *(LAS u32x4*)(sB + 24 * B4_PITCH) = S.b3;
    };
    auto compute = [&](int buf) {
        const LAS char* sA = lds + buf * SA_BYTES; const LAS char* sB = lds + 2 * SA_BYTES + buf * SB4_BYTES;
#pragma unroll
        for (int ks = 0; ks < 2; ++ks) {
            bf16x8 af[2], bfr[4];
#pragma unroll
            for (int tm = 0; tm < 2; ++tm) af[tm] = *(const LAS bf16x8*)(sA + (wm * 64 + tm * 32 + r) * A_PITCH + (ks * 16 + 8 * h) * 2);
#pragma unroll
            for (int tn = 0; tn < 4; ++tn) {
                const LAS char* pbb = sB + (ks * 16 + 8 * h + q) * B4_PITCH + (wn * 128 + tn * 32 + 16 * blk) * 2 + 8 * pp;
                s16x4 lo = tr_read(pbb), hi = tr_read(pbb + 4 * B4_PITCH);
                bfr[tn] = __builtin_shufflevector(lo, hi, 0, 1, 2, 3, 4, 5, 6, 7);
            }
#pragma unroll
            for (int tm = 0; tm < 2; ++tm)
#pragma unroll
                for (int tn = 0; tn < 4; ++tn) acc[tm][tn] = __builtin_amdgcn_mfma_f32_32x32x16_bf16(bfr[tn], af[tm], acc[tm][tn], 0, 0, 0);
        }
    };
    Stage S0, S1;
    gload(S0); gload(S1);
    sstore(S0, 0); __syncthreads();
#define GSTEP(SL, SS) { gload(SL); compute(kt & 1); sstore(SS, (kt + 1) & 1); __syncthreads(); if (++kt >= KT) break; }
    for (int kt = 0;;) {
        GSTEP(S0, S1)
        GSTEP(S1, S0)
    }
#undef GSTEP
    epi(acc, wm, wn, r, h);
}
struct Epi4Bf16 {
    bf16_t* out; size_t ld; char* lds_generic;
    DI void operator()(const f32x16 (&acc)[2][4], int wm, int wn, int r, int h) const {
        LAS char* lds = (LAS char*)lds_generic;
        constexpr int EP = 272;
        const int t = tid_();
#pragma unroll
        for (int s_ = 0; s_ < 2; ++s_) {
            if (wn == s_) {
#pragma unroll
                for (int tm = 0; tm < 2; ++tm)
#pragma unroll
                    for (int tn = 0; tn < 4; ++tn)
#pragma unroll
                        for (int g = 0; g < 4; ++g) {
                            u32x2 v; v.x = pk2(acc[tm][tn][4 * g], acc[tm][tn][4 * g + 1]); v.y = pk2(acc[tm][tn][4 * g + 2], acc[tm][tn][4 * g + 3]);
                            *(LAS u32x2*)(lds + (wm * 64 + tm * 32 + r) * EP + (tn * 32 + 8 * g + 4 * h) * 2) = v;
                        }
            }
            lds_barrier();
#pragma unroll
            for (int i = 0; i < 8; ++i) {
                const int c = t + 256 * i, row = c >> 4, ch = c & 15;
                *(u32x4*)(out + (size_t)row * ld + s_ * 128 + ch * 8) = *(const LAS u32x4*)(lds + row * EP + ch * 16);
            }
            lds_barrier();
        }
    }
};
struct Epi4Resid {
    bf16_t* out; const float* res32; const bf16_t* res16; size_t ld; char* lds_generic;
    DI void operator()(const f32x16 (&acc)[2][4], int wm, int wn, int r, int h) const {
        LAS char* lds = (LAS char*)lds_generic;
        constexpr int EP = 272;
        const int t = tid_();
#pragma unroll
        for (int qt = 0; qt < 4; ++qt) {
            if (wn == (qt >> 1)) {
#pragma unroll
                for (int tm = 0; tm < 2; ++tm)
#pragma unroll
                    for (int t2 = 0; t2 < 2; ++t2)
#pragma unroll
                        for (int g = 0; g < 4; ++g) {
                            const int tn = 2 * (qt & 1) + t2;
                            f32x4 v = {acc[tm][tn][4 * g], acc[tm][tn][4 * g + 1], acc[tm][tn][4 * g + 2], acc[tm][tn][4 * g + 3]};
                            *(LAS f32x4*)(lds + (wm * 64 + tm * 32 + r) * EP + (t2 * 32 + 8 * g + 4 * h) * 4) = v;
                        }
            }
            float4 xq[8];
#pragma unroll
            for (int i = 0; i < 8; ++i) {
                const int c = t + 256 * i, row = c >> 4, ch = c & 15;
                const size_t oo = (size_t)row * ld + qt * 64 + ch * 4;
                xq[i] = res32 ? *(const float4*)(res32 + oo) : bf4_to_f4(*(const u32x2*)(res16 + oo));
            }
            lds_barrier();
#pragma unroll
            for (int i = 0; i < 8; ++i) {
                const int c = t + 256 * i, row = c >> 4, ch = c & 15;
                const size_t oo = (size_t)row * ld + qt * 64 + ch * 4;
                const f32x4 a4 = *(const LAS f32x4*)(lds + row * EP + ch * 16);
                float4 x = xq[i];
                x.x += a4.x; x.y += a4.y; x.z += a4.z; x.w += a4.w;
                *(u32x2*)(out + oo) = f4_to_bf4(x);
            }
            lds_barrier();
        }
    }
};
struct Epi4ConvK {
    bf16_t* out; size_t ld; char* lds_generic; const float* cw; const float* cb; bf16_t* ckout;
    DI void operator()(const f32x16 (&acc)[2][4], int wm, int wn, int r, int h) const {
        LAS char* lds = (LAS char*)lds_generic;
        constexpr int EP = 272;
        const int t = tid_(), ch = t & 15;
#pragma unroll
        for (int s_ = 0; s_ < 2; ++s_) {
            float4 wv[4][2];
#pragma unroll
            for (int j = 0; j < 4; ++j) { wv[j][0] = *(const float4*)(cw + j * 512 + s_ * 128 + ch * 8); wv[j][1] = *(const float4*)(cw + j * 512 + s_ * 128 + ch * 8 + 4); }
            const float4 b0 = *(const float4*)(cb + s_ * 128 + ch * 8), b1 = *(const float4*)(cb + s_ * 128 + ch * 8 + 4);
            if (wn == s_) {
#pragma unroll
                for (int tm = 0; tm < 2; ++tm)
#pragma unroll
                    for (int tn = 0; tn < 4; ++tn)
#pragma unroll
                        for (int g = 0; g < 4; ++g) {
                            u32x2 v; v.x = pk2(acc[tm][tn][4 * g], acc[tm][tn][4 * g + 1]); v.y = pk2(acc[tm][tn][4 * g + 2], acc[tm][tn][4 * g + 3]);
                            *(LAS u32x2*)(lds + (wm * 64 + tm * 32 + r) * EP + (tn * 32 + 8 * g + 4 * h) * 2) = v;
                        }
            }
            lds_barrier();
#pragma unroll 2
            for (int i = 0; i < 8; ++i) {
                const int row = (t >> 4) + 16 * i;
                const u32x4 cur = *(const LAS u32x4*)(lds + row * EP + ch * 16);
                *(u32x4*)(out + (size_t)row * ld + s_ * 128 + ch * 8) = cur;
                if (row >= 3) {
                    float a[8] = {b0.x, b0.y, b0.z, b0.w, b1.x, b1.y, b1.z, b1.w};
#pragma unroll
                    for (int j = 0; j < 4; ++j) {
                        const u32x4 u = j == 3 ? cur : *(const LAS u32x4*)(lds + (row - (3 - j)) * EP + ch * 16);
                        a[0] += bf2f(u.x & 0xffff) * wv[j][0].x; a[1] += bf2f(u.x >> 16) * wv[j][0].y; a[2] += bf2f(u.y & 0xffff) * wv[j][0].z; a[3] += bf2f(u.y >> 16) * wv[j][0].w;
                        a[4] += bf2f(u.z & 0xffff) * wv[j][1].x; a[5] += bf2f(u.z >> 16) * wv[j][1].y; a[6] += bf2f(u.w & 0xffff) * wv[j][1].z; a[7] += bf2f(u.w >> 16) * wv[j][1].w;
                    }
#pragma unroll
                    for (int e = 0; e < 8; ++e) a[e] = a[e] * 0.125f * __builtin_amdgcn_rcpf(1.0f + __expf(-a[e]));
                    u32x4 o; o.x = pk2(a[0], a[1]); o.y = pk2(a[2], a[3]); o.z = pk2(a[4], a[5]); o.w = pk2(a[6], a[7]);
                    *(u32x4*)(ckout + (size_t)row * 512 + s_ * 128 + ch * 8) = o;
                }
            }
            lds_barrier();
        }
    }
};
struct Epi4Inproj {
    Epi4Bf16 eb; float* gout; const float* bi; const float* bf; bool isgate;
    bool iskey; const float* gk; float* kpart; int pos0;
    DI void operator()(f32x16 (&acc)[2][4], int wm, int wn, int r, int h) const {
        if (isgate) {
            if (wn == 0) {
#pragma unroll
                for (int tm = 0; tm < 2; ++tm) {
                    const float* bb = h ? bf : bi;
                    float4 x = {acc[tm][0][0] + bb[0], acc[tm][0][1] + bb[1], acc[tm][0][2] + bb[2], acc[tm][0][3] + bb[3]};
                    *(float4*)(gout + (size_t)(wm * 64 + tm * 32 + r) * 8 + 4 * h) = x;
                }
            }
            return;
        }
        if (!iskey) { eb(acc, wm, wn, r, h); return; }
        {
            float4 g4[2][4];
#pragma unroll
            for (int t2 = 0; t2 < 2; ++t2)
#pragma unroll
                for (int g = 0; g < 4; ++g) g4[t2][g] = *(const float4*)(gk + t2 * 32 + 8 * g + 4 * h);
#pragma unroll
            for (int tm = 0; tm < 2; ++tm) {
                const int pos = pos0 + wm * 64 + tm * 32 + r;
                float sn[4], cs[4];
#pragma unroll
                for (int i = 0; i < 4; ++i) {
                    constexpr double RINV[8] = {0.15915494309189535, 0.03086376340470123, 0.005985185712713705, 0.001160663641240061,
                                                0.00022507907903927653, 4.364795279280289e-05, 8.464330808241401e-06, 1.6414262627950345e-06};
                    double rr = (double)pos * (h ? RINV[4 + i] : RINV[i]);
                    rr -= floor(rr);
                    sn[i] = __builtin_amdgcn_sinf((float)rr); cs[i] = __builtin_amdgcn_cosf((float)rr);
                }
#pragma unroll
                for (int hq = 0; hq < 2; ++hq) {
                    f32x16& a0 = acc[tm][2 * hq]; f32x16& a1 = acc[tm][2 * hq + 1];
                    float ss = 0.f;
#pragma unroll
                    for (int e = 0; e < 16; ++e) ss += a0[e] * a0[e] + a1[e] * a1[e];
                    ss = half_swap_sum(ss);
                    const float rstd = rsqrtf(ss * (1.0f / 64.0f) + EPS);
#pragma unroll
                    for (int g = 0; g < 4; ++g) {
                        a0[4 * g] *= rstd * g4[0][g].x; a0[4 * g + 1] *= rstd * g4[0][g].y; a0[4 * g + 2] *= rstd * g4[0][g].z; a0[4 * g + 3] *= rstd * g4[0][g].w;
                        a1[4 * g] *= rstd * g4[1][g].x; a1[4 * g + 1] *= rstd * g4[1][g].y; a1[4 * g + 2] *= rstd * g4[1][g].z; a1[4 * g + 3] *= rstd * g4[1][g].w;
                    }
#pragma unroll
                    for (int i = 0; i < 4; ++i) {
                        const float x1 = a0[i], x2 = a0[4 + i];
                        a0[i] = x1 * cs[i] - x2 * sn[i]; a0[4 + i] = x2 * cs[i] + x1 * sn[i];
                    }
                }
            }
        }
        LAS char* lds = (LAS char*)eb.lds_generic;
        constexpr int EP = 272;
        LAS float* ksum = (LAS float*)(lds + 2 * SA_BYTES + SB4_BYTES);
        const int t = tid_();
#pragma unroll
        for (int s_ = 0; s_ < 2; ++s_) {
            if (wn == s_) {
#pragma unroll
                for (int tm = 0; tm < 2; ++tm)
#pragma unroll
                    for (int tn = 0; tn < 4; ++tn)
#pragma unroll
                        for (int g = 0; g < 4; ++g) {
                            u32x2 v; v.x = pk2(acc[tm][tn][4 * g], acc[tm][tn][4 * g + 1]); v.y = pk2(acc[tm][tn][4 * g + 2], acc[tm][tn][4 * g + 3]);
                            *(LAS u32x2*)(lds + (wm * 64 + tm * 32 + r) * EP + (tn * 32 + 8 * g + 4 * h) * 2) = v;
                        }
            }
            lds_barrier();
#pragma unroll
            for (int i = 0; i < 8; ++i) {
                const int c = t + 256 * i, row = c >> 4, ch = c & 15;
                *(u32x4*)(eb.out + (size_t)row * eb.ld + s_ * 128 + ch * 8) = *(const LAS u32x4*)(lds + row * EP + ch * 16);
            }
            {
                const int cg8 = t & 15, rg = t >> 4;
                float a[8] = {0.f, 0.f, 0.f, 0.f, 0.f, 0.f, 0.f, 0.f};
#pragma unroll
                for (int rr = 0; rr < 8; ++rr) {
                    const u32x4 u = *(const LAS u32x4*)(lds + (rg * 8 + rr) * EP + cg8 * 16);
                    a[0] += bf2f(u.x & 0xffff); a[1] += bf2f(u.x >> 16); a[2] += bf2f(u.y & 0xffff); a[3] += bf2f(u.y >> 16);
                    a[4] += bf2f(u.z & 0xffff); a[5] += bf2f(u.z >> 16); a[6] += bf2f(u.w & 0xffff); a[7] += bf2f(u.w >> 16);
                }
                const f32x4 lo = {a[0], a[1], a[2], a[3]}, hi = {a[4], a[5], a[6], a[7]};
                *(LAS f32x4*)(ksum + rg * 128 + cg8 * 8) = lo; *(LAS f32x4*)(ksum + rg * 128 + cg8 * 8 + 4) = hi;
            }
            lds_barrier();
            if (t < 128) {
                float sacc = 0.f;
#pragma unroll
                for (int rg = 0; rg < 16; ++rg) sacc += ksum[rg * 128 + t];
                kpart[(s_ * 2 + (t >> 6)) * 64 + (t & 63)] = sacc;
            }
        }
    }
};
struct GSeg6 { const bf16_t* a0; const bf16_t* a1; const bf16_t* a2; const bf16_t* b0; size_t ldb; int KT; };
constexpr int SA6_BYTES = 192 * A_PITCH, G6_LDS = 2 * SA6_BYTES + 2 * SB_BYTES;
struct Stage6 { u32x4 a0, a1, a2, b0, b1; };
struct Pre6 { Stage6 s0, s1; bool valid; };
DI void gload6(Stage6& S, const GSeg6& g, int kt) {
    const int k = kt < g.KT ? kt : g.KT - 1;
    S.a0 = *(const u32x4*)(g.a0 + k * BK); S.a1 = *(const u32x4*)(g.a1 + k * BK); S.a2 = *(const u32x4*)(g.a2 + k * BK);
    const bf16_t* pb = g.b0 + (size_t)(k * BK) * g.ldb;
    S.b0 = *(const u32x4*)(pb); S.b1 = *(const u32x4*)(pb + 16 * g.ldb);
}
template <class Epi>
DI void gemm6(const GSeg6& g1, const GSeg6& nxt, bool hasn, Pre6& pre, char* lds_generic, const Epi& epi) {
    const int KT = g1.KT;
    LAS char* lds = (LAS char*)lds_generic;
    const int t = tid_(), lane = t & 63, w = t >> 6, wm = w >> 1, wn = w & 1;
    const int r = lane & 31, h = lane >> 5;
    const int i16 = lane & 15, q = i16 >> 2, pp = i16 & 3, blk = (lane >> 4) & 1;
    const int arow = t >> 2, akc = t & 3, bk = t >> 4, bc = t & 15;
    f32x16 acc[3][2];
#pragma unroll
    for (int i = 0; i < 3; ++i)
#pragma unroll
        for (int j = 0; j < 2; ++j)
#pragma unroll
            for (int e = 0; e < 16; ++e) acc[i][j][e] = 0.f;
    auto sstore = [&](const Stage6& S, int buf) {
        LAS char* sA = lds + buf * SA6_BYTES + arow * A_PITCH + akc * 16; LAS char* sB = lds + 2 * SA6_BYTES + buf * SB_BYTES + bk * B_PITCH + bc * 16;
        *(LAS u32x4*)(sA) = S.a0; *(LAS u32x4*)(sA + 64 * A_PITCH) = S.a1; *(LAS u32x4*)(sA + 128 * A_PITCH) = S.a2;
        *(LAS u32x4*)(sB) = S.b0; *(LAS u32x4*)(sB + 16 * B_PITCH) = S.b1;
    };
    auto compute = [&](int buf) {
        const LAS char* sA = lds + buf * SA6_BYTES; const LAS char* sB = lds + 2 * SA6_BYTES + buf * SB_BYTES;
#pragma unroll
        for (int ks = 0; ks < 2; ++ks) {
            bf16x8 af[3], bfr[2];
#pragma unroll
            for (int tm = 0; tm < 3; ++tm) af[tm] = *(const LAS bf16x8*)(sA + (wm * 96 + tm * 32 + r) * A_PITCH + (ks * 16 + 8 * h) * 2);
#pragma unroll
            for (int tn = 0; tn < 2; ++tn) {
                const LAS char* pbb = sB + (ks * 16 + 8 * h + q) * B_PITCH + (wn * 64 + tn * 32 + 16 * blk) * 2 + 8 * pp;
                s16x4 lo = tr_read(pbb), hi = tr_read(pbb + 4 * B_PITCH);
                bfr[tn] = __builtin_shufflevector(lo, hi, 0, 1, 2, 3, 4, 5, 6, 7);
            }
#pragma unroll
            for (int tm = 0; tm < 3; ++tm)
#pragma unroll
                for (int tn = 0; tn < 2; ++tn) acc[tm][tn] = __builtin_amdgcn_mfma_f32_32x32x16_bf16(bfr[tn], af[tm], acc[tm][tn], 0, 0, 0);
        }
    };
    Stage6& S0 = pre.s0; Stage6& S1 = pre.s1;
    if (!pre.valid) { gload6(S0, g1, 0); gload6(S1, g1, 1); }
    sstore(S0, 0); gload6(S0, g1, 2); __syncthreads();
#define GSTEP(SX) { sstore(SX, (kt + 1) & 1); gload6(SX, g1, kt + 3); compute(kt & 1); __syncthreads(); if (++kt >= KT) break; }
    for (int kt = 0;;) {
        GSTEP(S1)
        GSTEP(S0)
    }
#undef GSTEP
    pre.valid = hasn;
    if (hasn) { gload6(S0, nxt, 0); gload6(S1, nxt, 1); }
    epi(acc, wm, wn, r, h);
}
DI float silu_mul(float g, float u) { return g * u * __builtin_amdgcn_rcpf(1.0f + __expf(-g)); }
struct Epi6GateUp {
    bf16_t* out;
    char* lds_generic;
    DI void operator()(const f32x16 (&acc)[3][2], int wm, int wn, int r, int h) const {
        LAS char* lds = (LAS char*)lds_generic;
        constexpr int EP = 144;
        const int t = tid_();
#pragma unroll
        for (int tm = 0; tm < 3; ++tm)
#pragma unroll
            for (int g = 0; g < 4; ++g) {
                u32x2 v;
                v.x = pk2(silu_mul(acc[tm][0][4 * g], acc[tm][1][4 * g]), silu_mul(acc[tm][0][4 * g + 1], acc[tm][1][4 * g + 1]));
                v.y = pk2(silu_mul(acc[tm][0][4 * g + 2], acc[tm][1][4 * g + 2]), silu_mul(acc[tm][0][4 * g + 3], acc[tm][1][4 * g + 3]));
                *(LAS u32x2*)(lds + (wm * 96 + tm * 32 + r) * EP + (wn * 32 + 8 * g + 4 * h) * 2) = v;
            }
        lds_barrier();
#pragma unroll
        for (int i = 0; i < 6; ++i) {
            const int c = t + 256 * i, row = c >> 3, ch = c & 7;
            *(u32x4*)(out + (size_t)row * DE + ch * 8) = *(const LAS u32x4*)(lds + row * EP + ch * 16);
        }
        lds_barrier();
    }
};
struct Epi6Down {
    bf16_t* out; const float* roww; int nvalid; char* lds_generic;
    DI void operator()(const f32x16 (&acc)[3][2], int wm, int wn, int r, int h) const {
        LAS char* lds = (LAS char*)lds_generic;
        constexpr int EP = 144;
        const int t = tid_();
#pragma unroll
        for (int s_ = 0; s_ < 2; ++s_) {
            if (wn == s_) {
#pragma unroll
                for (int tm = 0; tm < 3; ++tm) {
                    const int row = wm * 96 + tm * 32 + r;
                    const float wv = row < nvalid ? roww[row] : 0.f;
#pragma unroll
                    for (int tn = 0; tn < 2; ++tn)
#pragma unroll
                        for (int g = 0; g < 4; ++g) {
                            u32x2 v; v.x = pk2(acc[tm][tn][4 * g] * wv, acc[tm][tn][4 * g + 1] * wv); v.y = pk2(acc[tm][tn][4 * g + 2] * wv, acc[tm][tn][4 * g + 3] * wv);
                            *(LAS u32x2*)(lds + row * EP + (tn * 32 + 8 * g + 4 * h) * 2) = v;
                        }
                }
            }
            lds_barrier();
#pragma unroll
            for (int i = 0; i < 6; ++i) {
                const int c = t + 256 * i, row = c >> 3, ch = c & 7;
                *(u32x4*)(out + (size_t)row * DM + s_ * 64 + ch * 8) = *(const LAS u32x4*)(lds + row * EP + ch * 16);
            }
            lds_barrier();
        }
    }
};
struct EpiF32 {
    float* out; size_t ld;
    DI void operator()(const f32x16 (&acc)[2][2], int wm, int wn, int r, int h) const {
#pragma unroll
        for (int tm = 0; tm < 2; ++tm) {
            float* rp = out + (size_t)(wm * 64 + tm * 32 + r) * ld + wn * 64 + 4 * h;
#pragma unroll
            for (int tn = 0; tn < 2; ++tn)
#pragma unroll
                for (int g = 0; g < 4; ++g) { float4 x = {acc[tm][tn][4 * g], acc[tm][tn][4 * g + 1], acc[tm][tn][4 * g + 2], acc[tm][tn][4 * g + 3]}; *(float4*)(rp + tn * 32 + 8 * g) = x; }
        }
    }
};
DI float gelu_tanh(float v) {
    const float inner = 0.7978845608028654f * (v + 0.044715f * v * v * v);
    const float th = 1.0f - 2.0f * __builtin_amdgcn_rcpf(__expf(2.0f * inner) + 1.0f);
    return 0.5f * v * (1.0f + th);
}
struct EpiS5Y {
    bf16_t* zrow0;
    int ncol0;
    DI void operator()(const f32x16 (&acc)[2][2], int wm, int wn, int r, int h) const {
#pragma unroll
        for (int tm = 0; tm < 2; ++tm) {
            const int chunk = wm * 64 + tm * 32 + r;
#pragma unroll
            for (int tn = 0; tn < 2; ++tn)
#pragma unroll
                for (int g = 0; g < 4; ++g) {
                    const int n0 = ncol0 + wn * 64 + tn * 32 + 8 * g + 4 * h;
                    u32x2 v; v.x = pk2(gelu_tanh(acc[tm][tn][4 * g]), gelu_tanh(acc[tm][tn][4 * g + 1])); v.y = pk2(gelu_tanh(acc[tm][tn][4 * g + 2]), gelu_tanh(acc[tm][tn][4 * g + 3]));
                    *(u32x2*)(zrow0 + (size_t)(chunk * 16 + (n0 >> 4)) * 256 + (n0 & 15)) = v;
                }
        }
    }
};
struct EpiGlu {
    const bf16_t* z; bf16_t* out; const float* gb; const float* sg;
    DI void operator()(const f32x16 (&acc)[2][2], int wm, int wn, int r, int h) const {
#pragma unroll
        for (int tm = 0; tm < 2; ++tm) {
            const int row = wm * 64 + tm * 32 + r;
#pragma unroll
            for (int tn = 0; tn < 2; ++tn) {
                const int c0 = wn * 64 + tn * 32 + 4 * h;
                float y[16];
#pragma unroll
                for (int g = 0; g < 4; ++g) {
                    const u32x2 zz = *(const u32x2*)(z + (size_t)row * 256 + c0 + 8 * g);
                    const float4 b4 = *(const float4*)(gb + c0 + 8 * g);
                    y[4 * g + 0] = bf2f(zz.x & 0xffff) * __builtin_amdgcn_rcpf(1.0f + __expf(-(acc[tm][tn][4 * g + 0] + b4.x)));
                    y[4 * g + 1] = bf2f(zz.x >> 16) * __builtin_amdgcn_rcpf(1.0f + __expf(-(acc[tm][tn][4 * g + 1] + b4.y)));
                    y[4 * g + 2] = bf2f(zz.y & 0xffff) * __builtin_amdgcn_rcpf(1.0f + __expf(-(acc[tm][tn][4 * g + 2] + b4.z)));
                    y[4 * g + 3] = bf2f(zz.y >> 16) * __builtin_amdgcn_rcpf(1.0f + __expf(-(acc[tm][tn][4 * g + 3] + b4.w)));
                }
#pragma unroll
                for (int q = 0; q < 2; ++q) {
                    float ss = 0.f;
#pragma unroll
                    for (int e = 0; e < 8; ++e) ss += y[8 * q + e] * y[8 * q + e];
                    ss = half_swap_sum(ss);
                    const float rstd = rsqrtf(ss * (1.0f / 16.0f) + EPS);
#pragma unroll
                    for (int g = 2 * q; g < 2 * q + 2; ++g) {
                        const float4 s4 = *(const float4*)(sg + c0 + 8 * g);
                        u32x2 v; v.x = pk2(y[4 * g] * rstd * s4.x, y[4 * g + 1] * rstd * s4.y); v.y = pk2(y[4 * g + 2] * rstd * s4.z, y[4 * g + 3] * rstd * s4.w);
                        *(u32x2*)(out + (size_t)row * DM + c0 + 8 * g) = v;
                    }
                }
            }
        }
    }
};

constexpr int MOE_BM = 192;
DI void moe_prefix(const int* cnt, int* stp  ) {
    __syncthreads();
    if (tid_() == 0) { int a = 0; for (int e = 0; e < NE; ++e) { stp[e] = a; a += (cnt[e] + MOE_BM - 1) / MOE_BM; } stp[NE] = a; }
    __syncthreads();
}

DI void phase_norm1(const P& p, int l, char* lds) {
    const int t = tid_(), lane = t & 63, w = t >> 6;
    bf16_t* xres = (bf16_t*)(p.ws + WS_XRES);
    bf16_t* hbuf = (bf16_t*)(p.ws + WS_HBUF);
    const float* g1 = p.in[1] + l * DM;
    const float* win = p.in[2] + (size_t)l * DM * DIN;
    int* stp = (int*)lds;
    const bf16_t* ymoe = (const bf16_t*)(p.ws + WS_YMOE);
    const int4* tinfo = (const int4*)(p.ws + WS_TINFO);
    if (l > 0) moe_prefix((const int*)(p.ws + WS_CTL) + (l - 1) * NE, stp);
    if (l == 0) {
        const size_t stride = (size_t)gridDim.x * 256, i0 = (size_t)bid_() * 256 + t;
        const float4* s1 = (const float4*)p.in[2]; u32x2* d1 = (u32x2*)(p.ws + WS_WINB);
        for (size_t i = i0; i < (size_t)2 * DM * DIN / 4; i += stride) { const float4 v = s1[i]; u32x2 o; o.x = pk2(v.x, v.y); o.y = pk2(v.z, v.w); d1[i] = o; }
        const float4* s2 = (const float4*)p.in[22]; u32x2* d2 = (u32x2*)(p.ws + WS_WOUTB);
        for (size_t i = i0; i < (size_t)2 * DM * DM / 4; i += stride) { const float4 v = s2[i]; u32x2 o; o.x = pk2(v.x, v.y); o.y = pk2(v.z, v.w); d2[i] = o; }
    }
    for (int rb = bid_(); rb < T / 8; rb += gridDim.x) {
        __syncthreads();
        float4 v[2][4]; uint2 ya[2][4], yb[2][4]; float4 gq[4];
#pragma unroll
        for (int rr = 0; rr < 2; ++rr) {
            const int row = rb * 8 + w * 2 + rr;
#pragma unroll
            for (int i = 0; i < 4; ++i) v[rr][i] = (l == 0) ? *(const float4*)(p.in[0] + (size_t)row * DM + i * 256 + lane * 4) : bf4_to_f4(*(const u32x2*)(xres + (size_t)row * DM + i * 256 + lane * 4));
            if (l > 0) {
                const int4 ti = tinfo[row];
                const bf16_t* y0 = ymoe + (size_t)(stp[ti.x] * MOE_BM + ti.y) * DM;
                const bf16_t* y1 = ymoe + (size_t)(stp[ti.z] * MOE_BM + ti.w) * DM;
#pragma unroll
                for (int i = 0; i < 4; ++i) { ya[rr][i] = *(const uint2*)(y0 + i * 256 + lane * 4); yb[rr][i] = *(const uint2*)(y1 + i * 256 + lane * 4); }
            }
        }
#pragma unroll
        for (int i = 0; i < 4; ++i) gq[i] = *(const float4*)(g1 + i * 256 + lane * 4);
#pragma unroll
        for (int rr = 0; rr < 2; ++rr) {
            const int row = rb * 8 + w * 2 + rr;
            if (l > 0) {
#pragma unroll
                for (int i = 0; i < 4; ++i) {
                    const uint2 a = ya[rr][i], b2 = yb[rr][i];
                    v[rr][i].x += bf2f(a.x & 0xffff) + bf2f(b2.x & 0xffff); v[rr][i].y += bf2f(a.x >> 16) + bf2f(b2.x >> 16);
                    v[rr][i].z += bf2f(a.y & 0xffff) + bf2f(b2.y & 0xffff); v[rr][i].w += bf2f(a.y >> 16) + bf2f(b2.y >> 16);
                }
#pragma unroll
                for (int i = 0; i < 4; ++i) *(u32x2*)(xres + (size_t)row * DM + i * 256 + lane * 4) = f4_to_bf4(v[rr][i]);
            }
            float ss = 0.f;
#pragma unroll
            for (int i = 0; i < 4; ++i) ss += v[rr][i].x * v[rr][i].x + v[rr][i].y * v[rr][i].y + v[rr][i].z * v[rr][i].z + v[rr][i].w * v[rr][i].w;
            ss = wave_sum(ss);
            const float rstd = rsqrtf(ss * (1.0f / DM) + EPS);
#pragma unroll
            for (int i = 0; i < 4; ++i) {
                const int k0 = i * 256 + lane * 4;
                const float4 g = gq[i];
                float4 hv = {v[rr][i].x * rstd * g.x, v[rr][i].y * rstd * g.y, v[rr][i].z * rstd * g.z, v[rr][i].w * rstd * g.w};
                uint2 o; o.x = pk2(hv.x, hv.y); o.y = pk2(hv.z, hv.w);
                *(uint2*)(hbuf + (size_t)row * DM + k0) = o;
            }
        }
    }
}

DI void phase_inproj(const P& p, int l, char* lds) {
    const int t = tid_();
    const bf16_t* hbuf = (const bf16_t*)(p.ws + WS_HBUF);
    bf16_t* projb = (bf16_t*)(p.ws + WS_PROJ);
    const bf16_t* winb = (const bf16_t*)(p.ws + WS_WINB) + (size_t)l * DM * DIN;
    float* gates = (float*)(p.ws + WS_GATES);
    const int vx = bid_() & 7, vj = bid_() >> 3, nj = (gridDim.x - vx + 7) >> 3;
    {
      const bool tuned = gridDim.x == 512;
      for (int j = vj, k3 = 0; j < 192; j += nj, ++k3) {
        const int rd = j >> 6, jj = j & 63;
        int mt = vx * 16 + (jj >> 5) * 8 + ((jj & 31) >> 2), vt = rd * 4 + (jj & 3);
        if (tuned) {
            const unsigned code = vj < 32 ? ((vj & 1) ? 0x327u : 0x061u) : ((vj & 1) ? 0xB95u : 0xA84u);
            vt = (code >> (4 * k3)) & 15; mt = vx * 16 + ((vj & 31) >> 1);
        }
        const int acol = vt < 4 ? vt * 256 : (vt < 10 ? 1032 + (vt - 4) * 256 : (vt == 10 ? 2568 : 1024));
        const bf16_t* ar = hbuf + (size_t)(mt * 128 + (t >> 2)) * DM + (t & 3) * 8;
        GSeg4 g1{ar, ar + (size_t)64 * DM, 32, winb + (size_t)(t >> 5) * DIN + acol + (t & 31) * 8, DIN, DM / 32}; GSeg4 g2 = g1; g2.KT = 0;
        const bool iskey = vt == 6 || vt == 7;
        float* kpart = (float*)(p.ws + WS_KMEAN) + ((size_t)((mt >> 4) * 8 + ((mt & 15) >> 1)) * 2 + (mt & 1)) * 512 + (vt == 7 ? 256 : 0);
        Epi4Inproj epi{Epi4Bf16{projb + (size_t)mt * 128 * PJ + (vt % 11) * 256, (size_t)PJ, lds}, gates + (size_t)mt * 128 * 8, p.in[3] + l * 4, p.in[4] + l * 4, vt == 11,
                       iskey, p.in[9] + l * 64, kpart, (mt & 15) * 128};
        if (vt == 1) {
            Epi4ConvK eck{projb + (size_t)mt * 128 * PJ + 256, (size_t)PJ, lds, p.in[5] + l * 4 * 512 + 256, p.in[6] + l * 512 + 256, (bf16_t*)(p.ws + WS_MQKC) + (size_t)mt * 128 * 512 + 256};
            gemm4(g1, g2, lds, eck);
        } else gemm4(g1, g2, lds, epi);
      }
    }
}

DI void phase_qkprep(const P& p, int l, char* lds, unsigned long long& tsub) {
    unsigned long long tq0 = PROBE_SUB ? wall_clock64() : 0ull;
#define QSUB(bit) do { if (PROBE_SUB) { const unsigned long long tn_ = wall_clock64(); if (PROBE_SUB & (bit)) tsub += tn_ - tq0; tq0 = tn_; } } while (0)
    bf16_t* projb = (bf16_t*)(p.ws + WS_PROJ);
    const int t = tid_();
    QSUB(8);
    {
        bf16_t* mqkc = (bf16_t*)(p.ws + WS_MQKC);
        const float* cw = p.in[5] + l * 4 * 512; const float* cb = p.in[6] + l * 512;
        const int nthreads = gridDim.x * 256;
        for (int idx = bid_() * 256 + t; idx < (T / 128) * 96; idx += nthreads) {
            const int tile = idx / 96, rem = idx - tile * 96, token = tile * 128 + (rem >> 5), ch = 256 + (rem & 31) * 8, pos = token & (SEQ - 1);
            float a[8];
            { const float4 b0 = *(const float4*)(cb + ch), b1 = *(const float4*)(cb + ch + 4); a[0] = b0.x; a[1] = b0.y; a[2] = b0.z; a[3] = b0.w; a[4] = b1.x; a[5] = b1.y; a[6] = b1.z; a[7] = b1.w; }
#pragma unroll
            for (int j = 0; j < 4; ++j) {
                if (pos + j - 3 >= 0) {
                    const u32x4 u = *(const u32x4*)(projb + (size_t)(token + j - 3) * PJ + ch);
                    const float4 w0 = *(const float4*)(cw + j * 512 + ch), w1 = *(const float4*)(cw + j * 512 + ch + 4);
                    a[0] += bf2f(u.x & 0xffff) * w0.x; a[1] += bf2f(u.x >> 16) * w0.y; a[2] += bf2f(u.y & 0xffff) * w0.z; a[3] += bf2f(u.y >> 16) * w0.w;
                    a[4] += bf2f(u.z & 0xffff) * w1.x; a[5] += bf2f(u.z >> 16) * w1.y; a[6] += bf2f(u.w & 0xffff) * w1.z; a[7] += bf2f(u.w >> 16) * w1.w;
                }
            }
            const float sc = 0.125f;
#pragma unroll
            for (int e = 0; e < 8; ++e) a[e] = a[e] * sc * __builtin_amdgcn_rcpf(1.0f + __expf(-a[e]));
            u32x4 o; o.x = pk2(a[0], a[1]); o.y = pk2(a[2], a[3]); o.z = pk2(a[4], a[5]); o.w = pk2(a[6], a[7]);
            *(u32x4*)(mqkc + (size_t)token * 512 + ch) = o;
        }
    }
    QSUB(16);
    {
        const float* gates = (const float*)(p.ws + WS_GATES);
        float4* gscan = (float4*)(p.ws + WS_GSCAN);
        const int lane = t & 63, gwv = bid_() * 4 + (t >> 6), nwv = gridDim.x * 4;
        for (int it = gwv; it < (T / 64) * 4; it += nwv) {
            const int ck = it >> 2, hd = it & 3;
            const size_t row = (size_t)ck * 64 + lane;
            const float gi = gates[row * 8 + hd], gf = gates[row * 8 + 4 + hd];
            const float lf = fminf(gf, 0.f) - log1pf(expf(-fabsf(gf)));
            float bs = lf;
#pragma unroll
            for (int o = 1; o < 64; o <<= 1) { const float v = __shfl_up(bs, o); if (lane >= o) bs += v; }
            const float u = gi - bs; float um = u;
#pragma unroll
            for (int o = 1; o < 64; o <<= 1) { const float v = __shfl_up(um, o); if (lane >= o) um = fmaxf(um, v); }
            gscan[row * 4 + hd] = make_float4(bs, u, um, 0.f);
        }
    }
    QSUB(32);
    {
        float* Tm = (float*)(p.ws + WS_S5M + (size_t)l * S5M_LAYER);
        float* Em = (float*)(p.ws + WS_S5M + (size_t)l * S5M_LAYER + S5M_E);
        float* Fm = (float*)(p.ws + WS_S5M + (size_t)l * S5M_LAYER + S5M_F);
        float* sp = (float*)lds + 512;
        float* scr = sp + 384;
        float* sci = scr + 1024; float* sbr = sci + 1024; float* sbi = sbr + 1024;
        for (int it0 = bid_(); it0 < 512; it0 += gridDim.x) {
            const int item = gridDim.x == 512 ? (((it0 & 255) << 1) | (it0 >> 8)) : it0;
            const int g = item >> 5, tau = (item >> 1) & 15, part = item & 1, lg = l * 16 + g;
            float* Tg = Tm + (size_t)g * 256 * 256; float* Eg = Em + (size_t)g * 256 * 128; float* Fg = Fm + (size_t)g * 128 * 256;
            __syncthreads();
            {
                const float4 a0 = *(const float4*)(p.in[15] + (size_t)lg * 1024 + t * 4), a1 = *(const float4*)(p.in[16] + (size_t)lg * 1024 + t * 4);
                const float4 a2 = *(const float4*)(p.in[13] + (size_t)lg * 1024 + t * 4), a3 = *(const float4*)(p.in[14] + (size_t)lg * 1024 + t * 4);
                *(float4*)(scr + t * 4) = a0; *(float4*)(sci + t * 4) = a1; *(float4*)(sbr + t * 4) = a2; *(float4*)(sbi + t * 4) = a3;
            }
            if (t < 64) {
                const float lr = p.in[11][lg * 64 + t], li = p.in[12][lg * 64 + t], dt = expf(p.in[18][lg]);
                const float mag1 = expf(lr * dt), a1r = mag1 * cosf(li * dt), a1i = mag1 * sinf(li * dt);
                const float magt = expf(lr * dt * tau), atr = magt * cosf(li * dt * tau), ati = magt * sinf(li * dt * tau);
                const float zr = a1r - 1.0f, zi = a1i, dn = lr * lr + li * li;
                sp[t] = atr; sp[64 + t] = ati; sp[128 + t] = atr * a1r - ati * a1i; sp[192 + t] = atr * a1i + ati * a1r;
                sp[256 + t] = (zr * lr + zi * li) / dn; sp[320 + t] = (zi * lr - zr * li) / dn;
            }
            __syncthreads();
            if (part == 0) {
                const int hh = t >> 4, hp = t & 15;
                float kv = 0.f;
#pragma unroll 8
                for (int pi = 0; pi < 64; ++pi) {
                    const float fr = sp[256 + pi], fi = sp[320 + pi], br = sbr[pi * 16 + hp], bi = sbi[pi * 16 + hp];
                    const float bbr = fr * br - fi * bi, bbi = fr * bi + fi * br;
                    const float cr = scr[hh * 64 + pi], ci = sci[hh * 64 + pi], ar = sp[pi], ai = sp[64 + pi];
                    kv += (cr * ar - ci * ai) * bbr - (cr * ai + ci * ar) * bbi;
                }
                if (tau == 0 && hh == hp) kv += p.in[17][lg * 16 + hh];
                for (int s_ = 0; s_ + tau < 16; ++s_) {
                    const int t_ = s_ + tau;
                    Tg[(size_t)(s_ * 16 + hp) * 256 + t_ * 16 + hh] = kv;
                    if (tau > 0) Tg[(size_t)(t_ * 16 + hp) * 256 + s_ * 16 + hh] = 0.f;
                }
            }
            if (part == 1)
            for (int idx = t; idx < 1024; idx += 256) {
                const int pi = idx >> 4, x = idx & 15;
                {
                    const float fr = sp[256 + pi], fi = sp[320 + pi];
                    const float br = sbr[pi * 16 + x], bi = sbi[pi * 16 + x];
                    const float bbr = fr * br - fi * bi, bbi = fr * bi + fi * br, ar = sp[pi], ai = sp[64 + pi];
                    const size_t ro = (size_t)((15 - tau) * 16 + x) * 128;
                    Eg[ro + pi] = ar * bbr - ai * bbi; Eg[ro + 64 + pi] = ar * bbi + ai * bbr;
                }
                {
                    const float cr = scr[x * 64 + pi], ci = sci[x * 64 + pi];
                    const float ar = sp[128 + pi], ai = sp[192 + pi];
                    Fg[(size_t)pi * 256 + tau * 16 + x] = cr * ar - ci * ai; Fg[(size_t)(64 + pi) * 256 + tau * 16 + x] = -(cr * ai + ci * ar);
                }
            }
        }
    }
    QSUB(64);
#undef QSUB
}

constexpr int ML_QP = 144, ML_TP = 192;
constexpr int ML_Q = 0, ML_K = 9216, ML_KW = 18432, ML_V = 30720, ML_C = 43008, ML_N = 55296, ML_U = 55808, ML_NP = 56064, ML_SS = 57088, ML_DEC = 57600;
DI bf16x8 scale8(u32x4 v, float w) {
    u32x4 o;
    o.x = pk2(bf2f(v.x & 0xffff) * w, bf2f(v.x >> 16) * w); o.y = pk2(bf2f(v.y & 0xffff) * w, bf2f(v.y >> 16) * w);
    o.z = pk2(bf2f(v.z & 0xffff) * w, bf2f(v.z >> 16) * w); o.w = pk2(bf2f(v.w & 0xffff) * w, bf2f(v.w >> 16) * w);
    return __builtin_bit_cast(bf16x8, o);
}
DI bf16x8 tr_frag(const LAS char* p, int hi_off) {
    s16x4 lo = tr_read(p), hi = tr_read(p + hi_off);
    return __builtin_shufflevector(lo, hi, 0, 1, 2, 3, 4, 5, 6, 7);
}
DI void mlstm_mscan(const float4* gscan, size_t rowb, int hd, int lane, float& m_in, float& decay) {
    const int ci = lane & 31;
    const float4 gl = gscan[(rowb + ci * 64 + 63) * 4 + hd];
    float A = gl.x, B = gl.z + gl.x;
#pragma unroll
    for (int o = 1; o < 32; o <<= 1) {
        const float Ap = __shfl_up(A, o), Bp = __shfl_up(B, o);
        if (ci >= o) { B = fmaxf(Bp + A, B); A = Ap + A; }
    }
    const float mafter = fmaxf(A, B);
    const float mprev = __shfl_up(mafter, 1);
    m_in = ci == 0 ? 0.f : mprev;
    decay = __expf(m_in - fmaxf(m_in, gl.z));
}
DI void mlstm_state_item(const P& p, int l, int item, char* lds_generic) {
    LAS char* lds = (LAS char*)lds_generic;
    const int bh = item >> 5, c = item & 31, b = bh >> 2, hd = bh & 3;
    const int t = tid_(), lane = t & 63, w = t >> 6, r = lane & 31, h = lane >> 5;
    const int i16 = lane & 15, q4 = i16 >> 2, pp = i16 & 3, blk = (lane >> 4) & 1;
    const int wd = w & 1, wt = w >> 1;
    const bf16_t* projb = (const bf16_t*)(p.ws + WS_PROJ);
    const bf16_t* mqkc = (const bf16_t*)(p.ws + WS_MQKC);
    const float4* gscan = (const float4*)(p.ws + WS_GSCAN);
    bf16_t* dC = (bf16_t*)(p.ws + WS_HRAW) + (size_t)item * 4096;
    float* dn = (float*)(p.ws + WS_ZBUF + 8 * MiB) + (size_t)item * 64;
    LAS float* npart = (LAS float*)(lds + ML_NP);
    const int srow = t >> 3, sc16 = t & 7;
    const size_t rowb = (size_t)b * SEQ, row0 = rowb + c * 64;
    const bf16_t* kp = mqkc + (row0 + srow) * 512 + 256 + hd * 64 + sc16 * 8;
    const u32x4 rk0 = *(const u32x4*)kp, rk1 = *(const u32x4*)(kp + 32 * 512);
    const bf16_t* vp = projb + (row0 + srow) * PJ + C_MV + hd * 64 + sc16 * 8;
    const u32x4 rv0 = *(const u32x4*)vp, rv1 = *(const u32x4*)(vp + (size_t)32 * PJ);
    const float4 gl0 = gscan[(row0 + srow) * 4 + hd], gl1 = gscan[(row0 + srow + 32) * 4 + hd], glast = gscan[(row0 + 63) * 4 + hd];
    float m_in, dec; mlstm_mscan(gscan, rowb, hd, lane, m_in, dec);
    const float m = __shfl(m_in, c);
    const float Mlast = fmaxf(m, glast.z);
    __syncthreads();
    {
        const float w0 = __expf(gl0.y - Mlast), w1 = __expf(gl1.y - Mlast);
        *(LAS u32x4*)(lds + ML_V + srow * ML_TP + sc16 * 16) = rv0; *(LAS u32x4*)(lds + ML_V + (srow + 32) * ML_TP + sc16 * 16) = rv1;
        *(LAS bf16x8*)(lds + ML_KW + srow * ML_TP + sc16 * 16) = scale8(rk0, w0); *(LAS bf16x8*)(lds + ML_KW + (srow + 32) * ML_TP + sc16 * 16) = scale8(rk1, w1);
    }
    __syncthreads();
    f32x16 cacc;
#pragma unroll
    for (int e = 0; e < 16; ++e) cacc[e] = 0.f;
#pragma unroll
    for (int k4 = 0; k4 < 4; ++k4) {
        const bf16x8 vf = tr_frag(lds + ML_V + (k4 * 16 + 4 * h + q4) * ML_TP + (wd * 32 + 16 * blk) * 2 + 8 * pp, 8 * ML_TP);
        const bf16x8 kwf = tr_frag(lds + ML_KW + (k4 * 16 + 4 * h + q4) * ML_TP + (wt * 32 + 16 * blk) * 2 + 8 * pp, 8 * ML_TP);
        cacc = __builtin_amdgcn_mfma_f32_32x32x16_bf16(vf, kwf, cacc, 0, 0, 0);
    }
    {
        const int dk = t & 63, qd = t >> 6; float a = 0.f;
#pragma unroll
        for (int s_ = 0; s_ < 16; ++s_) a += bf2f(*(const LAS bf16_t*)(lds + ML_KW + (qd * 16 + s_) * ML_TP + dk * 2));
        npart[qd * 64 + dk] = a;
    }
#pragma unroll
    for (int g = 0; g < 4; ++g) { u32x2 x; x.x = pk2(cacc[4 * g], cacc[4 * g + 1]); x.y = pk2(cacc[4 * g + 2], cacc[4 * g + 3]); *(u32x2*)(dC + (wt * 32 + r) * 64 + wd * 32 + 8 * g + 4 * h) = x; }
    __syncthreads();
    if (t < 64) dn[t] = (npart[t] + npart[64 + t]) + (npart[128 + t] + npart[192 + t]);
}
DI void mlstm_out_item(const P& p, int l, int item, char* lds_generic) {
    LAS char* lds = (LAS char*)lds_generic;
    const int bh = item >> 5, c = item & 31, b = bh >> 2, hd = bh & 3;
    const int t = tid_(), lane = t & 63, w = t >> 6, r = lane & 31, h = lane >> 5;
    const int i16 = lane & 15, q4 = i16 >> 2, pp = i16 & 3, blk = (lane >> 4) & 1;
    const int wd = w & 1, wt = w >> 1;
    const bf16_t* projb = (const bf16_t*)(p.ws + WS_PROJ);
    const bf16_t* mqkc = (const bf16_t*)(p.ws + WS_MQKC);
    const float4* gscan = (const float4*)(p.ws + WS_GSCAN);
    const bf16_t* dCb = (const bf16_t*)(p.ws + WS_HRAW) + (size_t)bh * 32 * 4096;
    const float* dnb = (const float*)(p.ws + WS_ZBUF + 8 * MiB) + (size_t)bh * 32 * 64;
    bf16_t* mix = (bf16_t*)(p.ws + WS_MIX);
    const float* mg = p.in[7] + l * 256 + hd * 64;
    LAS float* nbuf = (LAS float*)(lds + ML_N); LAS float* ubuf2 = (LAS float*)(lds + ML_U); LAS float* ssbuf = (LAS float*)(lds + ML_SS); LAS float* decs = (LAS float*)(lds + ML_DEC);
    const int srow = t >> 3, sc16 = t & 7;
    const float LOG2E = 1.4426950408889634f;
    const size_t rowb = (size_t)b * SEQ, row0 = rowb + c * 64;
    const int tt = wt * 32 + r;
    const bf16_t* qp = mqkc + (row0 + srow) * 512 + hd * 64 + sc16 * 8;
    const u32x4 rk0 = *(const u32x4*)(qp + 256), rk1 = *(const u32x4*)(qp + 32 * 512 + 256);
    u32x4 rq0, rq1;
    {
        const float* cw = p.in[5] + l * 4 * 512 + hd * 64 + sc16 * 8; const float* cb = p.in[6] + l * 512 + hd * 64 + sc16 * 8;
        const bf16_t* mqraw = projb + C_MQ + hd * 64 + sc16 * 8;
#pragma unroll
        for (int half = 0; half < 2; ++half) {
            const int rowi = srow + 32 * half, pos = c * 64 + rowi;
            float a[8];
            { const float4 b0 = *(const float4*)(cb), b1 = *(const float4*)(cb + 4); a[0] = b0.x; a[1] = b0.y; a[2] = b0.z; a[3] = b0.w; a[4] = b1.x; a[5] = b1.y; a[6] = b1.z; a[7] = b1.w; }
#pragma unroll
            for (int j = 0; j < 4; ++j) {
                const bool ok = pos + j - 3 >= 0;
                const u32x4 u = *(const u32x4*)(mqraw + (row0 + rowi + (ok ? j - 3 : 0)) * PJ);
                const float mk = ok ? 1.0f : 0.0f;
                const float4 w0 = *(const float4*)(cw + j * 512), w1 = *(const float4*)(cw + j * 512 + 4);
                a[0] += bf2f(u.x & 0xffff) * (w0.x * mk); a[1] += bf2f(u.x >> 16) * (w0.y * mk); a[2] += bf2f(u.y & 0xffff) * (w0.z * mk); a[3] += bf2f(u.y >> 16) * (w0.w * mk);
                a[4] += bf2f(u.z & 0xffff) * (w1.x * mk); a[5] += bf2f(u.z >> 16) * (w1.y * mk); a[6] += bf2f(u.w & 0xffff) * (w1.z * mk); a[7] += bf2f(u.w >> 16) * (w1.w * mk);
            }
#pragma unroll
            for (int e = 0; e < 8; ++e) a[e] = a[e] * __builtin_amdgcn_rcpf(1.0f + __expf(-a[e]));
            u32x4 o; o.x = pk2(a[0], a[1]); o.y = pk2(a[2], a[3]); o.z = pk2(a[4], a[5]); o.w = pk2(a[6], a[7]);
            if (half == 0) rq0 = o; else rq1 = o;
        }
    }
    const bf16_t* vp = projb + (row0 + srow) * PJ + C_MV + hd * 64 + sc16 * 8;
    const u32x4 rv0 = *(const u32x4*)vp, rv1 = *(const u32x4*)(vp + (size_t)32 * PJ);
    const float4 gl0 = gscan[(row0 + srow) * 4 + hd], gl1 = gscan[(row0 + srow + 32) * 4 + hd], gtt = gscan[(row0 + tt) * 4 + hd];
    const bf16_t* opp = projb + (row0 + tt) * PJ + C_MO + hd * 64 + wd * 32 + 4 * h;
    const u32x2 opre[4] = {*(const u32x2*)(opp), *(const u32x2*)(opp + 8), *(const u32x2*)(opp + 16), *(const u32x2*)(opp + 24)};
    float4 mgr[4];
#pragma unroll
    for (int g = 0; g < 4; ++g) mgr[g] = *(const float4*)(mg + wd * 32 + 4 * h + 8 * g);
    float m_in, dec; mlstm_mscan(gscan, rowb, hd, lane, m_in, dec);
    const float m = __shfl(m_in, c);
    __syncthreads();
    if (t < 32) decs[t] = dec;
    __syncthreads();
    {
        float4 c0 = {0.f, 0.f, 0.f, 0.f}, c1 = c0, c2 = c0, c3 = c0; float nacc = 0.f;
        const bf16_t* src = dCb + (t >> 2) * 64 + (t & 3) * 16;
#pragma unroll 8
        for (int cc = 0; cc < c; ++cc) {
            const float d = decs[cc];
            const u32x4 u0 = *(const u32x4*)(src), u1 = *(const u32x4*)(src + 8);
            const float4 x0 = {bf2f(u0.x & 0xffff), bf2f(u0.x >> 16), bf2f(u0.y & 0xffff), bf2f(u0.y >> 16)}, x1 = {bf2f(u0.z & 0xffff), bf2f(u0.z >> 16), bf2f(u0.w & 0xffff), bf2f(u0.w >> 16)};
            const float4 x2 = {bf2f(u1.x & 0xffff), bf2f(u1.x >> 16), bf2f(u1.y & 0xffff), bf2f(u1.y >> 16)}, x3 = {bf2f(u1.z & 0xffff), bf2f(u1.z >> 16), bf2f(u1.w & 0xffff), bf2f(u1.w >> 16)};
            c0.x = c0.x * d + x0.x; c0.y = c0.y * d + x0.y; c0.z = c0.z * d + x0.z; c0.w = c0.w * d + x0.w;
            c1.x = c1.x * d + x1.x; c1.y = c1.y * d + x1.y; c1.z = c1.z * d + x1.z; c1.w = c1.w * d + x1.w;
            c2.x = c2.x * d + x2.x; c2.y = c2.y * d + x2.y; c2.z = c2.z * d + x2.z; c2.w = c2.w * d + x2.w;
            c3.x = c3.x * d + x3.x; c3.y = c3.y * d + x3.y; c3.z = c3.z * d + x3.z; c3.w = c3.w * d + x3.w;
            if (t < 64) nacc = nacc * d + dnb[cc * 64 + t];
            src += 4096;
        }
        u32x4 o0, o1;
        o0.x = pk2(c0.x, c0.y); o0.y = pk2(c0.z, c0.w); o0.z = pk2(c1.x, c1.y); o0.w = pk2(c1.z, c1.w);
        o1.x = pk2(c2.x, c2.y); o1.y = pk2(c2.z, c2.w); o1.z = pk2(c3.x, c3.y); o1.w = pk2(c3.z, c3.w);
        *(LAS u32x4*)(lds + ML_C + (t >> 2) * ML_TP + (t & 3) * 32) = o0; *(LAS u32x4*)(lds + ML_C + (t >> 2) * ML_TP + (t & 3) * 32 + 16) = o1;
        if (t < 64) nbuf[t] = nacc;
    }
    const float Mt_t = fmaxf(m, gtt.z), bs_t = gtt.x;
    {
        *(LAS u32x4*)(lds + ML_Q + srow * ML_QP + sc16 * 16) = rq0; *(LAS u32x4*)(lds + ML_Q + (srow + 32) * ML_QP + sc16 * 16) = rq1;
        *(LAS u32x4*)(lds + ML_K + srow * ML_QP + sc16 * 16) = rk0; *(LAS u32x4*)(lds + ML_K + (srow + 32) * ML_QP + sc16 * 16) = rk1;
        *(LAS u32x4*)(lds + ML_V + srow * ML_TP + sc16 * 16) = rv0; *(LAS u32x4*)(lds + ML_V + (srow + 32) * ML_TP + sc16 * 16) = rv1;
        if (sc16 == 0) { ubuf2[srow] = gl0.y * LOG2E; ubuf2[srow + 32] = gl1.y * LOG2E; }
    }
    __syncthreads();
    const float inter = __expf(m - Mt_t);
    bf16x8 qf[4];
#pragma unroll
    for (int ks = 0; ks < 4; ++ks) qf[ks] = *(const LAS bf16x8*)(lds + ML_Q + tt * ML_QP + (ks * 16 + 8 * h) * 2);
    f32x16 acca, accb;
#pragma unroll
    for (int e = 0; e < 16; ++e) { acca[e] = 0.f; accb[e] = 0.f; }
    float rs = 0.f;
    const float Mt2 = Mt_t * LOG2E;
#pragma unroll
    for (int st = 0; st < 2; ++st) {
        if (st <= wt) {
            f32x16 sa;
#pragma unroll
            for (int e = 0; e < 16; ++e) sa[e] = 0.f;
#pragma unroll
            for (int ks = 0; ks < 4; ++ks) {
                const bf16x8 kf = *(const LAS bf16x8*)(lds + ML_K + (st * 32 + r) * ML_QP + (ks * 16 + 8 * h) * 2);
                sa = __builtin_amdgcn_mfma_f32_32x32x16_bf16(kf, qf[ks], sa, 0, 0, 0);
            }
#pragma unroll
            for (int g = 0; g < 4; ++g) {
                const f32x4 u4 = *(const LAS f32x4*)(ubuf2 + st * 32 + 8 * g + 4 * h);
                const float uu[4] = {u4.x, u4.y, u4.z, u4.w};
#pragma unroll
                for (int i = 0; i < 4; ++i) {
                    const int sidx = st * 32 + 8 * g + 4 * h + i;
                    const float dv_ = (sidx <= tt) ? sa[4 * g + i] * __builtin_amdgcn_exp2f(uu[i] - Mt2) : 0.f;
                    sa[4 * g + i] = dv_; rs += dv_;
                }
            }
#pragma unroll
            for (int sk = 0; sk < 2; ++sk) {
                u32x4 pk; pk.x = pk2(sa[8 * sk], sa[8 * sk + 1]); pk.y = pk2(sa[8 * sk + 2], sa[8 * sk + 3]); pk.z = pk2(sa[8 * sk + 4], sa[8 * sk + 5]); pk.w = pk2(sa[8 * sk + 6], sa[8 * sk + 7]);
                const bf16x8 vf = tr_frag(lds + ML_V + ((st * 2 + sk) * 16 + 4 * h + q4) * ML_TP + (wd * 32 + 16 * blk) * 2 + 8 * pp, 8 * ML_TP);
                acca = __builtin_amdgcn_mfma_f32_32x32x16_bf16(vf, __builtin_bit_cast(bf16x8, pk), acca, 0, 0, 0);
            }
        }
    }
#pragma unroll
    for (int ks = 0; ks < 4; ++ks) {
        const bf16x8 cf = tr_frag(lds + ML_C + (ks * 16 + 8 * h + q4) * ML_TP + (wd * 32 + 16 * blk) * 2 + 8 * pp, 4 * ML_TP);
        accb = __builtin_amdgcn_mfma_f32_32x32x16_bf16(cf, qf[ks], accb, 0, 0, 0);
    }
    float qn = 0.f;
#pragma unroll
    for (int ks = 0; ks < 4; ++ks) {
        const f32x4 n0 = *(const LAS f32x4*)(nbuf + ks * 16 + 8 * h), n1 = *(const LAS f32x4*)(nbuf + ks * 16 + 8 * h + 4);
        qn += bf2f((bf16_t)qf[ks][0]) * n0.x + bf2f((bf16_t)qf[ks][1]) * n0.y + bf2f((bf16_t)qf[ks][2]) * n0.z + bf2f((bf16_t)qf[ks][3]) * n0.w
            + bf2f((bf16_t)qf[ks][4]) * n1.x + bf2f((bf16_t)qf[ks][5]) * n1.y + bf2f((bf16_t)qf[ks][6]) * n1.z + bf2f((bf16_t)qf[ks][7]) * n1.w;
    }
    qn = half_swap_sum(qn); rs = half_swap_sum(rs);
    const float hden = fmaxf(fabsf(inter * qn + rs), __expf(-(bs_t + Mt_t)));
    const float ihd = 1.0f / hden;
    float ss = 0.f;
#pragma unroll
    for (int e = 0; e < 16; ++e) { acca[e] = (acca[e] + inter * accb[e]) * ihd; ss += acca[e] * acca[e]; }
    ss = half_swap_sum(ss);
    if (h == 0) ssbuf[wd * 64 + tt] = ss;
    __syncthreads();
    {
        const float rstd = rsqrtf((ssbuf[tt] + ssbuf[64 + tt]) * (1.0f / 64.0f) + EPS);
        bf16_t* op = mix + (row0 + tt) * DM + hd * 64 + wd * 32 + 4 * h;
#pragma unroll
        for (int g = 0; g < 4; ++g) {
            const float4 g4 = mgr[g];
            const float o0 = bf2f(opre[g].x & 0xffff), o1 = bf2f(opre[g].x >> 16), o2 = bf2f(opre[g].y & 0xffff), o3 = bf2f(opre[g].y >> 16);
            u32x2 v;
            v.x = pk2(acca[4 * g] * rstd * g4.x * __builtin_amdgcn_rcpf(1.0f + __expf(-o0)), acca[4 * g + 1] * rstd * g4.y * __builtin_amdgcn_rcpf(1.0f + __expf(-o1)));
            v.y = pk2(acca[4 * g + 2] * rstd * g4.z * __builtin_amdgcn_rcpf(1.0f + __expf(-o2)), acca[4 * g + 3] * rstd * g4.w * __builtin_amdgcn_rcpf(1.0f + __expf(-o3)));
            *(u32x2*)(op + 8 * g) = v;
        }
    }
}

constexpr int KP = 144, VP = 192, ATT_K_BYTES = 64 * KP, ATT_BUF = 64 * KP + 64 * VP;
DI void moba_item(const P& p, int l, int item, char* lds_generic) {
    LAS char* lds = (LAS char*)lds_generic;
    const int b = item >> 7, hd = (item >> 4) & 7, qt = item & 15, qb = qt >> 1;
    const int t = tid_(), lane = t & 63, w = t >> 6, r = lane & 31, h = lane >> 5;
    const int i16 = lane & 15, q4 = i16 >> 2, pp = i16 & 3, blk = (lane >> 4) & 1;
    const bf16_t* projb = (const bf16_t*)(p.ws + WS_PROJ);
    bf16_t* mix = (bf16_t*)(p.ws + WS_MIX);
    const float* kmean = (const float*)(p.ws + WS_KMEAN);
    const size_t rowb = (size_t)b * SEQ;
    const int q0 = qt * 128, qpos = q0 + w * 32 + r;
    bf16x8 qf[4];
    {
        const bf16_t* qp = projb + (rowb + qpos) * PJ + C_AQ + hd * 64 + 8 * h;
        u32x4 raw[4];
#pragma unroll
        for (int ks = 0; ks < 4; ++ks) raw[ks] = *(const u32x4*)(qp + ks * 16);
        float x[4][8];
        float ss = 0.f;
#pragma unroll
        for (int ks = 0; ks < 4; ++ks) {
            x[ks][0] = bf2f(raw[ks].x & 0xffff); x[ks][1] = bf2f(raw[ks].x >> 16); x[ks][2] = bf2f(raw[ks].y & 0xffff); x[ks][3] = bf2f(raw[ks].y >> 16);
            x[ks][4] = bf2f(raw[ks].z & 0xffff); x[ks][5] = bf2f(raw[ks].z >> 16); x[ks][6] = bf2f(raw[ks].w & 0xffff); x[ks][7] = bf2f(raw[ks].w >> 16);
#pragma unroll
            for (int j = 0; j < 8; ++j) ss += x[ks][j] * x[ks][j];
        }
        ss = half_swap_sum(ss);
        const float rstd = rsqrtf(ss * (1.0f / 64.0f) + EPS);
        const float* gqp = p.in[8] + l * 64 + 8 * h;
#pragma unroll
        for (int ks = 0; ks < 4; ++ks) {
            const float4 g0 = *(const float4*)(gqp + ks * 16), g1 = *(const float4*)(gqp + ks * 16 + 4);
            x[ks][0] *= rstd * g0.x; x[ks][1] *= rstd * g0.y; x[ks][2] *= rstd * g0.z; x[ks][3] *= rstd * g0.w;
            x[ks][4] *= rstd * g1.x; x[ks][5] *= rstd * g1.y; x[ks][6] *= rstd * g1.z; x[ks][7] *= rstd * g1.w;
        }
#pragma unroll
        for (int j = 0; j < 8; ++j) {
            constexpr double RINV[8] = {0.15915494309189535, 0.03086376340470123, 0.005985185712713705, 0.001160663641240061,
                                        0.00022507907903927653, 4.364795279280289e-05, 8.464330808241401e-06, 1.6414262627950345e-06};
            double rr = (double)qpos * RINV[j];
            rr -= floor(rr);
            const float sn = __builtin_amdgcn_sinf((float)rr), cs = __builtin_amdgcn_cosf((float)rr);
            const float other = __shfl_xor(x[0][j], 32);
            x[0][j] = h == 0 ? x[0][j] * cs - other * sn : x[0][j] * cs + other * sn;
        }
        const float sc = 0.125f * 1.4426950408889634f;
#pragma unroll
        for (int ks = 0; ks < 4; ++ks) {
            u32x4 o; o.x = pk2(x[ks][0] * sc, x[ks][1] * sc); o.y = pk2(x[ks][2] * sc, x[ks][3] * sc); o.z = pk2(x[ks][4] * sc, x[ks][5] * sc); o.w = pk2(x[ks][6] * sc, x[ks][7] * sc);
            qf[ks] = __builtin_bit_cast(bf16x8, o);
        }
    }
    unsigned mask = 0;
    {
        LAS float* kst = (LAS float*)lds;
        {
            const int n_ = t >> 5, hf = (t >> 4) & 1, c4 = t & 15;
            *(LAS f32x4*)(kst + (n_ * 2 + hf) * 64 + c4 * 4) = *(const f32x4*)(kmean + ((size_t)((b * 8 + n_) * 2 + hf) * 8 + hd) * 64 + c4 * 4);
        }
        __syncthreads();
        float gate[8];
#pragma unroll
        for (int n = 0; n < 8; ++n) {
            float sacc = 0.f;
            if (n < qb) {
#pragma unroll
                for (int ks = 0; ks < 4; ++ks) {
                    const LAS float* k0 = kst + (n * 2) * 64 + 8 * h + ks * 16;
                    const f32x4 a0 = *(const LAS f32x4*)(k0), a1 = *(const LAS f32x4*)(k0 + 4), b0 = *(const LAS f32x4*)(k0 + 64), b1 = *(const LAS f32x4*)(k0 + 68);
                    sacc += bf2f((bf16_t)qf[ks][0]) * (a0.x + b0.x) + bf2f((bf16_t)qf[ks][1]) * (a0.y + b0.y) + bf2f((bf16_t)qf[ks][2]) * (a0.z + b0.z) + bf2f((bf16_t)qf[ks][3]) * (a0.w + b0.w)
                          + bf2f((bf16_t)qf[ks][4]) * (a1.x + b1.x) + bf2f((bf16_t)qf[ks][5]) * (a1.y + b1.y) + bf2f((bf16_t)qf[ks][6]) * (a1.z + b1.z) + bf2f((bf16_t)qf[ks][7]) * (a1.w + b1.w);
                }
            }
            gate[n] = half_swap_sum(sacc);
        }
#pragma unroll
        for (int it = 0; it < 3; ++it) {
            int best = -1; float bv = -INFINITY;
#pragma unroll
            for (int n = 0; n < 8; ++n) if (n < qb && !((mask >> n) & 1u) && gate[n] > bv) { bv = gate[n]; best = n; }
            if (best >= 0) mask |= 1u << best;
        }
    }
    const int nown = ((q0 & 255) >> 6) + 2, ntiles = nown + qb * 4;
    f32x16 o0, o1;
#pragma unroll
    for (int e = 0; e < 16; ++e) { o0[e] = 0.f; o1[e] = 0.f; }
    float m = -INFINITY, lsum = 0.f;
    const int srow = t >> 3, sc16 = t & 7;
    struct KVStage { u32x4 k0, k1, v0, v1; };
    auto key0_of = [&](int it) { return it < nown ? qb * 256 + it * 64 : ((it - nown) >> 2) * 256 + ((it - nown) & 3) * 64; };
    auto gload = [&](KVStage& S, int it) {
        const int key0 = key0_of(it < ntiles ? it : ntiles - 1);
        const bf16_t* base = projb + (rowb + key0 + srow) * PJ + hd * 64 + sc16 * 8;
        S.k0 = *(const u32x4*)(base + C_AK); S.k1 = *(const u32x4*)(base + (size_t)32 * PJ + C_AK);
        S.v0 = *(const u32x4*)(base + C_AV); S.v1 = *(const u32x4*)(base + (size_t)32 * PJ + C_AV);
    };
    auto sstore = [&](const KVStage& S, int buf) {
        LAS char* sK = lds + buf * ATT_BUF; LAS char* sV = sK + ATT_K_BYTES;
        *(LAS u32x4*)(sK + srow * KP + sc16 * 16) = S.k0; *(LAS u32x4*)(sK + (srow + 32) * KP + sc16 * 16) = S.k1;
        *(LAS u32x4*)(sV + srow * VP + sc16 * 16) = S.v0; *(LAS u32x4*)(sV + (srow + 32) * VP + sc16 * 16) = S.v1;
    };
    struct CvStage { float4 c0, c1, c2; };
    const int wu = __builtin_amdgcn_readfirstlane(w);
    const int gb = (item >> 4) * 272 + qt * (qt + 1);
    const float* cvg = p.in[28] + ((size_t)l << 24) + lane * 4; const float* cvu = p.in[29] + ((size_t)l << 24) + lane * 4; const float* cvd = p.in[30] + ((size_t)l << 24) + lane * 4;
    bf16_t* cog = (bf16_t*)(p.ws + WS_EXPG) + lane * 4; bf16_t* cou = (bf16_t*)(p.ws + WS_EXPU) + lane * 4; bf16_t* cod = (bf16_t*)(p.ws + WS_EXPD) + lane * 4;
    auto cvoff = [&](int it) { int g = (gb + (it < ntiles ? it : ntiles - 1)) * 4 + wu; g = g < 65536 ? g : g - 4096; return (size_t)g * 256; };
    auto cvload = [&](CvStage& C, int it) { const size_t o = cvoff(it); C.c0 = *(const float4*)(cvg + o); C.c1 = *(const float4*)(cvu + o); C.c2 = *(const float4*)(cvd + o); };
    auto cvstore = [&](const CvStage& C, int it) { const size_t o = cvoff(it); *(u32x2*)(cog + o) = f4_to_bf4(C.c0); *(u32x2*)(cou + o) = f4_to_bf4(C.c1); *(u32x2*)(cod + o) = f4_to_bf4(C.c2); };
    KVStage KA, KB; CvStage CA, CB;
    __syncthreads();
    gload(KA, 0); gload(KB, 1); cvload(CB, 0); sstore(KA, 0); __syncthreads();
    auto step = [&](int it, KVStage& SL, const KVStage& SS, CvStage& CL, const CvStage& CS) {
        gload(SL, it + 2); cvload(CL, it + 1);
        {
            const LAS char* sK = lds + (it & 1) * ATT_BUF; const LAS char* sV = sK + ATT_K_BYTES;
            const int key0 = key0_of(it), blockn = key0 >> 8;
            f32x16 s0, s1;
            const float minit = (it == 0) ? 0.f : -m;
#pragma unroll
            for (int e = 0; e < 16; ++e) { s0[e] = minit; s1[e] = minit; }
#pragma unroll
            for (int ks = 0; ks < 4; ++ks) {
                const bf16x8 k0 = *(const LAS bf16x8*)(sK + r * KP + (ks * 16 + 8 * h) * 2);
                const bf16x8 k1 = *(const LAS bf16x8*)(sK + (32 + r) * KP + (ks * 16 + 8 * h) * 2);
                s0 = __builtin_amdgcn_mfma_f32_32x32x16_bf16(k0, qf[ks], s0, 0, 0, 0);
                s1 = __builtin_amdgcn_mfma_f32_32x32x16_bf16(k1, qf[ks], s1, 0, 0, 0);
            }
            const bool own = (blockn == qb);
            const bool active = own || ((mask >> blockn) & 1u);
            if (!active) {
#pragma unroll
                for (int e = 0; e < 16; ++e) { s0[e] = -INFINITY; s1[e] = -INFINITY; }
            } else if (own && key0 + 63 > q0 + w * 32) {
#pragma unroll
                for (int e = 0; e < 16; ++e) {
                    const int kk = key0 + (e & 3) + 8 * (e >> 2) + 4 * h;
                    if (kk > qpos) s0[e] = -INFINITY;
                    if (kk + 32 > qpos) s1[e] = -INFINITY;
                }
            }
            float mx = fmaxf(fmaxf(s0[0], s1[0]), fmaxf(s0[1], s1[1]));
#pragma unroll
            for (int e = 2; e < 16; e += 2) mx = fmaxf(fmaxf(mx, fmaxf(s0[e], s1[e])), fmaxf(s0[e + 1], s1[e + 1]));
            mx = half_swap_max(mx);
            if (it == 0 || __builtin_amdgcn_ballot_w64(mx > 16.0f) != 0ull) {
                const float d = (it == 0) ? mx : fmaxf(mx, 0.f);
                const float alpha = __builtin_amdgcn_exp2f(-d);
                m = (it == 0) ? d : m + d;
                lsum *= alpha;
#pragma unroll
                for (int e = 0; e < 16; ++e) { s0[e] -= d; s1[e] -= d; o0[e] *= alpha; o1[e] *= alpha; }
            }
            float ps = 0.f;
#pragma unroll
            for (int e = 0; e < 16; ++e) { s0[e] = __builtin_amdgcn_exp2f(s0[e]); s1[e] = __builtin_amdgcn_exp2f(s1[e]); ps += s0[e] + s1[e]; }
            lsum += ps;
#pragma unroll
            for (int st = 0; st < 2; ++st)
#pragma unroll
                for (int sk = 0; sk < 2; ++sk) {
                    u32x4 pk;
                    if (st == 0) { pk.x = pk2(s0[8 * sk], s0[8 * sk + 1]); pk.y = pk2(s0[8 * sk + 2], s0[8 * sk + 3]); pk.z = pk2(s0[8 * sk + 4], s0[8 * sk + 5]); pk.w = pk2(s0[8 * sk + 6], s0[8 * sk + 7]); }
                    else         { pk.x = pk2(s1[8 * sk], s1[8 * sk + 1]); pk.y = pk2(s1[8 * sk + 2], s1[8 * sk + 3]); pk.z = pk2(s1[8 * sk + 4], s1[8 * sk + 5]); pk.w = pk2(s1[8 * sk + 6], s1[8 * sk + 7]); }
                    const bf16x8 pf = __builtin_bit_cast(bf16x8, pk);
                    const LAS char* vb = sV + (st * 32 + sk * 16 + 4 * h + q4) * VP + (16 * blk) * 2 + 8 * pp;
                    {
                        s16x4 lo = tr_read(vb), hi = tr_read(vb + 8 * VP);
                        const bf16x8 vf = __builtin_shufflevector(lo, hi, 0, 1, 2, 3, 4, 5, 6, 7);
                        o0 = __builtin_amdgcn_mfma_f32_32x32x16_bf16(vf, pf, o0, 0, 0, 0);
                    }
                    {
                        s16x4 lo = tr_read(vb + 64), hi = tr_read(vb + 64 + 8 * VP);
                        const bf16x8 vf = __builtin_shufflevector(lo, hi, 0, 1, 2, 3, 4, 5, 6, 7);
                        o1 = __builtin_amdgcn_mfma_f32_32x32x16_bf16(vf, pf, o1, 0, 0, 0);
                    }
                }
        }
        sstore(SS, (it + 1) & 1); cvstore(CS, it);
        lds_barrier();
    };
    for (int it = 0; it < ntiles; it += 2) { step(it, KA, KB, CA, CB); if (it + 1 < ntiles) step(it + 1, KB, KA, CB, CA); }
    const float il = 1.0f / half_swap_sum(lsum);
    float ss = 0.f;
#pragma unroll
    for (int e = 0; e < 16; ++e) { o0[e] *= il; o1[e] *= il; ss += o0[e] * o0[e] + o1[e] * o1[e]; }
    ss = half_swap_sum(ss);
    const float rstd = rsqrtf(ss * (1.0f / 64.0f) + EPS);
    const float* og = p.in[10] + (l * 8 + hd) * 64 + 4 * h;
    LAS char* stg = lds + 2 * ATT_BUF + w * (32 * 144);
#pragma unroll
    for (int g = 0; g < 4; ++g) {
        const float4 g0 = *(const float4*)(og + 8 * g), g1 = *(const float4*)(og + 32 + 8 * g);
        u32x2 v0, v1;
        v0.x = pk2(o0[4 * g] * rstd * g0.x, o0[4 * g + 1] * rstd * g0.y); v0.y = pk2(o0[4 * g + 2] * rstd * g0.z, o0[4 * g + 3] * rstd * g0.w);
        v1.x = pk2(o1[4 * g] * rstd * g1.x, o1[4 * g + 1] * rstd * g1.y); v1.y = pk2(o1[4 * g + 2] * rstd * g1.z, o1[4 * g + 3] * rstd * g1.w);
        *(LAS u32x2*)(stg + r * 144 + (4 * h + 8 * g) * 2) = v0; *(LAS u32x2*)(stg + r * 144 + (32 + 4 * h + 8 * g) * 2) = v1;
    }
    asm volatile("s_waitcnt lgkmcnt(0)" ::: "memory");
#pragma unroll
    for (int i = 0; i < 4; ++i) {
        const int c = lane + 64 * i, rw = c >> 3, ch = c & 7;
        *(u32x4*)(mix + (rowb + q0 + w * 32 + rw) * DM + 256 + hd * 64 + ch * 8) = *(const LAS u32x4*)(stg + rw * 144 + ch * 16);
    }
}

DI void s5_item(const P& p, int l, int item, char* lds) {
    const int b = item >> 4, g = item & 15, lg = l * 16 + g;
    const int t = tid_();
    const bf16_t* projb = (const bf16_t*)(p.ws + WS_PROJ);
    bf16_t* zbuf = (bf16_t*)(p.ws + WS_ZBUF);
    const float* Tg = (const float*)(p.ws + WS_S5M + (size_t)l * S5M_LAYER) + (size_t)g * 256 * 256;
    const float* Eg = (const float*)(p.ws + WS_S5M + (size_t)l * S5M_LAYER + S5M_E) + (size_t)g * 256 * 128;
    const float* Fg = (const float*)(p.ws + WS_S5M + (size_t)l * S5M_LAYER + S5M_F) + (size_t)g * 128 * 256;
    float* eloc = (float*)(p.ws + WS_ELOC) + ((size_t)l * 128 + item) * 128 * 128;
    bf16_t* carr = (bf16_t*)(p.ws + WS_CARR) + ((size_t)l * 128 + item) * 128 * 128;
    const size_t rowb = (size_t)b * SEQ;
    const bf16_t* ua0 = projb + (rowb + (size_t)(t >> 2) * 16 + ((t & 3) >> 1)) * PJ + C_SU + g * 16 + (t & 1) * 8;
    const bf16_t* ua1 = ua0 + (size_t)64 * 16 * PJ;
    {
        GSeg g1{ua0, ua1, 2 * PJ, Eg + (size_t)(t >> 5) * 128 + (t & 31) * 4, 128, 8}; GSeg g2 = g1; g2.KT = 0;
        EpiF32 epi{eloc, 128};
        gemm_tile2(g1, g2, lds, epi);
    }
    __syncthreads();
    if (t < 64) {
        const float lr = p.in[11][lg * 64 + t], li = p.in[12][lg * 64 + t], dt = expf(p.in[18][lg]);
        const float mag = expf(lr * dt * 16.0f), ar = mag * cosf(li * dt * 16.0f), ai = mag * sinf(li * dt * 16.0f);
        float sr = 0.f, si = 0.f;
        for (int bt = 0; bt < 8; ++bt) {
            float er[16], ei[16];
#pragma unroll
            for (int i = 0; i < 16; ++i) { er[i] = eloc[(size_t)(bt * 16 + i) * 128 + t]; ei[i] = eloc[(size_t)(bt * 16 + i) * 128 + 64 + t]; }
#pragma unroll
            for (int i = 0; i < 16; ++i) {
                carr[(size_t)(bt * 16 + i) * 128 + t] = f2bf(sr); carr[(size_t)(bt * 16 + i) * 128 + 64 + t] = f2bf(si);
                const float nr = ar * sr - ai * si + er[i], ni = ar * si + ai * sr + ei[i];
                sr = nr; si = ni;
            }
        }
    }
    __syncthreads();
    const bf16_t* ca0 = carr + (size_t)(t >> 2) * 128 + (t & 3) * 8;
#pragma unroll 1
    for (int nt = 0; nt < 2; ++nt) {
        GSeg g1{ua0, ua1, 2 * PJ, Tg + (size_t)(t >> 5) * 256 + nt * 128 + (t & 31) * 4, 256, 4 * (nt + 1)};
        GSeg g2{ca0, ca0 + (size_t)64 * 128, BK, Fg + (size_t)(t >> 5) * 256 + nt * 128 + (t & 31) * 4, 256, 4};
        EpiS5Y epi{zbuf + rowb * 256 + g * 16, nt * 128};
        gemm_tile2(g1, g2, lds, epi);
    }
}

DI void phase_mix(const P& p, int l, char* lds, unsigned long long& tsub) {
    const int b = bid_();
    if (gridDim.x == 512) {
        const int ty = b >> 6, bh = b & 63;
        constexpr unsigned long long TA = 0x007ull | (0x006ull << 12) | (0x08Eull << 24) | (0x09Dull << 36);
        constexpr unsigned long long TB = 0x01Full | (0x04Cull << 12) | (0x05Bull << 24) | (0x23Aull << 36);
        constexpr unsigned NC = 1u | (2u << 2) | (2u << 4) | (2u << 6) | (2u << 8) | (2u << 10) | (2u << 12) | (3u << 14);
        const unsigned qts = (unsigned)((ty < 4 ? TA >> (12 * ty) : TB >> (12 * (ty - 4))) & 0xFFFull);
        const int nq = (NC >> (2 * ty)) & 3;
        if (ty < 2) {
            const unsigned long long ts0 = PROBE_SUB ? wall_clock64() : 0ull;
            s5_item(p, l, b, lds);
            if (PROBE_SUB & 2) tsub += wall_clock64() - ts0;
        }
        {
            const unsigned long long ts0 = PROBE_SUB ? wall_clock64() : 0ull;
#pragma unroll 1
            for (int k = 0; k < nq; ++k) moba_item(p, l, (bh << 4) | ((qts >> (4 * k)) & 15), lds);
            if (PROBE_SUB & 4) tsub += wall_clock64() - ts0;
        }
        {
            const unsigned long long ts0 = PROBE_SUB ? wall_clock64() : 0ull;
            const int ns = (0x02013244u >> (4 * ty)) & 15, sb = (0xEEEDA840u >> (4 * ty)) & 15;
#pragma unroll 1
            for (int k = 0; k < ns; ++k) mlstm_state_item(p, l, (sb + k) * 64 + bh, lds);
            if (PROBE_SUB & 1) tsub += wall_clock64() - ts0;
        }
        return;
    }
    for (int item = b; item < 128 + 1024 + 1024; item += gridDim.x) {
        if (item >= 1152) mlstm_state_item(p, l, item - 1152, lds);
        else if (item < 128) s5_item(p, l, item, lds);
        else {
            const int i2 = item - 128;
            const int qo = i2 >> 6, bh = i2 & 63;
            moba_item(p, l, (bh << 4) | (15 - qo), lds);
        }
    }
}

DI void phase_glu(const P& p, int l, char* lds) {
    const int t = tid_();
    const bf16_t* zb = (const bf16_t*)(p.ws + WS_ZBUF);
    bf16_t* mix = (bf16_t*)(p.ws + WS_MIX);
    const float* gw = p.in[19] + (size_t)l * 256 * 256; const float* gb = p.in[20] + l * 256; const float* sg = p.in[21] + l * 256;
    for (int wi = bid_(); wi < 256 + 1024; wi += gridDim.x) {
      if (wi < 256) {
        const int tile = wi;
        const int mt = tile >> 1, nt = tile & 1;
        const bf16_t* a0 = zb + (size_t)(mt * 128 + (t >> 2)) * 256 + (t & 3) * 8;
        const float* b0 = gw + (size_t)(t >> 5) * 256 + nt * 128 + (t & 31) * 4;
        EpiGlu epi{zb + (size_t)mt * 128 * 256 + nt * 128, mix + (size_t)mt * 128 * DM + 768 + nt * 128, gb + nt * 128, sg + nt * 128};
        gemm_tile(a0, a0 + (size_t)64 * 256, b0, 256, 256 / BK, lds, epi);
      } else {
        const int item = wi - 256;
        mlstm_out_item(p, l, ((item & 31) << 5) | (31 - (item >> 5)), lds);
      }
    }
}

DI void phase_outproj(const P& p, int l, char* lds) {
    const int t = tid_();
    const bf16_t* mix = (const bf16_t*)(p.ws + WS_MIX);
    bf16_t* xres = (bf16_t*)(p.ws + WS_XRES);
    const bf16_t* woutb = (const bf16_t*)(p.ws + WS_WOUTB) + (size_t)l * DM * DM;
    const int vx = bid_() & 7, vj = bid_() >> 3, nj = (gridDim.x - vx + 7) >> 3;
    for (int j = vj; j < 64; j += nj) {
        const int mt = vx * 16 + (j >> 2), nt = j & 3;
        const bf16_t* ar = mix + (size_t)(mt * 128 + (t >> 2)) * DM + (t & 3) * 8;
        GSeg4 g1{ar, ar + (size_t)64 * DM, 32, woutb + (size_t)(t >> 5) * DM + nt * 256 + (t & 31) * 8, DM, DM / 32}; GSeg4 g2 = g1; g2.KT = 0;
        const size_t o = (size_t)mt * 128 * DM + nt * 256;
        Epi4Resid epi{xres + o, l == 0 ? p.in[0] + o : nullptr, xres + o, (size_t)DM, lds};
        gemm4(g1, g2, lds, epi);
    }
}

DI void phase_norm2(const P& p, int l, char* lds) {
    const int t = tid_(), lane = t & 63, w = t >> 6, nb = gridDim.x, myb = bid_();
    const bf16_t* xres = (const bf16_t*)(p.ws + WS_XRES);
    bf16_t* hbuf = (bf16_t*)(p.ws + WS_HBUF);
    const float* g2 = p.in[23] + l * DM;
    const float* wg = p.in[24] + (size_t)l * DM * 4; const float* bg = p.in[25] + l * 4;
    const float* we = p.in[26] + (size_t)l * DM * NE; const float* be = p.in[27] + l * NE;
    int4* rinfo = (int4*)(p.ws + WS_RINFO); int* hist = (int*)(p.ws + WS_HIST);
    int* lh = (int*)(lds + 65536 - 16 - 128);
    constexpr int XP = 132;
    float* xs = (float*)lds;
    float* wb = xs + 32 * XP;
    float* rstd_s = wb + 128 * 48;
    const int nit_all = (T / 8 - myb + nb - 1) / nb;
    __syncthreads();
    if (t < NE) lh[t] = 0;
    for (int it0 = 0; it0 < nit_all; it0 += 4) {
    const int nit = nit_all - it0 < 4 ? nit_all - it0 : 4;
    auto grow = [&](int lr) { return (size_t)((myb + (it0 + (lr >> 3)) * nb) * 8 + (lr & 7)); };
    __syncthreads();
    if (w < nit) {
        float4 cur[4], nxt[4], gq[4];
#pragma unroll
        for (int i = 0; i < 4; ++i) gq[i] = *(const float4*)(g2 + i * 256 + lane * 4);
#pragma unroll
        for (int i = 0; i < 4; ++i) cur[i] = bf4_to_f4(*(const u32x2*)(xres + grow(w * 8) * DM + i * 256 + lane * 4));
#pragma unroll
        for (int j = 0; j < 8; ++j) {
            const size_t row = grow(w * 8 + j);
            if (j < 7) {
#pragma unroll
                for (int i = 0; i < 4; ++i) nxt[i] = bf4_to_f4(*(const u32x2*)(xres + grow(w * 8 + j + 1) * DM + i * 256 + lane * 4));
            }
            float ss = 0.f;
#pragma unroll
            for (int i = 0; i < 4; ++i) ss += cur[i].x * cur[i].x + cur[i].y * cur[i].y + cur[i].z * cur[i].z + cur[i].w * cur[i].w;
            ss = wave_sum(ss);
            const float rstd = rsqrtf(ss * (1.0f / DM) + EPS);
            if (lane == 0) rstd_s[w * 8 + j] = rstd;
#pragma unroll
            for (int i = 0; i < 4; ++i) {
                const int k0 = i * 256 + lane * 4;
                const float4 g = gq[i];
                uint2 o; o.x = pk2(cur[i].x * rstd * g.x, cur[i].y * rstd * g.y); o.y = pk2(cur[i].z * rstd * g.z, cur[i].w * rstd * g.w);
                *(uint2*)(hbuf + row * DM + k0) = o;
                cur[i] = nxt[i];
            }
        }
    }
    __syncthreads();
    const int kq = lane >> 4, jc = lane & 15, xr0 = t >> 5, xk4 = (t & 31) * 4;
    f32x4 d[2][3];
#pragma unroll
    for (int a_ = 0; a_ < 2; ++a_)
#pragma unroll
        for (int c_ = 0; c_ < 3; ++c_) d[a_][c_] = (f32x4){0.f, 0.f, 0.f, 0.f};
    const float* wep = we + t * 4; const float* wgp = wg + (t & 127) * 4;
    const bf16_t* xp0 = xres + grow(xr0 < nit * 8 ? xr0 : 0) * DM + xk4;
    const bf16_t* xp1 = xres + grow(xr0 + 8 < nit * 8 ? xr0 + 8 : 0) * DM + xk4;
    const bf16_t* xp2 = xres + grow(xr0 + 16 < nit * 8 ? xr0 + 16 : 0) * DM + xk4;
    const bf16_t* xp3 = xres + grow(xr0 + 24 < nit * 8 ? xr0 + 24 : 0) * DM + xk4;
    const float rs0 = rstd_s[xr0], rs1 = rstd_s[xr0 + 8], rs2 = rstd_s[xr0 + 16], rs3 = rstd_s[xr0 + 24];
    float4 re0 = *(const float4*)(wep), re1 = *(const float4*)(wep + 1024), re2 = *(const float4*)(wep + 2048), re3 = *(const float4*)(wep + 3072);
    float4 rg = *(const float4*)(wgp);
    u32x2 ux0 = *(const u32x2*)xp0, ux1 = *(const u32x2*)xp1, ux2 = *(const u32x2*)xp2, ux3 = *(const u32x2*)xp3; float4 gg = *(const float4*)(g2 + xk4);
#pragma unroll 1
    for (int c = 0; c < 8; ++c) {
        {
            const int e0 = t * 4;
#pragma unroll
            for (int i = 0; i < 4; ++i) {
                const int e = e0 + i * 1024, kk = e >> 5, jj = e & 31;
                *(float4*)(wb + kk * 48 + jj) = (i == 0 ? re0 : i == 1 ? re1 : i == 2 ? re2 : re3);
            }
            if (t < 128) *(float4*)(wb + t * 48 + 32) = rg;
            const float4 x0 = bf4_to_f4(ux0), x1 = bf4_to_f4(ux1), x2 = bf4_to_f4(ux2), x3 = bf4_to_f4(ux3);
            float4 y;
            y.x = x0.x * rs0 * gg.x; y.y = x0.y * rs0 * gg.y; y.z = x0.z * rs0 * gg.z; y.w = x0.w * rs0 * gg.w; *(float4*)(xs + xr0 * XP + xk4) = y;
            y.x = x1.x * rs1 * gg.x; y.y = x1.y * rs1 * gg.y; y.z = x1.z * rs1 * gg.z; y.w = x1.w * rs1 * gg.w; *(float4*)(xs + (xr0 + 8) * XP + xk4) = y;
            y.x = x2.x * rs2 * gg.x; y.y = x2.y * rs2 * gg.y; y.z = x2.z * rs2 * gg.z; y.w = x2.w * rs2 * gg.w; *(float4*)(xs + (xr0 + 16) * XP + xk4) = y;
            y.x = x3.x * rs3 * gg.x; y.y = x3.y * rs3 * gg.y; y.z = x3.z * rs3 * gg.z; y.w = x3.w * rs3 * gg.w; *(float4*)(xs + (xr0 + 24) * XP + xk4) = y;
        }
        lds_barrier();
        {
            const int cn = c + 1 < 8 ? c + 1 : 7;
            const float* q = wep + (size_t)cn * 4096;
            re0 = *(const float4*)(q); re1 = *(const float4*)(q + 1024); re2 = *(const float4*)(q + 2048); re3 = *(const float4*)(q + 3072);
            rg = *(const float4*)(wgp + (size_t)cn * 512);
            ux0 = *(const u32x2*)(xp0 + cn * 128); ux1 = *(const u32x2*)(xp1 + cn * 128); ux2 = *(const u32x2*)(xp2 + cn * 128); ux3 = *(const u32x2*)(xp3 + cn * 128);
            gg = *(const float4*)(g2 + cn * 128 + xk4);
        }
        const float* xa = xs + (lane & 15) * XP + w * 32 + kq;
        const float* wbp = wb + (w * 32 + kq) * 48 + jc;
#pragma unroll
        for (int ks = 0; ks < 8; ++ks) {
            const float a0 = xa[ks * 4], a1 = xa[16 * XP + ks * 4];
            const float b0 = wbp[ks * 4 * 48], b1 = wbp[ks * 4 * 48 + 16], b2 = wbp[ks * 4 * 48 + 32];
            d[0][0] = __builtin_amdgcn_mfma_f32_16x16x4f32(a0, b0, d[0][0], 0, 0, 0);
            d[0][1] = __builtin_amdgcn_mfma_f32_16x16x4f32(a0, b1, d[0][1], 0, 0, 0);
            d[0][2] = __builtin_amdgcn_mfma_f32_16x16x4f32(a0, b2, d[0][2], 0, 0, 0);
            d[1][0] = __builtin_amdgcn_mfma_f32_16x16x4f32(a1, b0, d[1][0], 0, 0, 0);
            d[1][1] = __builtin_amdgcn_mfma_f32_16x16x4f32(a1, b1, d[1][1], 0, 0, 0);
            d[1][2] = __builtin_amdgcn_mfma_f32_16x16x4f32(a1, b2, d[1][2], 0, 0, 0);
        }
        lds_barrier();
    }
    float* pe = wb;
#pragma unroll
    for (int rt = 0; rt < 2; ++rt)
#pragma unroll
        for (int rg_ = 0; rg_ < 4; ++rg_) {
            const int row = rt * 16 + 4 * kq + rg_;
            pe[(w * 32 + row) * 48 + jc] = d[rt][0][rg_]; pe[(w * 32 + row) * 48 + 16 + jc] = d[rt][1][rg_]; pe[(w * 32 + row) * 48 + 32 + jc] = d[rt][2][rg_];
        }
    lds_barrier();
    if (t < nit * 8) {
        const size_t row = grow(t);
        float gl[4];
#pragma unroll
        for (int j = 0; j < 4; ++j) gl[j] = bg[j] + ((pe[(0 * 32 + t) * 48 + 32 + j] + pe[(1 * 32 + t) * 48 + 32 + j]) + (pe[(2 * 32 + t) * 48 + 32 + j] + pe[(3 * 32 + t) * 48 + 32 + j]));
        int gs = 0; float gm = gl[0];
#pragma unroll
        for (int j = 1; j < 4; ++j) if (gl[j] > gm) { gm = gl[j]; gs = j; }
        float se = 0.f;
#pragma unroll
        for (int j = 0; j < 4; ++j) se += expf(gl[j] - gm);
        const float pgv = 1.0f / se;
        float ev[8];
#pragma unroll
        for (int j = 0; j < 8; ++j) { const int cj = gs * 8 + j; ev[j] = be[cj] + ((pe[(0 * 32 + t) * 48 + cj] + pe[(1 * 32 + t) * 48 + cj]) + (pe[(2 * 32 + t) * 48 + cj] + pe[(3 * 32 + t) * 48 + cj])); }
        int i1 = 0; float v1 = ev[0];
#pragma unroll
        for (int j = 1; j < 8; ++j) if (ev[j] > v1) { v1 = ev[j]; i1 = j; }
        int i2 = (i1 + 1) & 7; float v2 = -INFINITY;
#pragma unroll
        for (int j = 0; j < 8; ++j) if (j != i1 && ev[j] > v2) { v2 = ev[j]; i2 = j; }
        const float ex = expf(v2 - v1);
        const float w1 = pgv / (1.0f + ex), w2 = pgv * ex / (1.0f + ex);
        const int e1 = gs * 8 + i1, e2 = gs * 8 + i2;
        atomicAdd(&lh[e1], 1); atomicAdd(&lh[e2], 1);
        rinfo[row] = make_int4(e1, e2, __float_as_int(w1), __float_as_int(w2));
    }
    }
    __syncthreads();
    if (t < NE) hist[((size_t)l * 1024 + myb) * NE + t] = lh[t];
}

DI void phase_assign(const P& p, int l, char* lds) {
    const int t = tid_(), myb = bid_(), nb = gridDim.x;
    const int* hist = (const int*)(p.ws + WS_HIST) + (size_t)l * 1024 * NE;
    const int4* rinfo = (const int4*)(p.ws + WS_RINFO);
    int* cnt = (int*)(p.ws + WS_CTL) + l * NE;
    int* tokl = (int*)(p.ws + WS_TOKL); float* wl = (float*)(p.ws + WS_WL); int4* tinfo = (int4*)(p.ws + WS_TINFO);
    int* part = (int*)lds;
    int* pre = part + 512;
    int* le1 = pre + 32;
    int* le2 = le1 + 64;
    {
        const int e4 = t & 7;
        int tot[4] = {0, 0, 0, 0}, pr[4] = {0, 0, 0, 0};
        const int4* h4 = (const int4*)hist;
        for (int base = 0; base < nb * 8; base += 256 * 16) {
            int4 v[16];
#pragma unroll
            for (int i = 0; i < 16; ++i) { const int idx = base + t + 256 * i; v[i] = idx < nb * 8 ? h4[idx] : make_int4(0, 0, 0, 0); }
#pragma unroll
            for (int i = 0; i < 16; ++i) {
                const int bb = (base + t + 256 * i) >> 3; const int m = bb < myb ? 1 : 0;
                tot[0] += v[i].x; tot[1] += v[i].y; tot[2] += v[i].z; tot[3] += v[i].w;
                pr[0] += m * v[i].x; pr[1] += m * v[i].y; pr[2] += m * v[i].z; pr[3] += m * v[i].w;
            }
        }
#pragma unroll
        for (int j = 0; j < 4; ++j) {
#pragma unroll
            for (int o = 8; o < 64; o <<= 1) { tot[j] += __shfl_xor(tot[j], o); pr[j] += __shfl_xor(pr[j], o); }
        }
        const int wv = t >> 6;
        if ((t & 63) < 8) {
#pragma unroll
            for (int j = 0; j < 4; ++j) { part[wv * 32 + e4 * 4 + j] = pr[j]; part[256 + wv * 32 + e4 * 4 + j] = tot[j]; }
        }
    }
    __syncthreads();
    if (t < 32) {
        int a = 0, tot = 0;
#pragma unroll
        for (int q = 0; q < 4; ++q) { a += part[q * 32 + t]; tot += part[256 + q * 32 + t]; }
        pre[t] = a;
        if (myb == 0) cnt[t] = tot;
    }
    const int nit = (T / 8 - myb + nb - 1) / nb;
    int4 ri = make_int4(0, 0, 0, 0); int row = -1;
    if (t < nit * 8 && t < 64) { row = (myb + (t >> 3) * nb) * 8 + (t & 7); ri = rinfo[row]; le1[t] = ri.x; le2[t] = ri.y; }
    __syncthreads();
    if (row >= 0) {
        int r1 = 0, r2 = 0;
        for (int j = 0; j < t; ++j) { const int a = le1[j], b2 = le2[j]; r1 += (a == ri.x) + (b2 == ri.x); r2 += (a == ri.y) + (b2 == ri.y); }
        const int s1 = pre[ri.x] + r1, s2 = pre[ri.y] + r2;
        tokl[ri.x * ECAP + s1] = row; wl[ri.x * ECAP + s1] = __int_as_float(ri.z);
        tokl[ri.y * ECAP + s2] = row; wl[ri.y * ECAP + s2] = __int_as_float(ri.w);
        tinfo[row] = make_int4(ri.x, s1, ri.y, s2);
    }
}

DI void phase_moe1(const P& p, int l, char* lds) {
    const int t = tid_();
    const bf16_t* hbuf = (const bf16_t*)(p.ws + WS_HBUF);
    bf16_t* hmoe = (bf16_t*)(p.ws + WS_HMOE);
    const int* cnt = (const int*)(p.ws + WS_CTL) + l * NE;
    const int* tokl = (const int*)(p.ws + WS_TOKL);
    int* stp = (int*)(lds + G6_LDS);
    moe_prefix(cnt, stp);
    const int vx = bid_() & 7, vj = bid_() >> 3, nj = (gridDim.x - vx + 7) >> 3;
    int tx[5]; tx[0] = 0;
#pragma unroll
    for (int i = 0; i < 4; ++i) tx[i + 1] = tx[i] + (stp[vx + 8 * i + 1] - stp[vx + 8 * i]) * 8;
    auto build = [&](int tile, GSeg6& g, bf16_t*& outp) {
        const int ei = (tile >= tx[1]) + (tile >= tx[2]) + (tile >= tx[3]);
        const int e = vx + 8 * ei, tbase = ei == 0 ? 0 : (ei == 1 ? tx[1] : (ei == 2 ? tx[2] : tx[3]));
        const int te = stp[e + 1] - stp[e], local = tile - tbase, nt = local / te, mt = local % te;
        const int ne = cnt[e];
        const int i0 = mt * MOE_BM + (t >> 2), i1 = i0 + 64, i2 = i0 + 128;
        const int tok0 = tokl[e * ECAP + (i0 < ne ? i0 : 0)], tok1 = tokl[e * ECAP + (i1 < ne ? i1 : 0)], tok2 = tokl[e * ECAP + (i2 < ne ? i2 : 0)];
        const int vcol = (t & 15) * 8, wn = vcol >> 6, tn = (vcol >> 5) & 1, rr = vcol & 31;
        const bf16_t* wsrc = (const bf16_t*)(p.ws + (tn ? WS_EXPU : WS_EXPG)) + (size_t)e * DM * DE;
        g.a0 = hbuf + (size_t)tok0 * DM + (t & 3) * 8; g.a1 = hbuf + (size_t)tok1 * DM + (t & 3) * 8; g.a2 = hbuf + (size_t)tok2 * DM + (t & 3) * 8;
        g.b0 = wsrc + (size_t)(t >> 4) * DE + nt * 64 + wn * 32 + rr; g.ldb = DE; g.KT = DM / BK;
        outp = hmoe + (size_t)(stp[e] + mt) * MOE_BM * DE + nt * 64;
    };
    Pre6 pre; pre.valid = false;
    for (int tile = vj; tile < tx[4]; tile += nj) {
        GSeg6 g1, g2; bf16_t* o1; bf16_t* o2;
        build(tile, g1, o1);
        const bool hasn = tile + nj < tx[4];
        build(hasn ? tile + nj : tile, g2, o2);
        Epi6GateUp epi{o1, lds};
        gemm6(g1, g2, hasn, pre, lds, epi);
    }
}

DI void phase_moe2(const P& p, int l, char* lds) {
    const int t = tid_();
    const bf16_t* hmoe = (const bf16_t*)(p.ws + WS_HMOE);
    bf16_t* ymoe = (bf16_t*)(p.ws + WS_YMOE);
    const int* cnt = (const int*)(p.ws + WS_CTL) + l * NE;
    const float* wl = (const float*)(p.ws + WS_WL);
    int* stp = (int*)(lds + G6_LDS);
    moe_prefix(cnt, stp);
    const int vx = bid_() & 7, vj = bid_() >> 3, nj = (gridDim.x - vx + 7) >> 3;
    int tx[5]; tx[0] = 0;
#pragma unroll
    for (int i = 0; i < 4; ++i) tx[i + 1] = tx[i] + (stp[vx + 8 * i + 1] - stp[vx + 8 * i]) * 8;
    auto build = [&](int tile, GSeg6& g, Epi6Down& ep) {
        const int ei = (tile >= tx[1]) + (tile >= tx[2]) + (tile >= tx[3]);
        const int e = vx + 8 * ei, tbase = ei == 0 ? 0 : (ei == 1 ? tx[1] : (ei == 2 ? tx[2] : tx[3]));
        const int te = stp[e + 1] - stp[e], local = tile - tbase, nt = local / te, mt = local % te;
        const int ne = cnt[e];
        const size_t r0 = (size_t)(stp[e] + mt) * MOE_BM;
        const bf16_t* a0 = hmoe + (r0 + (t >> 2)) * DE + (t & 3) * 8;
        g.a0 = a0; g.a1 = a0 + (size_t)64 * DE; g.a2 = a0 + (size_t)128 * DE;
        g.b0 = (const bf16_t*)(p.ws + WS_EXPD) + (size_t)e * DE * DM + (size_t)(t >> 4) * DM + nt * 128 + (t & 15) * 8; g.ldb = DM; g.KT = DE / BK;
        ep.out = ymoe + r0 * DM + nt * 128; ep.roww = wl + e * ECAP + mt * MOE_BM; ep.nvalid = ne - mt * MOE_BM; ep.lds_generic = lds;
    };
    Pre6 pre; pre.valid = false;
    for (int tile = vj; tile < tx[4]; tile += nj) {
        GSeg6 g1, g2; Epi6Down e1, e2;
        build(tile, g1, e1);
        const bool hasn = tile + nj < tx[4];
        build(hasn ? tile + nj : tile, g2, e2);
        gemm6(g1, g2, hasn, pre, lds, e1);
    }
}

DI void phase_final(const P& p, char* lds) {
    const int lane = tid_() & 63;
    const int gw = bid_() * 4 + (tid_() >> 6), nw = gridDim.x * 4;
    const bf16_t* xres = (const bf16_t*)(p.ws + WS_XRES);
    const bf16_t* ymoe = (const bf16_t*)(p.ws + WS_YMOE);
    const int4* tinfo = (const int4*)(p.ws + WS_TINFO);
    int* stp = (int*)lds;
    moe_prefix((const int*)(p.ws + WS_CTL) + NE, stp);
    for (int row = gw; row < T; row += nw) {
        int4 ti = tinfo[row];
        const bf16_t* y0 = ymoe + (size_t)(stp[ti.x] * MOE_BM + ti.y) * DM;
        const bf16_t* y1 = ymoe + (size_t)(stp[ti.z] * MOE_BM + ti.w) * DM;
#pragma unroll
        for (int i = 0; i < 4; ++i) {
            float4 v = bf4_to_f4(*(const u32x2*)(xres + (size_t)row * DM + i * 256 + lane * 4));
            uint2 a = *(const uint2*)(y0 + i * 256 + lane * 4), b = *(const uint2*)(y1 + i * 256 + lane * 4);
            v.x += bf2f(a.x & 0xffff) + bf2f(b.x & 0xffff); v.y += bf2f(a.x >> 16) + bf2f(b.x >> 16);
            v.z += bf2f(a.y & 0xffff) + bf2f(b.y & 0xffff); v.w += bf2f(a.y >> 16) + bf2f(b.y >> 16);
            *(float4*)(p.out + (size_t)row * DM + i * 256 + lane * 4) = v;
        }
    }
}

#define XB_TMO      128
#define XB_XCNT(j)  (256  + 64 * (j))
#define XB_XSUB(j)  (1280 + 64 * (j))
#define XB_XGEN(j)  (2304 + 64 * (j))
#define XB_TOP      3328
#define XB_TOPGEN   3392
#define XCD_BAR_WORDS 3456
#define XB_SPIN_CAP (1u << 18)

__device__ __forceinline__ unsigned xb_ld(unsigned* p)              { return __hip_atomic_load(p, __ATOMIC_RELAXED, __HIP_MEMORY_SCOPE_AGENT); }
__device__ __forceinline__ unsigned xb_add(unsigned* p, unsigned v) { return __hip_atomic_fetch_add(p, v, __ATOMIC_RELAXED, __HIP_MEMORY_SCOPE_AGENT); }
__device__ __forceinline__ unsigned xb_xcc_id() { return (unsigned)__builtin_amdgcn_s_getreg((3 << 11) | 20) & 0xFu; }
#define XB_SPIN(cond, bar) do { unsigned _sp = 0; while (cond) { __builtin_amdgcn_s_sleep(1); \
    if ((++_sp & 255u) == 0u) { if (xb_ld(&(bar)[XB_TMO])) break; if (_sp > XB_SPIN_CAP) { atomicAdd(&(bar)[XB_TMO], 1u); break; } } } } while (0)

struct XcdBarrier {
    unsigned* bar; unsigned x;
    volatile LAS unsigned* st;
};

__device__ __forceinline__ XcdBarrier xcd_barrier_post(unsigned* bar, volatile LAS unsigned* st) {
    XcdBarrier b; b.bar = bar; b.x = xb_xcc_id(); b.st = st;
    if (threadIdx.x == 0) (void)xb_add(&bar[XB_XCNT(b.x)], 1u);
    return b;
}
__device__ __forceinline__ void xcd_barrier_complete(unsigned* bar, unsigned x, unsigned& nloc, unsigned& nx) {
    const unsigned G = gridDim.x * gridDim.y * gridDim.z;
    unsigned sum, cnt, mine, sp = 0u;
    for (;;) {
        sum = 0u; cnt = 0u; mine = 0u;
#pragma unroll
        for (unsigned j = 0; j < 16; ++j) { const unsigned c = xb_ld(&bar[XB_XCNT(j)]); sum += c; cnt += (c > 0u) ? 1u : 0u; mine = (j == x) ? c : mine; }
        if (sum == G) break;
        __builtin_amdgcn_s_sleep(1);
        if ((++sp & 255u) == 0u) { if (xb_ld(&bar[XB_TMO])) break; if (sp > XB_SPIN_CAP) { atomicAdd(&bar[XB_TMO], 1u); break; } }
    }
    nloc = mine > 0u ? mine : 1u; nx = cnt > 0u ? cnt : 1u;
}

__device__ __forceinline__ void xcd_barrier_complete_w(unsigned* bar, unsigned x, unsigned& nloc, unsigned& nx) {
    const unsigned G = gridDim.x * gridDim.y * gridDim.z, lane = threadIdx.x & 63u;
    unsigned cnt, mine, sp = 0u;
    for (;;) {
        const unsigned c = lane < 16u ? xb_ld(&bar[XB_XCNT(lane)]) : 0u;
        unsigned sum = c;
#pragma unroll
        for (int o = 1; o < 64; o <<= 1) sum += (unsigned)__shfl_xor((int)sum, o);
        cnt = (unsigned)__popcll(__ballot(c > 0u)); mine = (unsigned)__shfl((int)c, (int)x);
        if (sum == G) break;
        __builtin_amdgcn_s_sleep(1);
        if ((++sp & 255u) == 0u) { if (xb_ld(&bar[XB_TMO])) break; if (sp > XB_SPIN_CAP) { if (lane == 0u) atomicAdd(&bar[XB_TMO], 1u); break; } }
    }
    nloc = mine > 0u ? mine : 1u; nx = cnt > 0u ? cnt : 1u;
}

__device__ __forceinline__ void xcd_barrier(const XcdBarrier& b) {
    asm volatile("s_waitcnt vmcnt(0)" ::: "memory");
    __syncthreads();
    if (threadIdx.x == 0) {
        unsigned* bar = b.bar;
        __builtin_amdgcn_s_waitcnt(0);
        unsigned nloc = b.st[0], nx = b.st[1];
        if (nloc == 0u) { xcd_barrier_complete(bar, b.x, nloc, nx); b.st[0] = nloc; b.st[1] = nx; }
        const unsigned old = xb_add(&bar[XB_XSUB(b.x)], 1u);
        const unsigned gen = old / nloc;
        if (old + 1u == (gen + 1u) * nloc) {
            __builtin_amdgcn_fence(__ATOMIC_RELEASE, "agent");
            asm volatile("s_waitcnt vmcnt(0)" ::: "memory");
            const unsigned og = xb_add(&bar[XB_TOP], 1u);
            const unsigned tg = og / nx;
            if (og + 1u == (tg + 1u) * nx) xb_add(&bar[XB_TOPGEN], 1u);
            else XB_SPIN(xb_ld(&bar[XB_TOPGEN]) == tg, bar);
            __builtin_amdgcn_fence(__ATOMIC_ACQUIRE, "agent");
            xb_add(&bar[XB_XGEN(b.x)], 1u);
            asm volatile("s_waitcnt vmcnt(0)" ::: "memory");
        } else {
            XB_SPIN(xb_ld(&bar[XB_XGEN(b.x)]) == gen, bar);
            __builtin_amdgcn_fence(__ATOMIC_ACQUIRE, "agent");
            asm volatile("s_waitcnt vmcnt(0)" ::: "memory");
        }
    }
    __syncthreads();
}


constexpr int LDS_BYTES = 65536;

__global__ void __launch_bounds__(256, 2) k_mega(P p) {
    extern __shared__ __attribute__((aligned(16))) char lds[];
    cg::grid_group grid = cg::this_grid();
    volatile LAS unsigned* bst = (volatile LAS unsigned*)((LAS char*)lds + LDS_BYTES - 16);
    if (threadIdx.x < 4) bst[threadIdx.x] = 0u;
    __syncthreads();
    XcdBarrier gbar = xcd_barrier_post((unsigned*)(p.ws + WS_BAR), bst);
    if (threadIdx.x < 64) {
        unsigned nl, nxx; xcd_barrier_complete_w(gbar.bar, gbar.x, nl, nxx);
        if (threadIdx.x == 0) { gbar.st[0] = nl; gbar.st[1] = nxx; }
    }
    if (p.ws == nullptr) grid.sync();
#define GSYNC() xcd_barrier(gbar)
#ifndef PROBE_MASK
#define PROBE_MASK 0
#endif
#ifndef PROBE_MULT
#define PROBE_MULT 4
#endif
#ifndef PROBE_BLK
#define PROBE_BLK 0
#endif
    unsigned long long tacc = 0, tprev = 0;
#define PH_BEGIN() do { if (PROBE_MASK) tprev = wall_clock64(); } while (0)
#define PH_END(ph) do { if (PROBE_MASK & (1 << (ph))) tacc += wall_clock64() - tprev; } while (0)
#pragma unroll
    for (int l = 0; l < 2; ++l) {
        PH_BEGIN(); phase_norm1(p, l, lds); GSYNC(); PH_END(0);
        PH_BEGIN(); phase_inproj(p, l, lds); GSYNC(); PH_END(1);
        PH_BEGIN(); phase_qkprep(p, l, lds, tacc); GSYNC(); PH_END(2);
        PH_BEGIN(); phase_mix(p, l, lds, tacc); GSYNC(); PH_END(3);
        PH_BEGIN(); phase_glu(p, l, lds); GSYNC(); PH_END(4);
        PH_BEGIN(); phase_outproj(p, l, lds); GSYNC(); PH_END(5);
        PH_BEGIN(); phase_norm2(p, l, lds); GSYNC(); phase_assign(p, l, lds); GSYNC(); PH_END(6);
        PH_BEGIN(); phase_moe1(p, l, lds); GSYNC(); PH_END(7);
        PH_BEGIN(); phase_moe2(p, l, lds); GSYNC(); PH_END(8);
    }
    PH_BEGIN(); phase_final(p, lds); PH_END(9);
#ifdef PROBE_SYNCS
    for (int i = 0; i < PROBE_SYNCS; ++i) GSYNC();
#endif
    if ((PROBE_MASK || PROBE_SUB) && blockIdx.x == PROBE_BLK) {
        const unsigned long long t0 = wall_clock64();
        while (wall_clock64() - t0 < (unsigned long long)PROBE_MULT * tacc) __builtin_amdgcn_s_sleep(8);
    }
}

extern "C" void kernel_launch(void* const* d_in, const int* in_sizes, int n_in, void* d_out, int out_size, void* d_ws, size_t ws_size, hipStream_t stream) {
    static int grid = 0;
    if (grid == 0) {
        if (n_in != 31 || out_size != T * DM || ws_size < WS_END) { fprintf(stderr, "kernel_launch: unexpected sizes n_in %d out %d ws %zu\n", n_in, out_size, ws_size); grid = -1; return; }
        int dev = 0, cus = 0, per_cu = 0;
        (void)hipGetDevice(&dev);
        (void)hipDeviceGetAttribute(&cus, hipDeviceAttributeMultiprocessorCount, dev);
        (void)hipFuncSetAttribute((const void*)k_mega, hipFuncAttributeMaxDynamicSharedMemorySize, LDS_BYTES);
        (void)hipOccupancyMaxActiveBlocksPerMultiprocessor(&per_cu, (const void*)k_mega, 256, LDS_BYTES);
        if (per_cu < 1) { fprintf(stderr, "kernel_launch: occupancy query gave %d\n", per_cu); per_cu = 1; }
        if (per_cu > 2) per_cu = 2;
        grid = cus * per_cu;
        fprintf(stderr, "kernel_launch: cus %d per_cu %d grid %d\n", cus, per_cu, grid);
    }
    if (grid < 0) return;
    (void)hipMemsetAsync((char*)d_ws + WS_CTL, 0, 65536, stream);
    P p{};
    for (int i = 0; i < 31; ++i) p.in[i] = (const float*)d_in[i];
    p.out = (float*)d_out; p.ws = (char*)d_ws;
    void* args[] = {&p};
    hipError_t e = hipLaunchCooperativeKernel((const void*)k_mega, dim3(grid), dim3(256), args, LDS_BYTES, stream);
    if (e != hipSuccess) fprintf(stderr, "cooperative launch failed: %s (grid %d)\n", hipGetErrorString(e), grid);
}
```
